# Optimizing an MI355X kernel written in HIP

```python
import math
import jax, jax.numpy as jnp
from jax import lax
import numpy as np

D_MODEL = 2048
BATCH = 4
SEQ = 8192
DEPTH = 2

N_A_LAYERS = DEPTH // 2
N_B_LAYERS = DEPTH - N_A_LAYERS
N_DENSE_LAYERS = (DEPTH + 1) // 2
N_MOE_LAYERS = DEPTH // 2

MIX_WIDTH = D_MODEL
MEM_WIDTH = D_MODEL // 4
MAIN_WIDTH = MIX_WIDTH - MEM_WIDTH
MEM_HEADS = 4
MEM_HEAD_DIM = MEM_WIDTH // MEM_HEADS
N_MEM = 256

CHUNK = 128
SG_GROUP_DIM = 128
SG_GROUPS = MAIN_WIDTH // SG_GROUP_DIM

DIFF_QK_DIM = 128
DIFF_V_DIM = 2 * DIFF_QK_DIM
DIFF_HEADS = MAIN_WIDTH // DIFF_V_DIM
Q_BLOCK = 128

D_FF_DENSE = 5632
N_EXPERTS = 8
TOP_K = 2
D_FF_EXPERT = 7168

ALPHA = (2.0 * DEPTH) ** 0.25
BETA = (8.0 * DEPTH) ** -0.25
LN_EPS = 1e-5

A_IN_COLS = 2 * MAIN_WIDTH + MEM_WIDTH
B_IN_COLS = 2 * DIFF_HEADS * DIFF_QK_DIM + MEM_WIDTH
KV_COLS = 2 * DIFF_HEADS * DIFF_QK_DIM + DIFF_HEADS * DIFF_V_DIM

kernel_name = "yoco_gmlp_diffattn_memxattn_moe_deepnorm"


def layer_norm(x, g, b):
    xf = x.astype(jnp.float32)
    mu = jnp.mean(xf, axis=-1, keepdims=True)
    var = jnp.mean(jnp.square(xf - mu), axis=-1, keepdims=True)
    return ((xf - mu) * lax.rsqrt(var + LN_EPS) * g + b).astype(x.dtype)


def rms_norm(x, g):
    xf = x.astype(jnp.float32)
    return (xf * lax.rsqrt(jnp.mean(jnp.square(xf), axis=-1, keepdims=True) + LN_EPS) * g).astype(x.dtype)


def chunked_spatial_gating(z, vnorm_g, vnorm_b, w_s, b_s):
    bsz, seq, _ = z.shape
    u, v = z[..., :MAIN_WIDTH], z[..., MAIN_WIDTH:]
    v = layer_norm(v, vnorm_g, vnorm_b)
    vc = v.reshape(bsz, seq // CHUNK, CHUNK, SG_GROUPS, SG_GROUP_DIM)
    causal = jnp.tril(jnp.ones((CHUNK, CHUNK), dtype=bool))
    w = jnp.where(causal[None], w_s, jnp.zeros_like(w_s))
    s = jnp.einsum('gts,bnsgd->bntgd', w, vc) + jnp.transpose(b_s)[:, :, None]
    return u * s.reshape(bsz, seq, MAIN_WIDTH)


def diff_attention(q, k, v, lam, lambda_init, subln_g):
    bsz, seq = q.shape[0], q.shape[1]
    nb = seq // Q_BLOCK
    scale = DIFF_QK_DIM ** -0.5
    qb = jnp.moveaxis(q.reshape(bsz, nb, Q_BLOCK, 2, DIFF_HEADS, DIFF_QK_DIM), 1, 0)
    kpos = jnp.arange(seq)

    def one_block(args):
        qi, i = args
        s = jnp.einsum('bqmhd,bkmhd->bmhqk', qi, k).astype(jnp.float32) * scale
        qpos = i * Q_BLOCK + jnp.arange(Q_BLOCK)
        mask = kpos[None, :] <= qpos[:, None]
        s = jnp.where(mask, s, jnp.finfo(jnp.float32).min)
        p = jax.nn.softmax(s, axis=-1)
        a = p[:, 0] - lam * p[:, 1]
        return jnp.einsum('bhqk,bkhd->bqhd', a.astype(v.dtype), v)

    out = lax.map(one_block, (qb, jnp.arange(nb)))
    out = jnp.moveaxis(out, 0, 1).reshape(bsz, seq, DIFF_HEADS, DIFF_V_DIM)
    out = rms_norm(out, subln_g) * (1.0 - lambda_init)
    return out.reshape(bsz, seq, MAIN_WIDTH)


def memory_attention(q_mem, mem, w_mem_kv):
    bsz, seq, _ = q_mem.shape
    kv = mem @ w_mem_kv
    k = kv[..., :MEM_WIDTH].reshape(bsz, -1, MEM_HEADS, MEM_HEAD_DIM)
    v = kv[..., MEM_WIDTH:].reshape(bsz, -1, MEM_HEADS, MEM_HEAD_DIM)
    q = q_mem.reshape(bsz, seq, MEM_HEADS, MEM_HEAD_DIM)
    s = jnp.einsum('bshd,bmhd->bhsm', q, k).astype(jnp.float32) * (MEM_HEAD_DIM ** -0.5)
    p = jax.nn.softmax(s, axis=-1).astype(v.dtype)
    return jnp.einsum('bhsm,bmhd->bshd', p, v).reshape(bsz, seq, MEM_WIDTH)


def swiglu(x, w_gate, w_up, w_down):
    return (jax.nn.silu(x @ w_gate) * (x @ w_up)) @ w_down


def moe_swiglu(x, w_router, w_gate, w_up, w_down):
    bsz, seq, d = x.shape
    xf = x.reshape(-1, d)
    logits = (xf @ w_router).astype(jnp.float32)
    top_v, top_i = lax.top_k(logits, TOP_K)
    top_w = jax.nn.softmax(top_v, axis=-1)
    gates = jnp.sum(jax.nn.one_hot(top_i, N_EXPERTS, dtype=jnp.float32) * top_w[..., None], axis=1)
    gates = gates.astype(x.dtype)
    y = jnp.zeros_like(xf)
    for e in range(N_EXPERTS):
        y = y + gates[:, e:e + 1] * swiglu(xf, w_gate[e], w_up[e], w_down[e])
    return y.reshape(bsz, seq, d)


def setup_inputs(seed: int = 0) -> dict:
    key = jax.random.key(seed)
    ks = jax.random.split(key, 32)
    f32 = jnp.float32
    d = D_MODEL

    def nrm(k, shape, scale):
        return jax.random.normal(k, shape, f32) * scale

    w_mem_kv = jnp.concatenate([
        nrm(ks[4], (DEPTH, d, MEM_WIDTH), d ** -0.5),
        nrm(ks[5], (DEPTH, d, MEM_WIDTH), d ** -0.5 * BETA)], axis=-1)
    shared_w_kv = jnp.concatenate([
        nrm(ks[11], (d, 2 * DIFF_HEADS * DIFF_QK_DIM), d ** -0.5),
        nrm(ks[12], (d, DIFF_HEADS * DIFF_V_DIM), d ** -0.5 * BETA)], axis=-1)
    return {
        "x": nrm(ks[0], (BATCH, SEQ, d), 1.0),
        "mem": nrm(ks[1], (BATCH, N_MEM, d), 1.0),
        "ln_g": 1.0 + nrm(ks[2], (DEPTH, 2, d), 0.02),
        "ln_b": nrm(ks[3], (DEPTH, 2, d), 0.02),
        "w_mix_out": nrm(ks[6], (DEPTH, MIX_WIDTH, d), MIX_WIDTH ** -0.5 * BETA),
        "w_mem_kv": w_mem_kv,
        "a_w_in": nrm(ks[7], (N_A_LAYERS, d, A_IN_COLS), d ** -0.5),
        "a_vnorm_g": 1.0 + nrm(ks[8], (N_A_LAYERS, MAIN_WIDTH), 0.02),
        "a_vnorm_b": nrm(ks[9], (N_A_LAYERS, MAIN_WIDTH), 0.02),
        "a_w_s": nrm(ks[10], (N_A_LAYERS, SG_GROUPS, CHUNK, CHUNK), CHUNK ** -0.5),
        "a_b_s": 1.0 + nrm(ks[13], (N_A_LAYERS, SG_GROUPS, CHUNK), 0.02),
        "shared_w_kv": shared_w_kv,
        "b_w_in": nrm(ks[14], (N_B_LAYERS, d, B_IN_COLS), d ** -0.5),
        "b_lambda_q1": nrm(ks[15], (N_B_LAYERS, DIFF_QK_DIM), 0.1),
        "b_lambda_k1": nrm(ks[16], (N_B_LAYERS, DIFF_QK_DIM), 0.1),
        "b_lambda_q2": nrm(ks[17], (N_B_LAYERS, DIFF_QK_DIM), 0.1),
        "b_lambda_k2": nrm(ks[18], (N_B_LAYERS, DIFF_QK_DIM), 0.1),
        "b_subln_g": 1.0 + nrm(ks[19], (N_B_LAYERS, DIFF_V_DIM), 0.02),
        "ffn_w_gate": nrm(ks[20], (N_DENSE_LAYERS, d, D_FF_DENSE), d ** -0.5),
        "ffn_w_up": nrm(ks[21], (N_DENSE_LAYERS, d, D_FF_DENSE), d ** -0.5 * BETA),
        "ffn_w_down": nrm(ks[22], (N_DENSE_LAYERS, D_FF_DENSE, d), D_FF_DENSE ** -0.5 * BETA),
        "moe_w_router": nrm(ks[23], (N_MOE_LAYERS, d, N_EXPERTS), d ** -0.5),
        "moe_w_gate": nrm(ks[24], (N_MOE_LAYERS, N_EXPERTS, d, D_FF_EXPERT), d ** -0.5),
        "moe_w_up": nrm(ks[25], (N_MOE_LAYERS, N_EXPERTS, d, D_FF_EXPERT), d ** -0.5 * BETA),
        "moe_w_down": nrm(ks[26], (N_MOE_LAYERS, N_EXPERTS, D_FF_EXPERT, d), D_FF_EXPERT ** -0.5 * BETA),
    }


def reference(x, mem, ln_g, ln_b, w_mix_out, w_mem_kv, a_w_in, a_vnorm_g, a_vnorm_b, a_w_s, a_b_s,
              shared_w_kv, b_w_in, b_lambda_q1, b_lambda_k1, b_lambda_q2, b_lambda_k2, b_subln_g,
              ffn_w_gate, ffn_w_up, ffn_w_down, moe_w_router, moe_w_gate, moe_w_up, moe_w_down):
    bsz, seq, _ = x.shape
    qk_cols = 2 * DIFF_HEADS * DIFF_QK_DIM
    k_sh = None
    v_sh = None
    for l in range(DEPTH):
        if l < N_A_LAYERS:
            a = l
            h = x @ a_w_in[a]
            z = jax.nn.gelu(h[..., :2 * MAIN_WIDTH])
            main = chunked_spatial_gating(z, a_vnorm_g[a], a_vnorm_b[a], a_w_s[a], a_b_s[a])
            q_mem = h[..., 2 * MAIN_WIDTH:]
        else:
            bi = l - N_A_LAYERS
            if bi == 0:
                kv = x @ shared_w_kv
                k_sh = kv[..., :qk_cols].reshape(bsz, seq, 2, DIFF_HEADS, DIFF_QK_DIM)
                v_sh = kv[..., qk_cols:].reshape(bsz, seq, DIFF_HEADS, DIFF_V_DIM)
            h = x @ b_w_in[bi]
            q = h[..., :qk_cols].reshape(bsz, seq, 2, DIFF_HEADS, DIFF_QK_DIM)
            lambda_init = 0.8 - 0.6 * math.exp(-0.3 * l)
            lam = (jnp.exp(jnp.sum(b_lambda_q1[bi] * b_lambda_k1[bi]).astype(jnp.float32))
                   - jnp.exp(jnp.sum(b_lambda_q2[bi] * b_lambda_k2[bi]).astype(jnp.float32))
                   + lambda_init)
            main = diff_attention(q, k_sh, v_sh, lam, lambda_init, b_subln_g[bi])
            q_mem = h[..., qk_cols:]
        mem_out = memory_attention(q_mem, mem, w_mem_kv[l])
        mix = jnp.concatenate([main, mem_out], axis=-1) @ w_mix_out[l]
        x = layer_norm(ALPHA * x + mix, ln_g[l, 0], ln_b[l, 0])
        if l % 2 == 0:
            j = l // 2
            f = swiglu(x, ffn_w_gate[j], ffn_w_up[j], ffn_w_down[j])
        else:
            j = l // 2
            f = moe_swiglu(x, moe_w_router[j], moe_w_gate[j], moe_w_up[j], moe_w_down[j])
        x = layer_norm(ALPHA * x + f, ln_g[l, 1], ln_b[l, 1])
    return x
```

```cpp
#include <hip/hip_runtime.h>
#include <hip/hip_bf16.h>
#include <cstdio>
#include <cstdint>

#ifndef MK_DEBUG
#define MK_DEBUG 0
#endif
#ifndef MK_PHMASK
#define MK_PHMASK 0x1ffff
#endif
#ifndef MK_LAST_PHASE
#define MK_LAST_PHASE 18
#endif

__device__ __forceinline__ int mk_lane() { int r; asm volatile("v_mbcnt_lo_u32_b32 %0, -1, 0\n\tv_mbcnt_hi_u32_b32 %0, -1, %0" : "=v"(r)); return r; }
namespace pg8 {
#define PG8_LAS __attribute__((address_space(3)))
typedef unsigned short bf16_t;
typedef short bf16x8 __attribute__((ext_vector_type(8)));
typedef float f32x4 __attribute__((ext_vector_type(4)));
typedef float f32x2 __attribute__((ext_vector_type(2)));
typedef unsigned u32x4 __attribute__((ext_vector_type(4)));
constexpr int BM = 256, BK = 64, HALF = 128, HTB = HALF * BK * 2  , STAGE_BYTES = 8 * HTB, NXCD = 8, WGM = 8;

__host__ __device__ __forceinline__ int lds_byte(int r, int c) { const int st = (r >> 4) * 2 + (c >> 5), rr = r & 15, cc = c & 31, ob = rr * 64 + cc * 2; return st * 1024 + (ob ^ (((ob >> 9) & 1) << 5)); }
__host__ __device__ __forceinline__ void stage_rc(int b, int& R, int& C) { const int st = b / 1024, sb = b % 1024, swz = sb ^ (((sb >> 9) & 1) << 5); R = (st >> 1) * 16 + swz / 64; C = (st & 1) * 32 + (swz % 64) / 2; }
__host__ __device__ __forceinline__ int perm32(int rho) { const int n = rho >> 4, i = rho & 15; return 8 * (i >> 2) + 4 * n + (i & 3); }

struct Unit { int pa, pb, pm, pn; };
struct Gemm { const bf16_t* A; const bf16_t* Bt; int M, N, K; };

__host__ __device__ __forceinline__ void tile_of(int wgid, int nM, int nN, int& pm, int& pn) {
    const int nwg = nM * nN;
    { const int q = nwg / NXCD, r = nwg % NXCD, xcd = wgid % NXCD, off = wgid / NXCD; wgid = (xcd < r ? xcd * (q + 1) : r * (q + 1) + (xcd - r) * q) + off; }
    const int nig = WGM * nN, gid = wgid / nig, fm = gid * WGM, gsz = (nM - fm) < WGM ? (nM - fm) : WGM;
    pm = fm + ((wgid % nig) % gsz); pn = (wgid % nig) / gsz;
}
struct StaticOrder {
    int nM, nN, nwg, G, c;
    __host__ __device__ void init(int M, int N, int G_, int c_) { nM = M / BM; nN = N / BM; nwg = nM * nN; G = G_; c = c_; }
    __host__ __device__ bool next(int i, Unit& u) const {
        const long L = (long)i * G + c; if (L >= nwg) return false;
        int pm, pn; tile_of((int)L, nM, nN, pm, pn); u.pa = pm; u.pb = pn; u.pm = pm; u.pn = pn; return true;
    }
    __device__ __forceinline__ void a_ready(const Unit&) const {}
    __device__ __forceinline__ void done(const Unit&) const {}
};
template <bool A_LOCAL> struct MoeOrder {
    int nM, nN, nwg, G, c, t0; const PG8_LAS int* tstart;
    __device__ bool next(int i, Unit& u) const {
        const long L = (long)i * G + c; if (L >= nwg) return false;
        int pm, pn; tile_of((int)L, nM, nN, pm, pn); const int t = t0 + pm; int e = 0;
#pragma unroll
        for (int j = 1; j < 8; ++j) e += (t >= tstart[j]) ? 1 : 0;
        u.pa = A_LOCAL ? pm : t; u.pm = A_LOCAL ? t : pm; u.pb = e * nN + pn; u.pn = pn; return true;
    }
    __device__ __forceinline__ void a_ready(const Unit&) const {}
    __device__ __forceinline__ void done(const Unit&) const {}
};

__device__ __forceinline__ unsigned cvt_pk_bf16(float lo, float hi) { unsigned r; asm volatile("v_cvt_pk_bf16_f32 %0, %1, %2" : "=v"(r) : "v"(lo), "v"(hi)); return r; }
__device__ __forceinline__ float gelu_tanh(float x) { const float u = x * (1.0f + 0.044715f * x * x); const float e = __builtin_amdgcn_exp2f(-2.302208198f * u); return x * __builtin_amdgcn_rcpf(1.0f + e); }
__device__ __forceinline__ float silu_f(float x) { const float e = __builtin_amdgcn_exp2f(-1.4426950409f * x); return x * __builtin_amdgcn_rcpf(1.0f + e); }

struct EpiBf16 {
    static constexpr bool PERM = true, AFTER_DRAIN = false;
    bf16_t* O; int ldc; int gelu_cols;
    __device__ __forceinline__ void operator()(const f32x4 (&acc)[2][2][4][2], const Unit& u, int wr, int wc, int fr, int fq) const {
        const int row0 = u.pm * BM + wr * 64 + fr, col0 = u.pn * BM + wc * 32 + 8 * fq; const bool act = (u.pn * BM) < gelu_cols;
#pragma unroll
        for (int ai = 0; ai < 2; ++ai)
#pragma unroll
            for (int m = 0; m < 4; ++m) { bf16_t* rowp = O + (size_t)(row0 + ai * HALF + m * 16) * ldc + col0;
#pragma unroll
                for (int bj = 0; bj < 2; ++bj) { f32x4 v0 = acc[ai][bj][m][0], v1 = acc[ai][bj][m][1];
                    if (act) {
#pragma unroll
                        for (int j = 0; j < 4; ++j) { v0[j] = gelu_tanh(v0[j]); v1[j] = gelu_tanh(v1[j]); } }
                    u32x4 w; w.x = cvt_pk_bf16(v0[0], v0[1]); w.y = cvt_pk_bf16(v0[2], v0[3]); w.z = cvt_pk_bf16(v1[0], v1[1]); w.w = cvt_pk_bf16(v1[2], v1[3]);
                    *(u32x4*)(rowp + bj * HALF) = w; } }
    }
};
struct EpiRes {
    static constexpr bool PERM = false, AFTER_DRAIN = false;
    const float* base; float* out; int ldc; float alpha;
    __device__ __forceinline__ void operator()(const f32x4 (&acc)[2][2][4][2], const Unit& u, int wr, int wc, int fr, int fq) const {
        const int row0 = u.pm * BM + wr * 64 + fr, col0 = u.pn * BM + wc * 32 + 4 * fq;
#pragma unroll
        for (int ai = 0; ai < 2; ++ai)
#pragma unroll
            for (int m = 0; m < 4; ++m) { const size_t off = (size_t)(row0 + ai * HALF + m * 16) * ldc + col0;
                f32x4 b[2][2];
#pragma unroll
                for (int bj = 0; bj < 2; ++bj)
#pragma unroll
                    for (int n = 0; n < 2; ++n) b[bj][n] = *(const f32x4*)(base + off + bj * HALF + n * 16);
#pragma unroll
                for (int bj = 0; bj < 2; ++bj)
#pragma unroll
                    for (int n = 0; n < 2; ++n) *(f32x4*)(out + off + bj * HALF + n * 16) = b[bj][n] * alpha + acc[ai][bj][m][n];
                asm volatile("" ::: "memory"); }
    }
};
struct EpiSwiglu {
    static constexpr bool PERM = true, AFTER_DRAIN = false;
    bf16_t* H; int ldh;
    __device__ __forceinline__ void operator()(const f32x4 (&acc)[2][2][4][2], const Unit& u, int wr, int wc, int fr, int fq) const {
        const int row0 = u.pm * BM + wr * 64 + fr, col0 = u.pn * HALF + wc * 32 + 8 * fq;
#pragma unroll
        for (int ai = 0; ai < 2; ++ai)
#pragma unroll
            for (int m = 0; m < 4; ++m) { bf16_t* rowp = H + (size_t)(row0 + ai * HALF + m * 16) * ldh + col0;
                f32x4 v0, v1;
#pragma unroll
                for (int j = 0; j < 4; ++j) { v0[j] = silu_f(acc[ai][0][m][0][j]) * acc[ai][1][m][0][j]; v1[j] = silu_f(acc[ai][0][m][1][j]) * acc[ai][1][m][1][j]; }
                u32x4 w; w.x = cvt_pk_bf16(v0[0], v0[1]); w.y = cvt_pk_bf16(v0[2], v0[3]); w.z = cvt_pk_bf16(v1[0], v1[1]); w.w = cvt_pk_bf16(v1[2], v1[3]);
                *(u32x4*)rowp = w; }
    }
};
struct EpiRowScale {
    static constexpr bool PERM = true, AFTER_DRAIN = false;
    bf16_t* O; int ldc; const float* rs;
    __device__ __forceinline__ void operator()(const f32x4 (&acc)[2][2][4][2], const Unit& u, int wr, int wc, int fr, int fq) const {
        const int row0 = u.pm * BM + wr * 64 + fr, col0 = u.pn * BM + wc * 32 + 8 * fq;
#pragma unroll
        for (int ai = 0; ai < 2; ++ai)
#pragma unroll
            for (int m = 0; m < 4; ++m) { const int row = row0 + ai * HALF + m * 16; const float s = rs[row]; bf16_t* rowp = O + (size_t)row * ldc + col0;
#pragma unroll
                for (int bj = 0; bj < 2; ++bj) { const f32x4 v0 = acc[ai][bj][m][0] * s, v1 = acc[ai][bj][m][1] * s;
                    u32x4 w; w.x = cvt_pk_bf16(v0[0], v0[1]); w.y = cvt_pk_bf16(v0[2], v0[3]); w.z = cvt_pk_bf16(v1[0], v1[1]); w.w = cvt_pk_bf16(v1[2], v1[3]);
                    *(u32x4*)(rowp + bj * HALF) = w; } }
    }
};

template <class Epi, class Sched, bool ALIGN_EPI = false, bool SP2 = false>
__device__ __forceinline__ void gemm_phase(PG8_LAS unsigned char* lds, const Gemm g, const Sched& S, const Epi& E, const int mk_wid) {
    const int wid = mk_wid, lane = mk_lane(), tid = wid * 64 + lane, wr = wid >> 2, wc = wid & 3, fr = lane & 15, fq = lane >> 4;
    const int K = g.K, nt = K / BK;
    unsigned voffA[2], voffB[2];
#pragma unroll
    for (int i = 0; i < 2; ++i) { int R, C; stage_rc(tid * 16 + i * 8192, R, C); const int Rb = Epi::PERM ? ((R & ~31) + perm32(R & 31)) : R;
        voffA[i] = (unsigned)(R * K + C) * 2u; voffB[i] = (unsigned)(Rb * K + C) * 2u; }
    const size_t kstep = (size_t)(BK * 2);
    const size_t hstep = (size_t)HALF * K * 2;
    const size_t tstep = 2 * hstep;
    const unsigned ldsw = (unsigned)wid * 1024u;
    const int aoff = lds_byte(wr * 64 + fr, fq * 8), boff = lds_byte(wc * 32 + fr, fq * 8);
#define PG8_SA(b, h) (((b) * 2 + (h)) * HTB)
#define PG8_SB(b, h) ((4 + (b) * 2 + (h)) * HTB)
#define PG8_STAGE(bufoff, gbase, voff) do { _Pragma("unroll") for (int _i = 0; _i < 2; ++_i) \
        __builtin_amdgcn_global_load_lds((const unsigned*)((const char*)(gbase) + (voff)[_i]), (PG8_LAS unsigned*)(lds + (bufoff) + ldsw + _i * 8192), 16, 0, 0); } while (0)
#define PG8_LDA(dst, b, h) do { _Pragma("unroll") for (int m = 0; m < 4; ++m) _Pragma("unroll") for (int k = 0; k < 2; ++k) dst[m][k] = *(const PG8_LAS bf16x8*)(lds + PG8_SA(b, h) + aoff + m * 2048 + k * 1024); } while (0)
#define PG8_LDB(dst, b, h) do { _Pragma("unroll") for (int n = 0; n < 2; ++n) _Pragma("unroll") for (int k = 0; k < 2; ++k) dst[n][k] = *(const PG8_LAS bf16x8*)(lds + PG8_SB(b, h) + boff + n * 2048 + k * 1024); } while (0)
#define PG8_MMA(ai, bj, At, Bt) do { __builtin_amdgcn_s_setprio(1); _Pragma("unroll") for (int m = 0; m < 4; ++m) _Pragma("unroll") for (int n = 0; n < 2; ++n) _Pragma("unroll") for (int k = 0; k < 2; ++k) \
        acc[ai][bj][m][n] = __builtin_amdgcn_mfma_f32_16x16x32_bf16(Bt[n][k], At[m][k], acc[ai][bj][m][n], 0, 0, 0); __builtin_amdgcn_s_setprio(0); } while (0)
#define PG8_WAIT_V(n) asm volatile("s_waitcnt vmcnt(" #n ")" ::: "memory")
#define PG8_WAIT_L(n) asm volatile("s_waitcnt lgkmcnt(" #n ")" ::: "memory")
#define PG8_BAR __builtin_amdgcn_s_barrier()
#define PG8_SCHED __builtin_amdgcn_sched_barrier(0)
    Unit cur, nxt; int ui = 0;
    if (!S.next(0, cur)) return;
    f32x4 acc[2][2][4][2];
#pragma unroll
    for (int a = 0; a < 2; ++a)
#pragma unroll
        for (int b = 0; b < 2; ++b)
#pragma unroll
            for (int m = 0; m < 4; ++m)
#pragma unroll
                for (int n = 0; n < 2; ++n) acc[a][b][m][n] = (f32x4){0.f, 0.f, 0.f, 0.f};
    bf16x8 At[4][2], B0[2][2], B1[2][2];
    const char* cA = (const char*)g.A + (size_t)cur.pa * tstep; const char* cB = (const char*)g.Bt + (size_t)cur.pb * tstep;
    S.a_ready(cur);
    if constexpr (SP2) {
        PG8_STAGE(PG8_SB(0, 0), cB, voffB); PG8_STAGE(PG8_SB(0, 1), cB + hstep, voffB); PG8_STAGE(PG8_SA(0, 0), cA, voffA); PG8_STAGE(PG8_SA(0, 1), cA + hstep, voffA);
        if (wr == 1) PG8_BAR;
        PG8_WAIT_V(2); PG8_BAR;
        PG8_STAGE(PG8_SB(1, 0), cB + kstep, voffB); PG8_STAGE(PG8_SA(1, 0), cA + kstep, voffA); PG8_STAGE(PG8_SB(1, 1), cB + hstep + kstep, voffB);
        PG8_WAIT_V(6); PG8_BAR;
    } else {
        PG8_STAGE(PG8_SB(0, 0), cB, voffB); PG8_STAGE(PG8_SA(0, 0), cA, voffA); PG8_STAGE(PG8_SB(0, 1), cB + hstep, voffB); PG8_STAGE(PG8_SA(0, 1), cA + hstep, voffA);
        if (wr == 1) PG8_BAR;
        PG8_WAIT_V(4); PG8_BAR;
        PG8_STAGE(PG8_SB(1, 0), cB + kstep, voffB); PG8_STAGE(PG8_SA(1, 0), cA + kstep, voffA); PG8_STAGE(PG8_SB(1, 1), cB + hstep + kstep, voffB);
        PG8_WAIT_V(6); PG8_BAR;
    }
    for (;;) {
        const bool has_next = S.next(ui + 1, nxt);
        const char* nA = has_next ? (const char*)g.A + (size_t)nxt.pa * tstep : cA; const char* nB = has_next ? (const char*)g.Bt + (size_t)nxt.pb * tstep : cB;
        for (int t = 0; t < nt; t += 2) {
            const bool last = (t == nt - 2);
            const char* a1 = cA + (size_t)(t + 1) * kstep;
            const char* a2 = last ? nA : cA + (size_t)(t + 2) * kstep; const char* b2 = last ? nB : cB + (size_t)(t + 2) * kstep;
            const char* a3 = a2 + kstep; const char* b3 = b2 + kstep;
            if (last && has_next) S.a_ready(nxt);
            if constexpr (SP2) {
            PG8_LDB(B0, 0, 0); PG8_LDB(B1, 0, 1); PG8_SCHED; PG8_LDA(At, 0, 0); PG8_STAGE(PG8_SA(1, 1), a1 + hstep, voffA);
            PG8_WAIT_V(8); PG8_WAIT_L(0); PG8_BAR; PG8_MMA(0, 0, At, B0); PG8_MMA(0, 1, At, B1); PG8_BAR; PG8_SCHED;
            PG8_LDA(At, 0, 1); PG8_STAGE(PG8_SB(0, 0), b2, voffB); PG8_STAGE(PG8_SB(0, 1), b2 + hstep, voffB); PG8_STAGE(PG8_SA(0, 0), a2, voffA);
            PG8_WAIT_V(8); PG8_WAIT_L(0); PG8_BAR; PG8_MMA(1, 0, At, B0); PG8_MMA(1, 1, At, B1); PG8_BAR; PG8_SCHED;
            PG8_LDB(B0, 1, 0); PG8_LDB(B1, 1, 1); PG8_SCHED; PG8_LDA(At, 1, 0); PG8_STAGE(PG8_SA(0, 1), a2 + hstep, voffA);
            PG8_WAIT_V(8); PG8_WAIT_L(0); PG8_BAR; PG8_MMA(0, 0, At, B0); PG8_MMA(0, 1, At, B1); PG8_BAR; PG8_SCHED;
            PG8_LDA(At, 1, 1); PG8_STAGE(PG8_SB(1, 0), b3, voffB); PG8_STAGE(PG8_SB(1, 1), b3 + hstep, voffB); PG8_STAGE(PG8_SA(1, 0), a3, voffA);
            PG8_WAIT_V(8); PG8_WAIT_L(0); PG8_BAR; PG8_MMA(1, 0, At, B0); PG8_MMA(1, 1, At, B1); PG8_BAR; PG8_SCHED;
            } else {
            PG8_LDB(B0, 0, 0); PG8_SCHED; PG8_LDA(At, 0, 0); PG8_STAGE(PG8_SA(1, 1), a1 + hstep, voffA);
            PG8_WAIT_L(8); PG8_BAR; PG8_WAIT_L(0); PG8_MMA(0, 0, At, B0); PG8_BAR; PG8_SCHED;
            PG8_LDB(B1, 0, 1); PG8_STAGE(PG8_SB(0, 0), b2, voffB);
            PG8_BAR; PG8_WAIT_L(0); PG8_MMA(0, 1, At, B1); PG8_BAR;
            PG8_LDA(At, 0, 1); PG8_STAGE(PG8_SA(0, 0), a2, voffA);
            PG8_BAR; PG8_WAIT_L(0); PG8_MMA(1, 0, At, B0); PG8_BAR; PG8_SCHED;
            PG8_STAGE(PG8_SB(0, 1), b2 + hstep, voffB);
            PG8_WAIT_V(6); PG8_BAR; PG8_MMA(1, 1, At, B1); PG8_BAR;
            PG8_LDB(B0, 1, 0); PG8_SCHED; PG8_LDA(At, 1, 0); PG8_STAGE(PG8_SA(0, 1), a2 + hstep, voffA);
            PG8_WAIT_L(8); PG8_BAR; PG8_WAIT_L(0); PG8_MMA(0, 0, At, B0); PG8_BAR; PG8_SCHED;
            PG8_LDB(B1, 1, 1); PG8_STAGE(PG8_SB(1, 0), b3, voffB);
            PG8_BAR; PG8_WAIT_L(0); PG8_MMA(0, 1, At, B1); PG8_BAR;
            PG8_LDA(At, 1, 1); PG8_STAGE(PG8_SA(1, 0), a3, voffA);
            PG8_BAR; PG8_WAIT_L(0); PG8_MMA(1, 0, At, B0); PG8_BAR; PG8_SCHED;
            PG8_STAGE(PG8_SB(1, 1), b3 + hstep, voffB);
            PG8_WAIT_V(6); PG8_BAR; PG8_MMA(1, 1, At, B1); PG8_BAR;
            }
        }
        if constexpr (ALIGN_EPI) { if (wr == 0) PG8_BAR; }
        if constexpr (!Epi::AFTER_DRAIN) { E(acc, cur, wr, wc, fr, fq); S.done(cur); }
        if (!has_next) break;
#pragma unroll
        for (int a = 0; a < 2; ++a)
#pragma unroll
            for (int b = 0; b < 2; ++b)
#pragma unroll
                for (int m = 0; m < 4; ++m)
#pragma unroll
                    for (int n = 0; n < 2; ++n) acc[a][b][m][n] = (f32x4){0.f, 0.f, 0.f, 0.f};
        cur = nxt; cA = nA; cB = nB; ++ui;
        if constexpr (ALIGN_EPI) { if (wr == 1) PG8_BAR; }
    }
    PG8_WAIT_V(0);
    if constexpr (!ALIGN_EPI) { if (wr == 0) PG8_BAR; }
    PG8_BAR;
    if constexpr (Epi::AFTER_DRAIN) { E.fused(acc, cur, wr, wc, fr, fq, lds, wid, lane); S.done(cur); }
#undef PG8_SA
#undef PG8_SB
#undef PG8_STAGE
#undef PG8_LDA
#undef PG8_LDB
#undef PG8_MMA
#undef PG8_WAIT_V
#undef PG8_WAIT_L
#undef PG8_BAR
#undef PG8_SCHED
}
}

namespace at128 {
constexpr int D = 128;
constexpr float THR = 8.f;
constexpr bool WSKIP = false;
constexpr float SCALE = 0.08838834764831845f;
constexpr int NW = 8, QBLK = 32, KVBLK = 64, QB = NW * QBLK;
constexpr int SHM_V = KVBLK * D * 2, SHM_K = KVBLK * D * 2;
constexpr int LDS_BYTES = 2 * SHM_V + 2 * SHM_K + NW * 64 * 4;

using bf16 = __hip_bfloat16;
typedef short bf16x8 __attribute__((ext_vector_type(8)));
typedef short s16x4 __attribute__((ext_vector_type(4)));
typedef float f32x16 __attribute__((ext_vector_type(16)));
typedef float f32x4 __attribute__((ext_vector_type(4)));
typedef unsigned u32x4 __attribute__((ext_vector_type(4)));
template <class A, class Bt> struct same_t { static constexpr bool v = false; };
template <class A> struct same_t<A, A> { static constexpr bool v = true; };

#define KSWZ(row, colB) ((row) * 256 + ((colB) ^ (((row) & 7) << 4)))
#define SBAR() __builtin_amdgcn_sched_barrier(0)
__device__ __forceinline__ int v_st(int k, int c) { const int kk = (k & ~0xC) | ((k & 4) << 1) | ((k & 8) >> 1); return ((kk >> 3) * 4 + (c >> 5)) * 512 + ((kk & 7) * 32 + (c & 31)) * 2; }
__device__ __forceinline__ int v_rd_base(int lane) { return ((lane & 3) << 3) | (((lane >> 2) & 3) << 6) | (((lane >> 4) & 1) << 5) | (((lane >> 5) & 1) << 8); }
constexpr int v_rd_off(int d0, int ks, int half) { return d0 * 512 + ks * 4096 + half * 2048; }
__device__ __forceinline__ int crow(int r, int hi) { return (r & 3) + 8 * (r >> 2) + 4 * hi; }
__device__ __forceinline__ unsigned cvtpk(float lo, float hi) {
    unsigned r; asm volatile("v_cvt_pk_bf16_f32 %0, %1, %2" : "=v"(r) : "v"(lo), "v"(hi)); return r;
}
__device__ __forceinline__ bf16x8 pack8(f32x4 a, f32x4 b) {
    u32x4 w = {cvtpk(a[0], a[1]), cvtpk(a[2], a[3]), cvtpk(b[0], b[1]), cvtpk(b[2], b[3])};
    return *reinterpret_cast<bf16x8*>(&w);
}
template <class T> __device__ __forceinline__ bf16x8 load8(const T* p) {
    if constexpr (same_t<T, float>::v) { return pack8(*(const f32x4*)p, *(const f32x4*)(p + 4)); }
    else { return *reinterpret_cast<const bf16x8*>(p); }
}
__device__ __forceinline__ void mask_tile(f32x16& p0, f32x16& p1, int dq, unsigned W) {
    const float NEG = -__builtin_inff();
#pragma unroll
    for (int r = 0; r < 16; ++r) {
        const int c = (r & 3) + 8 * (r >> 2);
        if ((unsigned)(dq - c) >= W) p0[r] = NEG;
        if ((unsigned)(dq - c - 32) >= W) p1[r] = NEG;
    }
}
__device__ __forceinline__ void partialSM(f32x16& p0, f32x16& p1, float& m_reg, float& mn, float& alpha) {
    float pmax = p0[0]; for (int r = 1; r < 16; ++r) pmax = fmaxf(pmax, p0[r]); for (int r = 0; r < 16; ++r) pmax = fmaxf(pmax, p1[r]);
    { auto rr = __builtin_amdgcn_permlane32_swap(__float_as_uint(pmax), __float_as_uint(pmax), false, false);
      pmax = fmaxf(__uint_as_float(rr[0]), __uint_as_float(rr[1])); }
    constexpr float C2 = 1.4426950408889634f * SCALE;
    if (__builtin_expect(__all((pmax - m_reg) * SCALE <= THR), 1)) { mn = m_reg; alpha = 1.f; }
    else { mn = fmaxf(m_reg, pmax); alpha = __builtin_amdgcn_exp2f((m_reg - mn) * C2); m_reg = mn; }
    const float mnL = -mn * C2;
    for (int r = 0; r < 16; ++r) p0[r] = fmaf(p0[r], C2, mnL); for (int r = 0; r < 16; ++r) p1[r] = fmaf(p1[r], C2, mnL);
    for (int r = 0; r < 16; ++r) p0[r] = __builtin_amdgcn_exp2f(p0[r]);
}
__device__ __forceinline__ void finishSM(f32x16& p0, f32x16& p1, float alpha, float& l_reg, bf16x8& pa0, bf16x8& pa1, bf16x8& pa2, bf16x8& pa3) {
    for (int r = 0; r < 16; ++r) p1[r] = __builtin_amdgcn_exp2f(p1[r]);
    float ps = 0; for (int r = 0; r < 16; ++r) ps += p0[r]; for (int r = 0; r < 16; ++r) ps += p1[r];
    { auto rr = __builtin_amdgcn_permlane32_swap(__float_as_uint(ps), __float_as_uint(ps), false, false);
      ps = __uint_as_float(rr[0]) + __uint_as_float(rr[1]); }
    l_reg = l_reg * alpha + ps;
#define PK4(P, B_, OUT) do { unsigned a0 = cvtpk(P[B_+0], P[B_+1]), a1 = cvtpk(P[B_+2], P[B_+3]);                          \
        unsigned b0 = cvtpk(P[B_+4], P[B_+5]), b1 = cvtpk(P[B_+6], P[B_+7]);                                             \
        auto r0 = __builtin_amdgcn_permlane32_swap(a0, b0, false, false); auto r1 = __builtin_amdgcn_permlane32_swap(a1, b1, false, false); \
        u32x4 w = {r0[0], r1[0], r0[1], r1[1]}; OUT = *reinterpret_cast<bf16x8*>(&w); } while (0)
    PK4(p0, 0, pa0); PK4(p0, 8, pa1); PK4(p1, 0, pa2); PK4(p1, 8, pa3);
#undef PK4
}
template <int KB, bool SK>
__device__ __forceinline__ void qkt(f32x16& p0, f32x16& p1, const char* K_lds, int r32, int hi, const bf16x8* qr, bool act) {
    if (SK && !act) { const float NEG = -__builtin_inff();
#pragma unroll
        for (int r = 0; r < 16; ++r) { p0[r] = NEG; p1[r] = NEG; } return; }
    p0 = f32x16{}; p1 = f32x16{};
    const char* kb[4];
#pragma unroll
    for (int dd = 0; dd < 4; ++dd) kb[dd] = K_lds + KB * SHM_K + KSWZ(r32, (dd * 16 + hi * 8) * 2);
#pragma unroll
    for (int d0 = 0; d0 < 8; ++d0) { const char* a = kb[d0 & 3] + (d0 >> 2) * 128;
        bf16x8 b0 = *reinterpret_cast<const bf16x8*>(a);
        bf16x8 b1 = *reinterpret_cast<const bf16x8*>(a + 32 * 256);
        p0 = __builtin_amdgcn_mfma_f32_32x32x16_bf16(b0, qr[d0], p0, 0, 0, 0);
        p1 = __builtin_amdgcn_mfma_f32_32x32x16_bf16(b1, qr[d0], p1, 0, 0, 0); }
}
template <int VB, bool SK>
__device__ __forceinline__ void pv_tile(f32x16* o, int vb0, bf16x8 pa0, bf16x8 pa1, bf16x8 pa2, bf16x8 pa3, bool act) {
    if (SK && !act) return;
#define TRRD(dst, off) asm volatile("ds_read_b64_tr_b16 %0, %1 offset:%2" : "=&v"(dst) : "v"(vb0), "i"(off) : "memory")
#define PV_D0(d0) do { s16x4 l0, l1, l2, l3, h0, h1, h2, h3; constexpr int b_ = VB * SHM_V + v_rd_off(d0, 0, 0);     \
        TRRD(l0, b_); TRRD(h0, b_ + 2048); TRRD(l1, b_ + 4096); TRRD(h1, b_ + 6144); TRRD(l2, b_ + 8192); TRRD(h2, b_ + 10240); TRRD(l3, b_ + 12288); TRRD(h3, b_ + 14336); \
        asm volatile("s_waitcnt lgkmcnt(0)" ::: "memory"); SBAR();                 \
        o[d0] = __builtin_amdgcn_mfma_f32_32x32x16_bf16(pa0, (bf16x8){l0[0], l0[1], l0[2], l0[3], h0[0], h0[1], h0[2], h0[3]}, o[d0], 0, 0, 0);   \
        o[d0] = __builtin_amdgcn_mfma_f32_32x32x16_bf16(pa1, (bf16x8){l1[0], l1[1], l1[2], l1[3], h1[0], h1[1], h1[2], h1[3]}, o[d0], 0, 0, 0);   \
        o[d0] = __builtin_amdgcn_mfma_f32_32x32x16_bf16(pa2, (bf16x8){l2[0], l2[1], l2[2], l2[3], h2[0], h2[1], h2[2], h2[3]}, o[d0], 0, 0, 0);   \
        o[d0] = __builtin_amdgcn_mfma_f32_32x32x16_bf16(pa3, (bf16x8){l3[0], l3[1], l3[2], l3[3], h3[0], h3[1], h3[2], h3[3]}, o[d0], 0, 0, 0); } while (0)
    PV_D0(0); PV_D0(1); PV_D0(2); PV_D0(3);
#undef PV_D0
#undef TRRD
}

template <class TIn, class TOut> struct BlockRef { const TIn* Q; const TIn* K; const TIn* V; TOut* O; int P0; };
template <class TIn> struct Seam {
    bf16x8 qr[8];
    bf16x8 st_v0, st_v1, st_k0, st_k1; f32x4 sf0, sf1, sf2, sf3;
    f32x4 tq[16];
};
__device__ __forceinline__ int swa_jlo(int P0, int W) { const int lowk = P0 - W + 1; return lowk > 0 ? lowk / KVBLK : 0; }
#define ROW(p, k0, rr) ((p) + (size_t)((k0) + (rr)) * PKV + sc)
#define VMW() asm volatile("s_waitcnt vmcnt(0)" ::: "memory")
#define VMWN(n) asm volatile("s_waitcnt vmcnt(%0)" :: "i"(n) : "memory")
#define SLOAD_H(Kp, Vp, k0) do { S.st_v0 = load8<TIn>(ROW(Vp, k0, sr)); S.st_v1 = load8<TIn>(ROW(Vp, k0, 32 + sr));              \
                         S.st_k0 = load8<TIn>(ROW(Kp, k0, sr)); S.st_k1 = load8<TIn>(ROW(Kp, k0, 32 + sr)); } while (0)
#define SWRITE_HK(bf) do { *(bf16x8*)(K_lds + (bf) * SHM_K + kws) = S.st_k0; *(bf16x8*)(K_lds + (bf) * SHM_K + kws + 32 * 256) = S.st_k1; } while (0)
#define SWRITE_HV(bf) do { *(bf16x8*)(V_lds + (bf) * SHM_V + vst0) = S.st_v0; *(bf16x8*)(V_lds + (bf) * SHM_V + vst1) = S.st_v1; } while (0)
#define SWRITE_H(bf) do { SWRITE_HV(bf); SWRITE_HK(bf); } while (0)
#define SLOAD_F(p, k0) do { S.sf0 = *(const f32x4*)ROW(p, k0, sr); S.sf1 = *(const f32x4*)(ROW(p, k0, sr) + 4);                \
                            S.sf2 = *(const f32x4*)ROW(p, k0, 32 + sr); S.sf3 = *(const f32x4*)(ROW(p, k0, 32 + sr) + 4); } while (0)
#define SWRITE_KF(bf) do { *(bf16x8*)(K_lds + (bf) * SHM_K + kws) = pack8(S.sf0, S.sf1); *(bf16x8*)(K_lds + (bf) * SHM_K + kws + 32 * 256) = pack8(S.sf2, S.sf3); } while (0)
#define SWRITE_VF(bf) do { *(bf16x8*)(V_lds + (bf) * SHM_V + vst0) = pack8(S.sf0, S.sf1); *(bf16x8*)(V_lds + (bf) * SHM_V + vst1) = pack8(S.sf2, S.sf3); } while (0)
template <class TIn, class TOut, int PQ, int PKV, int PO>
__device__ __forceinline__ void causal_swa_prime(const BlockRef<TIn, TOut>& cur, int W, char* lds, Seam<TIn>& S, const int mk_wid) {
    constexpr bool F32 = same_t<TIn, float>::v;
    const int wid = mk_wid, lane = mk_lane(), tid = wid * 64 + lane, r32 = lane & 31, hi = lane >> 5;
    const int sr = tid >> 4, sc = (tid & 15) * 8, kws = KSWZ(sr, sc * 2); char* K_lds = lds + 2 * SHM_V;
    const int kb0 = swa_jlo(cur.P0, W) * KVBLK;
    for (int d0 = 0; d0 < 8; ++d0) S.qr[d0] = load8<TIn>(cur.Q + (size_t)(wid * QBLK + r32) * PQ + d0 * 16 + hi * 8);
    if constexpr (F32) { SLOAD_F((const float*)cur.K, kb0); VMW(); SWRITE_KF(0); SBAR(); SLOAD_F((const float*)cur.V, kb0); }
    else { SLOAD_H(cur.K, cur.V, kb0); VMW(); SWRITE_HK(0); }
    __syncthreads();
}
template <class TIn, class TOut, int PQ, int PKV, int PO>
__device__ __forceinline__ void causal_swa_block(const BlockRef<TIn, TOut>& cur, const BlockRef<TIn, TOut>& nxt, int skv, int W, char* lds, Seam<TIn>& S, const int mk_wid) {
    constexpr bool F32 = same_t<TIn, float>::v;
    const int wid = mk_wid, lane = mk_lane(), tid = wid * 64 + lane, r32 = lane & 31, hi = lane >> 5;
    const int j_lo = swa_jlo(cur.P0, W);
    int j_hi = (cur.P0 + QB - 1) / KVBLK + 1; if (j_hi > skv / KVBLK) j_hi = skv / KVBLK;
    const int NT = j_hi - j_lo;
    const int kbn = swa_jlo(nxt.P0, W) * KVBLK;
    const int qlo = cur.P0 + wid * QBLK, qm = qlo + r32 - 4 * hi;
    char* V_lds = lds; char* K_lds = lds + 2 * SHM_V;
    float* ws = (float*)(lds + 2 * SHM_V + 2 * SHM_K) + wid * 64; float* li_l = ws, * al_l = ws + 32;
    float m_reg = -1e30f, l_reg = 0; f32x16 o[4] = {};
    const int sr = tid >> 4, sc = (tid & 15) * 8, vst0 = v_st(sr, sc), vst1 = v_st(32 + sr, sc), kws = KSWZ(sr, sc * 2);
    const int vb0 = (int)(uintptr_t)V_lds + v_rd_base(lane);
    const TIn* Kh = cur.K; const TIn* Vh = cur.V;
#define RESC(a) do { if (__any((a) < 1.f)) { if (hi == 0) al_l[r32] = (a); asm volatile("s_waitcnt lgkmcnt(0)" ::: "memory");              \
                     for (int d_ = 0; d_ < 4; ++d_) for (int r = 0; r < 16; ++r) o[d_][r] *= al_l[crow(r, hi)]; } } while (0)
#define KBASE(t) ((j_lo + (t)) * KVBLK)
#define ACT(t) (KBASE(t) <= qlo + QBLK - 1 && KBASE(t) + KVBLK - 1 >= qlo - W + 1)
#define MASKT(P0_, P1_, t) do { const int kb_ = KBASE(t); if ((!SK || ACT(t)) && (kb_ + KVBLK - 1 > qlo || kb_ <= qlo + QBLK - 1 - W)) mask_tile(P0_, P1_, qm - kb_, (unsigned)W); } while (0)
    constexpr int NQL = F32 ? 16 : 8;
    constexpr bool SK = WSKIP && !F32;
#define SEAM_K0() do { VMWN(NQL); if constexpr (F32) { SWRITE_KF(0); SBAR(); SLOAD_F((const float*)nxt.V, kbn); } else { SWRITE_HK(0); } SBAR(); } while (0)
    f32x16 pA0, pA1, pB0, pB1; float mnA, mnB, alA, alB; bf16x8 pa0, pa1, pa2, pa3;
    if constexpr (F32) { VMW(); SWRITE_VF(0); SBAR(); } else { SWRITE_HV(0); SBAR(); }
    if (NT > 1) { if constexpr (F32) SLOAD_F((const float*)Kh, KBASE(1)); else SLOAD_H(Kh, Vh, KBASE(1)); }
    SBAR(); qkt<0, SK>(pA0, pA1, K_lds, r32, hi, S.qr, ACT(0));
    if constexpr (F32) { if (NT > 1) { VMW(); SWRITE_KF(1); SBAR(); SLOAD_F((const float*)Vh, KBASE(1)); } }
    MASKT(pA0, pA1, 0); partialSM(pA0, pA1, m_reg, mnA, alA);
    if (NT > 1) { VMW(); if constexpr (F32) { SWRITE_VF(1); SBAR(); if (NT > 2) SLOAD_F((const float*)Kh, KBASE(2)); } else SWRITE_H(1); }
    __syncthreads();
#define HALF_STEP(PX0, PX1, mnX, alX, PY0, PY1, alY, t, KB, VB, SB) do {                                                      \
        SBAR(); qkt<KB, SK>(PX0, PX1, K_lds, r32, hi, S.qr, ACT(t));                                             \
        finishSM(PY0, PY1, alY, l_reg, pa0, pa1, pa2, pa3); SBAR();                                                           \
        if ((t) + 1 < NT) { if constexpr (F32) { VMW(); SWRITE_KF(SB); SBAR(); SLOAD_F((const float*)Vh, KBASE((t) + 1)); }  \
                            else { SLOAD_H(Kh, Vh, KBASE((t) + 1)); } SBAR(); }                                               \
        pv_tile<VB, SK>(o, vb0, pa0, pa1, pa2, pa3, ACT((t) - 1)); MASKT(PX0, PX1, (t)); partialSM(PX0, PX1, m_reg, mnX, alX);                                        \
        __syncthreads();                                                                                                      \
        if ((t) + 1 < NT) { VMW(); if constexpr (F32) { SWRITE_VF(SB); SBAR(); if ((t) + 2 < NT) SLOAD_F((const float*)Kh, KBASE((t) + 2)); } \
                            else { SWRITE_H(SB); } }                                                                          \
        RESC(alX); __syncthreads(); } while (0)
    for (int t = 1; t + 1 < NT; t += 2) {
        HALF_STEP(pB0, pB1, mnB, alB, pA0, pA1, alA, t, 1, 0, 0);
        HALF_STEP(pA0, pA1, mnA, alA, pB0, pB1, alB, t + 1, 0, 1, 1);
    }
    const bool even = (NT & 1) == 0;
    if (even) { SBAR(); qkt<1, SK>(pB0, pB1, K_lds, r32, hi, S.qr, ACT(NT - 1)); SBAR(); }
#define QROW(e) (nxt.Q + (size_t)(wid * QBLK + r32) * PQ + ((e) >> 1) * 16 + hi * 8 + ((e) & 1) * 4)
    if constexpr (F32) { SLOAD_F((const float*)nxt.K, kbn); SBAR();
#pragma unroll
        for (int e = 0; e < 8; ++e) S.tq[e] = *(const f32x4*)QROW(e); }
    else { SLOAD_H(nxt.K, nxt.V, kbn); SBAR();
#pragma unroll
        for (int d0 = 0; d0 < 8; ++d0) S.qr[d0] = load8<TIn>(nxt.Q + (size_t)(wid * QBLK + r32) * PQ + d0 * 16 + hi * 8); }
    SBAR();
    finishSM(pA0, pA1, alA, l_reg, pa0, pa1, pa2, pa3); SBAR();
    if constexpr (F32) {
#pragma unroll
        for (int e = 8; e < 16; ++e) S.tq[e] = *(const f32x4*)QROW(e); SBAR(); }
#undef QROW
    pv_tile<0, SK>(o, vb0, pa0, pa1, pa2, pa3, ACT(even ? NT - 2 : NT - 1));
    if (even) { MASKT(pB0, pB1, NT - 1); partialSM(pB0, pB1, m_reg, mnB, alB); __syncthreads(); RESC(alB);
        finishSM(pB0, pB1, alB, l_reg, pa0, pa1, pa2, pa3); SBAR(); pv_tile<1, SK>(o, vb0, pa0, pa1, pa2, pa3, ACT(NT - 1)); }
    SBAR(); SEAM_K0();
    if (hi == 0) li_l[r32] = l_reg; asm volatile("s_waitcnt lgkmcnt(0)" ::: "memory");
    float rli[16];
#pragma unroll
    for (int r = 0; r < 16; ++r) rli[r] = __builtin_amdgcn_rcpf(li_l[crow(r, hi)]);
    TOut* Ow = cur.O + (size_t)(wid * QBLK) * PO;
#pragma unroll
    for (int r = 0; r < 16; ++r) { const int orow = crow(r, hi);
#pragma unroll
        for (int d0 = 0; d0 < 4; ++d0) { const float v = o[d0][r] * rli[r];
            if constexpr (same_t<TOut, float>::v) { Ow[(size_t)orow * PO + d0 * 32 + r32] = v; }
            else { const float vn = __shfl_xor(v, 1);
                   if ((r32 & 1) == 0) *(unsigned*)(Ow + (size_t)orow * PO + d0 * 32 + r32) = cvtpk(v, vn); } } }
    if constexpr (F32) {
#pragma unroll
        for (int d0 = 0; d0 < 8; ++d0) S.qr[d0] = pack8(S.tq[2 * d0], S.tq[2 * d0 + 1]); }
    __syncthreads();
#undef RESC
#undef KBASE
#undef ACT
#undef MASKT
#undef SEAM_K0
#undef HALF_STEP
}
#undef ROW
#undef VMW
#undef VMWN
#undef SLOAD_H
#undef SWRITE_HK
#undef SWRITE_HV
#undef SWRITE_H
#undef SLOAD_F
#undef SWRITE_KF
#undef SWRITE_VF

}

constexpr int NWAVES = 8;
constexpr int NTOK = 32768, DM = 2048, SEQ = 8192, NBATCH = 4;
constexpr int MAINW = 1536, MEMW = 512, NMEM = 256;
constexpr int A_IN = 3584;
constexpr int B_IN = 5120;
constexpr int FF = 5632, FFE = 7168, NEXP = 8;
constexpr int NSG = 12;
constexpr float ALPHA = 1.41421356237309515f;
constexpr float LN_EPS = 1e-5f;
constexpr float LAMBDA_INIT = 0.355509067592f;
constexpr int MAXT = 264;
constexpr int MOE_CHUNK_T = 132;
constexpr int NPHASE = 19;

constexpr size_t MiB = 1u << 20;
constexpr size_t WS_CTL = 0, CTL_ZERO_BYTES = 1 * MiB;
constexpr size_t WS_WSBF = 1 * MiB;
constexpr size_t WS_MEMB = 2 * MiB;
constexpr size_t WS_MEMKV = 6 * MiB;
constexpr size_t WS_ROUTE_E = 10 * MiB;
constexpr size_t WS_ROUTE_W = 10 * MiB + 256 * 1024;
constexpr size_t WS_TOKSLOT = 10 * MiB + 512 * 1024;
constexpr size_t WS_SLOTGATE = 11 * MiB;
constexpr size_t WS_SLOTTOK = 11 * MiB + 512 * 1024;
constexpr size_t WS_HIST = 12 * MiB;
constexpr size_t WS_MOETAB = 12 * MiB + 256 * 1024;
constexpr size_t WS_W_MOE_GU = 16 * MiB;
constexpr size_t WS_W_MOE_D = 464 * MiB;
constexpr size_t WS_W_A_IN = 688 * MiB;
constexpr size_t WS_W_MIX = 702 * MiB;
constexpr size_t WS_W_FFN_GU = 718 * MiB;
constexpr size_t WS_W_FFN_D = 762 * MiB;
constexpr size_t WS_W_B_IN = 784 * MiB;
constexpr size_t WS_W_MEMKV = 804 * MiB;
constexpr size_t WS_XB = 812 * MiB;
constexpr size_t WS_H0 = 940 * MiB;
constexpr size_t WS_CONCAT = 1164 * MiB;
constexpr size_t WS_HID = 940 * MiB;
constexpr size_t WS_H1 = 940 * MiB;
constexpr size_t WS_AO = 1260 * MiB;
constexpr size_t WS_CONCAT1 = 1452 * MiB;
constexpr size_t WS_X3B = 1580 * MiB;
constexpr size_t WS_XS = 812 * MiB;
constexpr size_t WS_OS = 1076 * MiB;
constexpr size_t WS_HIDM = 1340 * MiB;
constexpr size_t WS_END = 1802 * MiB;
static_assert(WS_H0 + (size_t)NTOK * A_IN * 2 <= WS_CONCAT && WS_CONCAT + (size_t)NTOK * DM * 2 <= WS_AO + 32 * MiB, "L0 map");
static_assert(WS_HID + (size_t)NTOK * FF * 2 <= 1292 * MiB && WS_H1 + (size_t)NTOK * B_IN * 2 <= WS_AO && WS_AO + (size_t)NTOK * 3072 * 2 <= WS_CONCAT1, "L1 map");
static_assert(WS_CONCAT1 + (size_t)NTOK * DM * 2 <= WS_X3B && WS_X3B + (size_t)NTOK * DM * 2 <= WS_END, "L1 map 2");
static_assert(WS_XS + (size_t)MAXT * 256 * DM * 2 <= WS_OS && WS_OS + (size_t)MAXT * 256 * DM * 2 <= WS_HIDM && WS_HIDM + (size_t)MOE_CHUNK_T * 256 * FFE * 2 <= WS_END, "MoE map");
static_assert(WS_XS + (size_t)MAXT * 256 * DM * 2 <= WS_CONCAT1, "XS must not overlap CONCAT1/X3B");
constexpr int CW_TMO = 0, CW_CODE = 1;
constexpr int CW_BAR = 4096;
constexpr int CW_CHK = 8192;

constexpr int RING_OFF = 0, RING_BYTES = 131072;
constexpr int LDSCTL_OFF = RING_BYTES, MISC_OFF = LDSCTL_OFF + 320;
constexpr int LDS_BYTES = 147456;

#define GAS __attribute__((address_space(1)))
#define LAS __attribute__((address_space(3)))
typedef unsigned short bf16;
typedef unsigned v4u __attribute__((ext_vector_type(4)));
typedef float f32x4 __attribute__((ext_vector_type(4)));
typedef short bf16x8 __attribute__((ext_vector_type(8)));
typedef GAS unsigned gu32;
typedef GAS unsigned long long gu64;
#define RLX_AGENT __ATOMIC_RELAXED, __HIP_MEMORY_SCOPE_AGENT
#define LDS_WAIT() asm volatile("s_waitcnt lgkmcnt(0)" ::: "memory")
#define VM_WAIT() asm volatile("s_waitcnt vmcnt(0)" ::: "memory")
__device__ __forceinline__ unsigned f2bf(float f) { unsigned u = __builtin_bit_cast(unsigned, f); return (u + 0x7fffu + ((u >> 16) & 1u)) >> 16; }
__device__ __forceinline__ unsigned pk2(float lo, float hi) { return f2bf(lo) | (f2bf(hi) << 16); }

#define XB_TMO      128
#define XB_XCNT(j)  (256  + 64 * (j))
#define XB_XSUB(j)  (1280 + 64 * (j))
#define XB_XGEN(j)  (2304 + 64 * (j))
#define XB_TOP      3328
#define XB_TOPGEN   3392
#define XCD_BAR_WORDS 3456
#define XB_SPIN_CAP (1u << 18)

__device__ __forceinline__ unsigned xb_ld(unsigned* p)              { return __hip_atomic_load(p, __ATOMIC_RELAXED, __HIP_MEMORY_SCOPE_AGENT); }
__device__ __forceinline__ unsigned xb_add(unsigned* p, unsigned v) { return __hip_atomic_fetch_add(p, v, __ATOMIC_RELAXED, __HIP_MEMORY_SCOPE_AGENT); }
__device__ __forceinline__ unsigned xb_xcc_id() { return (unsigned)__builtin_amdgcn_s_getreg((3 << 11) | 20) & 0xFu; }
#define XB_SPIN(cond, bar) do { unsigned _sp = 0; while (cond) { __builtin_amdgcn_s_sleep(1); \
    if ((++_sp & 255u) == 0u) { if (xb_ld(&(bar)[XB_TMO])) break; if (_sp > XB_SPIN_CAP) { atomicAdd(&(bar)[XB_TMO], 1u); break; } } } } while (0)

struct XcdBarrier {
    unsigned* bar; unsigned x; int wave;
    volatile LAS unsigned* st;
};

__device__ __forceinline__ XcdBarrier xcd_barrier_post(unsigned* bar, volatile LAS unsigned* st) {
    XcdBarrier b; b.bar = bar; b.x = xb_xcc_id(); b.st = st;
    if (threadIdx.x == 0) (void)xb_add(&bar[XB_XCNT(b.x)], 1u);
    return b;
}
__device__ __forceinline__ void xcd_barrier_complete(unsigned* bar, unsigned x, unsigned& nloc, unsigned& nx) {
    const unsigned G = gridDim.x * gridDim.y * gridDim.z;
    unsigned sum, cnt, mine, sp = 0u;
    for (;;) {
        sum = 0u; cnt = 0u; mine = 0u;
#pragma unroll
        for (unsigned j = 0; j < 16; ++j) { const unsigned c = xb_ld(&bar[XB_XCNT(j)]); sum += c; cnt += (c > 0u) ? 1u : 0u; mine = (j == x) ? c : mine; }
        if (sum == G) break;
        __builtin_amdgcn_s_sleep(1);
        if ((++sp & 255u) == 0u) { if (xb_ld(&bar[XB_TMO])) break; if (sp > XB_SPIN_CAP) { atomicAdd(&bar[XB_TMO], 1u); break; } }
    }
    nloc = mine > 0u ? mine : 1u; nx = cnt > 0u ? cnt : 1u;
}

__device__ __forceinline__ void xcd_barrier(const XcdBarrier& b) {
    asm volatile("s_waitcnt vmcnt(0)" ::: "memory");
    __syncthreads();
    if (b.wave == 0 && mk_lane() == 0) {
        unsigned* bar = b.bar;
        __builtin_amdgcn_s_waitcnt(0);
        unsigned nloc = b.st[0], nx = b.st[1];
        if (nloc == 0u) { xcd_barrier_complete(bar, b.x, nloc, nx); b.st[0] = nloc; b.st[1] = nx; }
        const unsigned old = xb_add(&bar[XB_XSUB(b.x)], 1u);
        const unsigned gen = old / nloc;
        if (old + 1u == (gen + 1u) * nloc) {
            __builtin_amdgcn_fence(__ATOMIC_RELEASE, "agent");
            asm volatile("s_waitcnt vmcnt(0)" ::: "memory");
            const unsigned og = xb_add(&bar[XB_TOP], 1u);
            const unsigned tg = og / nx;
            if (og + 1u == (tg + 1u) * nx) xb_add(&bar[XB_TOPGEN], 1u);
            else XB_SPIN(xb_ld(&bar[XB_TOPGEN]) == tg, bar);
            __builtin_amdgcn_fence(__ATOMIC_ACQUIRE, "agent");
            xb_add(&bar[XB_XGEN(b.x)], 1u);
            asm volatile("s_waitcnt vmcnt(0)" ::: "memory");
        } else {
            XB_SPIN(xb_ld(&bar[XB_XGEN(b.x)]) == gen, bar);
            __builtin_amdgcn_fence(__ATOMIC_ACQUIRE, "agent");
            asm volatile("s_waitcnt vmcnt(0)" ::: "memory");
        }
    }
    __syncthreads();
}


struct Frame {
    LAS unsigned char* lds;
    volatile LAS unsigned* MISC;
    gu32* ctl;
    int wave;
    int G;
    unsigned char* ws;
    const float* in[25]; float* out;
};
enum { I_X = 0, I_MEM, I_LNG, I_LNB, I_WMIX, I_WMEMKV, I_AWIN, I_AVG, I_AVB, I_AWS, I_ABS, I_SWKV, I_BWIN, I_LQ1, I_LK1, I_LQ2, I_LK2, I_SUBLN, I_FG, I_FU, I_FD, I_ROUTER, I_MG, I_MU, I_MD };

__device__ __forceinline__ float wave_sum(float v) {
#pragma unroll
    for (int o = 1; o < 64; o <<= 1) v += __shfl_xor(v, o);
    return v;
}
__device__ __forceinline__ float bf2f(unsigned short b) { return __builtin_bit_cast(float, (unsigned)b << 16); }
__device__ __forceinline__ float bflo(unsigned w) { return __builtin_bit_cast(float, w << 16); }
__device__ __forceinline__ float bfhi(unsigned w) { return __builtin_bit_cast(float, w & 0xffff0000u); }

__device__ __forceinline__ void tr_item(const float* W, int K, int N, bf16* WT, int k0, int n0, int drow0, LAS float* scr, int lane) {
#pragma unroll 8
    for (int i = 0; i < 32; ++i) { const int kk = 2 * i + (lane >> 5); scr[kk * 33 + (lane & 31)] = W[(size_t)(k0 + kk) * N + n0 + (lane & 31)]; }
    LDS_WAIT(); asm volatile("" ::: "memory");
    const int c = lane & 7;
#pragma unroll
    for (int j = 0; j < 4; ++j) { const int n = (lane >> 3) + 8 * j; const LAS float* s = scr + (8 * c) * 33 + n;
        v4u o; o.x = pk2(s[0 * 33], s[1 * 33]); o.y = pk2(s[2 * 33], s[3 * 33]); o.z = pk2(s[4 * 33], s[5 * 33]); o.w = pk2(s[6 * 33], s[7 * 33]);
        *(GAS v4u*)(WT + (size_t)(drow0 + n) * K + k0 + 8 * c) = o; }
    LDS_WAIT(); asm volatile("" ::: "memory");
}
__device__ __forceinline__ void tr_matrix_item(const float* W, int K, int N, bf16* WT, int row_off, int mode, int item, LAS float* scr, int lane) {
    const int nblk = N / 32, kb = item / nblk, nb = item % nblk, k0 = 64 * kb, n0 = 32 * nb;
    const int drow0 = row_off + (mode == 0 ? n0 : ((n0 >> 7) * 256 + (n0 & 127) + (mode == 2 ? 128 : 0)));
    tr_item(W, K, N, WT, k0, n0, drow0, scr, lane);
}
__device__ __forceinline__ void p0_prologue(Frame& F) {
    const int lane_ = mk_lane(), tid_ = F.wave * 64 + lane_;
    LAS float* scr = (LAS float*)(F.lds + RING_OFF + F.wave * 16384);
    const int gw = blockIdx.x * NWAVES + F.wave, NGW = F.G * NWAVES;
    bf16* ws16 = (bf16*)F.ws;
    constexpr int I_E = (DM / 64) * (FFE / 32);
    constexpr int I_MOE = 3 * NEXP * I_E;
    constexpr int I_AIN = (DM / 64) * (A_IN / 32), I_MIXW = (DM / 64) * (DM / 32), I_FGU = (DM / 64) * (FF / 32), I_FDN = (FF / 64) * (DM / 32);
    constexpr int I_KV = (DM / 64) * (3072 / 32), I_BIN = (DM / 64) * (DM / 32), I_MKV = (DM / 64) * (1024 / 32);
    constexpr int NITEMS = I_MOE + I_AIN + 2 * I_MIXW + 2 * I_FGU + I_FDN + I_KV + I_BIN + 2 * I_MKV;
    for (int it = gw; it < NITEMS; it += NGW) {
        int r = it;
        if (r < I_MOE) { const int which = r / (NEXP * I_E), rr = r % (NEXP * I_E), e = rr / I_E, item = rr % I_E;
            if (which == 0) tr_matrix_item(F.in[I_MG] + (size_t)e * DM * FFE, DM, FFE, (bf16*)(F.ws + WS_W_MOE_GU), e * 2 * FFE, 1, item, scr, lane_);
            else if (which == 1) tr_matrix_item(F.in[I_MU] + (size_t)e * DM * FFE, DM, FFE, (bf16*)(F.ws + WS_W_MOE_GU), e * 2 * FFE, 2, item, scr, lane_);
            else tr_matrix_item(F.in[I_MD] + (size_t)e * FFE * DM, FFE, DM, (bf16*)(F.ws + WS_W_MOE_D), e * DM, 0, item, scr, lane_);
            continue; } r -= I_MOE;
        if (r < I_AIN) { tr_matrix_item(F.in[I_AWIN], DM, A_IN, (bf16*)(F.ws + WS_W_A_IN), 0, 0, r, scr, lane_); continue; } r -= I_AIN;
        if (r < 2 * I_MIXW) { const int l = r / I_MIXW; tr_matrix_item(F.in[I_WMIX] + (size_t)l * DM * DM, DM, DM, (bf16*)(F.ws + WS_W_MIX), l * DM, 0, r % I_MIXW, scr, lane_); continue; } r -= 2 * I_MIXW;
        if (r < I_FGU) { tr_matrix_item(F.in[I_FG], DM, FF, (bf16*)(F.ws + WS_W_FFN_GU), 0, 1, r, scr, lane_); continue; } r -= I_FGU;
        if (r < I_FGU) { tr_matrix_item(F.in[I_FU], DM, FF, (bf16*)(F.ws + WS_W_FFN_GU), 0, 2, r, scr, lane_); continue; } r -= I_FGU;
        if (r < I_FDN) { tr_matrix_item(F.in[I_FD], FF, DM, (bf16*)(F.ws + WS_W_FFN_D), 0, 0, r, scr, lane_); continue; } r -= I_FDN;
        if (r < I_KV) { tr_matrix_item(F.in[I_SWKV], DM, 3072, (bf16*)(F.ws + WS_W_B_IN), 0, 0, r, scr, lane_); continue; } r -= I_KV;
        if (r < I_BIN) { tr_matrix_item(F.in[I_BWIN], DM, DM, (bf16*)(F.ws + WS_W_B_IN), 3072, 0, r, scr, lane_); continue; } r -= I_BIN;
        { const int l = r / I_MKV; tr_matrix_item(F.in[I_WMEMKV] + (size_t)l * DM * 1024, DM, 1024, (bf16*)(F.ws + WS_W_MEMKV), l * 1024, 0, r % I_MKV, scr, lane_); }
    }
    (void)ws16;
    { const size_t gt = (size_t)blockIdx.x * (NWAVES * 64) + tid_, NT = (size_t)F.G * NWAVES * 64;
      const GAS f32x4* x4 = (const GAS f32x4*)F.in[I_X]; GAS v4u* xb = (GAS v4u*)(F.ws + WS_XB);
      for (size_t i = gt; i < (size_t)NTOK * DM / 8; i += NT) { const f32x4 a = x4[2 * i], b = x4[2 * i + 1]; v4u o; o.x = pk2(a.x, a.y); o.y = pk2(a.z, a.w); o.z = pk2(b.x, b.y); o.w = pk2(b.z, b.w); xb[i] = o; }
      const GAS f32x4* m4 = (const GAS f32x4*)F.in[I_MEM]; GAS v4u* mb = (GAS v4u*)(F.ws + WS_MEMB);
      for (size_t i = gt; i < (size_t)NBATCH * NMEM * DM / 8; i += NT) { const f32x4 a = m4[2 * i], b = m4[2 * i + 1]; v4u o; o.x = pk2(a.x, a.y); o.y = pk2(a.z, a.w); o.z = pk2(b.x, b.y); o.w = pk2(b.z, b.w); mb[i] = o; }
      const float* wsrc = F.in[I_AWS]; bf16* wd = (bf16*)(F.ws + WS_WSBF);
      for (size_t i = gt; i < (size_t)NSG * 128 * 128; i += NT) { const int s = (int)(i & 127), t = (int)((i >> 7) & 127); wd[i] = (bf16)(s <= t ? f2bf(wsrc[i]) : 0u); }
    }
}

__device__ __forceinline__ void ln_load(const float* row, int lane, f32x4 (&v)[8]) { const GAS f32x4* xr = (const GAS f32x4*)row + lane;
#pragma unroll
    for (int j = 0; j < 8; ++j) v[j] = xr[64 * j]; }
__device__ __forceinline__ void ln_norm(f32x4 (&v)[8], const float* g, const float* b, int lane) {
    float s = 0.f;
#pragma unroll
    for (int j = 0; j < 8; ++j) s += (v[j].x + v[j].y) + (v[j].z + v[j].w);
    const float mean = wave_sum(s) * (1.f / DM); float s2 = 0.f;
#pragma unroll
    for (int j = 0; j < 8; ++j) { v[j] = v[j] - mean; s2 += (v[j].x * v[j].x + v[j].y * v[j].y) + (v[j].z * v[j].z + v[j].w * v[j].w); }
    const float rstd = 1.f / sqrtf(wave_sum(s2) * (1.f / DM) + LN_EPS);
    const GAS f32x4* g4 = (const GAS f32x4*)g + lane; const GAS f32x4* b4 = (const GAS f32x4*)b + lane;
#pragma unroll
    for (int j = 0; j < 8; ++j) v[j] = v[j] * rstd * g4[64 * j] + b4[64 * j];
}
__device__ __forceinline__ void ln_store(const f32x4 (&v)[8], float* drow, bf16* brow, int lane) {
    GAS f32x4* o4 = (GAS f32x4*)drow + lane;
#pragma unroll
    for (int j = 0; j < 8; ++j) o4[64 * j] = v[j];
    if (brow) { GAS unsigned long long* o8 = (GAS unsigned long long*)brow + lane;
#pragma unroll
        for (int j = 0; j < 8; ++j) o8[64 * j] = (unsigned long long)pk2(v[j].x, v[j].y) | ((unsigned long long)pk2(v[j].z, v[j].w) << 32); }
}
__device__ __forceinline__ void ln_phase(Frame& F, const float* src, float* dst, bf16* dstb, const float* g, const float* b) {
    const int lane_ = mk_lane();
    const int gw = blockIdx.x * NWAVES + F.wave, NGW = F.G * NWAVES;
    for (int base = gw * 16; base < NTOK; base += NGW * 16)
        for (int r = 0; r < 16; ++r) { const int m = base + r; f32x4 v[8]; ln_load(src + (size_t)m * DM, lane_, v); ln_norm(v, g, b, lane_); ln_store(v, dst + (size_t)m * DM, dstb ? dstb + (size_t)m * DM : nullptr, lane_); }
}

typedef at128::bf16 abf;
typedef at128::BlockRef<abf, abf> ABlk;
template <int PQ> __device__ __forceinline__ ABlk memattn_ref(int L, const abf* Qb, const abf* KVb, abf* Ob) {
    const int tile = L >> 2, h = L & 3, b = tile >> 5; ABlk r;
    r.Q = Qb + (size_t)tile * 256 * PQ + h * 128; r.K = KVb + (size_t)b * NMEM * 2048 + h * 128; r.V = r.K + MEMW; r.O = Ob + (size_t)tile * 256 * DM + h * 128; r.P0 = 1 << 20; return r;
}
template <int PQ> __device__ __forceinline__ void memattn_phase(int G, int wv, char* lds, const abf* Qb, const abf* KVb, abf* Ob) {
    constexpr int total = (NTOK / 256) * 4, W = 1 << 30;
    int L = blockIdx.x; if (L >= total) return;
    ABlk cur = memattn_ref<PQ>(L, Qb, KVb, Ob); at128::Seam<abf> S;
    at128::causal_swa_prime<abf, abf, PQ, 2048, DM>(cur, W, lds, S, wv);
    for (;;) { const bool last = L + G >= total; const ABlk nxt = last ? cur : memattn_ref<PQ>(L + G, Qb, KVb, Ob);
        at128::causal_swa_block<abf, abf, PQ, 2048, DM>(cur, nxt, NMEM, W, lds, S, wv); if (last) break; cur = nxt; L += G; }
}
__device__ __forceinline__ ABlk diff_ref(int vh, int qb, const abf* H1, abf* AO) {
    const int b = vh / 24, rem = vh % 24, h = rem >> 2, m = (rem >> 1) & 1, half = rem & 1; ABlk r;
    const abf* base = H1 + (size_t)b * SEQ * B_IN;
    r.Q = base + (size_t)qb * 256 * B_IN + 3072 + (m * 6 + h) * 128; r.K = base + (m * 6 + h) * 128; r.V = base + 1536 + h * 256 + half * 128;
    r.O = AO + ((size_t)b * SEQ + (size_t)qb * 256) * 3072 + m * 1536 + h * 256 + half * 128; r.P0 = qb * 256; return r;
}
__device__ __forceinline__ void diffattn_phase(int G, int wv, char* lds, const abf* H1, abf* AO) {
    constexpr int NX = 16, total = 96 * NX, W = SEQ;
    int L = blockIdx.x; if (L >= total) return;
    int pass = 0; ABlk cur = diff_ref(L / NX, L % NX, H1, AO); at128::Seam<abf> S;
    at128::causal_swa_prime<abf, abf, B_IN, B_IN, 3072>(cur, W, lds, S, wv);
    for (;;) {
        const bool more_item = L + G < total, last = pass == 1 && !more_item;
        int Ln = L, passn = pass + 1; if (pass == 1) { passn = 0; Ln = more_item ? L + G : L; }
        const int x = Ln % NX; const ABlk nxt = last ? cur : diff_ref(Ln / NX, passn ? 31 - x : x, H1, AO);
        at128::causal_swa_block<abf, abf, B_IN, B_IN, 3072>(cur, nxt, SEQ, W, lds, S, wv);
        if (last) break; cur = nxt; L = Ln; pass = passn;
    }
}

__device__ __forceinline__ void sg_phase(Frame& F) {
    const bf16* H0 = (const bf16*)(F.ws + WS_H0); bf16* CC = (bf16*)(F.ws + WS_CONCAT); const bf16* WSB = (const bf16*)(F.ws + WS_WSBF);
    const float* vg = F.in[I_AVG]; const float* vb = F.in[I_AVB]; const float* bsp = F.in[I_ABS];
    const int lane = mk_lane(), wid = F.wave, tid = wid * 64 + lane, r32 = lane & 31, hi = lane >> 5;
    LAS float* stats = (LAS float*)(F.lds + 65536);
    for (int c = blockIdx.x; c < NTOK / 128; c += F.G) {
        const size_t R0 = (size_t)c * 128;
        for (int r = 0; r < 16; ++r) {
            const int t = wid * 16 + r; const bf16* vr = H0 + (R0 + t) * A_IN + MAINW; float x[24];
#pragma unroll
            for (int j = 0; j < 3; ++j) { const v4u w = *(const GAS v4u*)(vr + j * 512 + lane * 8);
                x[8 * j + 0] = bflo(w.x); x[8 * j + 1] = bfhi(w.x); x[8 * j + 2] = bflo(w.y); x[8 * j + 3] = bfhi(w.y); x[8 * j + 4] = bflo(w.z); x[8 * j + 5] = bfhi(w.z); x[8 * j + 6] = bflo(w.w); x[8 * j + 7] = bfhi(w.w); }
            float s = 0.f;
#pragma unroll
            for (int j = 0; j < 24; ++j) s += x[j];
            const float mean = wave_sum(s) * (1.f / MAINW); float q = 0.f;
#pragma unroll
            for (int j = 0; j < 24; ++j) { const float d = x[j] - mean; q += d * d; }
            const float rstd = 1.f / sqrtf(wave_sum(q) * (1.f / MAINW) + LN_EPS);
            if (lane == 0) { stats[2 * t] = mean; stats[2 * t + 1] = rstd; }
        }
        __syncthreads();
        for (int gp = 0; gp < NSG / 2; ++gp) {
#pragma unroll
            for (int i = 0; i < 8; ++i) {
                const int p = tid + 512 * i, gsel = p >> 11, kt = (p >> 10) & 1, key = (p >> 4) & 63, c8 = (p & 15) * 8, tok = kt * 64 + key, col = (2 * gp + gsel) * 128 + c8;
                const v4u w = *(const GAS v4u*)(H0 + (R0 + tok) * A_IN + MAINW + col);
                const float mean = stats[2 * tok], rstd = stats[2 * tok + 1];
                const f32x4 g0 = *(const GAS f32x4*)(vg + col), g1 = *(const GAS f32x4*)(vg + col + 4), b0 = *(const GAS f32x4*)(vb + col), b1 = *(const GAS f32x4*)(vb + col + 4);
                v4u o;
                o.x = pk2((bflo(w.x) - mean) * rstd * g0.x + b0.x, (bfhi(w.x) - mean) * rstd * g0.y + b0.y);
                o.y = pk2((bflo(w.y) - mean) * rstd * g0.z + b0.z, (bfhi(w.y) - mean) * rstd * g0.w + b0.w);
                o.z = pk2((bflo(w.z) - mean) * rstd * g1.x + b1.x, (bfhi(w.z) - mean) * rstd * g1.y + b1.y);
                o.w = pk2((bflo(w.w) - mean) * rstd * g1.z + b1.z, (bfhi(w.w) - mean) * rstd * g1.w + b1.w);
                *(LAS v4u*)(F.lds + (gsel * 2 + kt) * 16384 + at128::v_st(key, c8)) = o;
            }
            __syncthreads();
            { const int gsel = wid >> 2, tb = wid & 3, g = 2 * gp + gsel;
              at128::f32x16 o[4] = {};
              const int vb0 = (int)(unsigned long)(F.lds) + gsel * 32768 + at128::v_rd_base(lane);
              const bf16* wrow = WSB + ((size_t)g * 128 + tb * 32 + r32) * 128 + hi * 8;
              { const at128::bf16x8 pa0 = *(const GAS at128::bf16x8*)(wrow), pa1 = *(const GAS at128::bf16x8*)(wrow + 16), pa2 = *(const GAS at128::bf16x8*)(wrow + 32), pa3 = *(const GAS at128::bf16x8*)(wrow + 48);
                at128::pv_tile<0, false>(o, vb0, pa0, pa1, pa2, pa3, true); }
              if (tb >= 2) { const at128::bf16x8 pa0 = *(const GAS at128::bf16x8*)(wrow + 64), pa1 = *(const GAS at128::bf16x8*)(wrow + 80), pa2 = *(const GAS at128::bf16x8*)(wrow + 96), pa3 = *(const GAS at128::bf16x8*)(wrow + 112);
                at128::pv_tile<1, false>(o, vb0, pa0, pa1, pa2, pa3, true); }
#pragma unroll
              for (int r = 0; r < 16; ++r) { const int t = tb * 32 + at128::crow(r, hi); const float bsv = bsp[g * 128 + t];
                  const bf16* urow = H0 + (R0 + t) * A_IN + g * 128 + r32; bf16* orow = CC + (R0 + t) * DM + g * 128 + r32;
#pragma unroll
                  for (int d0 = 0; d0 < 4; ++d0) { const float val = (o[d0][r] + bsv) * bf2f(urow[d0 * 32]); const float vn = __shfl_xor(val, 1);
                      if ((r32 & 1) == 0) *(GAS unsigned*)(orow + d0 * 32) = pk2(val, vn); } }
            }
            __syncthreads();
        }
    }
}

__device__ __forceinline__ void combine_phase(Frame& F) {
    const bf16* AO = (const bf16*)(F.ws + WS_AO); bf16* CC = (bf16*)(F.ws + WS_CONCAT1);
    const int lane = mk_lane(), gw = blockIdx.x * NWAVES + F.wave, NGW = F.G * NWAVES;
    const float* q1 = F.in[I_LQ1]; const float* k1 = F.in[I_LK1]; const float* q2 = F.in[I_LQ2]; const float* k2 = F.in[I_LK2];
    const float s1 = wave_sum(q1[lane] * k1[lane] + q1[lane + 64] * k1[lane + 64]), s2 = wave_sum(q2[lane] * k2[lane] + q2[lane + 64] * k2[lane + 64]);
    const float lam = expf(s1) - expf(s2) + LAMBDA_INIT, post = 1.0f - LAMBDA_INIT;
    const f32x4 g4 = *(const GAS f32x4*)(F.in[I_SUBLN] + 4 * lane);
    for (int m = gw; m < NTOK; m += NGW) {
        const bf16* r1 = AO + (size_t)m * 3072 + 4 * lane; bf16* orow = CC + (size_t)m * DM + 4 * lane;
#pragma unroll
        for (int h = 0; h < 6; ++h) {
            const unsigned long long a = *(const GAS unsigned long long*)(r1 + h * 256), b = *(const GAS unsigned long long*)(r1 + 1536 + h * 256);
            const unsigned a0 = (unsigned)a, a1 = (unsigned)(a >> 32), b0 = (unsigned)b, b1 = (unsigned)(b >> 32);
            const float x0 = bflo(a0) - lam * bflo(b0), x1 = bfhi(a0) - lam * bfhi(b0), x2 = bflo(a1) - lam * bflo(b1), x3 = bfhi(a1) - lam * bfhi(b1);
            const float ss = wave_sum((x0 * x0 + x1 * x1) + (x2 * x2 + x3 * x3));
            const float r = post / sqrtf(ss * (1.f / 256.f) + LN_EPS);
            *(GAS unsigned long long*)(orow + h * 256) = (unsigned long long)pk2(x0 * r * g4.x, x1 * r * g4.y) | ((unsigned long long)pk2(x2 * r * g4.z, x3 * r * g4.w) << 32);
        }
    }
}

__device__ __forceinline__ void ln_router_phase(Frame& F, float* xio, bf16* xb, const float* g, const float* b) {
    LAS float* wr = (LAS float*)(F.lds);
    const float* wsrc = F.in[I_ROUTER];
    const int lane = mk_lane();
    for (int i = F.wave * 64 + lane; i < DM * NEXP; i += NWAVES * 64) wr[(i & 7) * DM + (i >> 3)] = wsrc[i];
    __syncthreads();
    int* route_e = (int*)(F.ws + WS_ROUTE_E); float* route_w = (float*)(F.ws + WS_ROUTE_W); int* hist = (int*)(F.ws + WS_HIST);
    const int gw = blockIdx.x * NWAVES + F.wave, NGW = F.G * NWAVES;
    for (int grp = gw; grp < NTOK / 16; grp += NGW) {
        int cnt = 0;
        for (int r = 0; r < 16; ++r) {
            const int m = grp * 16 + r; f32x4 v[8]; ln_load(xio + (size_t)m * DM, lane, v); ln_norm(v, g, b, lane); ln_store(v, xio + (size_t)m * DM, xb + (size_t)m * DM, lane);
            float lg[8];
#pragma unroll
            for (int e = 0; e < 8; ++e) lg[e] = 0.f;
#pragma unroll
            for (int j = 0; j < 8; ++j) {
#pragma unroll
                for (int e = 0; e < 8; ++e) { const f32x4 w = *(const LAS f32x4*)(wr + e * DM + 256 * j + 4 * lane); lg[e] += (v[j].x * w.x + v[j].y * w.y) + (v[j].z * w.z + v[j].w * w.w); }
                asm volatile("" ::: "memory"); }
#pragma unroll
            for (int e = 0; e < 8; ++e) lg[e] = wave_sum(lg[e]);
            int e0 = 0; float l0 = lg[0];
#pragma unroll
            for (int e = 1; e < 8; ++e) if (lg[e] > l0) { l0 = lg[e]; e0 = e; }
            int e1 = -1; float l1 = -3.0e38f;
#pragma unroll
            for (int e = 0; e < 8; ++e) if (e != e0 && lg[e] > l1) { l1 = lg[e]; e1 = e; }
            const float ex = expf(l1 - l0), w0 = 1.0f / (1.0f + ex), w1 = ex / (1.0f + ex);
            if (lane == 0) { route_e[m] = e0 | (e1 << 8); route_w[2 * m] = w0; route_w[2 * m + 1] = w1; }
            cnt += (lane == e0) + (lane == e1);
        }
        if (lane < 8) hist[grp * 8 + lane] = cnt;
    }
}

__device__ __forceinline__ void dispatch_phase(Frame& F) {
    LAS int* gpre = (LAS int*)(F.lds);
    LAS int* wtot = (LAS int*)(F.lds + 65536);
    LAS int* tst = (LAS int*)(F.lds + 65536 + 256);
    const int* hist = (const int*)(F.ws + WS_HIST); const int lane = mk_lane(), wid = F.wave, tid = wid * 64 + lane;
    int h[4][8], sum[8];
#pragma unroll
    for (int e = 0; e < 8; ++e) sum[e] = 0;
#pragma unroll
    for (int i = 0; i < 4; ++i) { const v4u a = *(const GAS v4u*)(hist + (4 * tid + i) * 8), b = *(const GAS v4u*)(hist + (4 * tid + i) * 8 + 4);
        h[i][0] = a.x; h[i][1] = a.y; h[i][2] = a.z; h[i][3] = a.w; h[i][4] = b.x; h[i][5] = b.y; h[i][6] = b.z; h[i][7] = b.w;
#pragma unroll
        for (int e = 0; e < 8; ++e) sum[e] += h[i][e]; }
    int inc[8];
#pragma unroll
    for (int e = 0; e < 8; ++e) { int v = sum[e];
#pragma unroll
        for (int o = 1; o < 64; o <<= 1) { const int t = __shfl_up(v, o); if (lane >= o) v += t; }
        inc[e] = v; if (lane == 63) wtot[wid * 8 + e] = v; }
    __syncthreads();
    int tot[8];
#pragma unroll
    for (int e = 0; e < 8; ++e) { int pre = 0, all = 0;
#pragma unroll
        for (int w = 0; w < 8; ++w) { const int t = wtot[w * 8 + e]; all += t; if (w < wid) pre += t; }
        tot[e] = all; int run = pre + inc[e] - sum[e];
#pragma unroll
        for (int i = 0; i < 4; ++i) { gpre[(4 * tid + i) * 8 + e] = run; run += h[i][e]; } }
    if (tid == 0) { int ts = 0;
#pragma unroll
        for (int e = 0; e < 8; ++e) { tst[e] = ts; ts += (tot[e] + 255) >> 8; } tst[8] = ts;
        if (blockIdx.x == 0) { int* tab = (int*)(F.ws + WS_MOETAB);
#pragma unroll
            for (int e = 0; e <= 8; ++e) tab[e] = tst[e]; } }
    __syncthreads();
    const int* route_e = (const int*)(F.ws + WS_ROUTE_E); const float* route_w = (const float*)(F.ws + WS_ROUTE_W);
    int* tokslot = (int*)(F.ws + WS_TOKSLOT); int* slottok = (int*)(F.ws + WS_SLOTTOK); float* slotgate = (float*)(F.ws + WS_SLOTGATE);
    const bf16* X3B = (const bf16*)(F.ws + WS_X3B); bf16* XS = (bf16*)(F.ws + WS_XS);
    const int gw = blockIdx.x * NWAVES + wid, NGW = F.G * NWAVES;
    for (int grp = gw; grp < NTOK / 16; grp += NGW) {
        const int a = lane & 31, tok = grp * 16 + (a >> 1), k = a & 1;
        const int e = (route_e[tok] >> (8 * k)) & 0xff; const float w = route_w[2 * tok + k];
        int rank = 0;
#pragma unroll
        for (int ee = 0; ee < 8; ++ee) { const unsigned long long mk = __ballot(lane < 32 && e == ee); if (e == ee) rank = __popcll(mk & ((1ull << lane) - 1ull)); }
        const int slot = tst[e] * 256 + gpre[grp * 8 + e] + rank;
        if (lane < 32) { slottok[slot] = tok; slotgate[slot] = w; tokslot[2 * tok + k] = slot; }
        for (int q = 0; q < 32; ++q) { const int sl = __shfl(slot, q), tk = grp * 16 + (q >> 1);
            const GAS v4u* src = (const GAS v4u*)(X3B + (size_t)tk * DM) + lane; GAS v4u* dst = (GAS v4u*)(XS + (size_t)sl * DM) + lane;
#pragma unroll
            for (int j = 0; j < 4; ++j) dst[64 * j] = src[64 * j]; }
    }
}

__device__ __forceinline__ void final_phase(Frame& F, const float* g, const float* b) {
    const int* tokslot = (const int*)(F.ws + WS_TOKSLOT); const bf16* OS = (const bf16*)(F.ws + WS_OS);
    const int gw = blockIdx.x * NWAVES + F.wave, NGW = F.G * NWAVES, lane = mk_lane();
    for (int base = gw * 16; base < NTOK; base += NGW * 16)
        for (int r = 0; r < 16; ++r) { const int m = base + r; f32x4 v[8]; ln_load(F.out + (size_t)m * DM, lane, v);
            const int s0 = tokslot[2 * m], s1 = tokslot[2 * m + 1];
            const GAS unsigned long long* o0 = (const GAS unsigned long long*)(OS + (size_t)s0 * DM) + lane; const GAS unsigned long long* o1 = (const GAS unsigned long long*)(OS + (size_t)s1 * DM) + lane;
#pragma unroll
            for (int j = 0; j < 8; ++j) { const unsigned long long p = o0[64 * j], q = o1[64 * j]; const unsigned p0 = (unsigned)p, p1 = (unsigned)(p >> 32), q0 = (unsigned)q, q1 = (unsigned)(q >> 32);
                v[j].x = v[j].x * ALPHA + (bflo(p0) + bflo(q0)); v[j].y = v[j].y * ALPHA + (bfhi(p0) + bfhi(q0)); v[j].z = v[j].z * ALPHA + (bflo(p1) + bflo(q1)); v[j].w = v[j].w * ALPHA + (bfhi(p1) + bfhi(q1)); }
            ln_norm(v, g, b, lane); ln_store(v, F.out + (size_t)m * DM, nullptr, lane); }
}

struct Args { const float* in[25]; float* out; unsigned char* ws; int ph_lo, ph_hi, ch_lo, ch_hi; };
__global__ void __launch_bounds__(NWAVES * 64, 2) mk_fwd(Args args) {
    extern __shared__ __attribute__((aligned(16))) unsigned char lds[];
    Frame F;
    F.lds = (LAS unsigned char*)lds; F.MISC = (volatile LAS unsigned*)(F.lds + MISC_OFF);
    F.wave = __builtin_amdgcn_readfirstlane(threadIdx.x >> 6); F.G = gridDim.x;
    F.ws = args.ws; F.ctl = (gu32*)(args.ws + WS_CTL); F.out = args.out;
#pragma unroll
    for (int i = 0; i < 25; ++i) F.in[i] = args.in[i];
    for (int u = threadIdx.x; u < (LDS_BYTES - LDSCTL_OFF) / 4; u += NWAVES * 64) ((LAS unsigned*)(F.lds + LDSCTL_OFF))[u] = 0u;
    __syncthreads();
    const int lo = args.ph_lo, hi = args.ph_hi;
    XcdBarrier bar; bar.bar = (unsigned*)(F.ctl + CW_BAR); bar.x = 0; bar.st = nullptr; bar.wave = F.wave;
    if (hi - lo > 1) { bar = xcd_barrier_post((unsigned*)(F.ctl + CW_BAR), F.MISC + 8); bar.wave = F.wave; }
#define IN(k) (((MK_PHMASK >> (k)) & 1) && lo <= (k) && (k) < hi)
#define BOTH(k) (IN(k) && IN((k) + 1))
#define GRID_BAR() xcd_barrier(bar)
    unsigned char* ws = args.ws;
    bf16* XB = (bf16*)(ws + WS_XB);
    LAS unsigned char* ring = F.lds + RING_OFF;

    if (IN(0)) { p0_prologue(F); if (BOTH(0)) GRID_BAR(); }
    if (IN(1)) {
        { pg8::Gemm g{XB, (const bf16*)(ws + WS_W_A_IN), NTOK, A_IN, DM}; pg8::StaticOrder S; S.init(NTOK, A_IN, F.G, (int)blockIdx.x);
          pg8::EpiBf16 E{(bf16*)(ws + WS_H0), A_IN, 2 * MAINW}; pg8::gemm_phase<pg8::EpiBf16, pg8::StaticOrder, true, true>(ring, g, S, E, F.wave); }
        { pg8::Gemm g{(const bf16*)(ws + WS_MEMB), (const bf16*)(ws + WS_W_MEMKV), NBATCH * NMEM, 2048, DM}; pg8::StaticOrder S; S.init(NBATCH * NMEM, 2048, F.G, (int)blockIdx.x);
          pg8::EpiBf16 E{(bf16*)(ws + WS_MEMKV), 2048, 0}; pg8::gemm_phase<pg8::EpiBf16, pg8::StaticOrder, true, true>(ring, g, S, E, F.wave); }
        if (BOTH(1)) GRID_BAR();
    }
    if (IN(2)) {
        memattn_phase<A_IN>(F.G, F.wave, (char*)lds + RING_OFF, (const abf*)(ws + WS_H0) + 2 * MAINW, (const abf*)(ws + WS_MEMKV), (abf*)(ws + WS_CONCAT) + MAINW);
        __syncthreads();
        sg_phase(F);
        if (BOTH(2)) GRID_BAR();
    }
    if (IN(3)) {
        pg8::Gemm g{(const bf16*)(ws + WS_CONCAT), (const bf16*)(ws + WS_W_MIX), NTOK, DM, DM}; pg8::StaticOrder S; S.init(NTOK, DM, F.G, (int)blockIdx.x);
        pg8::EpiRes E{F.in[I_X], F.out, DM, ALPHA}; pg8::gemm_phase<pg8::EpiRes, pg8::StaticOrder, true, true>(ring, g, S, E, F.wave);
        if (BOTH(3)) GRID_BAR();
    }
    if (IN(4)) { ln_phase(F, F.out, F.out, XB, F.in[I_LNG] + 0 * DM, F.in[I_LNB] + 0 * DM); if (BOTH(4)) GRID_BAR(); }
    if (IN(5)) {
        pg8::Gemm g{XB, (const bf16*)(ws + WS_W_FFN_GU), NTOK, 2 * FF, DM}; pg8::StaticOrder S; S.init(NTOK, 2 * FF, F.G, (int)blockIdx.x);
        pg8::EpiSwiglu E{(bf16*)(ws + WS_HID), FF}; pg8::gemm_phase<pg8::EpiSwiglu, pg8::StaticOrder, true, true>(ring, g, S, E, F.wave);
        if (BOTH(5)) GRID_BAR();
    }
    if (IN(6)) {
        pg8::Gemm g{(const bf16*)(ws + WS_HID), (const bf16*)(ws + WS_W_FFN_D), NTOK, DM, FF}; pg8::StaticOrder S; S.init(NTOK, DM, F.G, (int)blockIdx.x);
        pg8::EpiRes E{F.out, F.out, DM, ALPHA}; pg8::gemm_phase<pg8::EpiRes, pg8::StaticOrder, true, true>(ring, g, S, E, F.wave);
        if (BOTH(6)) GRID_BAR();
    }
    if (IN(7)) { ln_phase(F, F.out, F.out, XB, F.in[I_LNG] + 1 * DM, F.in[I_LNB] + 1 * DM); if (BOTH(7)) GRID_BAR(); }
    if (IN(8)) {
        pg8::Gemm g{XB, (const bf16*)(ws + WS_W_B_IN), NTOK, B_IN, DM}; pg8::StaticOrder S; S.init(NTOK, B_IN, F.G, (int)blockIdx.x);
        pg8::EpiBf16 E{(bf16*)(ws + WS_H1), B_IN, 0}; pg8::gemm_phase<pg8::EpiBf16, pg8::StaticOrder, true, true>(ring, g, S, E, F.wave);
        if (BOTH(8)) GRID_BAR();
    }
    if (IN(9)) { diffattn_phase(F.G, F.wave, (char*)lds + RING_OFF, (const abf*)(ws + WS_H1), (abf*)(ws + WS_AO)); if (BOTH(9)) GRID_BAR(); }
    if (IN(10)) {
        memattn_phase<B_IN>(F.G, F.wave, (char*)lds + RING_OFF, (const abf*)(ws + WS_H1) + 4608, (const abf*)(ws + WS_MEMKV) + 1024, (abf*)(ws + WS_CONCAT1) + MAINW);
        combine_phase(F);
        if (BOTH(10)) GRID_BAR();
    }
    if (IN(11)) {
        pg8::Gemm g{(const bf16*)(ws + WS_CONCAT1), (const bf16*)(ws + WS_W_MIX) + (size_t)DM * DM, NTOK, DM, DM}; pg8::StaticOrder S; S.init(NTOK, DM, F.G, (int)blockIdx.x);
        pg8::EpiRes E{F.out, F.out, DM, ALPHA}; pg8::gemm_phase<pg8::EpiRes, pg8::StaticOrder, true, true>(ring, g, S, E, F.wave);
        if (BOTH(11)) GRID_BAR();
    }
    if (IN(12)) { ln_router_phase(F, F.out, (bf16*)(ws + WS_X3B), F.in[I_LNG] + 2 * DM, F.in[I_LNB] + 2 * DM); if (BOTH(12)) GRID_BAR(); }
    if (IN(13)) { dispatch_phase(F); if (BOTH(13)) GRID_BAR(); }
    if (IN(14) || IN(15)) {
        LAS int* tst = (LAS int*)(F.lds + LDSCTL_OFF);
        { const int t_ = F.wave * 64 + mk_lane(); if (t_ < 9) tst[t_] = ((const int*)(ws + WS_MOETAB))[t_]; }
        __syncthreads();
        const int T = tst[8];
        for (int ch = args.ch_lo; ch < args.ch_hi; ++ch) {
            const int t0 = ch * MOE_CHUNK_T; int nM = T - t0; nM = nM < 0 ? 0 : (nM > MOE_CHUNK_T ? MOE_CHUNK_T : nM);
            if (IN(14)) {
                pg8::Gemm g{(const bf16*)(ws + WS_XS), (const bf16*)(ws + WS_W_MOE_GU), 0, 2 * FFE, DM};
                pg8::MoeOrder<false> S; S.nM = nM; S.nN = 2 * FFE / 256; S.nwg = nM * S.nN; S.G = F.G; S.c = (int)blockIdx.x; S.t0 = t0; S.tstart = tst;
                pg8::EpiSwiglu E{(bf16*)(ws + WS_HIDM), FFE}; pg8::gemm_phase<pg8::EpiSwiglu, pg8::MoeOrder<false>, true, true>(ring, g, S, E, F.wave);
                if (IN(15)) GRID_BAR();
            }
            if (IN(15)) {
                pg8::Gemm g{(const bf16*)(ws + WS_HIDM), (const bf16*)(ws + WS_W_MOE_D), 0, DM, FFE};
                pg8::MoeOrder<true> S; S.nM = nM; S.nN = DM / 256; S.nwg = nM * S.nN; S.G = F.G; S.c = (int)blockIdx.x; S.t0 = t0; S.tstart = tst;
                pg8::EpiRowScale E{(bf16*)(ws + WS_OS), DM, (const float*)(ws + WS_SLOTGATE)}; pg8::gemm_phase<pg8::EpiRowScale, pg8::MoeOrder<true>, true, true>(ring, g, S, E, F.wave);
                if (ch + 1 < args.ch_hi ? IN(14) : IN(16)) GRID_BAR();
            }
        }
    }
    if (IN(16)) final_phase(F, F.in[I_LNG] + 3 * DM, F.in[I_LNB] + 3 * DM);
#undef IN
#undef BOTH
#undef GRID_BAR
}

#if MK_DEBUG
__device__ __forceinline__ unsigned hash32(unsigned x) { x ^= x >> 16; x *= 0x7feb352dU; x ^= x >> 15; x *= 0x846ca68bU; x ^= x >> 16; return x; }
__device__ __forceinline__ float wdot(const bf16* a, const bf16* b, int K, int lane) { float s = 0.f; for (int k = lane; k < K; k += 64) s += bf2f(a[k]) * bf2f(b[k]); return wave_sum(s); }
__device__ __forceinline__ bool okf(float got, float ref, float rel, float ab) { return fabsf(got - ref) <= rel * fabsf(ref) + ab; }
__device__ __forceinline__ float gelu_ref(float x) { return 0.5f * x * (1.0f + tanhf(0.7978845608f * (x + 0.044715f * x * x * x))); }
__device__ __forceinline__ float silu_ref(float x) { return x / (1.0f + expf(-x)); }
#define CHK_FAIL(stage) do { if (lane == 0) atomicAdd((unsigned*)(a.ws + WS_CTL) + CW_CHK + (stage), 1u); } while (0)
__device__ void chk_tr(const Args& a, int stage, const float* W, int K, int N, const bf16* WT, int row_off, int mode, unsigned s, int lane) {
    const int k = hash32(s * 2 + 1) % K, n = hash32(s * 2 + 2) % N; const int drow = row_off + (mode == 0 ? n : ((n >> 7) * 256 + (n & 127) + (mode == 2 ? 128 : 0)));
    if (WT[(size_t)drow * K + k] != (bf16)f2bf(W[(size_t)k * N + n])) CHK_FAIL(stage);
}
__device__ void chk_memattn(const Args& a, int stage, const bf16* q, const bf16* Kb, const bf16* Ob, float* pl, int lane) {
    float sc[4], mx = -3e38f;
    for (int i = 0; i < 4; ++i) { const int j = lane + 64 * i; float s = 0.f; for (int d = 0; d < 128; ++d) s += bf2f(q[d]) * bf2f(Kb[(size_t)j * 2048 + d]); sc[i] = s * 0.08838834764831845f; mx = fmaxf(mx, sc[i]); }
    for (int o = 1; o < 64; o <<= 1) mx = fmaxf(mx, __shfl_xor(mx, o));
    float sum = 0.f; for (int i = 0; i < 4; ++i) { sc[i] = expf(sc[i] - mx); sum += sc[i]; pl[lane + 64 * i] = sc[i]; }
    sum = wave_sum(sum); __syncthreads();
    bool bad = false;
    for (int dd = 0; dd < 2; ++dd) { const int d = lane + 64 * dd; float o = 0.f; for (int j = 0; j < 256; ++j) o += pl[j] * bf2f(Kb[(size_t)j * 2048 + 512 + d]); o /= sum;
        if (!okf(bf2f(Ob[d]), o, 0.03f, 0.004f)) bad = true; }
    if (__any(bad)) CHK_FAIL(stage);
    __syncthreads();
}
__global__ void __launch_bounds__(64) chk_kernel(Args a, int stage, int chunk) {
    __shared__ float pl[8192];
    const int lane = threadIdx.x; const unsigned s = blockIdx.x; unsigned char* ws = a.ws;
    const bf16* XB = (const bf16*)(ws + WS_XB);
    if (stage == 0) {
        switch (s % 12) {
        case 0: chk_tr(a, 0, a.in[I_AWIN], DM, A_IN, (const bf16*)(ws + WS_W_A_IN), 0, 0, s, lane); break;
        case 1: { const int l = (s / 12) & 1; chk_tr(a, 0, a.in[I_WMIX] + (size_t)l * DM * DM, DM, DM, (const bf16*)(ws + WS_W_MIX), l * DM, 0, s, lane); } break;
        case 2: chk_tr(a, 0, a.in[I_FG], DM, FF, (const bf16*)(ws + WS_W_FFN_GU), 0, 1, s, lane); break;
        case 3: chk_tr(a, 0, a.in[I_FU], DM, FF, (const bf16*)(ws + WS_W_FFN_GU), 0, 2, s, lane); break;
        case 4: chk_tr(a, 0, a.in[I_FD], FF, DM, (const bf16*)(ws + WS_W_FFN_D), 0, 0, s, lane); break;
        case 5: chk_tr(a, 0, a.in[I_SWKV], DM, 3072, (const bf16*)(ws + WS_W_B_IN), 0, 0, s, lane); break;
        case 6: chk_tr(a, 0, a.in[I_BWIN], DM, DM, (const bf16*)(ws + WS_W_B_IN), 3072, 0, s, lane); break;
        case 7: { const int l = (s / 12) & 1; chk_tr(a, 0, a.in[I_WMEMKV] + (size_t)l * DM * 1024, DM, 1024, (const bf16*)(ws + WS_W_MEMKV), l * 1024, 0, s, lane); } break;
        case 8: { const int e = (s / 12) & 7; chk_tr(a, 0, a.in[I_MG] + (size_t)e * DM * FFE, DM, FFE, (const bf16*)(ws + WS_W_MOE_GU), e * 2 * FFE, 1, s, lane); } break;
        case 9: { const int e = (s / 12) & 7; chk_tr(a, 0, a.in[I_MU] + (size_t)e * DM * FFE, DM, FFE, (const bf16*)(ws + WS_W_MOE_GU), e * 2 * FFE, 2, s, lane); } break;
        case 10: { const int e = (s / 12) & 7; chk_tr(a, 0, a.in[I_MD] + (size_t)e * FFE * DM, FFE, DM, (const bf16*)(ws + WS_W_MOE_D), e * DM, 0, s, lane); } break;
        default: { const size_t i = hash32(s) % ((size_t)NTOK * DM); if (XB[i] != (bf16)f2bf(a.in[I_X][i])) CHK_FAIL(0);
                   const size_t i2 = hash32(s + 7) % ((size_t)1024 * DM); if (((const bf16*)(ws + WS_MEMB))[i2] != (bf16)f2bf(a.in[I_MEM][i2])) CHK_FAIL(0);
                   const int i3 = hash32(s + 9) % (NSG * 128 * 128), ss = i3 & 127, tt = (i3 >> 7) & 127; if (((const bf16*)(ws + WS_WSBF))[i3] != (bf16)(ss <= tt ? f2bf(a.in[I_AWS][i3]) : 0u)) CHK_FAIL(0); } break;
        }
    } else if (stage == 1) {
        const int row = hash32(s) % NTOK, col = (s & 1) ? (3072 + hash32(s + 1) % 512) : (hash32(s + 1) % A_IN);
        float ref = wdot(XB + (size_t)row * DM, (const bf16*)(ws + WS_W_A_IN) + (size_t)col * DM, DM, lane); if (col < 3072) ref = gelu_ref(ref);
        if (!okf(bf2f(((const bf16*)(ws + WS_H0))[(size_t)row * A_IN + col]), ref, 0.02f, 0.02f)) CHK_FAIL(1);
        const int r2 = hash32(s + 3) % 1024, c2 = hash32(s + 4) % 2048;
        const float ref2 = wdot((const bf16*)(ws + WS_MEMB) + (size_t)r2 * DM, (const bf16*)(ws + WS_W_MEMKV) + (size_t)c2 * DM, DM, lane);
        if (!okf(bf2f(((const bf16*)(ws + WS_MEMKV))[(size_t)r2 * 2048 + c2]), ref2, 0.02f, 0.02f)) CHK_FAIL(1);
    } else if (stage == 2) {
        const int tok = hash32(s) % NTOK, h = hash32(s + 1) & 3, b = tok / SEQ; const bf16* H0 = (const bf16*)(ws + WS_H0);
        chk_memattn(a, 2, H0 + (size_t)tok * A_IN + 3072 + h * 128, (const bf16*)(ws + WS_MEMKV) + (size_t)b * 256 * 2048 + h * 128, (const bf16*)(ws + WS_CONCAT) + (size_t)tok * DM + 1536 + h * 128, pl, lane);
        const int g = hash32(s + 2) % NSG, t = tok & 127; const size_t R0 = (size_t)(tok - t);
        float mean[2], rstd[2];
        for (int i = 0; i < 2; ++i) { const int sidx = lane + 64 * i; const bf16* vr = H0 + (R0 + sidx) * A_IN + MAINW; float sm = 0.f; for (int k = 0; k < MAINW; ++k) sm += bf2f(vr[k]); sm /= MAINW; float q = 0.f; for (int k = 0; k < MAINW; ++k) { const float d = bf2f(vr[k]) - sm; q += d * d; } mean[i] = sm; rstd[i] = 1.0f / sqrtf(q / MAINW + LN_EPS); }
        for (int dd = 0; dd < 2; ++dd) { const int d = hash32(s + 10 + dd) & 127, col = g * 128 + d; float acc = 0.f;
            for (int i = 0; i < 2; ++i) { const int sidx = lane + 64 * i; if (sidx <= t) { const float lv = (bf2f(H0[(R0 + sidx) * A_IN + MAINW + col]) - mean[i]) * rstd[i] * a.in[I_AVG][col] + a.in[I_AVB][col]; acc += a.in[I_AWS][((size_t)g * 128 + t) * 128 + sidx] * lv; } }
            acc = wave_sum(acc); const float ref = (acc + a.in[I_ABS][g * 128 + t]) * bf2f(H0[(R0 + t) * A_IN + col]);
            if (!okf(bf2f(((const bf16*)(ws + WS_CONCAT))[(R0 + t) * DM + col]), ref, 0.03f, 0.03f)) CHK_FAIL(3); }
    } else if (stage == 3 || stage == 6 || stage == 11) {
        const int row = hash32(s) % NTOK, col = hash32(s + 1) % DM; float ref;
        if (stage == 3) ref = ALPHA * a.in[I_X][(size_t)row * DM + col] + wdot((const bf16*)(ws + WS_CONCAT) + (size_t)row * DM, (const bf16*)(ws + WS_W_MIX) + (size_t)col * DM, DM, lane);
        else if (stage == 6) ref = ALPHA * bf2f(XB[(size_t)row * DM + col]) + wdot((const bf16*)(ws + WS_HID) + (size_t)row * FF, (const bf16*)(ws + WS_W_FFN_D) + (size_t)col * FF, FF, lane);
        else ref = ALPHA * bf2f(XB[(size_t)row * DM + col]) + wdot((const bf16*)(ws + WS_CONCAT1) + (size_t)row * DM, (const bf16*)(ws + WS_W_MIX) + (size_t)DM * DM + (size_t)col * DM, DM, lane);
        if (!okf(a.out[(size_t)row * DM + col], ref, 0.02f, 0.03f)) CHK_FAIL(stage == 3 ? 4 : (stage == 6 ? 7 : 13));
    } else if (stage == 4 || stage == 7 || stage == 12) {
        const int row = hash32(s) % NTOK, li = stage == 4 ? 0 : (stage == 7 ? 1 : 2); const float* o = a.out + (size_t)row * DM; const float* g = a.in[I_LNG] + li * DM; const float* bb = a.in[I_LNB] + li * DM;
        const bf16* xb = stage == 12 ? (const bf16*)(ws + WS_X3B) : XB;
        float s1 = 0.f, s2 = 0.f; bool bad = false;
        for (int k = lane; k < DM; k += 64) { const float z = (o[k] - bb[k]) / g[k]; s1 += z; s2 += z * z; if (xb[(size_t)row * DM + k] != (bf16)f2bf(o[k])) bad = true; }
        s1 = wave_sum(s1) / DM; s2 = wave_sum(s2) / DM;
        if (__any(bad) || !(fabsf(s1) < 1e-3f) || !(fabsf(s2 - 1.0f) < 1e-2f)) CHK_FAIL(stage == 4 ? 5 : (stage == 7 ? 8 : 14));
        if (stage == 12) {
            float lg[8]; for (int e = 0; e < 8; ++e) { float p = 0.f; for (int k = lane; k < DM; k += 64) p += o[k] * a.in[I_ROUTER][k * 8 + e]; lg[e] = wave_sum(p); }
            int e0 = 0; for (int e = 1; e < 8; ++e) if (lg[e] > lg[e0]) e0 = e; int e1 = e0 == 0 ? 1 : 0; for (int e = 0; e < 8; ++e) if (e != e0 && lg[e] > lg[e1]) e1 = e;
            const int re = ((const int*)(ws + WS_ROUTE_E))[row]; const float w0 = ((const float*)(ws + WS_ROUTE_W))[2 * row];
            float third = -3e38f; for (int e = 0; e < 8; ++e) if (e != e0 && e != e1) third = fmaxf(third, lg[e]);
            const bool tie = (lg[e0] - lg[e1] < 1e-4f) || (lg[e1] - third < 1e-4f);
            if (!tie && (re != (e0 | (e1 << 8)) || !okf(w0, 1.0f / (1.0f + expf(lg[e1] - lg[e0])), 1e-3f, 1e-4f))) CHK_FAIL(15);
        }
    } else if (stage == 5) {
        const int row = hash32(s) % NTOK, hc = hash32(s + 1) % FF; const bf16* W = (const bf16*)(ws + WS_W_FFN_GU) + (size_t)((hc >> 7) * 256 + (hc & 127)) * DM;
        const float g = wdot(XB + (size_t)row * DM, W, DM, lane), u = wdot(XB + (size_t)row * DM, W + (size_t)128 * DM, DM, lane);
        if (!okf(bf2f(((const bf16*)(ws + WS_HID))[(size_t)row * FF + hc]), silu_ref(g) * u, 0.02f, 0.01f)) CHK_FAIL(6);
    } else if (stage == 8) {
        const int row = hash32(s) % NTOK, col = hash32(s + 1) % B_IN;
        const float ref = wdot(XB + (size_t)row * DM, (const bf16*)(ws + WS_W_B_IN) + (size_t)col * DM, DM, lane);
        if (!okf(bf2f(((const bf16*)(ws + WS_H1))[(size_t)row * B_IN + col]), ref, 0.02f, 0.02f)) CHK_FAIL(9);
    } else if (stage == 9) {
        const int tok = (s & 3) == 0 ? ((hash32(s) % (NTOK / 256)) * 256 + (hash32(s + 5) & 1 ? 255 : 0)) : hash32(s) % NTOK; const int b = tok / SEQ, pos = tok % SEQ, h = hash32(s + 1) % 6, m = hash32(s + 2) & 1, half = hash32(s + 3) & 1;
        const bf16* H1 = (const bf16*)(ws + WS_H1); const bf16* q = H1 + (size_t)tok * B_IN + 3072 + (m * 6 + h) * 128; const bf16* Kb = H1 + (size_t)b * SEQ * B_IN + (m * 6 + h) * 128; const bf16* Vb = H1 + (size_t)b * SEQ * B_IN + 1536 + h * 256 + half * 128;
        float mx = -3e38f; for (int j = lane; j <= pos; j += 64) { float sc = 0.f; for (int d = 0; d < 128; ++d) sc += bf2f(q[d]) * bf2f(Kb[(size_t)j * B_IN + d]); sc *= 0.08838834764831845f; pl[j] = sc; mx = fmaxf(mx, sc); }
        for (int o = 1; o < 64; o <<= 1) mx = fmaxf(mx, __shfl_xor(mx, o));
        float sum = 0.f; for (int j = lane; j <= pos; j += 64) { const float p = expf(pl[j] - mx); pl[j] = p; sum += p; } sum = wave_sum(sum); __syncthreads();
        bool bad = false;
        for (int dd = 0; dd < 2; ++dd) { const int d = lane + 64 * dd; float o = 0.f; for (int j = 0; j <= pos; ++j) o += pl[j] * bf2f(Vb[(size_t)j * B_IN + d]); o /= sum;
            if (!okf(bf2f(((const bf16*)(ws + WS_AO))[(size_t)tok * 3072 + m * 1536 + h * 256 + half * 128 + d]), o, 0.03f, 0.004f)) bad = true; }
        if (__any(bad)) CHK_FAIL(10);
    } else if (stage == 10) {
        const int tok = hash32(s) % NTOK, h4 = hash32(s + 1) & 3, b = tok / SEQ; const bf16* H1 = (const bf16*)(ws + WS_H1);
        chk_memattn(a, 11, H1 + (size_t)tok * B_IN + 4608 + h4 * 128, (const bf16*)(ws + WS_MEMKV) + (size_t)b * 256 * 2048 + 1024 + h4 * 128, (const bf16*)(ws + WS_CONCAT1) + (size_t)tok * DM + 1536 + h4 * 128, pl, lane);
        const int h = hash32(s + 2) % 6; const bf16* AO = (const bf16*)(ws + WS_AO) + (size_t)tok * 3072;
        float s1 = 0.f, s2 = 0.f; for (int k = lane; k < 128; k += 64) { s1 += a.in[I_LQ1][k] * a.in[I_LK1][k]; s2 += a.in[I_LQ2][k] * a.in[I_LK2][k]; } s1 = wave_sum(s1); s2 = wave_sum(s2);
        const float lam = expf(s1) - expf(s2) + LAMBDA_INIT; float x[4], ss = 0.f;
        for (int i = 0; i < 4; ++i) { const int d = lane + 64 * i; x[i] = bf2f(AO[h * 256 + d]) - lam * bf2f(AO[1536 + h * 256 + d]); ss += x[i] * x[i]; } ss = wave_sum(ss);
        bool bad = false; for (int i = 0; i < 4; ++i) { const int d = lane + 64 * i; const float ref = x[i] / sqrtf(ss / 256.f + LN_EPS) * a.in[I_SUBLN][d] * (1.0f - LAMBDA_INIT);
            if (!okf(bf2f(((const bf16*)(ws + WS_CONCAT1))[(size_t)tok * DM + h * 256 + d]), ref, 0.02f, 0.01f)) bad = true; }
        if (__any(bad)) CHK_FAIL(12);
    } else if (stage == 13 || stage == 14 || stage == 15) {
        const int tok = hash32(s) % NTOK, k = hash32(s + 1) & 1; const int slot = ((const int*)(ws + WS_TOKSLOT))[2 * tok + k]; const int* tab = (const int*)(ws + WS_MOETAB);
        const int e = (((const int*)(ws + WS_ROUTE_E))[tok] >> (8 * k)) & 0xff; const float gate = ((const float*)(ws + WS_ROUTE_W))[2 * tok + k];
        if (stage == 13) {
            bool bad = slot < 0 || slot >= MAXT * 256;
            if (!bad) { const int tile = slot >> 8; int te = 0; for (int j = 1; j < 8; ++j) te += tile >= tab[j]; bad = te != e || tile >= tab[8] || ((const int*)(ws + WS_SLOTTOK))[slot] != tok || ((const float*)(ws + WS_SLOTGATE))[slot] != gate;
                for (int j = lane; j < DM; j += 64) if (((const bf16*)(ws + WS_XS))[(size_t)slot * DM + j] != ((const bf16*)(ws + WS_X3B))[(size_t)tok * DM + j]) bad = true; }
            if (__any(bad)) CHK_FAIL(16);
        } else { const int loc = slot - chunk * MOE_CHUNK_T * 256;
            if (loc >= 0 && loc < MOE_CHUNK_T * 256) {
                if (stage == 14) { const int hc = hash32(s + 2) % FFE; const bf16* W = (const bf16*)(ws + WS_W_MOE_GU) + ((size_t)e * 2 * FFE + (hc >> 7) * 256 + (hc & 127)) * DM; const bf16* x = (const bf16*)(ws + WS_XS) + (size_t)slot * DM;
                    const float g = wdot(x, W, DM, lane), u = wdot(x, W + (size_t)128 * DM, DM, lane);
                    if (!okf(bf2f(((const bf16*)(ws + WS_HIDM))[(size_t)loc * FFE + hc]), silu_ref(g) * u, 0.02f, 0.01f)) CHK_FAIL(17);
                } else { const int col = hash32(s + 2) % DM; const float ref = gate * wdot((const bf16*)(ws + WS_HIDM) + (size_t)loc * FFE, (const bf16*)(ws + WS_W_MOE_D) + ((size_t)e * DM + col) * FFE, FFE, lane);
                    if (!okf(bf2f(((const bf16*)(ws + WS_OS))[(size_t)slot * DM + col]), ref, 0.02f, 0.004f)) CHK_FAIL(18); } } }
    }
}
__global__ void fin_kernel(Args a, int complete) {
    const unsigned* c = (const unsigned*)(a.ws + WS_CTL) + CW_CHK; int first = -1; for (int i = 0; i < 32; ++i) if (c[i] && first < 0) first = i;
    const unsigned* ctl = (const unsigned*)(a.ws + WS_CTL); if (first < 0 && (ctl[CW_TMO] || ctl[CW_BAR + XB_TMO])) first = 30;
    if (first < 0 && complete) return;
    const float v = sqrtf(first < 0 ? 76.0f : 10.0f + first);
    for (size_t i = (size_t)blockIdx.x * blockDim.x + threadIdx.x; i < (size_t)NTOK * DM; i += (size_t)gridDim.x * blockDim.x) a.out[i] = v;
}
#endif

extern "C" void kernel_launch(void* const* d_in, const int* in_sizes, int n_in, void* d_out, int out_size, void* d_ws, size_t ws_size, hipStream_t stream) {
    static int grid = 0;
    if (grid == 0) {
        if (n_in != 25 || in_sizes[0] != NTOK * DM || out_size != NTOK * DM || ws_size < WS_END) { fprintf(stderr, "kernel_launch: unexpected shapes (n_in %d, in0 %d, out %d, ws %zu < %zu); nothing launched\n", n_in, n_in > 0 ? in_sizes[0] : -1, out_size, ws_size, (size_t)WS_END); grid = -1; return; }
        int dev = 0, cus = 0, per_cu = 0;
        if (hipGetDevice(&dev) != hipSuccess || hipDeviceGetAttribute(&cus, hipDeviceAttributeMultiprocessorCount, dev) != hipSuccess) { grid = -1; return; }
        if (hipFuncSetAttribute((const void*)mk_fwd, hipFuncAttributeMaxDynamicSharedMemorySize, LDS_BYTES) != hipSuccess) { fprintf(stderr, "kernel_launch: hipFuncSetAttribute failed\n"); grid = -1; return; }
        if (hipOccupancyMaxActiveBlocksPerMultiprocessor(&per_cu, (const void*)mk_fwd, NWAVES * 64, LDS_BYTES) != hipSuccess || per_cu < 1) fprintf(stderr, "kernel_launch: occupancy query reports %d\n", per_cu);
        (void)hipGetLastError();
        grid = cus;
    }
    if (grid < 0) return;
    if (hipMemsetAsync((char*)d_ws + WS_CTL, 0, CTL_ZERO_BYTES, stream) != hipSuccess) return;
    Args a{};
    for (int i = 0; i < 25; ++i) a.in[i] = (const float*)d_in[i];
    a.out = (float*)d_out; a.ws = (unsigned char*)d_ws;
#if MK_DEBUG
    const int last = MK_LAST_PHASE;
    auto run = [&](int ph, int ch) { a.ph_lo = ph; a.ph_hi = ph + 1; a.ch_lo = ch; a.ch_hi = ch + 1; hipLaunchKernelGGL(mk_fwd, dim3(grid), dim3(NWAVES * 64), LDS_BYTES, stream, a); };
    auto chk = [&](int stage, int ch) { hipLaunchKernelGGL(chk_kernel, dim3(1024), dim3(64), 0, stream, a, stage, ch); };
    for (int ph = 0; ph <= last && ph <= 13; ++ph) { run(ph, 0); chk(ph, 0); }
    if (last >= 14) for (int ch = 0; ch < 2; ++ch) { run(14, ch); chk(14, ch); if (last >= 15) { run(15, ch); chk(15, ch); } }
    if (last >= 16) run(16, 0);
    hipLaunchKernelGGL(fin_kernel, dim3(1024), dim3(256), 0, stream, a, last >= 16 ? 1 : 0);
#else
    a.ph_lo = 0; a.ph_hi = 17; a.ch_lo = 0; a.ch_hi = 2;
    hipLaunchKernelGGL(mk_fwd, dim3(grid), dim3(NWAVES * 64), LDS_BYTES, stream, a);
#endif
}
```

```cpp
#include <hip/hip_runtime.h>
#include <hip/hip_bf16.h>
#include <cstdio>
#include <cstdint>

#ifndef MK_DEBUG
#define MK_DEBUG 0
#endif
#ifndef MK_FP8_MOE
#define MK_FP8_MOE 1
#endif
#ifndef MK_PHMASK
#define MK_PHMASK 0x1ffff
#endif
#ifndef MK_LAST_PHASE
#define MK_LAST_PHASE 18
#endif

__device__ __forceinline__ int mk_lane() { int r; asm volatile("v_mbcnt_lo_u32_b32 %0, -1, 0\n\tv_mbcnt_hi_u32_b32 %0, -1, %0" : "=v"(r)); return r; }
namespace pg8 {
#define PG8_LAS __attribute__((address_space(3)))
typedef unsigned short bf16_t;
typedef short bf16x8 __attribute__((ext_vector_type(8)));
typedef float f32x4 __attribute__((ext_vector_type(4)));
typedef float f32x2 __attribute__((ext_vector_type(2)));
typedef unsigned u32x4 __attribute__((ext_vector_type(4)));
typedef int v4i_t __attribute__((ext_vector_type(4)));
constexpr int BM = 256, BK = 64, HALF = 128, HTB = HALF * BK * 2  , STAGE_BYTES = 8 * HTB, NXCD = 8, WGM = 8;

__host__ __device__ __forceinline__ int lds_byte(int r, int c) { const int st = (r >> 4) * 2 + (c >> 5), rr = r & 15, cc = c & 31, ob = rr * 64 + cc * 2; return st * 1024 + (ob ^ (((ob >> 9) & 1) << 5)); }
__host__ __device__ __forceinline__ void stage_rc(int b, int& R, int& C) { const int st = b / 1024, sb = b % 1024, swz = sb ^ (((sb >> 9) & 1) << 5); R = (st >> 1) * 16 + swz / 64; C = (st & 1) * 32 + (swz % 64) / 2; }
__host__ __device__ __forceinline__ int perm32(int rho) { const int n = rho >> 4, i = rho & 15; return 8 * (i >> 2) + 4 * n + (i & 3); }

struct Unit { int pa, pb, pm, pn; };
struct Gemm { const bf16_t* A; const bf16_t* Bt; int M, N, K; };

__host__ __device__ __forceinline__ void tile_of(int wgid, int nM, int nN, int& pm, int& pn) {
    const int nwg = nM * nN;
    { const int q = nwg / NXCD, r = nwg % NXCD, xcd = wgid % NXCD, off = wgid / NXCD; wgid = (xcd < r ? xcd * (q + 1) : r * (q + 1) + (xcd - r) * q) + off; }
    const int nig = WGM * nN, gid = wgid / nig, fm = gid * WGM, gsz = (nM - fm) < WGM ? (nM - fm) : WGM;
    pm = fm + ((wgid % nig) % gsz); pn = (wgid % nig) / gsz;
}
struct StaticOrder {
    int nM, nN, nwg, G, c;
    __host__ __device__ void init(int M, int N, int G_, int c_) { nM = M / BM; nN = N / BM; nwg = nM * nN; G = G_; c = c_; }
    __host__ __device__ bool next(int i, Unit& u) const {
        const long L = (long)i * G + c; if (L >= nwg) return false;
        int pm, pn; tile_of((int)L, nM, nN, pm, pn); u.pa = pm; u.pb = pn; u.pm = pm; u.pn = pn; return true;
    }
    __device__ __forceinline__ void a_ready(const Unit&) const {}
    __device__ __forceinline__ void done(const Unit&) const {}
};
template <bool A_LOCAL> struct MoeOrder {
    int nM, nN, nwg, G, c, t0; const PG8_LAS int* tstart;
    __device__ bool next(int i, Unit& u) const {
        const long L = (long)i * G + c; if (L >= nwg) return false;
        int pm, pn; tile_of((int)L, nM, nN, pm, pn); const int t = t0 + pm; int e = 0;
#pragma unroll
        for (int j = 1; j < 8; ++j) e += (t >= tstart[j]) ? 1 : 0;
        u.pa = A_LOCAL ? pm : t; u.pm = A_LOCAL ? t : pm; u.pb = e * nN + pn; u.pn = pn; return true;
    }
    __device__ __forceinline__ void a_ready(const Unit&) const {}
    __device__ __forceinline__ void done(const Unit&) const {}
};

__device__ __forceinline__ unsigned cvt_pk_bf16(float lo, float hi) { unsigned r; asm volatile("v_cvt_pk_bf16_f32 %0, %1, %2" : "=v"(r) : "v"(lo), "v"(hi)); return r; }
__device__ __forceinline__ float gelu_tanh(float x) { const float u = x * (1.0f + 0.044715f * x * x); const float e = __builtin_amdgcn_exp2f(-2.302208198f * u); return x * __builtin_amdgcn_rcpf(1.0f + e); }
__device__ __forceinline__ float silu_f(float x) { const float e = __builtin_amdgcn_exp2f(-1.4426950409f * x); return x * __builtin_amdgcn_rcpf(1.0f + e); }

struct EpiBf16 {
    static constexpr bool PERM = true, AFTER_DRAIN = false;
    bf16_t* O; int ldc; int gelu_cols;
    __device__ __forceinline__ void operator()(const f32x4 (&acc)[2][2][4][2], const Unit& u, int wr, int wc, int fr, int fq) const {
        const int row0 = u.pm * BM + wr * 64 + fr, col0 = u.pn * BM + wc * 32 + 8 * fq; const bool act = (u.pn * BM) < gelu_cols;
#pragma unroll
        for (int ai = 0; ai < 2; ++ai)
#pragma unroll
            for (int m = 0; m < 4; ++m) { bf16_t* rowp = O + (size_t)(row0 + ai * HALF + m * 16) * ldc + col0;
#pragma unroll
                for (int bj = 0; bj < 2; ++bj) { f32x4 v0 = acc[ai][bj][m][0], v1 = acc[ai][bj][m][1];
                    if (act) {
#pragma unroll
                        for (int j = 0; j < 4; ++j) { v0[j] = gelu_tanh(v0[j]); v1[j] = gelu_tanh(v1[j]); } }
                    u32x4 w; w.x = cvt_pk_bf16(v0[0], v0[1]); w.y = cvt_pk_bf16(v0[2], v0[3]); w.z = cvt_pk_bf16(v1[0], v1[1]); w.w = cvt_pk_bf16(v1[2], v1[3]);
                    *(u32x4*)(rowp + bj * HALF) = w; } }
    }
};
struct EpiRes {
    static constexpr bool PERM = false, AFTER_DRAIN = false;
    const float* base; float* out; int ldc; float alpha;
    __device__ __forceinline__ void operator()(const f32x4 (&acc)[2][2][4][2], const Unit& u, int wr, int wc, int fr, int fq) const {
        const int row0 = u.pm * BM + wr * 64 + fr, col0 = u.pn * BM + wc * 32 + 4 * fq;
#pragma unroll
        for (int ai = 0; ai < 2; ++ai)
#pragma unroll
            for (int m = 0; m < 4; ++m) { const size_t off = (size_t)(row0 + ai * HALF + m * 16) * ldc + col0;
                f32x4 b[2][2];
#pragma unroll
                for (int bj = 0; bj < 2; ++bj)
#pragma unroll
                    for (int n = 0; n < 2; ++n) b[bj][n] = *(const f32x4*)(base + off + bj * HALF + n * 16);
#pragma unroll
                for (int bj = 0; bj < 2; ++bj)
#pragma unroll
                    for (int n = 0; n < 2; ++n) *(f32x4*)(out + off + bj * HALF + n * 16) = b[bj][n] * alpha + acc[ai][bj][m][n];
                asm volatile("" ::: "memory"); }
    }
};
struct EpiSwiglu {
    static constexpr bool PERM = true, AFTER_DRAIN = false;
    bf16_t* H; int ldh;
    __device__ __forceinline__ void operator()(const f32x4 (&acc)[2][2][4][2], const Unit& u, int wr, int wc, int fr, int fq) const {
        const int row0 = u.pm * BM + wr * 64 + fr, col0 = u.pn * HALF + wc * 32 + 8 * fq;
#pragma unroll
        for (int ai = 0; ai < 2; ++ai)
#pragma unroll
            for (int m = 0; m < 4; ++m) { bf16_t* rowp = H + (size_t)(row0 + ai * HALF + m * 16) * ldh + col0;
                f32x4 v0, v1;
#pragma unroll
                for (int j = 0; j < 4; ++j) { v0[j] = silu_f(acc[ai][0][m][0][j]) * acc[ai][1][m][0][j]; v1[j] = silu_f(acc[ai][0][m][1][j]) * acc[ai][1][m][1][j]; }
                u32x4 w; w.x = cvt_pk_bf16(v0[0], v0[1]); w.y = cvt_pk_bf16(v0[2], v0[3]); w.z = cvt_pk_bf16(v1[0], v1[1]); w.w = cvt_pk_bf16(v1[2], v1[3]);
                *(u32x4*)rowp = w; }
    }
};
struct EpiSwiglu8 {
    static constexpr bool PERM = true, AFTER_DRAIN = false;
    unsigned char* H; int ldh; float mul;
    __device__ __forceinline__ void operator()(const f32x4 (&acc)[2][2][4][2], const Unit& u, int wr, int wc, int fr, int fq) const {
        const int row0 = u.pm * BM + wr * 64 + fr, col0 = u.pn * HALF + wc * 32 + 8 * fq;
#pragma unroll
        for (int ai = 0; ai < 2; ++ai)
#pragma unroll
            for (int m = 0; m < 4; ++m) { unsigned char* rowp = H + (size_t)(row0 + ai * HALF + m * 16) * ldh + col0;
                f32x4 v0, v1;
#pragma unroll
                for (int j = 0; j < 4; ++j) { v0[j] = silu_f(acc[ai][0][m][0][j]) * acc[ai][1][m][0][j] * mul; v1[j] = silu_f(acc[ai][0][m][1][j]) * acc[ai][1][m][1][j] * mul; }
                int w0 = 0, w1 = 0;
                w0 = __builtin_amdgcn_cvt_pk_fp8_f32(v0[0], v0[1], w0, false); w0 = __builtin_amdgcn_cvt_pk_fp8_f32(v0[2], v0[3], w0, true);
                w1 = __builtin_amdgcn_cvt_pk_fp8_f32(v1[0], v1[1], w1, false); w1 = __builtin_amdgcn_cvt_pk_fp8_f32(v1[2], v1[3], w1, true);
                *(unsigned long long*)rowp = (unsigned long long)(unsigned)w0 | ((unsigned long long)(unsigned)w1 << 32); }
    }
};
struct EpiRowScale {
    static constexpr bool PERM = true, AFTER_DRAIN = false;
    bf16_t* O; int ldc; const float* rs;
    __device__ __forceinline__ void operator()(const f32x4 (&acc)[2][2][4][2], const Unit& u, int wr, int wc, int fr, int fq) const {
        const int row0 = u.pm * BM + wr * 64 + fr, col0 = u.pn * BM + wc * 32 + 8 * fq;
#pragma unroll
        for (int ai = 0; ai < 2; ++ai)
#pragma unroll
            for (int m = 0; m < 4; ++m) { const int row = row0 + ai * HALF + m * 16; const float s = rs[row]; bf16_t* rowp = O + (size_t)row * ldc + col0;
#pragma unroll
                for (int bj = 0; bj < 2; ++bj) { const f32x4 v0 = acc[ai][bj][m][0] * s, v1 = acc[ai][bj][m][1] * s;
                    u32x4 w; w.x = cvt_pk_bf16(v0[0], v0[1]); w.y = cvt_pk_bf16(v0[2], v0[3]); w.z = cvt_pk_bf16(v1[0], v1[1]); w.w = cvt_pk_bf16(v1[2], v1[3]);
                    *(u32x4*)(rowp + bj * HALF) = w; } }
    }
};

template <class Epi, class Sched, bool ALIGN_EPI = false, bool SP2 = false, int SCA = 0, int SCB = 0>
__device__ __forceinline__ void gemm_phase(PG8_LAS unsigned char* lds, const Gemm g, const Sched& S, const Epi& E, const int mk_wid) {
    const int wid = mk_wid, lane = mk_lane(), tid = wid * 64 + lane, wr = wid >> 2, wc = wid & 3, fr = lane & 15, fq = lane >> 4;
    const int K = g.K, nt = K / BK;
    unsigned voffA[2], voffB[2];
#pragma unroll
    for (int i = 0; i < 2; ++i) { int R, C; stage_rc(tid * 16 + i * 8192, R, C); const int Rb = Epi::PERM ? ((R & ~31) + perm32(R & 31)) : R;
        voffA[i] = (unsigned)(R * K + C) * 2u; voffB[i] = (unsigned)(Rb * K + C) * 2u; }
    const size_t kstep = (size_t)(BK * 2);
    const size_t hstep = (size_t)HALF * K * 2;
    const size_t tstep = 2 * hstep;
    const unsigned ldsw = (unsigned)wid * 1024u;
    const int aoff = lds_byte(wr * 64 + fr, fq * 8), boff = lds_byte(wc * 32 + fr, fq * 8);
#define PG8_SA(b, h) (((b) * 2 + (h)) * HTB)
#define PG8_SB(b, h) ((4 + (b) * 2 + (h)) * HTB)
#define PG8_STAGE(bufoff, gbase, voff) do { _Pragma("unroll") for (int _i = 0; _i < 2; ++_i) \
        __builtin_amdgcn_global_load_lds((const unsigned*)((const char*)(gbase) + (voff)[_i]), (PG8_LAS unsigned*)(lds + (bufoff) + ldsw + _i * 8192), 16, 0, 0); } while (0)
#define PG8_LDA(dst, b, h) do { _Pragma("unroll") for (int m = 0; m < 4; ++m) _Pragma("unroll") for (int k = 0; k < 2; ++k) dst[m][k] = *(const PG8_LAS bf16x8*)(lds + PG8_SA(b, h) + aoff + m * 2048 + k * 1024); } while (0)
#define PG8_LDB(dst, b, h) do { _Pragma("unroll") for (int n = 0; n < 2; ++n) _Pragma("unroll") for (int k = 0; k < 2; ++k) dst[n][k] = *(const PG8_LAS bf16x8*)(lds + PG8_SB(b, h) + boff + n * 2048 + k * 1024); } while (0)
#define PG8_CAT8(x, y) __builtin_shufflevector(__builtin_bit_cast(v4i_t, x), __builtin_bit_cast(v4i_t, y), 0, 1, 2, 3, 4, 5, 6, 7)
#define PG8_MMA(ai, bj, At, Bt) do { __builtin_amdgcn_s_setprio(1); \
        if constexpr (SCA != 0) { _Pragma("unroll") for (int m = 0; m < 4; ++m) _Pragma("unroll") for (int n = 0; n < 2; ++n) \
            asm volatile("s_nop 1\n\tv_mfma_scale_f32_16x16x128_f8f6f4 %0, %1, %2, %0, %3, %4 op_sel_hi:[0,0,0]" : "+v"(acc[ai][bj][m][n]) : "v"(PG8_CAT8(Bt[n][0], Bt[n][1])), "v"(PG8_CAT8(At[m][0], At[m][1])), "v"(scb_), "v"(sca_)); } \
        else { _Pragma("unroll") for (int m = 0; m < 4; ++m) _Pragma("unroll") for (int n = 0; n < 2; ++n) _Pragma("unroll") for (int k = 0; k < 2; ++k) \
            acc[ai][bj][m][n] = __builtin_amdgcn_mfma_f32_16x16x32_bf16(Bt[n][k], At[m][k], acc[ai][bj][m][n], 0, 0, 0); } \
        __builtin_amdgcn_s_setprio(0); } while (0)
#define PG8_WAIT_V(n) asm volatile("s_waitcnt vmcnt(" #n ")" ::: "memory")
#define PG8_WAIT_L(n) asm volatile("s_waitcnt lgkmcnt(" #n ")" ::: "memory")
#define PG8_BAR __builtin_amdgcn_s_barrier()
#define PG8_SCHED __builtin_amdgcn_sched_barrier(0)
    Unit cur, nxt; int ui = 0;
    if (!S.next(0, cur)) return;
    f32x4 acc[2][2][4][2];
#pragma unroll
    for (int a = 0; a < 2; ++a)
#pragma unroll
        for (int b = 0; b < 2; ++b)
#pragma unroll
            for (int m = 0; m < 4; ++m)
#pragma unroll
                for (int n = 0; n < 2; ++n) acc[a][b][m][n] = (f32x4){0.f, 0.f, 0.f, 0.f};
    bf16x8 At[4][2], B0[2][2], B1[2][2];
    const int sca_ = SCA, scb_ = SCB;
    const char* cA = (const char*)g.A + (size_t)cur.pa * tstep; const char* cB = (const char*)g.Bt + (size_t)cur.pb * tstep;
    S.a_ready(cur);
    if constexpr (SP2) {
        PG8_STAGE(PG8_SB(0, 0), cB, voffB); PG8_STAGE(PG8_SB(0, 1), cB + hstep, voffB); PG8_STAGE(PG8_SA(0, 0), cA, voffA); PG8_STAGE(PG8_SA(0, 1), cA + hstep, voffA);
        if (wr == 1) PG8_BAR;
        PG8_WAIT_V(2); PG8_BAR;
        PG8_STAGE(PG8_SB(1, 0), cB + kstep, voffB); PG8_STAGE(PG8_SA(1, 0), cA + kstep, voffA); PG8_STAGE(PG8_SB(1, 1), cB + hstep + kstep, voffB);
        PG8_WAIT_V(6); PG8_BAR;
    } else {
        PG8_STAGE(PG8_SB(0, 0), cB, voffB); PG8_STAGE(PG8_SA(0, 0), cA, voffA); PG8_STAGE(PG8_SB(0, 1), cB + hstep, voffB); PG8_STAGE(PG8_SA(0, 1), cA + hstep, voffA);
        if (wr == 1) PG8_BAR;
        PG8_WAIT_V(4); PG8_BAR;
        PG8_STAGE(PG8_SB(1, 0), cB + kstep, voffB); PG8_STAGE(PG8_SA(1, 0), cA + kstep, voffA); PG8_STAGE(PG8_SB(1, 1), cB + hstep + kstep, voffB);
        PG8_WAIT_V(6); PG8_BAR;
    }
    for (;;) {
        const bool has_next = S.next(ui + 1, nxt);
        const char* nA = has_next ? (const char*)g.A + (size_t)nxt.pa * tstep : cA; const char* nB = has_next ? (const char*)g.Bt + (size_t)nxt.pb * tstep : cB;
        for (int t = 0; t < nt; t += 2) {
            const bool last = (t == nt - 2);
            const char* a1 = cA + (size_t)(t + 1) * kstep;
            const char* a2 = last ? nA : cA + (size_t)(t + 2) * kstep; const char* b2 = last ? nB : cB + (size_t)(t + 2) * kstep;
            const char* a3 = a2 + kstep; const char* b3 = b2 + kstep;
            if (last && has_next) S.a_ready(nxt);
            if constexpr (SP2) {
            PG8_LDB(B0, 0, 0); PG8_LDB(B1, 0, 1); PG8_SCHED; PG8_LDA(At, 0, 0); PG8_STAGE(PG8_SA(1, 1), a1 + hstep, voffA);
            PG8_WAIT_V(8); PG8_WAIT_L(0); PG8_BAR; PG8_MMA(0, 0, At, B0); PG8_MMA(0, 1, At, B1); PG8_BAR; PG8_SCHED;
            PG8_LDA(At, 0, 1); PG8_STAGE(PG8_SB(0, 0), b2, voffB); PG8_STAGE(PG8_SB(0, 1), b2 + hstep, voffB); PG8_STAGE(PG8_SA(0, 0), a2, voffA);
            PG8_WAIT_V(8); PG8_WAIT_L(0); PG8_BAR; PG8_MMA(1, 0, At, B0); PG8_MMA(1, 1, At, B1); PG8_BAR; PG8_SCHED;
            PG8_LDB(B0, 1, 0); PG8_LDB(B1, 1, 1); PG8_SCHED; PG8_LDA(At, 1, 0); PG8_STAGE(PG8_SA(0, 1), a2 + hstep, voffA);
            PG8_WAIT_V(8); PG8_WAIT_L(0); PG8_BAR; PG8_MMA(0, 0, At, B0); PG8_MMA(0, 1, At, B1); PG8_BAR; PG8_SCHED;
            PG8_LDA(At, 1, 1); PG8_STAGE(PG8_SB(1, 0), b3, voffB); PG8_STAGE(PG8_SB(1, 1), b3 + hstep, voffB); PG8_STAGE(PG8_SA(1, 0), a3, voffA);
            PG8_WAIT_V(8); PG8_WAIT_L(0); PG8_BAR; PG8_MMA(1, 0, At, B0); PG8_MMA(1, 1, At, B1); PG8_BAR; PG8_SCHED;
            } else {
            PG8_LDB(B0, 0, 0); PG8_SCHED; PG8_LDA(At, 0, 0); PG8_STAGE(PG8_SA(1, 1), a1 + hstep, voffA);
            PG8_WAIT_L(8); PG8_BAR; PG8_WAIT_L(0); PG8_MMA(0, 0, At, B0); PG8_BAR; PG8_SCHED;
            PG8_LDB(B1, 0, 1); PG8_STAGE(PG8_SB(0, 0), b2, voffB);
            PG8_BAR; PG8_WAIT_L(0); PG8_MMA(0, 1, At, B1); PG8_BAR;
            PG8_LDA(At, 0, 1); PG8_STAGE(PG8_SA(0, 0), a2, voffA);
            PG8_BAR; PG8_WAIT_L(0); PG8_MMA(1, 0, At, B0); PG8_BAR; PG8_SCHED;
            PG8_STAGE(PG8_SB(0, 1), b2 + hstep, voffB);
            PG8_WAIT_V(6); PG8_BAR; PG8_MMA(1, 1, At, B1); PG8_BAR;
            PG8_LDB(B0, 1, 0); PG8_SCHED; PG8_LDA(At, 1, 0); PG8_STAGE(PG8_SA(0, 1), a2 + hstep, voffA);
            PG8_WAIT_L(8); PG8_BAR; PG8_WAIT_L(0); PG8_MMA(0, 0, At, B0); PG8_BAR; PG8_SCHED;
            PG8_LDB(B1, 1, 1); PG8_STAGE(PG8_SB(1, 0), b3, voffB);
            PG8_BAR; PG8_WAIT_L(0); PG8_MMA(0, 1, At, B1); PG8_BAR;
            PG8_LDA(At, 1, 1); PG8_STAGE(PG8_SA(1, 0), a3, voffA);
            PG8_BAR; PG8_WAIT_L(0); PG8_MMA(1, 0, At, B0); PG8_BAR; PG8_SCHED;
            PG8_STAGE(PG8_SB(1, 1), b3 + hstep, voffB);
            PG8_WAIT_V(6); PG8_BAR; PG8_MMA(1, 1, At, B1); PG8_BAR;
            }
        }
        if constexpr (SCA != 0) asm volatile("s_nop 15\n\ts_nop 15" ::: "memory");
        if constexpr (ALIGN_EPI) { if (wr == 0) PG8_BAR; }
        if constexpr (!Epi::AFTER_DRAIN) { E(acc, cur, wr, wc, fr, fq); S.done(cur); }
        if (!has_next) break;
#pragma unroll
        for (int a = 0; a < 2; ++a)
#pragma unroll
            for (int b = 0; b < 2; ++b)
#pragma unroll
                for (int m = 0; m < 4; ++m)
#pragma unroll
                    for (int n = 0; n < 2; ++n) acc[a][b][m][n] = (f32x4){0.f, 0.f, 0.f, 0.f};
        cur = nxt; cA = nA; cB = nB; ++ui;
        if constexpr (ALIGN_EPI) { if (wr == 1) PG8_BAR; }
    }
    PG8_WAIT_V(0);
    if constexpr (!ALIGN_EPI) { if (wr == 0) PG8_BAR; }
    PG8_BAR;
    if constexpr (Epi::AFTER_DRAIN) { E.fused(acc, cur, wr, wc, fr, fq, lds, wid, lane); S.done(cur); }
#undef PG8_SA
#undef PG8_SB
#undef PG8_STAGE
#undef PG8_LDA
#undef PG8_LDB
#undef PG8_MMA
#undef PG8_CAT8
#undef PG8_WAIT_V
#undef PG8_WAIT_L
#undef PG8_BAR
#undef PG8_SCHED
}
}

namespace at128 {
constexpr int D = 128;
constexpr float THR = 8.f;
constexpr bool WSKIP = false;
constexpr float SCALE = 0.08838834764831845f;
constexpr int NW = 8, QBLK = 32, KVBLK = 64, QB = NW * QBLK;
constexpr int SHM_V = KVBLK * D * 2, SHM_K = KVBLK * D * 2;
constexpr int LDS_BYTES = 2 * SHM_V + 2 * SHM_K + NW * 64 * 4;

using bf16 = __hip_bfloat16;
typedef short bf16x8 __attribute__((ext_vector_type(8)));
typedef short s16x4 __attribute__((ext_vector_type(4)));
typedef float f32x16 __attribute__((ext_vector_type(16)));
typedef float f32x4 __attribute__((ext_vector_type(4)));
typedef unsigned u32x4 __attribute__((ext_vector_type(4)));
template <class A, class Bt> struct same_t { static constexpr bool v = false; };
template <class A> struct same_t<A, A> { static constexpr bool v = true; };

#define KSWZ(row, colB) ((row) * 256 + ((colB) ^ (((row) & 7) << 4)))
#define SBAR() __builtin_amdgcn_sched_barrier(0)
__device__ __forceinline__ int v_st(int k, int c) { const int kk = (k & ~0xC) | ((k & 4) << 1) | ((k & 8) >> 1); return ((kk >> 3) * 4 + (c >> 5)) * 512 + ((kk & 7) * 32 + (c & 31)) * 2; }
__device__ __forceinline__ int v_rd_base(int lane) { return ((lane & 3) << 3) | (((lane >> 2) & 3) << 6) | (((lane >> 4) & 1) << 5) | (((lane >> 5) & 1) << 8); }
constexpr int v_rd_off(int d0, int ks, int half) { return d0 * 512 + ks * 4096 + half * 2048; }
__device__ __forceinline__ int crow(int r, int hi) { return (r & 3) + 8 * (r >> 2) + 4 * hi; }
__device__ __forceinline__ unsigned cvtpk(float lo, float hi) {
    unsigned r; asm volatile("v_cvt_pk_bf16_f32 %0, %1, %2" : "=v"(r) : "v"(lo), "v"(hi)); return r;
}
__device__ __forceinline__ bf16x8 pack8(f32x4 a, f32x4 b) {
    u32x4 w = {cvtpk(a[0], a[1]), cvtpk(a[2], a[3]), cvtpk(b[0], b[1]), cvtpk(b[2], b[3])};
    return *reinterpret_cast<bf16x8*>(&w);
}
template <class T> __device__ __forceinline__ bf16x8 load8(const T* p) {
    if constexpr (same_t<T, float>::v) { return pack8(*(const f32x4*)p, *(const f32x4*)(p + 4)); }
    else { return *reinterpret_cast<const bf16x8*>(p); }
}
__device__ __forceinline__ void mask_tile(f32x16& p0, f32x16& p1, int dq, unsigned W) {
    const float NEG = -__builtin_inff();
#pragma unroll
    for (int r = 0; r < 16; ++r) {
        const int c = (r & 3) + 8 * (r >> 2);
        if ((unsigned)(dq - c) >= W) p0[r] = NEG;
        if ((unsigned)(dq - c - 32) >= W) p1[r] = NEG;
    }
}
__device__ __forceinline__ void partialSM(f32x16& p0, f32x16& p1, float& m_reg, float& mn, float& alpha) {
    float pmax = p0[0]; for (int r = 1; r < 16; ++r) pmax = fmaxf(pmax, p0[r]); for (int r = 0; r < 16; ++r) pmax = fmaxf(pmax, p1[r]);
    { auto rr = __builtin_amdgcn_permlane32_swap(__float_as_uint(pmax), __float_as_uint(pmax), false, false);
      pmax = fmaxf(__uint_as_float(rr[0]), __uint_as_float(rr[1])); }
    constexpr float C2 = 1.4426950408889634f * SCALE;
    if (__builtin_expect(__all((pmax - m_reg) * SCALE <= THR), 1)) { mn = m_reg; alpha = 1.f; }
    else { mn = fmaxf(m_reg, pmax); alpha = __builtin_amdgcn_exp2f((m_reg - mn) * C2); m_reg = mn; }
    const float mnL = -mn * C2;
    for (int r = 0; r < 16; ++r) p0[r] = fmaf(p0[r], C2, mnL); for (int r = 0; r < 16; ++r) p1[r] = fmaf(p1[r], C2, mnL);
    for (int r = 0; r < 16; ++r) p0[r] = __builtin_amdgcn_exp2f(p0[r]);
}
__device__ __forceinline__ void finishSM(f32x16& p0, f32x16& p1, float alpha, float& l_reg, bf16x8& pa0, bf16x8& pa1, bf16x8& pa2, bf16x8& pa3) {
    for (int r = 0; r < 16; ++r) p1[r] = __builtin_amdgcn_exp2f(p1[r]);
    float ps = 0; for (int r = 0; r < 16; ++r) ps += p0[r]; for (int r = 0; r < 16; ++r) ps += p1[r];
    { auto rr = __builtin_amdgcn_permlane32_swap(__float_as_uint(ps), __float_as_uint(ps), false, false);
      ps = __uint_as_float(rr[0]) + __uint_as_float(rr[1]); }
    l_reg = l_reg * alpha + ps;
#define PK4(P, B_, OUT) do { unsigned a0 = cvtpk(P[B_+0], P[B_+1]), a1 = cvtpk(P[B_+2], P[B_+3]);                          \
        unsigned b0 = cvtpk(P[B_+4], P[B_+5]), b1 = cvtpk(P[B_+6], P[B_+7]);                                             \
        auto r0 = __builtin_amdgcn_permlane32_swap(a0, b0, false, false); auto r1 = __builtin_amdgcn_permlane32_swap(a1, b1, false, false); \
        u32x4 w = {r0[0], r1[0], r0[1], r1[1]}; OUT = *reinterpret_cast<bf16x8*>(&w); } while (0)
    PK4(p0, 0, pa0); PK4(p0, 8, pa1); PK4(p1, 0, pa2); PK4(p1, 8, pa3);
#undef PK4
}
template <int KB, bool SK>
__device__ __forceinline__ void qkt(f32x16& p0, f32x16& p1, const char* K_lds, int r32, int hi, const bf16x8* qr, bool act) {
    if (SK && !act) { const float NEG = -__builtin_inff();
#pragma unroll
        for (int r = 0; r < 16; ++r) { p0[r] = NEG; p1[r] = NEG; } return; }
    p0 = f32x16{}; p1 = f32x16{};
    const char* kb[4];
#pragma unroll
    for (int dd = 0; dd < 4; ++dd) kb[dd] = K_lds + KB * SHM_K + KSWZ(r32, (dd * 16 + hi * 8) * 2);
#pragma unroll
    for (int d0 = 0; d0 < 8; ++d0) { const char* a = kb[d0 & 3] + (d0 >> 2) * 128;
        bf16x8 b0 = *reinterpret_cast<const bf16x8*>(a);
        bf16x8 b1 = *reinterpret_cast<const bf16x8*>(a + 32 * 256);
        p0 = __builtin_amdgcn_mfma_f32_32x32x16_bf16(b0, qr[d0], p0, 0, 0, 0);
        p1 = __builtin_amdgcn_mfma_f32_32x32x16_bf16(b1, qr[d0], p1, 0, 0, 0); }
}
template <int VB, bool SK>
__device__ __forceinline__ void pv_tile(f32x16* o, int vb0, bf16x8 pa0, bf16x8 pa1, bf16x8 pa2, bf16x8 pa3, bool act) {
    if (SK && !act) return;
#define TRRD(dst, off) asm volatile("ds_read_b64_tr_b16 %0, %1 offset:%2" : "=&v"(dst) : "v"(vb0), "i"(off) : "memory")
#define PV_D0(d0) do { s16x4 l0, l1, l2, l3, h0, h1, h2, h3; constexpr int b_ = VB * SHM_V + v_rd_off(d0, 0, 0);     \
        TRRD(l0, b_); TRRD(h0, b_ + 2048); TRRD(l1, b_ + 4096); TRRD(h1, b_ + 6144); TRRD(l2, b_ + 8192); TRRD(h2, b_ + 10240); TRRD(l3, b_ + 12288); TRRD(h3, b_ + 14336); \
        asm volatile("s_waitcnt lgkmcnt(0)" ::: "memory"); SBAR();                 \
        o[d0] = __builtin_amdgcn_mfma_f32_32x32x16_bf16(pa0, (bf16x8){l0[0], l0[1], l0[2], l0[3], h0[0], h0[1], h0[2], h0[3]}, o[d0], 0, 0, 0);   \
        o[d0] = __builtin_amdgcn_mfma_f32_32x32x16_bf16(pa1, (bf16x8){l1[0], l1[1], l1[2], l1[3], h1[0], h1[1], h1[2], h1[3]}, o[d0], 0, 0, 0);   \
        o[d0] = __builtin_amdgcn_mfma_f32_32x32x16_bf16(pa2, (bf16x8){l2[0], l2[1], l2[2], l2[3], h2[0], h2[1], h2[2], h2[3]}, o[d0], 0, 0, 0);   \
        o[d0] = __builtin_amdgcn_mfma_f32_32x32x16_bf16(pa3, (bf16x8){l3[0], l3[1], l3[2], l3[3], h3[0], h3[1], h3[2], h3[3]}, o[d0], 0, 0, 0); } while (0)
    PV_D0(0); PV_D0(1); PV_D0(2); PV_D0(3);
#undef PV_D0
#undef TRRD
}

template <class TIn, class TOut> struct BlockRef { const TIn* Q; const TIn* K; const TIn* V; TOut* O; int P0; };
template <class TIn> struct Seam {
    bf16x8 qr[8];
    bf16x8 st_v0, st_v1, st_k0, st_k1; f32x4 sf0, sf1, sf2, sf3;
    f32x4 tq[16];
};
__device__ __forceinline__ int swa_jlo(int P0, int W) { const int lowk = P0 - W + 1; return lowk > 0 ? lowk / KVBLK : 0; }
#define ROW(p, k0, rr) ((p) + (size_t)((k0) + (rr)) * PKV + sc)
#define VMW() asm volatile("s_waitcnt vmcnt(0)" ::: "memory")
#define VMWN(n) asm volatile("s_waitcnt vmcnt(%0)" :: "i"(n) : "memory")
#define SLOAD_H(Kp, Vp, k0) do { S.st_v0 = load8<TIn>(ROW(Vp, k0, sr)); S.st_v1 = load8<TIn>(ROW(Vp, k0, 32 + sr));              \
                         S.st_k0 = load8<TIn>(ROW(Kp, k0, sr)); S.st_k1 = load8<TIn>(ROW(Kp, k0, 32 + sr)); } while (0)
#define SWRITE_HK(bf) do { *(bf16x8*)(K_lds + (bf) * SHM_K + kws) = S.st_k0; *(bf16x8*)(K_lds + (bf) * SHM_K + kws + 32 * 256) = S.st_k1; } while (0)
#define SWRITE_HV(bf) do { *(bf16x8*)(V_lds + (bf) * SHM_V + vst0) = S.st_v0; *(bf16x8*)(V_lds + (bf) * SHM_V + vst1) = S.st_v1; } while (0)
#define SWRITE_H(bf) do { SWRITE_HV(bf); SWRITE_HK(bf); } while (0)
#define SLOAD_F(p, k0) do { S.sf0 = *(const f32x4*)ROW(p, k0, sr); S.sf1 = *(const f32x4*)(ROW(p, k0, sr) + 4);                \
                            S.sf2 = *(const f32x4*)ROW(p, k0, 32 + sr); S.sf3 = *(const f32x4*)(ROW(p, k0, 32 + sr) + 4); } while (0)
#define SWRITE_KF(bf) do { *(bf16x8*)(K_lds + (bf) * SHM_K + kws) = pack8(S.sf0, S.sf1); *(bf16x8*)(K_lds + (bf) * SHM_K + kws + 32 * 256) = pack8(S.sf2, S.sf3); } while (0)
#define SWRITE_VF(bf) do { *(bf16x8*)(V_lds + (bf) * SHM_V + vst0) = pack8(S.sf0, S.sf1); *(bf16x8*)(V_lds + (bf) * SHM_V + vst1) = pack8(S.sf2, S.sf3); } while (0)
template <class TIn, class TOut, int PQ, int PKV, int PO>
__device__ __forceinline__ void causal_swa_prime(const BlockRef<TIn, TOut>& cur, int W, char* lds, Seam<TIn>& S, const int mk_wid) {
    constexpr bool F32 = same_t<TIn, float>::v;
    const int wid = mk_wid, lane = mk_lane(), tid = wid * 64 + lane, r32 = lane & 31, hi = lane >> 5;
    const int sr = tid >> 4, sc = (tid & 15) * 8, kws = KSWZ(sr, sc * 2); char* K_lds = lds + 2 * SHM_V;
    const int kb0 = swa_jlo(cur.P0, W) * KVBLK;
    for (int d0 = 0; d0 < 8; ++d0) S.qr[d0] = load8<TIn>(cur.Q + (size_t)(wid * QBLK + r32) * PQ + d0 * 16 + hi * 8);
    if constexpr (F32) { SLOAD_F((const float*)cur.K, kb0); VMW(); SWRITE_KF(0); SBAR(); SLOAD_F((const float*)cur.V, kb0); }
    else { SLOAD_H(cur.K, cur.V, kb0); VMW(); SWRITE_HK(0); }
    __syncthreads();
}
template <class TIn, class TOut, int PQ, int PKV, int PO>
__device__ __forceinline__ void causal_swa_block(const BlockRef<TIn, TOut>& cur, const BlockRef<TIn, TOut>& nxt, int skv, int W, char* lds, Seam<TIn>& S, const int mk_wid) {
    constexpr bool F32 = same_t<TIn, float>::v;
    const int wid = mk_wid, lane = mk_lane(), tid = wid * 64 + lane, r32 = lane & 31, hi = lane >> 5;
    const int j_lo = swa_jlo(cur.P0, W);
    int j_hi = (cur.P0 + QB - 1) / KVBLK + 1; if (j_hi > skv / KVBLK) j_hi = skv / KVBLK;
    const int NT = j_hi - j_lo;
    const int kbn = swa_jlo(nxt.P0, W) * KVBLK;
    const int qlo = cur.P0 + wid * QBLK, qm = qlo + r32 - 4 * hi;
    char* V_lds = lds; char* K_lds = lds + 2 * SHM_V;
    float* ws = (float*)(lds + 2 * SHM_V + 2 * SHM_K) + wid * 64; float* li_l = ws, * al_l = ws + 32;
    float m_reg = -1e30f, l_reg = 0; f32x16 o[4] = {};
    const int sr = tid >> 4, sc = (tid & 15) * 8, vst0 = v_st(sr, sc), vst1 = v_st(32 + sr, sc), kws = KSWZ(sr, sc * 2);
    const int vb0 = (int)(uintptr_t)V_lds + v_rd_base(lane);
    const TIn* Kh = cur.K; const TIn* Vh = cur.V;
#define RESC(a) do { if (__any((a) < 1.f)) { if (hi == 0) al_l[r32] = (a); asm volatile("s_waitcnt lgkmcnt(0)" ::: "memory");              \
                     for (int d_ = 0; d_ < 4; ++d_) for (int r = 0; r < 16; ++r) o[d_][r] *= al_l[crow(r, hi)]; } } while (0)
#define KBASE(t) ((j_lo + (t)) * KVBLK)
#define ACT(t) (KBASE(t) <= qlo + QBLK - 1 && KBASE(t) + KVBLK - 1 >= qlo - W + 1)
#define MASKT(P0_, P1_, t) do { const int kb_ = KBASE(t); if ((!SK || ACT(t)) && (kb_ + KVBLK - 1 > qlo || kb_ <= qlo + QBLK - 1 - W)) mask_tile(P0_, P1_, qm - kb_, (unsigned)W); } while (0)
    constexpr int NQL = F32 ? 16 : 8;
    constexpr bool SK = WSKIP && !F32;
#define SEAM_K0() do { VMWN(NQL); if constexpr (F32) { SWRITE_KF(0); SBAR(); SLOAD_F((const float*)nxt.V, kbn); } else { SWRITE_HK(0); } SBAR(); } while (0)
    f32x16 pA0, pA1, pB0, pB1; float mnA, mnB, alA, alB; bf16x8 pa0, pa1, pa2, pa3;
    if constexpr (F32) { VMW(); SWRITE_VF(0); SBAR(); } else { SWRITE_HV(0); SBAR(); }
    if (NT > 1) { if constexpr (F32) SLOAD_F((const float*)Kh, KBASE(1)); else SLOAD_H(Kh, Vh, KBASE(1)); }
    SBAR(); qkt<0, SK>(pA0, pA1, K_lds, r32, hi, S.qr, ACT(0));
    if constexpr (F32) { if (NT > 1) { VMW(); SWRITE_KF(1); SBAR(); SLOAD_F((const float*)Vh, KBASE(1)); } }
    MASKT(pA0, pA1, 0); partialSM(pA0, pA1, m_reg, mnA, alA);
    if (NT > 1) { VMW(); if constexpr (F32) { SWRITE_VF(1); SBAR(); if (NT > 2) SLOAD_F((const float*)Kh, KBASE(2)); } else SWRITE_H(1); }
    __syncthreads();
#define HALF_STEP(PX0, PX1, mnX, alX, PY0, PY1, alY, t, KB, VB, SB) do {                                                      \
        SBAR(); qkt<KB, SK>(PX0, PX1, K_lds, r32, hi, S.qr, ACT(t));                                             \
        finishSM(PY0, PY1, alY, l_reg, pa0, pa1, pa2, pa3); SBAR();                                                           \
        if ((t) + 1 < NT) { if constexpr (F32) { VMW(); SWRITE_KF(SB); SBAR(); SLOAD_F((const float*)Vh, KBASE((t) + 1)); }  \
                            else { SLOAD_H(Kh, Vh, KBASE((t) + 1)); } SBAR(); }                                               \
        pv_tile<VB, SK>(o, vb0, pa0, pa1, pa2, pa3, ACT((t) - 1)); MASKT(PX0, PX1, (t)); partialSM(PX0, PX1, m_reg, mnX, alX);                                        \
        __syncthreads();                                                                                                      \
        if ((t) + 1 < NT) { VMW(); if constexpr (F32) { SWRITE_VF(SB); SBAR(); if ((t) + 2 < NT) SLOAD_F((const float*)Kh, KBASE((t) + 2)); } \
                            else { SWRITE_H(SB); } }                                                                          \
        RESC(alX); __syncthreads(); } while (0)
    for (int t = 1; t + 1 < NT; t += 2) {
        HALF_STEP(pB0, pB1, mnB, alB, pA0, pA1, alA, t, 1, 0, 0);
        HALF_STEP(pA0, pA1, mnA, alA, pB0, pB1, alB, t + 1, 0, 1, 1);
    }
    const bool even = (NT & 1) == 0;
    if (even) { SBAR(); qkt<1, SK>(pB0, pB1, K_lds, r32, hi, S.qr, ACT(NT - 1)); SBAR(); }
#define QROW(e) (nxt.Q + (size_t)(wid * QBLK + r32) * PQ + ((e) >> 1) * 16 + hi * 8 + ((e) & 1) * 4)
    if constexpr (F32) { SLOAD_F((const float*)nxt.K, kbn); SBAR();
#pragma unroll
        for (int e = 0; e < 8; ++e) S.tq[e] = *(const f32x4*)QROW(e); }
    else { SLOAD_H(nxt.K, nxt.V, kbn); SBAR();
#pragma unroll
        for (int d0 = 0; d0 < 8; ++d0) S.qr[d0] = load8<TIn>(nxt.Q + (size_t)(wid * QBLK + r32) * PQ + d0 * 16 + hi * 8); }
    SBAR();
    finishSM(pA0, pA1, alA, l_reg, pa0, pa1, pa2, pa3); SBAR();
    if constexpr (F32) {
#pragma unroll
        for (int e = 8; e < 16; ++e) S.tq[e] = *(const f32x4*)QROW(e); SBAR(); }
#undef QROW
    pv_tile<0, SK>(o, vb0, pa0, pa1, pa2, pa3, ACT(even ? NT - 2 : NT - 1));
    if (even) { MASKT(pB0, pB1, NT - 1); partialSM(pB0, pB1, m_reg, mnB, alB); __syncthreads(); RESC(alB);
        finishSM(pB0, pB1, alB, l_reg, pa0, pa1, pa2, pa3); SBAR(); pv_tile<1, SK>(o, vb0, pa0, pa1, pa2, pa3, ACT(NT - 1)); }
    SBAR(); SEAM_K0();
    if (hi == 0) li_l[r32] = l_reg; asm volatile("s_waitcnt lgkmcnt(0)" ::: "memory");
    float rli[16];
#pragma unroll
    for (int r = 0; r < 16; ++r) rli[r] = __builtin_amdgcn_rcpf(li_l[crow(r, hi)]);
    TOut* Ow = cur.O + (size_t)(wid * QBLK) * PO;
#pragma unroll
    for (int r = 0; r < 16; ++r) { const int orow = crow(r, hi);
#pragma unroll
        for (int d0 = 0; d0 < 4; ++d0) { const float v = o[d0][r] * rli[r];
            if constexpr (same_t<TOut, float>::v) { Ow[(size_t)orow * PO + d0 * 32 + r32] = v; }
            else { const float vn = __shfl_xor(v, 1);
                   if ((r32 & 1) == 0) *(unsigned*)(Ow + (size_t)orow * PO + d0 * 32 + r32) = cvtpk(v, vn); } } }
    if constexpr (F32) {
#pragma unroll
        for (int d0 = 0; d0 < 8; ++d0) S.qr[d0] = pack8(S.tq[2 * d0], S.tq[2 * d0 + 1]); }
    __syncthreads();
#undef RESC
#undef KBASE
#undef ACT
#undef MASKT
#undef SEAM_K0
#undef HALF_STEP
}
#undef ROW
#undef VMW
#undef VMWN
#undef SLOAD_H
#undef SWRITE_HK
#undef SWRITE_HV
#undef SWRITE_H
#undef SLOAD_F
#undef SWRITE_KF
#undef SWRITE_VF

}

constexpr int NWAVES = 8;
constexpr int NTOK = 32768, DM = 2048, SEQ = 8192, NBATCH = 4;
constexpr int MAINW = 1536, MEMW = 512, NMEM = 256;
constexpr int A_IN = 3584;
constexpr int B_IN = 5120;
constexpr int FF = 5632, FFE = 7168, NEXP = 8;
constexpr int NSG = 12;
constexpr float ALPHA = 1.41421356237309515f;
constexpr float LN_EPS = 1e-5f;
constexpr float LAMBDA_INIT = 0.355509067592f;
constexpr int MAXT = 264;
constexpr int NPHASE = 17;
constexpr float W8_GU_MUL = 64.f, W8_D_MUL = 128.f, H8_MUL = 16.f;
constexpr int SC_ONE = 0x7f7f7f7f, SC_M4 = 0x7b7b7b7b, SC_M6 = 0x79797979, SC_M7 = 0x78787878;

constexpr size_t MiB = 1u << 20;
constexpr size_t WS_CTL = 0, CTL_ZERO_BYTES = 1 * MiB;
constexpr size_t WS_WSBF = 1 * MiB;
constexpr size_t WS_MEMB = 2 * MiB;
constexpr size_t WS_MEMKV = 6 * MiB;
constexpr size_t WS_ROUTE_E = 10 * MiB;
constexpr size_t WS_ROUTE_W = 10 * MiB + 256 * 1024;
constexpr size_t WS_TOKSLOT = 10 * MiB + 512 * 1024;
constexpr size_t WS_SLOTGATE = 11 * MiB;
constexpr size_t WS_SLOTTOK = 11 * MiB + 512 * 1024;
constexpr size_t WS_HIST = 12 * MiB;
constexpr size_t WS_MOETAB = 12 * MiB + 256 * 1024;
#if MK_FP8_MOE
constexpr int MOE_CHUNK_T = MAXT;
constexpr size_t WS_W_MOE_GU = 16 * MiB;
constexpr size_t WS_W_MOE_D = 240 * MiB;
constexpr size_t WS_XS = 352 * MiB;
#else
constexpr size_t WS_W_MOE_GU = 16 * MiB;
constexpr size_t WS_W_MOE_D = 464 * MiB;
constexpr size_t WS_XS = 812 * MiB;
#endif
constexpr size_t WS_W_A_IN = 688 * MiB;
constexpr size_t WS_W_MIX = 702 * MiB;
constexpr size_t WS_W_FFN_GU = 718 * MiB;
constexpr size_t WS_W_FFN_D = 762 * MiB;
constexpr size_t WS_W_B_IN = 784 * MiB;
constexpr size_t WS_W_MEMKV = 804 * MiB;
constexpr size_t WS_XB = 812 * MiB;
constexpr size_t WS_H0 = 940 * MiB;
constexpr size_t WS_CONCAT = 1164 * MiB;
constexpr size_t WS_HID = 940 * MiB;
constexpr size_t WS_H1 = 940 * MiB;
constexpr size_t WS_AO = 1260 * MiB;
constexpr size_t WS_CONCAT1 = 1452 * MiB;
constexpr size_t WS_X3B = 1580 * MiB;
#if MK_FP8_MOE
constexpr size_t WS_OS = 812 * MiB;
constexpr size_t WS_HIDM = 1076 * MiB;
constexpr size_t WS_END = 1708 * MiB;
static_assert(WS_W_MOE_D + (size_t)NEXP * DM * FFE <= WS_XS && WS_XS + (size_t)MAXT * 256 * DM <= WS_W_A_IN, "fp8 MoE weight map");
static_assert(WS_OS + (size_t)MAXT * 256 * DM * 2 <= WS_HIDM && WS_HIDM + (size_t)MAXT * 256 * FFE <= WS_X3B, "fp8 MoE map");
#else
constexpr size_t WS_OS = 1076 * MiB;
constexpr size_t WS_HIDM = 1340 * MiB;
constexpr size_t WS_END = 1802 * MiB;
static_assert(WS_XS + (size_t)MAXT * 256 * DM * 2 <= WS_OS && WS_OS + (size_t)MAXT * 256 * DM * 2 <= WS_HIDM && WS_HIDM + (size_t)MOE_CHUNK_T * 256 * FFE * 2 <= WS_END, "MoE map");
static_assert(WS_XS + (size_t)MAXT * 256 * DM * 2 <= WS_CONCAT1, "XS must not overlap CONCAT1/X3B");
#endif
static_assert(WS_H0 + (size_t)NTOK * A_IN * 2 <= WS_CONCAT && WS_HID + (size_t)NTOK * FF * 2 <= 1292 * MiB && WS_H1 + (size_t)NTOK * B_IN * 2 <= WS_AO && WS_AO + (size_t)NTOK * 3072 * 2 <= WS_CONCAT1, "activation map");
static_assert(WS_CONCAT1 + (size_t)NTOK * DM * 2 <= WS_X3B && WS_X3B + (size_t)NTOK * DM * 2 <= 1708 * MiB, "activation map 2");
constexpr int CW_TMO = 0, CW_CODE = 1;
constexpr int CW_BAR = 4096;
constexpr int CW_CHK = 8192;

constexpr int RING_OFF = 0, RING_BYTES = 131072;
constexpr int LDSCTL_OFF = RING_BYTES, MISC_OFF = LDSCTL_OFF + 320;
constexpr int LDS_BYTES = 147456;

#define GAS __attribute__((address_space(1)))
#define LAS __attribute__((address_space(3)))
typedef unsigned short bf16;
typedef unsigned v4u __attribute__((ext_vector_type(4)));
typedef float f32x4 __attribute__((ext_vector_type(4)));
typedef short bf16x8 __attribute__((ext_vector_type(8)));
typedef GAS unsigned gu32;
typedef GAS unsigned long long gu64;
#define RLX_AGENT __ATOMIC_RELAXED, __HIP_MEMORY_SCOPE_AGENT
#define LDS_WAIT() asm volatile("s_waitcnt lgkmcnt(0)" ::: "memory")
#define VM_WAIT() asm volatile("s_waitcnt vmcnt(0)" ::: "memory")
__device__ __forceinline__ unsigned f2bf(float f) { unsigned u = __builtin_bit_cast(unsigned, f); return (u + 0x7fffu + ((u >> 16) & 1u)) >> 16; }
__device__ __forceinline__ unsigned pk2(float lo, float hi) { return f2bf(lo) | (f2bf(hi) << 16); }

#define XB_TMO      128
#define XB_XCNT(j)  (256  + 64 * (j))
#define XB_XSUB(j)  (1280 + 64 * (j))
#define XB_XGEN(j)  (2304 + 64 * (j))
#define XB_TOP      3328
#define XB_TOPGEN   3392
#define XCD_BAR_WORDS 3456
#define XB_SPIN_CAP (1u << 18)

__device__ __forceinline__ unsigned xb_ld(unsigned* p)              { return __hip_atomic_load(p, __ATOMIC_RELAXED, __HIP_MEMORY_SCOPE_AGENT); }
__device__ __forceinline__ unsigned xb_add(unsigned* p, unsigned v) { return __hip_atomic_fetch_add(p, v, __ATOMIC_RELAXED, __HIP_MEMORY_SCOPE_AGENT); }
__device__ __forceinline__ unsigned xb_xcc_id() { return (unsigned)__builtin_amdgcn_s_getreg((3 << 11) | 20) & 0xFu; }
#define XB_SPIN(cond, bar) do { unsigned _sp = 0; while (cond) { __builtin_amdgcn_s_sleep(1); \
    if ((++_sp & 255u) == 0u) { if (xb_ld(&(bar)[XB_TMO])) break; if (_sp > XB_SPIN_CAP) { atomicAdd(&(bar)[XB_TMO], 1u); break; } } } } while (0)

struct XcdBarrier {
    unsigned* bar; unsigned x; int wave;
    volatile LAS unsigned* st;
};

__device__ __forceinline__ XcdBarrier xcd_barrier_post(unsigned* bar, volatile LAS unsigned* st) {
    XcdBarrier b; b.bar = bar; b.x = xb_xcc_id(); b.st = st;
    if (threadIdx.x == 0) (void)xb_add(&bar[XB_XCNT(b.x)], 1u);
    return b;
}
__device__ __forceinline__ void xcd_barrier_complete(unsigned* bar, unsigned x, unsigned& nloc, unsigned& nx) {
    const unsigned G = gridDim.x * gridDim.y * gridDim.z;
    unsigned sum, cnt, mine, sp = 0u;
    for (;;) {
        sum = 0u; cnt = 0u; mine = 0u;
#pragma unroll
        for (unsigned j = 0; j < 16; ++j) { const unsigned c = xb_ld(&bar[XB_XCNT(j)]); sum += c; cnt += (c > 0u) ? 1u : 0u; mine = (j == x) ? c : mine; }
        if (sum == G) break;
        __builtin_amdgcn_s_sleep(1);
        if ((++sp & 255u) == 0u) { if (xb_ld(&bar[XB_TMO])) break; if (sp > XB_SPIN_CAP) { atomicAdd(&bar[XB_TMO], 1u); break; } }
    }
    nloc = mine > 0u ? mine : 1u; nx = cnt > 0u ? cnt : 1u;
}

__device__ __forceinline__ void xcd_barrier(const XcdBarrier& b) {
    asm volatile("s_waitcnt vmcnt(0)" ::: "memory");
    __syncthreads();
    if (b.wave == 0 && mk_lane() == 0) {
        unsigned* bar = b.bar;
        __builtin_amdgcn_s_waitcnt(0);
        unsigned nloc = b.st[0], nx = b.st[1];
        if (nloc == 0u) { xcd_barrier_complete(bar, b.x, nloc, nx); b.st[0] = nloc; b.st[1] = nx; }
        const unsigned old = xb_add(&bar[XB_XSUB(b.x)], 1u);
        const unsigned gen = old / nloc;
        if (old + 1u == (gen + 1u) * nloc) {
            __builtin_amdgcn_fence(__ATOMIC_RELEASE, "agent");
            asm volatile("s_waitcnt vmcnt(0)" ::: "memory");
            const unsigned og = xb_add(&bar[XB_TOP], 1u);
            const unsigned tg = og / nx;
            if (og + 1u == (tg + 1u) * nx) xb_add(&bar[XB_TOPGEN], 1u);
            else XB_SPIN(xb_ld(&bar[XB_TOPGEN]) == tg, bar);
            __builtin_amdgcn_fence(__ATOMIC_ACQUIRE, "agent");
            xb_add(&bar[XB_XGEN(b.x)], 1u);
            asm volatile("s_waitcnt vmcnt(0)" ::: "memory");
        } else {
            XB_SPIN(xb_ld(&bar[XB_XGEN(b.x)]) == gen, bar);
            __builtin_amdgcn_fence(__ATOMIC_ACQUIRE, "agent");
            asm volatile("s_waitcnt vmcnt(0)" ::: "memory");
        }
    }
    __syncthreads();
}


struct Frame {
    LAS unsigned char* lds;
    volatile LAS unsigned* MISC;
    gu32* ctl;
    int wave;
    int G;
    unsigned char* ws;
    const float* in[25]; float* out;
};
enum { I_X = 0, I_MEM, I_LNG, I_LNB, I_WMIX, I_WMEMKV, I_AWIN, I_AVG, I_AVB, I_AWS, I_ABS, I_SWKV, I_BWIN, I_LQ1, I_LK1, I_LQ2, I_LK2, I_SUBLN, I_FG, I_FU, I_FD, I_ROUTER, I_MG, I_MU, I_MD };

__device__ __forceinline__ float wave_sum(float v) {
#pragma unroll
    for (int o = 1; o < 64; o <<= 1) v += __shfl_xor(v, o);
    return v;
}
__device__ __forceinline__ float bf2f(unsigned short b) { return __builtin_bit_cast(float, (unsigned)b << 16); }
__device__ __forceinline__ float bflo(unsigned w) { return __builtin_bit_cast(float, w << 16); }
__device__ __forceinline__ float bfhi(unsigned w) { return __builtin_bit_cast(float, w & 0xffff0000u); }

__device__ __forceinline__ void tr_item(const float* W, int K, int N, bf16* WT, int k0, int n0, int drow0, LAS float* scr, int lane) {
#pragma unroll 8
    for (int i = 0; i < 32; ++i) { const int kk = 2 * i + (lane >> 5); scr[kk * 33 + (lane & 31)] = W[(size_t)(k0 + kk) * N + n0 + (lane & 31)]; }
    LDS_WAIT(); asm volatile("" ::: "memory");
    const int c = lane & 7;
#pragma unroll
    for (int j = 0; j < 4; ++j) { const int n = (lane >> 3) + 8 * j; const LAS float* s = scr + (8 * c) * 33 + n;
        v4u o; o.x = pk2(s[0 * 33], s[1 * 33]); o.y = pk2(s[2 * 33], s[3 * 33]); o.z = pk2(s[4 * 33], s[5 * 33]); o.w = pk2(s[6 * 33], s[7 * 33]);
        *(GAS v4u*)(WT + (size_t)(drow0 + n) * K + k0 + 8 * c) = o; }
    LDS_WAIT(); asm volatile("" ::: "memory");
}
__device__ __forceinline__ void tr_item8(const float* W, int K, int N, unsigned char* WT, int k0, int n0, int drow0, float mul, LAS float* scr, int lane) {
#pragma unroll 8
    for (int i = 0; i < 32; ++i) { const int kk = 2 * i + (lane >> 5); scr[kk * 33 + (lane & 31)] = W[(size_t)(k0 + kk) * N + n0 + (lane & 31)]; }
    LDS_WAIT(); asm volatile("" ::: "memory");
    const int n = lane >> 1, hf = lane & 1; const LAS float* s = scr + (32 * hf) * 33 + n;
    int w[8];
#pragma unroll
    for (int q = 0; q < 8; ++q) { int t = 0; t = __builtin_amdgcn_cvt_pk_fp8_f32(s[(4 * q) * 33] * mul, s[(4 * q + 1) * 33] * mul, t, false); t = __builtin_amdgcn_cvt_pk_fp8_f32(s[(4 * q + 2) * 33] * mul, s[(4 * q + 3) * 33] * mul, t, true); w[q] = t; }
    GAS v4u* dst = (GAS v4u*)(WT + (size_t)(drow0 + n) * K + k0 + 32 * hf);
    dst[0] = (v4u){(unsigned)w[0], (unsigned)w[1], (unsigned)w[2], (unsigned)w[3]}; dst[1] = (v4u){(unsigned)w[4], (unsigned)w[5], (unsigned)w[6], (unsigned)w[7]};
    LDS_WAIT(); asm volatile("" ::: "memory");
}
__device__ __forceinline__ void tr_matrix_item8(const float* W, int K, int N, unsigned char* WT, int row_off, int mode, float mul, int item, LAS float* scr, int lane) {
    const int nblk = N / 32, kb = item / nblk, nb = item % nblk, k0 = 64 * kb, n0 = 32 * nb;
    const int drow0 = row_off + (mode == 0 ? n0 : ((n0 >> 7) * 256 + (n0 & 127) + (mode == 2 ? 128 : 0)));
    tr_item8(W, K, N, WT, k0, n0, drow0, mul, scr, lane);
}
__device__ __forceinline__ void tr_matrix_item(const float* W, int K, int N, bf16* WT, int row_off, int mode, int item, LAS float* scr, int lane) {
    const int nblk = N / 32, kb = item / nblk, nb = item % nblk, k0 = 64 * kb, n0 = 32 * nb;
    const int drow0 = row_off + (mode == 0 ? n0 : ((n0 >> 7) * 256 + (n0 & 127) + (mode == 2 ? 128 : 0)));
    tr_item(W, K, N, WT, k0, n0, drow0, scr, lane);
}
__device__ __forceinline__ void p0_prologue(Frame& F) {
    const int lane_ = mk_lane(), tid_ = F.wave * 64 + lane_;
    LAS float* scr = (LAS float*)(F.lds + RING_OFF + F.wave * 16384);
    const int gw = blockIdx.x * NWAVES + F.wave, NGW = F.G * NWAVES;
    bf16* ws16 = (bf16*)F.ws;
    constexpr int I_E = (DM / 64) * (FFE / 32);
    constexpr int I_MOE = 3 * NEXP * I_E;
    constexpr int I_AIN = (DM / 64) * (A_IN / 32), I_MIXW = (DM / 64) * (DM / 32), I_FGU = (DM / 64) * (FF / 32), I_FDN = (FF / 64) * (DM / 32);
    constexpr int I_KV = (DM / 64) * (3072 / 32), I_BIN = (DM / 64) * (DM / 32), I_MKV = (DM / 64) * (1024 / 32);
    constexpr int NITEMS = I_MOE + I_AIN + 2 * I_MIXW + 2 * I_FGU + I_FDN + I_KV + I_BIN + 2 * I_MKV;
    for (int it = gw; it < NITEMS; it += NGW) {
        int r = it;
        if (r < I_MOE) { const int which = r / (NEXP * I_E), rr = r % (NEXP * I_E), e = rr / I_E, item = rr % I_E;
#if MK_FP8_MOE
            if (which == 0) tr_matrix_item8(F.in[I_MG] + (size_t)e * DM * FFE, DM, FFE, F.ws + WS_W_MOE_GU, e * 2 * FFE, 1, W8_GU_MUL, item, scr, lane_);
            else if (which == 1) tr_matrix_item8(F.in[I_MU] + (size_t)e * DM * FFE, DM, FFE, F.ws + WS_W_MOE_GU, e * 2 * FFE, 2, W8_GU_MUL, item, scr, lane_);
            else tr_matrix_item8(F.in[I_MD] + (size_t)e * FFE * DM, FFE, DM, F.ws + WS_W_MOE_D, e * DM, 0, W8_D_MUL, item, scr, lane_);
#else
            if (which == 0) tr_matrix_item(F.in[I_MG] + (size_t)e * DM * FFE, DM, FFE, (bf16*)(F.ws + WS_W_MOE_GU), e * 2 * FFE, 1, item, scr, lane_);
            else if (which == 1) tr_matrix_item(F.in[I_MU] + (size_t)e * DM * FFE, DM, FFE, (bf16*)(F.ws + WS_W_MOE_GU), e * 2 * FFE, 2, item, scr, lane_);
            else tr_matrix_item(F.in[I_MD] + (size_t)e * FFE * DM, FFE, DM, (bf16*)(F.ws + WS_W_MOE_D), e * DM, 0, item, scr, lane_);
#endif
            continue; } r -= I_MOE;
        if (r < I_AIN) { tr_matrix_item(F.in[I_AWIN], DM, A_IN, (bf16*)(F.ws + WS_W_A_IN), 0, 0, r, scr, lane_); continue; } r -= I_AIN;
        if (r < 2 * I_MIXW) { const int l = r / I_MIXW; tr_matrix_item(F.in[I_WMIX] + (size_t)l * DM * DM, DM, DM, (bf16*)(F.ws + WS_W_MIX), l * DM, 0, r % I_MIXW, scr, lane_); continue; } r -= 2 * I_MIXW;
        if (r < I_FGU) { tr_matrix_item(F.in[I_FG], DM, FF, (bf16*)(F.ws + WS_W_FFN_GU), 0, 1, r, scr, lane_); continue; } r -= I_FGU;
        if (r < I_FGU) { tr_matrix_item(F.in[I_FU], DM, FF, (bf16*)(F.ws + WS_W_FFN_GU), 0, 2, r, scr, lane_); continue; } r -= I_FGU;
        if (r < I_FDN) { tr_matrix_item(F.in[I_FD], FF, DM, (bf16*)(F.ws + WS_W_FFN_D), 0, 0, r, scr, lane_); continue; } r -= I_FDN;
        if (r < I_KV) { tr_matrix_item(F.in[I_SWKV], DM, 3072, (bf16*)(F.ws + WS_W_B_IN), 0, 0, r, scr, lane_); continue; } r -= I_KV;
        if (r < I_BIN) { tr_matrix_item(F.in[I_BWIN], DM, DM, (bf16*)(F.ws + WS_W_B_IN), 3072, 0, r, scr, lane_); continue; } r -= I_BIN;
        { const int l = r / I_MKV; tr_matrix_item(F.in[I_WMEMKV] + (size_t)l * DM * 1024, DM, 1024, (bf16*)(F.ws + WS_W_MEMKV), l * 1024, 0, r % I_MKV, scr, lane_); }
    }
    (void)ws16;
    { const size_t gt = (size_t)blockIdx.x * (NWAVES * 64) + tid_, NT = (size_t)F.G * NWAVES * 64;
      const GAS f32x4* x4 = (const GAS f32x4*)F.in[I_X]; GAS v4u* xb = (GAS v4u*)(F.ws + WS_XB);
      for (size_t i = gt; i < (size_t)NTOK * DM / 8; i += NT) { const f32x4 a = x4[2 * i], b = x4[2 * i + 1]; v4u o; o.x = pk2(a.x, a.y); o.y = pk2(a.z, a.w); o.z = pk2(b.x, b.y); o.w = pk2(b.z, b.w); xb[i] = o; }
      const GAS f32x4* m4 = (const GAS f32x4*)F.in[I_MEM]; GAS v4u* mb = (GAS v4u*)(F.ws + WS_MEMB);
      for (size_t i = gt; i < (size_t)NBATCH * NMEM * DM / 8; i += NT) { const f32x4 a = m4[2 * i], b = m4[2 * i + 1]; v4u o; o.x = pk2(a.x, a.y); o.y = pk2(a.z, a.w); o.z = pk2(b.x, b.y); o.w = pk2(b.z, b.w); mb[i] = o; }
      const float* wsrc = F.in[I_AWS]; bf16* wd = (bf16*)(F.ws + WS_WSBF);
      for (size_t i = gt; i < (size_t)NSG * 128 * 128; i += NT) { const int s = (int)(i & 127), t = (int)((i >> 7) & 127); wd[i] = (bf16)(s <= t ? f2bf(wsrc[i]) : 0u); }
    }
}

__device__ __forceinline__ void ln_load(const float* row, int lane, f32x4 (&v)[8]) { const GAS f32x4* xr = (const GAS f32x4*)row + lane;
#pragma unroll
    for (int j = 0; j < 8; ++j) v[j] = xr[64 * j]; }
__device__ __forceinline__ void ln_norm(f32x4 (&v)[8], const float* g, const float* b, int lane) {
    float s = 0.f;
#pragma unroll
    for (int j = 0; j < 8; ++j) s += (v[j].x + v[j].y) + (v[j].z + v[j].w);
    const float mean = wave_sum(s) * (1.f / DM); float s2 = 0.f;
#pragma unroll
    for (int j = 0; j < 8; ++j) { v[j] = v[j] - mean; s2 += (v[j].x * v[j].x + v[j].y * v[j].y) + (v[j].z * v[j].z + v[j].w * v[j].w); }
    const float rstd = 1.f / sqrtf(wave_sum(s2) * (1.f / DM) + LN_EPS);
    const GAS f32x4* g4 = (const GAS f32x4*)g + lane; const GAS f32x4* b4 = (const GAS f32x4*)b + lane;
#pragma unroll
    for (int j = 0; j < 8; ++j) v[j] = v[j] * rstd * g4[64 * j] + b4[64 * j];
}
__device__ __forceinline__ void ln_store(const f32x4 (&v)[8], float* drow, bf16* brow, int lane) {
    GAS f32x4* o4 = (GAS f32x4*)drow + lane;
#pragma unroll
    for (int j = 0; j < 8; ++j) o4[64 * j] = v[j];
    if (brow) { GAS unsigned long long* o8 = (GAS unsigned long long*)brow + lane;
#pragma unroll
        for (int j = 0; j < 8; ++j) o8[64 * j] = (unsigned long long)pk2(v[j].x, v[j].y) | ((unsigned long long)pk2(v[j].z, v[j].w) << 32); }
}
__device__ __forceinline__ void ln_store8(const f32x4 (&v)[8], unsigned char* brow, int lane) {
    GAS unsigned* o4 = (GAS unsigned*)brow + lane;
#pragma unroll
    for (int j = 0; j < 8; ++j) { int t = 0; t = __builtin_amdgcn_cvt_pk_fp8_f32(v[j].x, v[j].y, t, false); t = __builtin_amdgcn_cvt_pk_fp8_f32(v[j].z, v[j].w, t, true); o4[64 * j] = (unsigned)t; }
}
__device__ __forceinline__ void ln_phase(Frame& F, const float* src, float* dst, bf16* dstb, const float* g, const float* b) {
    const int lane_ = mk_lane();
    const int gw = blockIdx.x * NWAVES + F.wave, NGW = F.G * NWAVES;
    for (int base = gw * 16; base < NTOK; base += NGW * 16)
        for (int r = 0; r < 16; ++r) { const int m = base + r; f32x4 v[8]; ln_load(src + (size_t)m * DM, lane_, v); ln_norm(v, g, b, lane_); ln_store(v, dst + (size_t)m * DM, dstb ? dstb + (size_t)m * DM : nullptr, lane_); }
}

typedef at128::bf16 abf;
typedef at128::BlockRef<abf, abf> ABlk;
template <int PQ> __device__ __forceinline__ ABlk memattn_ref(int L, const abf* Qb, const abf* KVb, abf* Ob) {
    const int tile = L >> 2, h = L & 3, b = tile >> 5; ABlk r;
    r.Q = Qb + (size_t)tile * 256 * PQ + h * 128; r.K = KVb + (size_t)b * NMEM * 2048 + h * 128; r.V = r.K + MEMW; r.O = Ob + (size_t)tile * 256 * DM + h * 128; r.P0 = 1 << 20; return r;
}
template <int PQ> __device__ __forceinline__ void memattn_phase(int G, int wv, char* lds, const abf* Qb, const abf* KVb, abf* Ob) {
    constexpr int total = (NTOK / 256) * 4, W = 1 << 30;
    int L = blockIdx.x; if (L >= total) return;
    ABlk cur = memattn_ref<PQ>(L, Qb, KVb, Ob); at128::Seam<abf> S;
    at128::causal_swa_prime<abf, abf, PQ, 2048, DM>(cur, W, lds, S, wv);
    for (;;) { const bool last = L + G >= total; const ABlk nxt = last ? cur : memattn_ref<PQ>(L + G, Qb, KVb, Ob);
        at128::causal_swa_block<abf, abf, PQ, 2048, DM>(cur, nxt, NMEM, W, lds, S, wv); if (last) break; cur = nxt; L += G; }
}
__device__ __forceinline__ ABlk diff_ref(int vh, int qb, const abf* H1, abf* AO) {
    const int b = vh / 24, rem = vh % 24, h = rem >> 2, m = (rem >> 1) & 1, half = rem & 1; ABlk r;
    const abf* base = H1 + (size_t)b * SEQ * B_IN;
    r.Q = base + (size_t)qb * 256 * B_IN + 3072 + (m * 6 + h) * 128; r.K = base + (m * 6 + h) * 128; r.V = base + 1536 + h * 256 + half * 128;
    r.O = AO + ((size_t)b * SEQ + (size_t)qb * 256) * 3072 + m * 1536 + h * 256 + half * 128; r.P0 = qb * 256; return r;
}
__device__ __forceinline__ void diffattn_phase(int G, int wv, char* lds, const abf* H1, abf* AO) {
    constexpr int NX = 16, total = 96 * NX, W = SEQ;
    int L = blockIdx.x; if (L >= total) return;
    int pass = 0; ABlk cur = diff_ref(L / NX, L % NX, H1, AO); at128::Seam<abf> S;
    at128::causal_swa_prime<abf, abf, B_IN, B_IN, 3072>(cur, W, lds, S, wv);
    for (;;) {
        const bool more_item = L + G < total, last = pass == 1 && !more_item;
        int Ln = L, passn = pass + 1; if (pass == 1) { passn = 0; Ln = more_item ? L + G : L; }
        const int x = Ln % NX; const ABlk nxt = last ? cur : diff_ref(Ln / NX, passn ? 31 - x : x, H1, AO);
        at128::causal_swa_block<abf, abf, B_IN, B_IN, 3072>(cur, nxt, SEQ, W, lds, S, wv);
        if (last) break; cur = nxt; L = Ln; pass = passn;
    }
}

__device__ __forceinline__ void sg_phase(Frame& F) {
    const bf16* H0 = (const bf16*)(F.ws + WS_H0); bf16* CC = (bf16*)(F.ws + WS_CONCAT); const bf16* WSB = (const bf16*)(F.ws + WS_WSBF);
    const float* vg = F.in[I_AVG]; const float* vb = F.in[I_AVB]; const float* bsp = F.in[I_ABS];
    const int lane = mk_lane(), wid = F.wave, tid = wid * 64 + lane, r32 = lane & 31, hi = lane >> 5;
    LAS float* stats = (LAS float*)(F.lds + 65536);
    for (int c = blockIdx.x; c < NTOK / 128; c += F.G) {
        const size_t R0 = (size_t)c * 128;
        for (int r = 0; r < 16; ++r) {
            const int t = wid * 16 + r; const bf16* vr = H0 + (R0 + t) * A_IN + MAINW; float x[24];
#pragma unroll
            for (int j = 0; j < 3; ++j) { const v4u w = *(const GAS v4u*)(vr + j * 512 + lane * 8);
                x[8 * j + 0] = bflo(w.x); x[8 * j + 1] = bfhi(w.x); x[8 * j + 2] = bflo(w.y); x[8 * j + 3] = bfhi(w.y); x[8 * j + 4] = bflo(w.z); x[8 * j + 5] = bfhi(w.z); x[8 * j + 6] = bflo(w.w); x[8 * j + 7] = bfhi(w.w); }
            float s = 0.f;
#pragma unroll
            for (int j = 0; j < 24; ++j) s += x[j];
            const float mean = wave_sum(s) * (1.f / MAINW); float q = 0.f;
#pragma unroll
            for (int j = 0; j < 24; ++j) { const float d = x[j] - mean; q += d * d; }
            const float rstd = 1.f / sqrtf(wave_sum(q) * (1.f / MAINW) + LN_EPS);
            if (lane == 0) { stats[2 * t] = mean; stats[2 * t + 1] = rstd; }
        }
        __syncthreads();
        for (int gp = 0; gp < NSG / 2; ++gp) {
#pragma unroll
            for (int i = 0; i < 8; ++i) {
                const int p = tid + 512 * i, gsel = p >> 11, kt = (p >> 10) & 1, key = (p >> 4) & 63, c8 = (p & 15) * 8, tok = kt * 64 + key, col = (2 * gp + gsel) * 128 + c8;
                const v4u w = *(const GAS v4u*)(H0 + (R0 + tok) * A_IN + MAINW + col);
                const float mean = stats[2 * tok], rstd = stats[2 * tok + 1];
                const f32x4 g0 = *(const GAS f32x4*)(vg + col), g1 = *(const GAS f32x4*)(vg + col + 4), b0 = *(const GAS f32x4*)(vb + col), b1 = *(const GAS f32x4*)(vb + col + 4);
                v4u o;
                o.x = pk2((bflo(w.x) - mean) * rstd * g0.x + b0.x, (bfhi(w.x) - mean) * rstd * g0.y + b0.y);
                o.y = pk2((bflo(w.y) - mean) * rstd * g0.z + b0.z, (bfhi(w.y) - mean) * rstd * g0.w + b0.w);
                o.z = pk2((bflo(w.z) - mean) * rstd * g1.x + b1.x, (bfhi(w.z) - mean) * rstd * g1.y + b1.y);
                o.w = pk2((bflo(w.w) - mean) * rstd * g1.z + b1.z, (bfhi(w.w) - mean) * rstd * g1.w + b1.w);
                *(LAS v4u*)(F.lds + (gsel * 2 + kt) * 16384 + at128::v_st(key, c8)) = o;
            }
            __syncthreads();
            { const int gsel = wid >> 2, tb = wid & 3, g = 2 * gp + gsel;
              at128::f32x16 o[4] = {};
              const int vb0 = (int)(unsigned long)(F.lds) + gsel * 32768 + at128::v_rd_base(lane);
              const bf16* wrow = WSB + ((size_t)g * 128 + tb * 32 + r32) * 128 + hi * 8;
              { const at128::bf16x8 pa0 = *(const GAS at128::bf16x8*)(wrow), pa1 = *(const GAS at128::bf16x8*)(wrow + 16), pa2 = *(const GAS at128::bf16x8*)(wrow + 32), pa3 = *(const GAS at128::bf16x8*)(wrow + 48);
                at128::pv_tile<0, false>(o, vb0, pa0, pa1, pa2, pa3, true); }
              if (tb >= 2) { const at128::bf16x8 pa0 = *(const GAS at128::bf16x8*)(wrow + 64), pa1 = *(const GAS at128::bf16x8*)(wrow + 80), pa2 = *(const GAS at128::bf16x8*)(wrow + 96), pa3 = *(const GAS at128::bf16x8*)(wrow + 112);
                at128::pv_tile<1, false>(o, vb0, pa0, pa1, pa2, pa3, true); }
#pragma unroll
              for (int r = 0; r < 16; ++r) { const int t = tb * 32 + at128::crow(r, hi); const float bsv = bsp[g * 128 + t];
                  const bf16* urow = H0 + (R0 + t) * A_IN + g * 128 + r32; bf16* orow = CC + (R0 + t) * DM + g * 128 + r32;
#pragma unroll
                  for (int d0 = 0; d0 < 4; ++d0) { const float val = (o[d0][r] + bsv) * bf2f(urow[d0 * 32]); const float vn = __shfl_xor(val, 1);
                      if ((r32 & 1) == 0) *(GAS unsigned*)(orow + d0 * 32) = pk2(val, vn); } }
            }
            __syncthreads();
        }
    }
}

__device__ __forceinline__ void combine_phase(Frame& F) {
    const bf16* AO = (const bf16*)(F.ws + WS_AO); bf16* CC = (bf16*)(F.ws + WS_CONCAT1);
    const int lane = mk_lane(), gw = blockIdx.x * NWAVES + F.wave, NGW = F.G * NWAVES;
    const float* q1 = F.in[I_LQ1]; const float* k1 = F.in[I_LK1]; const float* q2 = F.in[I_LQ2]; const float* k2 = F.in[I_LK2];
    const float s1 = wave_sum(q1[lane] * k1[lane] + q1[lane + 64] * k1[lane + 64]), s2 = wave_sum(q2[lane] * k2[lane] + q2[lane + 64] * k2[lane + 64]);
    const float lam = expf(s1) - expf(s2) + LAMBDA_INIT, post = 1.0f - LAMBDA_INIT;
    const f32x4 g4 = *(const GAS f32x4*)(F.in[I_SUBLN] + 4 * lane);
    for (int m = gw; m < NTOK; m += NGW) {
        const bf16* r1 = AO + (size_t)m * 3072 + 4 * lane; bf16* orow = CC + (size_t)m * DM + 4 * lane;
#pragma unroll
        for (int h = 0; h < 6; ++h) {
            const unsigned long long a = *(const GAS unsigned long long*)(r1 + h * 256), b = *(const GAS unsigned long long*)(r1 + 1536 + h * 256);
            const unsigned a0 = (unsigned)a, a1 = (unsigned)(a >> 32), b0 = (unsigned)b, b1 = (unsigned)(b >> 32);
            const float x0 = bflo(a0) - lam * bflo(b0), x1 = bfhi(a0) - lam * bfhi(b0), x2 = bflo(a1) - lam * bflo(b1), x3 = bfhi(a1) - lam * bfhi(b1);
            const float ss = wave_sum((x0 * x0 + x1 * x1) + (x2 * x2 + x3 * x3));
            const float r = post / sqrtf(ss * (1.f / 256.f) + LN_EPS);
            *(GAS unsigned long long*)(orow + h * 256) = (unsigned long long)pk2(x0 * r * g4.x, x1 * r * g4.y) | ((unsigned long long)pk2(x2 * r * g4.z, x3 * r * g4.w) << 32);
        }
    }
}

__device__ __forceinline__ void ln_router_phase(Frame& F, float* xio, bf16* xb, const float* g, const float* b) {
    LAS float* wr = (LAS float*)(F.lds);
    const float* wsrc = F.in[I_ROUTER];
    const int lane = mk_lane();
    for (int i = F.wave * 64 + lane; i < DM * NEXP; i += NWAVES * 64) wr[(i & 7) * DM + (i >> 3)] = wsrc[i];
    __syncthreads();
    int* route_e = (int*)(F.ws + WS_ROUTE_E); float* route_w = (float*)(F.ws + WS_ROUTE_W); int* hist = (int*)(F.ws + WS_HIST);
    const int gw = blockIdx.x * NWAVES + F.wave, NGW = F.G * NWAVES;
    for (int grp = gw; grp < NTOK / 16; grp += NGW) {
        int cnt = 0;
        for (int r = 0; r < 16; ++r) {
            const int m = grp * 16 + r; f32x4 v[8]; ln_load(xio + (size_t)m * DM, lane, v); ln_norm(v, g, b, lane);
#if MK_FP8_MOE
            ln_store(v, xio + (size_t)m * DM, nullptr, lane); ln_store8(v, (unsigned char*)xb + (size_t)m * DM, lane);
#else
            ln_store(v, xio + (size_t)m * DM, xb + (size_t)m * DM, lane);
#endif
            float lg[8];
#pragma unroll
            for (int e = 0; e < 8; ++e) lg[e] = 0.f;
#pragma unroll
            for (int j = 0; j < 8; ++j) {
#pragma unroll
                for (int e = 0; e < 8; ++e) { const f32x4 w = *(const LAS f32x4*)(wr + e * DM + 256 * j + 4 * lane); lg[e] += (v[j].x * w.x + v[j].y * w.y) + (v[j].z * w.z + v[j].w * w.w); }
                asm volatile("" ::: "memory"); }
#pragma unroll
            for (int e = 0; e < 8; ++e) lg[e] = wave_sum(lg[e]);
            int e0 = 0; float l0 = lg[0];
#pragma unroll
            for (int e = 1; e < 8; ++e) if (lg[e] > l0) { l0 = lg[e]; e0 = e; }
            int e1 = -1; float l1 = -3.0e38f;
#pragma unroll
            for (int e = 0; e < 8; ++e) if (e != e0 && lg[e] > l1) { l1 = lg[e]; e1 = e; }
            const float ex = expf(l1 - l0), w0 = 1.0f / (1.0f + ex), w1 = ex / (1.0f + ex);
            if (lane == 0) { route_e[m] = e0 | (e1 << 8); route_w[2 * m] = w0; route_w[2 * m + 1] = w1; }
            cnt += (lane == e0) + (lane == e1);
        }
        if (lane < 8) hist[grp * 8 + lane] = cnt;
    }
}

__device__ __forceinline__ void dispatch_phase(Frame& F) {
    LAS int* gpre = (LAS int*)(F.lds);
    LAS int* wtot = (LAS int*)(F.lds + 65536);
    LAS int* tst = (LAS int*)(F.lds + 65536 + 256);
    const int* hist = (const int*)(F.ws + WS_HIST); const int lane = mk_lane(), wid = F.wave, tid = wid * 64 + lane;
    int h[4][8], sum[8];
#pragma unroll
    for (int e = 0; e < 8; ++e) sum[e] = 0;
#pragma unroll
    for (int i = 0; i < 4; ++i) { const v4u a = *(const GAS v4u*)(hist + (4 * tid + i) * 8), b = *(const GAS v4u*)(hist + (4 * tid + i) * 8 + 4);
        h[i][0] = a.x; h[i][1] = a.y; h[i][2] = a.z; h[i][3] = a.w; h[i][4] = b.x; h[i][5] = b.y; h[i][6] = b.z; h[i][7] = b.w;
#pragma unroll
        for (int e = 0; e < 8; ++e) sum[e] += h[i][e]; }
    int inc[8];
#pragma unroll
    for (int e = 0; e < 8; ++e) { int v = sum[e];
#pragma unroll
        for (int o = 1; o < 64; o <<= 1) { const int t = __shfl_up(v, o); if (lane >= o) v += t; }
        inc[e] = v; if (lane == 63) wtot[wid * 8 + e] = v; }
    __syncthreads();
    int tot[8];
#pragma unroll
    for (int e = 0; e < 8; ++e) { int pre = 0, all = 0;
#pragma unroll
        for (int w = 0; w < 8; ++w) { const int t = wtot[w * 8 + e]; all += t; if (w < wid) pre += t; }
        tot[e] = all; int run = pre + inc[e] - sum[e];
#pragma unroll
        for (int i = 0; i < 4; ++i) { gpre[(4 * tid + i) * 8 + e] = run; run += h[i][e]; } }
    if (tid == 0) { int ts = 0;
#pragma unroll
        for (int e = 0; e < 8; ++e) { tst[e] = ts; ts += (tot[e] + 255) >> 8; } tst[8] = ts;
        if (blockIdx.x == 0) { int* tab = (int*)(F.ws + WS_MOETAB);
#pragma unroll
            for (int e = 0; e <= 8; ++e) tab[e] = tst[e]; } }
    __syncthreads();
    const int* route_e = (const int*)(F.ws + WS_ROUTE_E); const float* route_w = (const float*)(F.ws + WS_ROUTE_W);
    int* tokslot = (int*)(F.ws + WS_TOKSLOT); int* slottok = (int*)(F.ws + WS_SLOTTOK); float* slotgate = (float*)(F.ws + WS_SLOTGATE);
    const bf16* X3B = (const bf16*)(F.ws + WS_X3B); bf16* XS = (bf16*)(F.ws + WS_XS);
    const int gw = blockIdx.x * NWAVES + wid, NGW = F.G * NWAVES;
    for (int grp = gw; grp < NTOK / 16; grp += NGW) {
        const int a = lane & 31, tok = grp * 16 + (a >> 1), k = a & 1;
        const int e = (route_e[tok] >> (8 * k)) & 0xff; const float w = route_w[2 * tok + k];
        int rank = 0;
#pragma unroll
        for (int ee = 0; ee < 8; ++ee) { const unsigned long long mk = __ballot(lane < 32 && e == ee); if (e == ee) rank = __popcll(mk & ((1ull << lane) - 1ull)); }
        const int slot = tst[e] * 256 + gpre[grp * 8 + e] + rank;
        if (lane < 32) { slottok[slot] = tok; slotgate[slot] = w; tokslot[2 * tok + k] = slot; }
        for (int q = 0; q < 32; ++q) { const int sl = __shfl(slot, q), tk = grp * 16 + (q >> 1);
#if MK_FP8_MOE
            const GAS v4u* src = (const GAS v4u*)((const unsigned char*)X3B + (size_t)tk * DM) + lane; GAS v4u* dst = (GAS v4u*)((unsigned char*)XS + (size_t)sl * DM) + lane;
#pragma unroll
            for (int j = 0; j < 2; ++j) dst[64 * j] = src[64 * j]; }
#else
            const GAS v4u* src = (const GAS v4u*)(X3B + (size_t)tk * DM) + lane; GAS v4u* dst = (GAS v4u*)(XS + (size_t)sl * DM) + lane;
#pragma unroll
            for (int j = 0; j < 4; ++j) dst[64 * j] = src[64 * j]; }
#endif
    }
}

__device__ __forceinline__ void final_phase(Frame& F, const float* g, const float* b) {
    const int* tokslot = (const int*)(F.ws + WS_TOKSLOT); const bf16* OS = (const bf16*)(F.ws + WS_OS);
    const int gw = blockIdx.x * NWAVES + F.wave, NGW = F.G * NWAVES, lane = mk_lane();
    for (int base = gw * 16; base < NTOK; base += NGW * 16)
        for (int r = 0; r < 16; ++r) { const int m = base + r; f32x4 v[8]; ln_load(F.out + (size_t)m * DM, lane, v);
            const int s0 = tokslot[2 * m], s1 = tokslot[2 * m + 1];
            const GAS unsigned long long* o0 = (const GAS unsigned long long*)(OS + (size_t)s0 * DM) + lane; const GAS unsigned long long* o1 = (const GAS unsigned long long*)(OS + (size_t)s1 * DM) + lane;
#pragma unroll
            for (int j = 0; j < 8; ++j) { const unsigned long long p = o0[64 * j], q = o1[64 * j]; const unsigned p0 = (unsigned)p, p1 = (unsigned)(p >> 32), q0 = (unsigned)q, q1 = (unsigned)(q >> 32);
                v[j].x = v[j].x * ALPHA + (bflo(p0) + bflo(q0)); v[j].y = v[j].y * ALPHA + (bfhi(p0) + bfhi(q0)); v[j].z = v[j].z * ALPHA + (bflo(p1) + bflo(q1)); v[j].w = v[j].w * ALPHA + (bfhi(p1) + bfhi(q1)); }
            ln_norm(v, g, b, lane); ln_store(v, F.out + (size_t)m * DM, nullptr, lane); }
}

struct Args { const float* in[25]; float* out; unsigned char* ws; int ph_lo, ph_hi, ch_lo, ch_hi; };
__global__ void __launch_bounds__(NWAVES * 64, 2) mk_fwd(Args args) {
    extern __shared__ __attribute__((aligned(16))) unsigned char lds[];
    Frame F;
    F.lds = (LAS unsigned char*)lds; F.MISC = (volatile LAS unsigned*)(F.lds + MISC_OFF);
    F.wave = __builtin_amdgcn_readfirstlane(threadIdx.x >> 6); F.G = gridDim.x;
    F.ws = args.ws; F.ctl = (gu32*)(args.ws + WS_CTL); F.out = args.out;
#pragma unroll
    for (int i = 0; i < 25; ++i) F.in[i] = args.in[i];
    for (int u = threadIdx.x; u < (LDS_BYTES - LDSCTL_OFF) / 4; u += NWAVES * 64) ((LAS unsigned*)(F.lds + LDSCTL_OFF))[u] = 0u;
    __syncthreads();
    const int lo = args.ph_lo, hi = args.ph_hi;
    XcdBarrier bar; bar.bar = (unsigned*)(F.ctl + CW_BAR); bar.x = 0; bar.st = nullptr; bar.wave = F.wave;
    if (hi - lo > 1) { bar = xcd_barrier_post((unsigned*)(F.ctl + CW_BAR), F.MISC + 8); bar.wave = F.wave; }
#define IN(k) (((MK_PHMASK >> (k)) & 1) && lo <= (k) && (k) < hi)
#define BOTH(k) (IN(k) && IN((k) + 1))
#define GRID_BAR() xcd_barrier(bar)
    unsigned char* ws = args.ws;
    bf16* XB = (bf16*)(ws + WS_XB);
    LAS unsigned char* ring = F.lds + RING_OFF;

    if (IN(0)) { p0_prologue(F); if (BOTH(0)) GRID_BAR(); }
    if (IN(1)) {
        { pg8::Gemm g{XB, (const bf16*)(ws + WS_W_A_IN), NTOK, A_IN, DM}; pg8::StaticOrder S; S.init(NTOK, A_IN, F.G, (int)blockIdx.x);
          pg8::EpiBf16 E{(bf16*)(ws + WS_H0), A_IN, 2 * MAINW}; pg8::gemm_phase<pg8::EpiBf16, pg8::StaticOrder, true, true>(ring, g, S, E, F.wave); }
        { pg8::Gemm g{(const bf16*)(ws + WS_MEMB), (const bf16*)(ws + WS_W_MEMKV), NBATCH * NMEM, 2048, DM}; pg8::StaticOrder S; S.init(NBATCH * NMEM, 2048, F.G, (int)blockIdx.x);
          pg8::EpiBf16 E{(bf16*)(ws + WS_MEMKV), 2048, 0}; pg8::gemm_phase<pg8::EpiBf16, pg8::StaticOrder, true, true>(ring, g, S, E, F.wave); }
        if (BOTH(1)) GRID_BAR();
    }
    if (IN(2)) {
        memattn_phase<A_IN>(F.G, F.wave, (char*)lds + RING_OFF, (const abf*)(ws + WS_H0) + 2 * MAINW, (const abf*)(ws + WS_MEMKV), (abf*)(ws + WS_CONCAT) + MAINW);
        __syncthreads();
        sg_phase(F);
        if (BOTH(2)) GRID_BAR();
    }
    if (IN(3)) {
        pg8::Gemm g{(const bf16*)(ws + WS_CONCAT), (const bf16*)(ws + WS_W_MIX), NTOK, DM, DM}; pg8::StaticOrder S; S.init(NTOK, DM, F.G, (int)blockIdx.x);
        pg8::EpiRes E{F.in[I_X], F.out, DM, ALPHA}; pg8::gemm_phase<pg8::EpiRes, pg8::StaticOrder, true, true>(ring, g, S, E, F.wave);
        if (BOTH(3)) GRID_BAR();
    }
    if (IN(4)) { ln_phase(F, F.out, F.out, XB, F.in[I_LNG] + 0 * DM, F.in[I_LNB] + 0 * DM); if (BOTH(4)) GRID_BAR(); }
    if (IN(5)) {
        pg8::Gemm g{XB, (const bf16*)(ws + WS_W_FFN_GU), NTOK, 2 * FF, DM}; pg8::StaticOrder S; S.init(NTOK, 2 * FF, F.G, (int)blockIdx.x);
        pg8::EpiSwiglu E{(bf16*)(ws + WS_HID), FF}; pg8::gemm_phase<pg8::EpiSwiglu, pg8::StaticOrder, true, true>(ring, g, S, E, F.wave);
        if (BOTH(5)) GRID_BAR();
    }
    if (IN(6)) {
        pg8::Gemm g{(const bf16*)(ws + WS_HID), (const bf16*)(ws + WS_W_FFN_D), NTOK, DM, FF}; pg8::StaticOrder S; S.init(NTOK, DM, F.G, (int)blockIdx.x);
        pg8::EpiRes E{F.out, F.out, DM, ALPHA}; pg8::gemm_phase<pg8::EpiRes, pg8::StaticOrder, true, true>(ring, g, S, E, F.wave);
        if (BOTH(6)) GRID_BAR();
    }
    if (IN(7)) { ln_phase(F, F.out, F.out, XB, F.in[I_LNG] + 1 * DM, F.in[I_LNB] + 1 * DM); if (BOTH(7)) GRID_BAR(); }
    if (IN(8)) {
        pg8::Gemm g{XB, (const bf16*)(ws + WS_W_B_IN), NTOK, B_IN, DM}; pg8::StaticOrder S; S.init(NTOK, B_IN, F.G, (int)blockIdx.x);
        pg8::EpiBf16 E{(bf16*)(ws + WS_H1), B_IN, 0}; pg8::gemm_phase<pg8::EpiBf16, pg8::StaticOrder, true, true>(ring, g, S, E, F.wave);
        if (BOTH(8)) GRID_BAR();
    }
    if (IN(9)) { diffattn_phase(F.G, F.wave, (char*)lds + RING_OFF, (const abf*)(ws + WS_H1), (abf*)(ws + WS_AO)); if (BOTH(9)) GRID_BAR(); }
    if (IN(10)) {
        memattn_phase<B_IN>(F.G, F.wave, (char*)lds + RING_OFF, (const abf*)(ws + WS_H1) + 4608, (const abf*)(ws + WS_MEMKV) + 1024, (abf*)(ws + WS_CONCAT1) + MAINW);
        combine_phase(F);
        if (BOTH(10)) GRID_BAR();
    }
    if (IN(11)) {
        pg8::Gemm g{(const bf16*)(ws + WS_CONCAT1), (const bf16*)(ws + WS_W_MIX) + (size_t)DM * DM, NTOK, DM, DM}; pg8::StaticOrder S; S.init(NTOK, DM, F.G, (int)blockIdx.x);
        pg8::EpiRes E{F.out, F.out, DM, ALPHA}; pg8::gemm_phase<pg8::EpiRes, pg8::StaticOrder, true, true>(ring, g, S, E, F.wave);
        if (BOTH(11)) GRID_BAR();
    }
    if (IN(12)) { ln_router_phase(F, F.out, (bf16*)(ws + WS_X3B), F.in[I_LNG] + 2 * DM, F.in[I_LNB] + 2 * DM); if (BOTH(12)) GRID_BAR(); }
    if (IN(13)) { dispatch_phase(F); if (BOTH(13)) GRID_BAR(); }
    if (IN(14) || IN(15)) {
        LAS int* tst = (LAS int*)(F.lds + LDSCTL_OFF);
        { const int t_ = F.wave * 64 + mk_lane(); if (t_ < 9) tst[t_] = ((const int*)(ws + WS_MOETAB))[t_]; }
        __syncthreads();
        const int T = tst[8];
        for (int ch = args.ch_lo; ch < args.ch_hi; ++ch) {
            const int t0 = ch * MOE_CHUNK_T; int nM = T - t0; nM = nM < 0 ? 0 : (nM > MOE_CHUNK_T ? MOE_CHUNK_T : nM);
            if (IN(14)) {
                pg8::MoeOrder<false> S; S.nM = nM; S.nN = 2 * FFE / 256; S.nwg = nM * S.nN; S.G = F.G; S.c = (int)blockIdx.x; S.t0 = t0; S.tstart = tst;
#if MK_FP8_MOE
                pg8::Gemm g{(const bf16*)(ws + WS_XS), (const bf16*)(ws + WS_W_MOE_GU), 0, 2 * FFE, DM / 2};
                pg8::EpiSwiglu8 E{ws + WS_HIDM, FFE, H8_MUL}; pg8::gemm_phase<pg8::EpiSwiglu8, pg8::MoeOrder<false>, true, true, SC_ONE, SC_M6>(ring, g, S, E, F.wave);
#else
                pg8::Gemm g{(const bf16*)(ws + WS_XS), (const bf16*)(ws + WS_W_MOE_GU), 0, 2 * FFE, DM};
                pg8::EpiSwiglu E{(bf16*)(ws + WS_HIDM), FFE}; pg8::gemm_phase<pg8::EpiSwiglu, pg8::MoeOrder<false>, true, true>(ring, g, S, E, F.wave);
#endif
                if (IN(15)) GRID_BAR();
            }
            if (IN(15)) {
                pg8::MoeOrder<true> S; S.nM = nM; S.nN = DM / 256; S.nwg = nM * S.nN; S.G = F.G; S.c = (int)blockIdx.x; S.t0 = t0; S.tstart = tst;
                pg8::EpiRowScale E{(bf16*)(ws + WS_OS), DM, (const float*)(ws + WS_SLOTGATE)};
#if MK_FP8_MOE
                pg8::Gemm g{(const bf16*)(ws + WS_HIDM), (const bf16*)(ws + WS_W_MOE_D), 0, DM, FFE / 2};
                pg8::gemm_phase<pg8::EpiRowScale, pg8::MoeOrder<true>, true, true, SC_M4, SC_M7>(ring, g, S, E, F.wave);
#else
                pg8::Gemm g{(const bf16*)(ws + WS_HIDM), (const bf16*)(ws + WS_W_MOE_D), 0, DM, FFE};
                pg8::gemm_phase<pg8::EpiRowScale, pg8::MoeOrder<true>, true, true>(ring, g, S, E, F.wave);
#endif
                if (ch + 1 < args.ch_hi ? IN(14) : IN(16)) GRID_BAR();
            }
        }
    }
    if (IN(16)) final_phase(F, F.in[I_LNG] + 3 * DM, F.in[I_LNB] + 3 * DM);
#undef IN
#undef BOTH
#undef GRID_BAR
}

#if MK_DEBUG
__device__ __forceinline__ unsigned hash32(unsigned x) { x ^= x >> 16; x *= 0x7feb352dU; x ^= x >> 15; x *= 0x846ca68bU; x ^= x >> 16; return x; }
__device__ __forceinline__ float wdot(const bf16* a, const bf16* b, int K, int lane) { float s = 0.f; for (int k = lane; k < K; k += 64) s += bf2f(a[k]) * bf2f(b[k]); return wave_sum(s); }
__device__ __forceinline__ bool okf(float got, float ref, float rel, float ab) { return fabsf(got - ref) <= rel * fabsf(ref) + ab; }
__device__ __forceinline__ float gelu_ref(float x) { return 0.5f * x * (1.0f + tanhf(0.7978845608f * (x + 0.044715f * x * x * x))); }
__device__ __forceinline__ float silu_ref(float x) { return x / (1.0f + expf(-x)); }
__device__ __forceinline__ float f8f(unsigned char b) { return __builtin_amdgcn_cvt_f32_fp8((int)b, 0); }
__device__ __forceinline__ unsigned char f2f8(float x) { return (unsigned char)(__builtin_amdgcn_cvt_pk_fp8_f32(x, 0.f, 0, false) & 0xff); }
__device__ __forceinline__ float wdot8(const unsigned char* a, const unsigned char* b, int K, int lane) { float s = 0.f; for (int k = lane; k < K; k += 64) s += f8f(a[k]) * f8f(b[k]); return wave_sum(s); }
#define CHK_FAIL(stage) do { if (lane == 0) atomicAdd((unsigned*)(a.ws + WS_CTL) + CW_CHK + (stage), 1u); } while (0)
__device__ void chk_tr8(const Args& a, int stage, const float* W, int K, int N, const unsigned char* WT, int row_off, int mode, float mul, unsigned s, int lane) {
    const int k = hash32(s * 2 + 1) % K, n = hash32(s * 2 + 2) % N; const int drow = row_off + (mode == 0 ? n : ((n >> 7) * 256 + (n & 127) + (mode == 2 ? 128 : 0)));
    if (WT[(size_t)drow * K + k] != f2f8(W[(size_t)k * N + n] * mul)) CHK_FAIL(stage);
}
__device__ void chk_tr(const Args& a, int stage, const float* W, int K, int N, const bf16* WT, int row_off, int mode, unsigned s, int lane) {
    const int k = hash32(s * 2 + 1) % K, n = hash32(s * 2 + 2) % N; const int drow = row_off + (mode == 0 ? n : ((n >> 7) * 256 + (n & 127) + (mode == 2 ? 128 : 0)));
    if (WT[(size_t)drow * K + k] != (bf16)f2bf(W[(size_t)k * N + n])) CHK_FAIL(stage);
}
__device__ void chk_memattn(const Args& a, int stage, const bf16* q, const bf16* Kb, const bf16* Ob, float* pl, int lane) {
    float sc[4], mx = -3e38f;
    for (int i = 0; i < 4; ++i) { const int j = lane + 64 * i; float s = 0.f; for (int d = 0; d < 128; ++d) s += bf2f(q[d]) * bf2f(Kb[(size_t)j * 2048 + d]); sc[i] = s * 0.08838834764831845f; mx = fmaxf(mx, sc[i]); }
    for (int o = 1; o < 64; o <<= 1) mx = fmaxf(mx, __shfl_xor(mx, o));
    float sum = 0.f; for (int i = 0; i < 4; ++i) { sc[i] = expf(sc[i] - mx); sum += sc[i]; pl[lane + 64 * i] = sc[i]; }
    sum = wave_sum(sum); __syncthreads();
    bool bad = false;
    for (int dd = 0; dd < 2; ++dd) { const int d = lane + 64 * dd; float o = 0.f; for (int j = 0; j < 256; ++j) o += pl[j] * bf2f(Kb[(size_t)j * 2048 + 512 + d]); o /= sum;
        if (!okf(bf2f(Ob[d]), o, 0.03f, 0.004f)) bad = true; }
    if (__any(bad)) CHK_FAIL(stage);
    __syncthreads();
}
__global__ void __launch_bounds__(64) chk_kernel(Args a, int stage, int chunk) {
    __shared__ float pl[8192];
    const int lane = threadIdx.x; const unsigned s = blockIdx.x; unsigned char* ws = a.ws;
    const bf16* XB = (const bf16*)(ws + WS_XB);
    if (stage == 0) {
        switch (s % 12) {
        case 0: chk_tr(a, 0, a.in[I_AWIN], DM, A_IN, (const bf16*)(ws + WS_W_A_IN), 0, 0, s, lane); break;
        case 1: { const int l = (s / 12) & 1; chk_tr(a, 0, a.in[I_WMIX] + (size_t)l * DM * DM, DM, DM, (const bf16*)(ws + WS_W_MIX), l * DM, 0, s, lane); } break;
        case 2: chk_tr(a, 0, a.in[I_FG], DM, FF, (const bf16*)(ws + WS_W_FFN_GU), 0, 1, s, lane); break;
        case 3: chk_tr(a, 0, a.in[I_FU], DM, FF, (const bf16*)(ws + WS_W_FFN_GU), 0, 2, s, lane); break;
        case 4: chk_tr(a, 0, a.in[I_FD], FF, DM, (const bf16*)(ws + WS_W_FFN_D), 0, 0, s, lane); break;
        case 5: chk_tr(a, 0, a.in[I_SWKV], DM, 3072, (const bf16*)(ws + WS_W_B_IN), 0, 0, s, lane); break;
        case 6: chk_tr(a, 0, a.in[I_BWIN], DM, DM, (const bf16*)(ws + WS_W_B_IN), 3072, 0, s, lane); break;
        case 7: { const int l = (s / 12) & 1; chk_tr(a, 0, a.in[I_WMEMKV] + (size_t)l * DM * 1024, DM, 1024, (const bf16*)(ws + WS_W_MEMKV), l * 1024, 0, s, lane); } break;
#if MK_FP8_MOE
        case 8: { const int e = (s / 12) & 7; chk_tr8(a, 0, a.in[I_MG] + (size_t)e * DM * FFE, DM, FFE, ws + WS_W_MOE_GU, e * 2 * FFE, 1, W8_GU_MUL, s, lane); } break;
        case 9: { const int e = (s / 12) & 7; chk_tr8(a, 0, a.in[I_MU] + (size_t)e * DM * FFE, DM, FFE, ws + WS_W_MOE_GU, e * 2 * FFE, 2, W8_GU_MUL, s, lane); } break;
        case 10: { const int e = (s / 12) & 7; chk_tr8(a, 0, a.in[I_MD] + (size_t)e * FFE * DM, FFE, DM, ws + WS_W_MOE_D, e * DM, 0, W8_D_MUL, s, lane); } break;
#else
        case 8: { const int e = (s / 12) & 7; chk_tr(a, 0, a.in[I_MG] + (size_t)e * DM * FFE, DM, FFE, (const bf16*)(ws + WS_W_MOE_GU), e * 2 * FFE, 1, s, lane); } break;
        case 9: { const int e = (s / 12) & 7; chk_tr(a, 0, a.in[I_MU] + (size_t)e * DM * FFE, DM, FFE, (const bf16*)(ws + WS_W_MOE_GU), e * 2 * FFE, 2, s, lane); } break;
        case 10: { const int e = (s / 12) & 7; chk_tr(a, 0, a.in[I_MD] + (size_t)e * FFE * DM, FFE, DM, (const bf16*)(ws + WS_W_MOE_D), e * DM, 0, s, lane); } break;
#endif
        default: { const size_t i = hash32(s) % ((size_t)NTOK * DM); if (XB[i] != (bf16)f2bf(a.in[I_X][i])) CHK_FAIL(0);
                   const size_t i2 = hash32(s + 7) % ((size_t)1024 * DM); if (((const bf16*)(ws + WS_MEMB))[i2] != (bf16)f2bf(a.in[I_MEM][i2])) CHK_FAIL(0);
                   const int i3 = hash32(s + 9) % (NSG * 128 * 128), ss = i3 & 127, tt = (i3 >> 7) & 127; if (((const bf16*)(ws + WS_WSBF))[i3] != (bf16)(ss <= tt ? f2bf(a.in[I_AWS][i3]) : 0u)) CHK_FAIL(0); } break;
        }
    } else if (stage == 1) {
        const int row = hash32(s) % NTOK, col = (s & 1) ? (3072 + hash32(s + 1) % 512) : (hash32(s + 1) % A_IN);
        float ref = wdot(XB + (size_t)row * DM, (const bf16*)(ws + WS_W_A_IN) + (size_t)col * DM, DM, lane); if (col < 3072) ref = gelu_ref(ref);
        if (!okf(bf2f(((const bf16*)(ws + WS_H0))[(size_t)row * A_IN + col]), ref, 0.02f, 0.02f)) CHK_FAIL(1);
        const int r2 = hash32(s + 3) % 1024, c2 = hash32(s + 4) % 2048;
        const float ref2 = wdot((const bf16*)(ws + WS_MEMB) + (size_t)r2 * DM, (const bf16*)(ws + WS_W_MEMKV) + (size_t)c2 * DM, DM, lane);
        if (!okf(bf2f(((const bf16*)(ws + WS_MEMKV))[(size_t)r2 * 2048 + c2]), ref2, 0.02f, 0.02f)) CHK_FAIL(1);
    } else if (stage == 2) {
        const int tok = hash32(s) % NTOK, h = hash32(s + 1) & 3, b = tok / SEQ; const bf16* H0 = (const bf16*)(ws + WS_H0);
        chk_memattn(a, 2, H0 + (size_t)tok * A_IN + 3072 + h * 128, (const bf16*)(ws + WS_MEMKV) + (size_t)b * 256 * 2048 + h * 128, (const bf16*)(ws + WS_CONCAT) + (size_t)tok * DM + 1536 + h * 128, pl, lane);
        const int g = hash32(s + 2) % NSG, t = tok & 127; const size_t R0 = (size_t)(tok - t);
        float mean[2], rstd[2];
        for (int i = 0; i < 2; ++i) { const int sidx = lane + 64 * i; const bf16* vr = H0 + (R0 + sidx) * A_IN + MAINW; float sm = 0.f; for (int k = 0; k < MAINW; ++k) sm += bf2f(vr[k]); sm /= MAINW; float q = 0.f; for (int k = 0; k < MAINW; ++k) { const float d = bf2f(vr[k]) - sm; q += d * d; } mean[i] = sm; rstd[i] = 1.0f / sqrtf(q / MAINW + LN_EPS); }
        for (int dd = 0; dd < 2; ++dd) { const int d = hash32(s + 10 + dd) & 127, col = g * 128 + d; float acc = 0.f;
            for (int i = 0; i < 2; ++i) { const int sidx = lane + 64 * i; if (sidx <= t) { const float lv = (bf2f(H0[(R0 + sidx) * A_IN + MAINW + col]) - mean[i]) * rstd[i] * a.in[I_AVG][col] + a.in[I_AVB][col]; acc += a.in[I_AWS][((size_t)g * 128 + t) * 128 + sidx] * lv; } }
            acc = wave_sum(acc); const float ref = (acc + a.in[I_ABS][g * 128 + t]) * bf2f(H0[(R0 + t) * A_IN + col]);
            if (!okf(bf2f(((const bf16*)(ws + WS_CONCAT))[(R0 + t) * DM + col]), ref, 0.03f, 0.03f)) CHK_FAIL(3); }
    } else if (stage == 3 || stage == 6 || stage == 11) {
        const int row = hash32(s) % NTOK, col = hash32(s + 1) % DM; float ref;
        if (stage == 3) ref = ALPHA * a.in[I_X][(size_t)row * DM + col] + wdot((const bf16*)(ws + WS_CONCAT) + (size_t)row * DM, (const bf16*)(ws + WS_W_MIX) + (size_t)col * DM, DM, lane);
        else if (stage == 6) ref = ALPHA * bf2f(XB[(size_t)row * DM + col]) + wdot((const bf16*)(ws + WS_HID) + (size_t)row * FF, (const bf16*)(ws + WS_W_FFN_D) + (size_t)col * FF, FF, lane);
        else ref = ALPHA * bf2f(XB[(size_t)row * DM + col]) + wdot((const bf16*)(ws + WS_CONCAT1) + (size_t)row * DM, (const bf16*)(ws + WS_W_MIX) + (size_t)DM * DM + (size_t)col * DM, DM, lane);
        if (!okf(a.out[(size_t)row * DM + col], ref, 0.02f, 0.03f)) CHK_FAIL(stage == 3 ? 4 : (stage == 6 ? 7 : 13));
    } else if (stage == 4 || stage == 7 || stage == 12) {
        const int row = hash32(s) % NTOK, li = stage == 4 ? 0 : (stage == 7 ? 1 : 2); const float* o = a.out + (size_t)row * DM; const float* g = a.in[I_LNG] + li * DM; const float* bb = a.in[I_LNB] + li * DM;
        const bf16* xb = stage == 12 ? (const bf16*)(ws + WS_X3B) : XB;
        float s1 = 0.f, s2 = 0.f; bool bad = false;
        for (int k = lane; k < DM; k += 64) { const float z = (o[k] - bb[k]) / g[k]; s1 += z; s2 += z * z;
#if MK_FP8_MOE
            if (stage == 12) { if (((const unsigned char*)(ws + WS_X3B))[(size_t)row * DM + k] != f2f8(o[k])) bad = true; } else
#endif
            if (xb[(size_t)row * DM + k] != (bf16)f2bf(o[k])) bad = true; }
        s1 = wave_sum(s1) / DM; s2 = wave_sum(s2) / DM;
        if (__any(bad) || !(fabsf(s1) < 1e-3f) || !(fabsf(s2 - 1.0f) < 1e-2f)) CHK_FAIL(stage == 4 ? 5 : (stage == 7 ? 8 : 14));
        if (stage == 12) {
            float lg[8]; for (int e = 0; e < 8; ++e) { float p = 0.f; for (int k = lane; k < DM; k += 64) p += o[k] * a.in[I_ROUTER][k * 8 + e]; lg[e] = wave_sum(p); }
            int e0 = 0; for (int e = 1; e < 8; ++e) if (lg[e] > lg[e0]) e0 = e; int e1 = e0 == 0 ? 1 : 0; for (int e = 0; e < 8; ++e) if (e != e0 && lg[e] > lg[e1]) e1 = e;
            const int re = ((const int*)(ws + WS_ROUTE_E))[row]; const float w0 = ((const float*)(ws + WS_ROUTE_W))[2 * row];
            float third = -3e38f; for (int e = 0; e < 8; ++e) if (e != e0 && e != e1) third = fmaxf(third, lg[e]);
            const bool tie = (lg[e0] - lg[e1] < 1e-4f) || (lg[e1] - third < 1e-4f);
            if (!tie && (re != (e0 | (e1 << 8)) || !okf(w0, 1.0f / (1.0f + expf(lg[e1] - lg[e0])), 1e-3f, 1e-4f))) CHK_FAIL(15);
        }
    } else if (stage == 5) {
        const int row = hash32(s) % NTOK, hc = hash32(s + 1) % FF; const bf16* W = (const bf16*)(ws + WS_W_FFN_GU) + (size_t)((hc >> 7) * 256 + (hc & 127)) * DM;
        const float g = wdot(XB + (size_t)row * DM, W, DM, lane), u = wdot(XB + (size_t)row * DM, W + (size_t)128 * DM, DM, lane);
        if (!okf(bf2f(((const bf16*)(ws + WS_HID))[(size_t)row * FF + hc]), silu_ref(g) * u, 0.02f, 0.01f)) CHK_FAIL(6);
    } else if (stage == 8) {
        const int row = hash32(s) % NTOK, col = hash32(s + 1) % B_IN;
        const float ref = wdot(XB + (size_t)row * DM, (const bf16*)(ws + WS_W_B_IN) + (size_t)col * DM, DM, lane);
        if (!okf(bf2f(((const bf16*)(ws + WS_H1))[(size_t)row * B_IN + col]), ref, 0.02f, 0.02f)) CHK_FAIL(9);
    } else if (stage == 9) {
        const int tok = (s & 3) == 0 ? ((hash32(s) % (NTOK / 256)) * 256 + (hash32(s + 5) & 1 ? 255 : 0)) : hash32(s) % NTOK; const int b = tok / SEQ, pos = tok % SEQ, h = hash32(s + 1) % 6, m = hash32(s + 2) & 1, half = hash32(s + 3) & 1;
        const bf16* H1 = (const bf16*)(ws + WS_H1); const bf16* q = H1 + (size_t)tok * B_IN + 3072 + (m * 6 + h) * 128; const bf16* Kb = H1 + (size_t)b * SEQ * B_IN + (m * 6 + h) * 128; const bf16* Vb = H1 + (size_t)b * SEQ * B_IN + 1536 + h * 256 + half * 128;
        float mx = -3e38f; for (int j = lane; j <= pos; j += 64) { float sc = 0.f; for (int d = 0; d < 128; ++d) sc += bf2f(q[d]) * bf2f(Kb[(size_t)j * B_IN + d]); sc *= 0.08838834764831845f; pl[j] = sc; mx = fmaxf(mx, sc); }
        for (int o = 1; o < 64; o <<= 1) mx = fmaxf(mx, __shfl_xor(mx, o));
        float sum = 0.f; for (int j = lane; j <= pos; j += 64) { const float p = expf(pl[j] - mx); pl[j] = p; sum += p; } sum = wave_sum(sum); __syncthreads();
        bool bad = false;
        for (int dd = 0; dd < 2; ++dd) { const int d = lane + 64 * dd; float o = 0.f; for (int j = 0; j <= pos; ++j) o += pl[j] * bf2f(Vb[(size_t)j * B_IN + d]); o /= sum;
            if (!okf(bf2f(((const bf16*)(ws + WS_AO))[(size_t)tok * 3072 + m * 1536 + h * 256 + half * 128 + d]), o, 0.03f, 0.004f)) bad = true; }
        if (__any(bad)) CHK_FAIL(10);
    } else if (stage == 10) {
        const int tok = hash32(s) % NTOK, h4 = hash32(s + 1) & 3, b = tok / SEQ; const bf16* H1 = (const bf16*)(ws + WS_H1);
        chk_memattn(a, 11, H1 + (size_t)tok * B_IN + 4608 + h4 * 128, (const bf16*)(ws + WS_MEMKV) + (size_t)b * 256 * 2048 + 1024 + h4 * 128, (const bf16*)(ws + WS_CONCAT1) + (size_t)tok * DM + 1536 + h4 * 128, pl, lane);
        const int h = hash32(s + 2) % 6; const bf16* AO = (const bf16*)(ws + WS_AO) + (size_t)tok * 3072;
        float s1 = 0.f, s2 = 0.f; for (int k = lane; k < 128; k += 64) { s1 += a.in[I_LQ1][k] * a.in[I_LK1][k]; s2 += a.in[I_LQ2][k] * a.in[I_LK2][k]; } s1 = wave_sum(s1); s2 = wave_sum(s2);
        const float lam = expf(s1) - expf(s2) + LAMBDA_INIT; float x[4], ss = 0.f;
        for (int i = 0; i < 4; ++i) { const int d = lane + 64 * i; x[i] = bf2f(AO[h * 256 + d]) - lam * bf2f(AO[1536 + h * 256 + d]); ss += x[i] * x[i]; } ss = wave_sum(ss);
        bool bad = false; for (int i = 0; i < 4; ++i) { const int d = lane + 64 * i; const float ref = x[i] / sqrtf(ss / 256.f + LN_EPS) * a.in[I_SUBLN][d] * (1.0f - LAMBDA_INIT);
            if (!okf(bf2f(((const bf16*)(ws + WS_CONCAT1))[(size_t)tok * DM + h * 256 + d]), ref, 0.02f, 0.01f)) bad = true; }
        if (__any(bad)) CHK_FAIL(12);
    } else if (stage == 13 || stage == 14 || stage == 15) {
        const int tok = hash32(s) % NTOK, k = hash32(s + 1) & 1; const int slot = ((const int*)(ws + WS_TOKSLOT))[2 * tok + k]; const int* tab = (const int*)(ws + WS_MOETAB);
        const int e = (((const int*)(ws + WS_ROUTE_E))[tok] >> (8 * k)) & 0xff; const float gate = ((const float*)(ws + WS_ROUTE_W))[2 * tok + k];
        if (stage == 13) {
            bool bad = slot < 0 || slot >= MAXT * 256;
            if (!bad) { const int tile = slot >> 8; int te = 0; for (int j = 1; j < 8; ++j) te += tile >= tab[j]; bad = te != e || tile >= tab[8] || ((const int*)(ws + WS_SLOTTOK))[slot] != tok || ((const float*)(ws + WS_SLOTGATE))[slot] != gate;

#if MK_FP8_MOE
                for (int j = lane; j < DM; j += 64) if (((const unsigned char*)(ws + WS_XS))[(size_t)slot * DM + j] != ((const unsigned char*)(ws + WS_X3B))[(size_t)tok * DM + j]) bad = true; }
#else
                for (int j = lane; j < DM; j += 64) if (((const bf16*)(ws + WS_XS))[(size_t)slot * DM + j] != ((const bf16*)(ws + WS_X3B))[(size_t)tok * DM + j]) bad = true; }
#endif
            if (__any(bad)) CHK_FAIL(16);
        } else { const int loc = slot - chunk * MOE_CHUNK_T * 256;
            if (loc >= 0 && loc < MOE_CHUNK_T * 256) {
#if MK_FP8_MOE
                if (stage == 14) { const int hc = hash32(s + 2) % FFE; const unsigned char* W = ws + WS_W_MOE_GU + ((size_t)e * 2 * FFE + (hc >> 7) * 256 + (hc & 127)) * DM; const unsigned char* x = ws + WS_XS + (size_t)slot * DM;
                    const float g = wdot8(x, W, DM, lane) / W8_GU_MUL, u = wdot8(x, W + (size_t)128 * DM, DM, lane) / W8_GU_MUL;
                    if (!okf(f8f((ws + WS_HIDM)[(size_t)loc * FFE + hc]) / H8_MUL, silu_ref(g) * u, 0.08f, 0.004f)) CHK_FAIL(17);
                } else { const int col = hash32(s + 2) % DM; const float ref = gate * wdot8(ws + WS_HIDM + (size_t)loc * FFE, ws + WS_W_MOE_D + ((size_t)e * DM + col) * FFE, FFE, lane) / (H8_MUL * W8_D_MUL);
                    if (!okf(bf2f(((const bf16*)(ws + WS_OS))[(size_t)slot * DM + col]), ref, 0.02f, 0.004f)) CHK_FAIL(18); } } }
#else
                if (stage == 14) { const int hc = hash32(s + 2) % FFE; const bf16* W = (const bf16*)(ws + WS_W_MOE_GU) + ((size_t)e * 2 * FFE + (hc >> 7) * 256 + (hc & 127)) * DM; const bf16* x = (const bf16*)(ws + WS_XS) + (size_t)slot * DM;
                    const float g = wdot(x, W, DM, lane), u = wdot(x, W + (size_t)128 * DM, DM, lane);
                    if (!okf(bf2f(((const bf16*)(ws + WS_HIDM))[(size_t)loc * FFE + hc]), silu_ref(g) * u, 0.02f, 0.01f)) CHK_FAIL(17);
                } else { const int col = hash32(s + 2) % DM; const float ref = gate * wdot((const bf16*)(ws + WS_HIDM) + (size_t)loc * FFE, (const bf16*)(ws + WS_W_MOE_D) + ((size_t)e * DM + col) * FFE, FFE, lane);
                    if (!okf(bf2f(((const bf16*)(ws + WS_OS))[(size_t)slot * DM + col]), ref, 0.02f, 0.004f)) CHK_FAIL(18); } } }
#endif
    }
}
__global__ void fin_kernel(Args a, int complete) {
    const unsigned* c = (const unsigned*)(a.ws + WS_CTL) + CW_CHK; int first = -1; for (int i = 0; i < 32; ++i) if (c[i] && first < 0) first = i;
    const unsigned* ctl = (const unsigned*)(a.ws + WS_CTL); if (first < 0 && (ctl[CW_TMO] || ctl[CW_BAR + XB_TMO])) first = 30;
    if (first < 0 && complete) return;
    const float v = sqrtf(first < 0 ? 76.0f : 10.0f + first);
    for (size_t i = (size_t)blockIdx.x * blockDim.x + threadIdx.x; i < (size_t)NTOK * DM; i += (size_t)gridDim.x * blockDim.x) a.out[i] = v;
}
#endif

extern "C" void kernel_launch(void* const* d_in, const int* in_sizes, int n_in, void* d_out, int out_size, void* d_ws, size_t ws_size, hipStream_t stream) {
    static int grid = 0;
    if (grid == 0) {
        if (n_in != 25 || in_sizes[0] != NTOK * DM || out_size != NTOK * DM || ws_size < WS_END) { fprintf(stderr, "kernel_launch: unexpected shapes (n_in %d, in0 %d, out %d, ws %zu < %zu); nothing launched\n", n_in, n_in > 0 ? in_sizes[0] : -1, out_size, ws_size, (size_t)WS_END); grid = -1; return; }
        int dev = 0, cus = 0, per_cu = 0;
        if (hipGetDevice(&dev) != hipSuccess || hipDeviceGetAttribute(&cus, hipDeviceAttributeMultiprocessorCount, dev) != hipSuccess) { grid = -1; return; }
        if (hipFuncSetAttribute((const void*)mk_fwd, hipFuncAttributeMaxDynamicSharedMemorySize, LDS_BYTES) != hipSuccess) { fprintf(stderr, "kernel_launch: hipFuncSetAttribute failed\n"); grid = -1; return; }
        if (hipOccupancyMaxActiveBlocksPerMultiprocessor(&per_cu, (const void*)mk_fwd, NWAVES * 64, LDS_BYTES) != hipSuccess || per_cu < 1) fprintf(stderr, "kernel_launch: occupancy query reports %d\n", per_cu);
        (void)hipGetLastError();
        grid = cus;
    }
    if (grid < 0) return;
    if (hipMemsetAsync((char*)d_ws + WS_CTL, 0, CTL_ZERO_BYTES, stream) != hipSuccess) return;
    Args a{};
    for (int i = 0; i < 25; ++i) a.in[i] = (const float*)d_in[i];
    a.out = (float*)d_out; a.ws = (unsigned char*)d_ws;
#if MK_DEBUG
    const int last = MK_LAST_PHASE;
    auto run = [&](int ph, int ch) { a.ph_lo = ph; a.ph_hi = ph + 1; a.ch_lo = ch; a.ch_hi = ch + 1; hipLaunchKernelGGL(mk_fwd, dim3(grid), dim3(NWAVES * 64), LDS_BYTES, stream, a); };
    auto chk = [&](int stage, int ch) { hipLaunchKernelGGL(chk_kernel, dim3(1024), dim3(64), 0, stream, a, stage, ch); };
    for (int ph = 0; ph <= last && ph <= 13; ++ph) { run(ph, 0); chk(ph, 0); }
    if (last >= 14) for (int ch = 0; ch < (MAXT + MOE_CHUNK_T - 1) / MOE_CHUNK_T; ++ch) { run(14, ch); chk(14, ch); if (last >= 15) { run(15, ch); chk(15, ch); } }
    if (last >= 16) run(16, 0);
    hipLaunchKernelGGL(fin_kernel, dim3(1024), dim3(256), 0, stream, a, last >= 16 ? 1 : 0);
#else
    a.ph_lo = 0; a.ph_hi = 17; a.ch_lo = 0; a.ch_hi = (MAXT + MOE_CHUNK_T - 1) / MOE_CHUNK_T;
    hipLaunchKernelGGL(mk_fwd, dim3(grid), dim3(NWAVES * 64), LDS_BYTES, stream, a);
#endif
}
```

```cpp
#include <hip/hip_runtime.h>
#include <hip/hip_bf16.h>
#include <cstdio>
#include <cstdint>

#ifndef MK_DEBUG
#define MK_DEBUG 0
#endif
#ifndef MK_FP8_MOE
#define MK_FP8_MOE 1
#endif
#ifndef MK_FP8_FFN
#define MK_FP8_FFN 1
#endif
#ifndef MK_BG
#define MK_BG 1
#endif
#ifndef MK_PROBE
#define MK_PROBE 0
#endif
#ifndef MK_PROBE_A
#define MK_PROBE_A 0x1
#endif
#define MK_PROBE_MULT 8
#ifndef MK_PROBE_BARMASK
#define MK_PROBE_BARMASK 0xffffff
#endif
#ifndef MK_PROBE_BLK
#define MK_PROBE_BLK 0
#endif
#ifndef MK_PHMASK
#define MK_PHMASK 0x1ffff
#endif
#ifndef MK_LAST_PHASE
#define MK_LAST_PHASE 18
#endif

__device__ __forceinline__ int mk_lane() { int r; asm volatile("v_mbcnt_lo_u32_b32 %0, -1, 0\n\tv_mbcnt_hi_u32_b32 %0, -1, %0" : "=v"(r)); return r; }
namespace pg8 {
#define PG8_LAS __attribute__((address_space(3)))
typedef unsigned short bf16_t;
typedef short bf16x8 __attribute__((ext_vector_type(8)));
typedef float f32x4 __attribute__((ext_vector_type(4)));
typedef float f32x2 __attribute__((ext_vector_type(2)));
typedef unsigned u32x4 __attribute__((ext_vector_type(4)));
typedef int v4i_t __attribute__((ext_vector_type(4)));
constexpr int BM = 256, BK = 64, HALF = 128, HTB = HALF * BK * 2  , STAGE_BYTES = 8 * HTB, NXCD = 8, WGM = 8;

__host__ __device__ __forceinline__ int lds_byte(int r, int c) { const int st = (r >> 4) * 2 + (c >> 5), rr = r & 15, cc = c & 31, ob = rr * 64 + cc * 2; return st * 1024 + (ob ^ (((ob >> 9) & 1) << 5)); }
__host__ __device__ __forceinline__ void stage_rc(int b, int& R, int& C) { const int st = b / 1024, sb = b % 1024, swz = sb ^ (((sb >> 9) & 1) << 5); R = (st >> 1) * 16 + swz / 64; C = (st & 1) * 32 + (swz % 64) / 2; }
__host__ __device__ __forceinline__ int perm32(int rho) { const int n = rho >> 4, i = rho & 15; return 8 * (i >> 2) + 4 * n + (i & 3); }

struct Unit { int pa, pb, pm, pn, koff; };
struct Gemm { const bf16_t* A; const bf16_t* Bt; int M, N, K, KL; };

__host__ __device__ __forceinline__ void tile_of(int wgid, int nM, int nN, int& pm, int& pn) {
    const int nwg = nM * nN;
    { const int q = nwg / NXCD, r = nwg % NXCD, xcd = wgid % NXCD, off = wgid / NXCD; wgid = (xcd < r ? xcd * (q + 1) : r * (q + 1) + (xcd - r) * q) + off; }
    const int nig = WGM * nN, gid = wgid / nig, fm = gid * WGM, gsz = (nM - fm) < WGM ? (nM - fm) : WGM;
    pm = fm + ((wgid % nig) % gsz); pn = (wgid % nig) / gsz;
}
struct StaticOrder {
    int nM, nN, nwg, G, c;
    __host__ __device__ void init(int M, int N, int G_, int c_) { nM = M / BM; nN = N / BM; nwg = nM * nN; G = G_; c = c_; }
    __host__ __device__ bool next(int i, Unit& u) const {
        const long L = (long)i * G + c; if (L >= nwg) return false;
        int pm, pn; tile_of((int)L, nM, nN, pm, pn); u.pa = pm; u.pb = pn; u.pm = pm; u.pn = pn; u.koff = 0; return true;
    }
    __device__ __forceinline__ void a_ready(const Unit&) const {}
    __device__ __forceinline__ void done(const Unit&) const {}
};
template <bool A_LOCAL> struct MoeOrder {
    int nM, nN, nwg, G, c, t0; const PG8_LAS int* tstart;
    __device__ bool next(int i, Unit& u) const {
        const long L = (long)i * G + c; if (L >= nwg) return false;
        int pm, pn; tile_of((int)L, nM, nN, pm, pn); const int t = t0 + pm; int e = 0;
#pragma unroll
        for (int j = 1; j < 8; ++j) e += (t >= tstart[j]) ? 1 : 0;
        u.pa = A_LOCAL ? pm : t; u.pm = A_LOCAL ? t : pm; u.pb = e * nN + pn; u.pn = pn; u.koff = 0; return true;
    }
    __device__ __forceinline__ void a_ready(const Unit&) const {}
    __device__ __forceinline__ void done(const Unit&) const {}
};

struct MoeLeftOrder {
    int L, G, c, tl0, kq; const PG8_LAS int* tstart;
    __device__ bool next(int i, Unit& u) const {
        const long Lx = (long)i * G + c; if (Lx >= (long)L * 32) return false;
        const int q = (int)Lx & 3, pn = ((int)Lx >> 2) & 7, lt = (int)Lx >> 5, t = tl0 + lt; int e = 0;
#pragma unroll
        for (int j = 1; j < 8; ++j) e += (t >= tstart[j]) ? 1 : 0;
        u.pa = t; u.pb = e * 8 + pn; u.pm = q * 8 + lt; u.pn = pn; u.koff = q * kq; return true;
    }
    __device__ __forceinline__ void a_ready(const Unit&) const {}
    __device__ __forceinline__ void done(const Unit&) const {}
};

__device__ __forceinline__ unsigned cvt_pk_bf16(float lo, float hi) { unsigned r; asm volatile("v_cvt_pk_bf16_f32 %0, %1, %2" : "=v"(r) : "v"(lo), "v"(hi)); return r; }
__device__ __forceinline__ float gelu_tanh(float x) { const float u = x * (1.0f + 0.044715f * x * x); const float e = __builtin_amdgcn_exp2f(-2.302208198f * u); return x * __builtin_amdgcn_rcpf(1.0f + e); }
__device__ __forceinline__ float silu_f(float x) { const float e = __builtin_amdgcn_exp2f(-1.4426950409f * x); return x * __builtin_amdgcn_rcpf(1.0f + e); }

struct EpiBf16 {
    static constexpr bool PERM = true, AFTER_DRAIN = false;
    bf16_t* O; int ldc; int gelu_cols; int nt_cols;
    __device__ __forceinline__ void operator()(const f32x4 (&acc)[2][2][4][2], const Unit& u, int wr, int wc, int fr, int fq) const {
        const int row0 = u.pm * BM + wr * 64 + fr, col0 = u.pn * BM + wc * 32 + 8 * fq; const bool act = (u.pn * BM) < gelu_cols, nts = (u.pn * BM) >= nt_cols;
#pragma unroll
        for (int ai = 0; ai < 2; ++ai)
#pragma unroll
            for (int m = 0; m < 4; ++m) { bf16_t* rowp = O + (size_t)(row0 + ai * HALF + m * 16) * ldc + col0;
#pragma unroll
                for (int bj = 0; bj < 2; ++bj) { f32x4 v0 = acc[ai][bj][m][0], v1 = acc[ai][bj][m][1];
                    if (act) {
#pragma unroll
                        for (int j = 0; j < 4; ++j) { v0[j] = gelu_tanh(v0[j]); v1[j] = gelu_tanh(v1[j]); } }
                    u32x4 w; w.x = cvt_pk_bf16(v0[0], v0[1]); w.y = cvt_pk_bf16(v0[2], v0[3]); w.z = cvt_pk_bf16(v1[0], v1[1]); w.w = cvt_pk_bf16(v1[2], v1[3]);
                    if (nts) __builtin_nontemporal_store(w, (u32x4*)(rowp + bj * HALF)); else *(u32x4*)(rowp + bj * HALF) = w; } }
    }
};
struct EpiRes {
    static constexpr bool PERM = false, AFTER_DRAIN = false;
    const float* base; float* out; int ldc; float alpha;
    __device__ __forceinline__ void operator()(const f32x4 (&acc)[2][2][4][2], const Unit& u, int wr, int wc, int fr, int fq) const {
        const int row0 = u.pm * BM + wr * 64 + fr, col0 = u.pn * BM + wc * 32 + 4 * fq;
#pragma unroll
        for (int ai = 0; ai < 2; ++ai)
#pragma unroll
            for (int m = 0; m < 4; ++m) { const size_t off = (size_t)(row0 + ai * HALF + m * 16) * ldc + col0;
                f32x4 b[2][2];
#pragma unroll
                for (int bj = 0; bj < 2; ++bj)
#pragma unroll
                    for (int n = 0; n < 2; ++n) b[bj][n] = *(const f32x4*)(base + off + bj * HALF + n * 16);
#pragma unroll
                for (int bj = 0; bj < 2; ++bj)
#pragma unroll
                    for (int n = 0; n < 2; ++n) *(f32x4*)(out + off + bj * HALF + n * 16) = b[bj][n] * alpha + acc[ai][bj][m][n];
                asm volatile("" ::: "memory"); }
    }
};
struct EpiResLn {
    static constexpr bool PERM = false, AFTER_DRAIN = false;
    float* out; const float* stats; const float* g; const float* b;
    __device__ __forceinline__ void operator()(const f32x4 (&acc)[2][2][4][2], const Unit& u, int wr, int wc, int fr, int fq) const {
        constexpr int ldc = 2048; constexpr float alpha = 1.41421356237309515f;
        const int row0 = u.pm * BM + wr * 64 + fr, col0 = u.pn * BM + wc * 32 + 4 * fq;
        f32x4 gv[2][2], bv[2][2];
#pragma unroll
        for (int bj = 0; bj < 2; ++bj)
#pragma unroll
            for (int n = 0; n < 2; ++n) { gv[bj][n] = *(const f32x4*)(g + col0 + bj * HALF + n * 16) * alpha; bv[bj][n] = *(const f32x4*)(b + col0 + bj * HALF + n * 16) * alpha; }
#pragma unroll
        for (int ai = 0; ai < 2; ++ai)
#pragma unroll
            for (int m = 0; m < 4; ++m) { const int row = row0 + ai * HALF + m * 16; const size_t off = (size_t)row * ldc + col0; const f32x2 st = *(const f32x2*)(stats + 2 * row);
                f32x4 y[2][2];
#pragma unroll
                for (int bj = 0; bj < 2; ++bj)
#pragma unroll
                    for (int n = 0; n < 2; ++n) y[bj][n] = *(const f32x4*)(out + off + bj * HALF + n * 16);
#pragma unroll
                for (int bj = 0; bj < 2; ++bj)
#pragma unroll
                    for (int n = 0; n < 2; ++n) *(f32x4*)(out + off + bj * HALF + n * 16) = (y[bj][n] - st.x) * st.y * gv[bj][n] + bv[bj][n] + acc[ai][bj][m][n];
                __builtin_amdgcn_sched_barrier(0); }
    }
};
struct EpiSwiglu {
    static constexpr bool PERM = true, AFTER_DRAIN = false;
    bf16_t* H; int ldh;
    __device__ __forceinline__ void operator()(const f32x4 (&acc)[2][2][4][2], const Unit& u, int wr, int wc, int fr, int fq) const {
        const int row0 = u.pm * BM + wr * 64 + fr, col0 = u.pn * HALF + wc * 32 + 8 * fq;
#pragma unroll
        for (int ai = 0; ai < 2; ++ai)
#pragma unroll
            for (int m = 0; m < 4; ++m) { bf16_t* rowp = H + (size_t)(row0 + ai * HALF + m * 16) * ldh + col0;
                f32x4 v0, v1;
#pragma unroll
                for (int j = 0; j < 4; ++j) { v0[j] = silu_f(acc[ai][0][m][0][j]) * acc[ai][1][m][0][j]; v1[j] = silu_f(acc[ai][0][m][1][j]) * acc[ai][1][m][1][j]; }
                u32x4 w; w.x = cvt_pk_bf16(v0[0], v0[1]); w.y = cvt_pk_bf16(v0[2], v0[3]); w.z = cvt_pk_bf16(v1[0], v1[1]); w.w = cvt_pk_bf16(v1[2], v1[3]);
                *(u32x4*)rowp = w; }
    }
};
template <bool NT> struct EpiSwiglu8 {
    static constexpr bool PERM = true, AFTER_DRAIN = false;
    unsigned char* H; int ldh;
    __device__ __forceinline__ void operator()(const f32x4 (&acc)[2][2][4][2], const Unit& u, int wr, int wc, int fr, int fq) const {
        const int row0 = u.pm * BM + wr * 64 + fr, col0 = u.pn * HALF + wc * 32 + 8 * fq;
#pragma unroll
        for (int ai = 0; ai < 2; ++ai)
#pragma unroll
            for (int m = 0; m < 4; ++m) { unsigned char* rowp = H + (size_t)(row0 + ai * HALF + m * 16) * ldh + col0;
                f32x4 v0, v1;
#pragma unroll
                for (int j = 0; j < 4; ++j) { const float g0 = acc[ai][0][m][0][j], g1 = acc[ai][0][m][1][j];
                    v0[j] = g0 * acc[ai][1][m][0][j] * __builtin_amdgcn_rcpf(1.0f + __builtin_amdgcn_exp2f(g0)); v1[j] = g1 * acc[ai][1][m][1][j] * __builtin_amdgcn_rcpf(1.0f + __builtin_amdgcn_exp2f(g1)); }
                int w0 = 0, w1 = 0;
                w0 = __builtin_amdgcn_cvt_pk_fp8_f32(v0[0], v0[1], w0, false); w0 = __builtin_amdgcn_cvt_pk_fp8_f32(v0[2], v0[3], w0, true);
                w1 = __builtin_amdgcn_cvt_pk_fp8_f32(v1[0], v1[1], w1, false); w1 = __builtin_amdgcn_cvt_pk_fp8_f32(v1[2], v1[3], w1, true);
                const unsigned long long pk_ = (unsigned long long)(unsigned)w0 | ((unsigned long long)(unsigned)w1 << 32);
                if (NT) __builtin_nontemporal_store(pk_, (unsigned long long*)rowp); else *(unsigned long long*)rowp = pk_; }
    }
};
struct EpiRowScale {
    static constexpr bool PERM = true, AFTER_DRAIN = false;
    bf16_t* O; int ldc; const float* rs;
    __device__ __forceinline__ void operator()(const f32x4 (&acc)[2][2][4][2], const Unit& u, int wr, int wc, int fr, int fq) const {
        const int row0 = u.pm * BM + wr * 64 + fr, col0 = u.pn * BM + wc * 32 + 8 * fq;
#pragma unroll
        for (int ai = 0; ai < 2; ++ai)
#pragma unroll
            for (int m = 0; m < 4; ++m) { const int row = row0 + ai * HALF + m * 16; const float s = rs[row + (u.pa - u.pm) * BM]; bf16_t* rowp = O + (size_t)row * ldc + col0;
#pragma unroll
                for (int bj = 0; bj < 2; ++bj) { const f32x4 v0 = acc[ai][bj][m][0] * s, v1 = acc[ai][bj][m][1] * s;
                    u32x4 w; w.x = cvt_pk_bf16(v0[0], v0[1]); w.y = cvt_pk_bf16(v0[2], v0[3]); w.z = cvt_pk_bf16(v1[0], v1[1]); w.w = cvt_pk_bf16(v1[2], v1[3]);
                    *(u32x4*)(rowp + bj * HALF) = w; } }
    }
};

template <class Epi, class Sched, bool ALIGN_EPI = false, bool SP2 = false, int SCA = 0, int SCB = 0>
__device__ __forceinline__ void gemm_phase(PG8_LAS unsigned char* lds, const Gemm g, const Sched& S, const Epi& E, const int mk_wid) {
    const int wid = mk_wid, lane = mk_lane(), tid = wid * 64 + lane, wr = wid >> 2, wc = wid & 3, fr = lane & 15, fq = lane >> 4;
    const int K = g.K, nt = (g.KL ? g.KL : K) / BK;
    unsigned voffA[2], voffB[2];
#pragma unroll
    for (int i = 0; i < 2; ++i) { int R, C; stage_rc(tid * 16 + i * 8192, R, C); const int Rb = Epi::PERM ? ((R & ~31) + perm32(R & 31)) : R;
        voffA[i] = (unsigned)(R * K + C) * 2u; voffB[i] = (unsigned)(Rb * K + C) * 2u; }
    const size_t kstep = (size_t)(BK * 2);
    const size_t hstep = (size_t)HALF * K * 2;
    const size_t tstep = 2 * hstep;
    const unsigned ldsw = (unsigned)wid * 1024u;
    const int aoff = lds_byte(wr * 64 + fr, fq * 8), boff = lds_byte(wc * 32 + fr, fq * 8);
#define PG8_SA(b, h) (((b) * 2 + (h)) * HTB)
#define PG8_SB(b, h) ((4 + (b) * 2 + (h)) * HTB)
#define PG8_STAGE(bufoff, gbase, voff) do { _Pragma("unroll") for (int _i = 0; _i < 2; ++_i) \
        __builtin_amdgcn_global_load_lds((const unsigned*)((const char*)(gbase) + (voff)[_i]), (PG8_LAS unsigned*)(lds + (bufoff) + ldsw + _i * 8192), 16, 0, 0); } while (0)
#define PG8_LDA(dst, b, h) do { _Pragma("unroll") for (int m = 0; m < 4; ++m) _Pragma("unroll") for (int k = 0; k < 2; ++k) dst[m][k] = *(const PG8_LAS bf16x8*)(lds + PG8_SA(b, h) + aoff + m * 2048 + k * 1024); } while (0)
#define PG8_LDB(dst, b, h) do { _Pragma("unroll") for (int n = 0; n < 2; ++n) _Pragma("unroll") for (int k = 0; k < 2; ++k) dst[n][k] = *(const PG8_LAS bf16x8*)(lds + PG8_SB(b, h) + boff + n * 2048 + k * 1024); } while (0)
#define PG8_CAT8(x, y) __builtin_shufflevector(__builtin_bit_cast(v4i_t, x), __builtin_bit_cast(v4i_t, y), 0, 1, 2, 3, 4, 5, 6, 7)
#define PG8_MMA(ai, bj, At, Bt) do { __builtin_amdgcn_s_setprio(1); if constexpr (SCA != 0) asm volatile("s_nop 1" ::: "memory"); \
        if constexpr (SCA != 0) { _Pragma("unroll") for (int m = 0; m < 4; ++m) _Pragma("unroll") for (int n = 0; n < 2; ++n) \
            asm volatile("v_mfma_scale_f32_16x16x128_f8f6f4 %0, %1, %2, %0, %3, %4 op_sel_hi:[0,0,0]" : "+v"(acc[ai][bj][m][n]) : "v"(PG8_CAT8(Bt[n][0], Bt[n][1])), "v"(PG8_CAT8(At[m][0], At[m][1])), "v"(scb_), "v"(sca_)); } \
        else { _Pragma("unroll") for (int m = 0; m < 4; ++m) _Pragma("unroll") for (int n = 0; n < 2; ++n) _Pragma("unroll") for (int k = 0; k < 2; ++k) \
            acc[ai][bj][m][n] = __builtin_amdgcn_mfma_f32_16x16x32_bf16(Bt[n][k], At[m][k], acc[ai][bj][m][n], 0, 0, 0); } \
        __builtin_amdgcn_s_setprio(0); } while (0)
#define PG8_WAIT_V(n) asm volatile("s_waitcnt vmcnt(" #n ")" ::: "memory")
#define PG8_WAIT_L(n) asm volatile("s_waitcnt lgkmcnt(" #n ")" ::: "memory")
#define PG8_BAR __builtin_amdgcn_s_barrier()
#define PG8_SCHED __builtin_amdgcn_sched_barrier(0)
    Unit cur, nxt; int ui = 0;
    if (!S.next(0, cur)) return;
    f32x4 acc[2][2][4][2];
#pragma unroll
    for (int a = 0; a < 2; ++a)
#pragma unroll
        for (int b = 0; b < 2; ++b)
#pragma unroll
            for (int m = 0; m < 4; ++m)
#pragma unroll
                for (int n = 0; n < 2; ++n) acc[a][b][m][n] = (f32x4){0.f, 0.f, 0.f, 0.f};
    bf16x8 At[4][2], B0[2][2], B1[2][2];
    const int sca_ = SCA, scb_ = SCB;
    const char* cA = (const char*)g.A + (size_t)cur.pa * tstep + cur.koff; const char* cB = (const char*)g.Bt + (size_t)cur.pb * tstep + cur.koff;
    S.a_ready(cur);
    if constexpr (SP2) {
        PG8_STAGE(PG8_SB(0, 0), cB, voffB); PG8_STAGE(PG8_SB(0, 1), cB + hstep, voffB); PG8_STAGE(PG8_SA(0, 0), cA, voffA); PG8_STAGE(PG8_SA(0, 1), cA + hstep, voffA);
        if (wr == 1) PG8_BAR;
        PG8_WAIT_V(2); PG8_BAR;
        PG8_STAGE(PG8_SB(1, 0), cB + kstep, voffB); PG8_STAGE(PG8_SA(1, 0), cA + kstep, voffA); PG8_STAGE(PG8_SB(1, 1), cB + hstep + kstep, voffB);
        PG8_WAIT_V(6); PG8_BAR;
    } else {
        PG8_STAGE(PG8_SB(0, 0), cB, voffB); PG8_STAGE(PG8_SA(0, 0), cA, voffA); PG8_STAGE(PG8_SB(0, 1), cB + hstep, voffB); PG8_STAGE(PG8_SA(0, 1), cA + hstep, voffA);
        if (wr == 1) PG8_BAR;
        PG8_WAIT_V(4); PG8_BAR;
        PG8_STAGE(PG8_SB(1, 0), cB + kstep, voffB); PG8_STAGE(PG8_SA(1, 0), cA + kstep, voffA); PG8_STAGE(PG8_SB(1, 1), cB + hstep + kstep, voffB);
        PG8_WAIT_V(6); PG8_BAR;
    }
    for (;;) {
        const bool has_next = S.next(ui + 1, nxt);
        const char* nA = has_next ? (const char*)g.A + (size_t)nxt.pa * tstep + nxt.koff : cA; const char* nB = has_next ? (const char*)g.Bt + (size_t)nxt.pb * tstep + nxt.koff : cB;
        for (int t = 0; t < nt; t += 2) {
            const bool last = (t == nt - 2);
            const char* a1 = cA + (size_t)(t + 1) * kstep;
            const char* a2 = last ? nA : cA + (size_t)(t + 2) * kstep; const char* b2 = last ? nB : cB + (size_t)(t + 2) * kstep;
            const char* a3 = a2 + kstep; const char* b3 = b2 + kstep;
            if (last && has_next) S.a_ready(nxt);
            if constexpr (SP2) {
            PG8_LDB(B0, 0, 0); PG8_LDB(B1, 0, 1); PG8_SCHED; PG8_LDA(At, 0, 0); PG8_STAGE(PG8_SA(1, 1), a1 + hstep, voffA);
            PG8_WAIT_V(8); PG8_WAIT_L(0); PG8_BAR; PG8_MMA(0, 0, At, B0); PG8_MMA(0, 1, At, B1); PG8_BAR; PG8_SCHED;
            PG8_LDA(At, 0, 1); PG8_STAGE(PG8_SB(0, 0), b2, voffB); PG8_STAGE(PG8_SB(0, 1), b2 + hstep, voffB); PG8_STAGE(PG8_SA(0, 0), a2, voffA);
            PG8_WAIT_V(8); PG8_WAIT_L(0); PG8_BAR; PG8_MMA(1, 0, At, B0); PG8_MMA(1, 1, At, B1); PG8_BAR; PG8_SCHED;
            PG8_LDB(B0, 1, 0); PG8_LDB(B1, 1, 1); PG8_SCHED; PG8_LDA(At, 1, 0); PG8_STAGE(PG8_SA(0, 1), a2 + hstep, voffA);
            PG8_WAIT_V(8); PG8_WAIT_L(0); PG8_BAR; PG8_MMA(0, 0, At, B0); PG8_MMA(0, 1, At, B1); PG8_BAR; PG8_SCHED;
            PG8_LDA(At, 1, 1); PG8_STAGE(PG8_SB(1, 0), b3, voffB); PG8_STAGE(PG8_SB(1, 1), b3 + hstep, voffB); PG8_STAGE(PG8_SA(1, 0), a3, voffA);
            PG8_WAIT_V(8); PG8_WAIT_L(0); PG8_BAR; PG8_MMA(1, 0, At, B0); PG8_MMA(1, 1, At, B1); PG8_BAR; PG8_SCHED;
            } else {
            PG8_LDB(B0, 0, 0); PG8_SCHED; PG8_LDA(At, 0, 0); PG8_STAGE(PG8_SA(1, 1), a1 + hstep, voffA);
            PG8_WAIT_L(8); PG8_BAR; PG8_WAIT_L(0); PG8_MMA(0, 0, At, B0); PG8_BAR; PG8_SCHED;
            PG8_LDB(B1, 0, 1); PG8_STAGE(PG8_SB(0, 0), b2, voffB);
            PG8_BAR; PG8_WAIT_L(0); PG8_MMA(0, 1, At, B1); PG8_BAR;
            PG8_LDA(At, 0, 1); PG8_STAGE(PG8_SA(0, 0), a2, voffA);
            PG8_BAR; PG8_WAIT_L(0); PG8_MMA(1, 0, At, B0); PG8_BAR; PG8_SCHED;
            PG8_STAGE(PG8_SB(0, 1), b2 + hstep, voffB);
            PG8_WAIT_V(6); PG8_BAR; PG8_MMA(1, 1, At, B1); PG8_BAR;
            PG8_LDB(B0, 1, 0); PG8_SCHED; PG8_LDA(At, 1, 0); PG8_STAGE(PG8_SA(0, 1), a2 + hstep, voffA);
            PG8_WAIT_L(8); PG8_BAR; PG8_WAIT_L(0); PG8_MMA(0, 0, At, B0); PG8_BAR; PG8_SCHED;
            PG8_LDB(B1, 1, 1); PG8_STAGE(PG8_SB(1, 0), b3, voffB);
            PG8_BAR; PG8_WAIT_L(0); PG8_MMA(0, 1, At, B1); PG8_BAR;
            PG8_LDA(At, 1, 1); PG8_STAGE(PG8_SA(1, 0), a3, voffA);
            PG8_BAR; PG8_WAIT_L(0); PG8_MMA(1, 0, At, B0); PG8_BAR; PG8_SCHED;
            PG8_STAGE(PG8_SB(1, 1), b3 + hstep, voffB);
            PG8_WAIT_V(6); PG8_BAR; PG8_MMA(1, 1, At, B1); PG8_BAR;
            }
        }
        if constexpr (SCA != 0) asm volatile("s_nop 15\n\ts_nop 15" ::: "memory");
        if constexpr (ALIGN_EPI) { if (wr == 0) PG8_BAR; }
        if constexpr (!Epi::AFTER_DRAIN) { E(acc, cur, wr, wc, fr, fq); S.done(cur); }
        if (!has_next) break;
#pragma unroll
        for (int a = 0; a < 2; ++a)
#pragma unroll
            for (int b = 0; b < 2; ++b)
#pragma unroll
                for (int m = 0; m < 4; ++m)
#pragma unroll
                    for (int n = 0; n < 2; ++n) acc[a][b][m][n] = (f32x4){0.f, 0.f, 0.f, 0.f};
        cur = nxt; cA = nA; cB = nB; ++ui;
        if constexpr (ALIGN_EPI) { if (wr == 1) PG8_BAR; }
    }
    PG8_WAIT_V(0);
    if constexpr (!ALIGN_EPI) { if (wr == 0) PG8_BAR; }
    PG8_BAR;
    if constexpr (Epi::AFTER_DRAIN) { E.fused(acc, cur, wr, wc, fr, fq, lds, wid, lane); S.done(cur); }
#undef PG8_SA
#undef PG8_SB
#undef PG8_STAGE
#undef PG8_LDA
#undef PG8_LDB
#undef PG8_MMA
#undef PG8_CAT8
#undef PG8_WAIT_V
#undef PG8_WAIT_L
#undef PG8_BAR
#undef PG8_SCHED
}
}

namespace at128 {
constexpr int D = 128;
constexpr float THR = 8.f;
constexpr bool WSKIP = false;
constexpr float SCALE = 0.08838834764831845f;
constexpr int NW = 8, QBLK = 32, KVBLK = 64, QB = NW * QBLK;
constexpr int SHM_V = KVBLK * D * 2, SHM_K = KVBLK * D * 2;
constexpr int LDS_BYTES = 2 * SHM_V + 2 * SHM_K + NW * 64 * 4;

using bf16 = __hip_bfloat16;
typedef short bf16x8 __attribute__((ext_vector_type(8)));
typedef short s16x4 __attribute__((ext_vector_type(4)));
typedef float f32x16 __attribute__((ext_vector_type(16)));
typedef float f32x4 __attribute__((ext_vector_type(4)));
typedef unsigned u32x4 __attribute__((ext_vector_type(4)));
template <class A, class Bt> struct same_t { static constexpr bool v = false; };
template <class A> struct same_t<A, A> { static constexpr bool v = true; };

#define KSWZ(row, colB) ((row) * 256 + ((colB) ^ (((row) & 7) << 4)))
#define SBAR() __builtin_amdgcn_sched_barrier(0)
__device__ __forceinline__ int v_st(int k, int c) { const int kk = (k & ~0xC) | ((k & 4) << 1) | ((k & 8) >> 1); return ((kk >> 3) * 4 + (c >> 5)) * 512 + ((kk & 7) * 32 + (c & 31)) * 2; }
__device__ __forceinline__ int v_rd_base(int lane) { return ((lane & 3) << 3) | (((lane >> 2) & 3) << 6) | (((lane >> 4) & 1) << 5) | (((lane >> 5) & 1) << 8); }
constexpr int v_rd_off(int d0, int ks, int half) { return d0 * 512 + ks * 4096 + half * 2048; }
__device__ __forceinline__ int crow(int r, int hi) { return (r & 3) + 8 * (r >> 2) + 4 * hi; }
__device__ __forceinline__ unsigned cvtpk(float lo, float hi) {
    unsigned r; asm volatile("v_cvt_pk_bf16_f32 %0, %1, %2" : "=v"(r) : "v"(lo), "v"(hi)); return r;
}
__device__ __forceinline__ bf16x8 pack8(f32x4 a, f32x4 b) {
    u32x4 w = {cvtpk(a[0], a[1]), cvtpk(a[2], a[3]), cvtpk(b[0], b[1]), cvtpk(b[2], b[3])};
    return *reinterpret_cast<bf16x8*>(&w);
}
template <class T> __device__ __forceinline__ bf16x8 load8(const T* p) {
    if constexpr (same_t<T, float>::v) { return pack8(*(const f32x4*)p, *(const f32x4*)(p + 4)); }
    else { return *reinterpret_cast<const bf16x8*>(p); }
}
__device__ __forceinline__ void mask_tile(f32x16& p0, f32x16& p1, int dq, unsigned W) {
    const float NEG = -__builtin_inff();
#pragma unroll
    for (int r = 0; r < 16; ++r) {
        const int c = (r & 3) + 8 * (r >> 2);
        if ((unsigned)(dq - c) >= W) p0[r] = NEG;
        if ((unsigned)(dq - c - 32) >= W) p1[r] = NEG;
    }
}
__device__ __forceinline__ void partialSM(f32x16& p0, f32x16& p1, float& m_reg, float& mn, float& alpha) {
    float pmax = p0[0]; for (int r = 1; r < 16; ++r) pmax = fmaxf(pmax, p0[r]); for (int r = 0; r < 16; ++r) pmax = fmaxf(pmax, p1[r]);
    { auto rr = __builtin_amdgcn_permlane32_swap(__float_as_uint(pmax), __float_as_uint(pmax), false, false);
      pmax = fmaxf(__uint_as_float(rr[0]), __uint_as_float(rr[1])); }
    constexpr float C2 = 1.4426950408889634f * SCALE;
    if (__builtin_expect(__all((pmax - m_reg) * SCALE <= THR), 1)) { mn = m_reg; alpha = 1.f; }
    else { mn = fmaxf(m_reg, pmax); alpha = __builtin_amdgcn_exp2f((m_reg - mn) * C2); m_reg = mn; }
    const float mnL = -mn * C2;
    for (int r = 0; r < 16; ++r) p0[r] = fmaf(p0[r], C2, mnL); for (int r = 0; r < 16; ++r) p1[r] = fmaf(p1[r], C2, mnL);
    for (int r = 0; r < 16; ++r) p0[r] = __builtin_amdgcn_exp2f(p0[r]);
}
__device__ __forceinline__ void finishSM(f32x16& p0, f32x16& p1, float alpha, float& l_reg, bf16x8& pa0, bf16x8& pa1, bf16x8& pa2, bf16x8& pa3) {
    for (int r = 0; r < 16; ++r) p1[r] = __builtin_amdgcn_exp2f(p1[r]);
    float ps = 0; for (int r = 0; r < 16; ++r) ps += p0[r]; for (int r = 0; r < 16; ++r) ps += p1[r];
    { auto rr = __builtin_amdgcn_permlane32_swap(__float_as_uint(ps), __float_as_uint(ps), false, false);
      ps = __uint_as_float(rr[0]) + __uint_as_float(rr[1]); }
    l_reg = l_reg * alpha + ps;
#define PK4(P, B_, OUT) do { unsigned a0 = cvtpk(P[B_+0], P[B_+1]), a1 = cvtpk(P[B_+2], P[B_+3]);                          \
        unsigned b0 = cvtpk(P[B_+4], P[B_+5]), b1 = cvtpk(P[B_+6], P[B_+7]);                                             \
        auto r0 = __builtin_amdgcn_permlane32_swap(a0, b0, false, false); auto r1 = __builtin_amdgcn_permlane32_swap(a1, b1, false, false); \
        u32x4 w = {r0[0], r1[0], r0[1], r1[1]}; OUT = *reinterpret_cast<bf16x8*>(&w); } while (0)
    PK4(p0, 0, pa0); PK4(p0, 8, pa1); PK4(p1, 0, pa2); PK4(p1, 8, pa3);
#undef PK4
}
template <int KB, bool SK>
__device__ __forceinline__ void qkt(f32x16& p0, f32x16& p1, const char* K_lds, int r32, int hi, const bf16x8* qr, bool act) {
    if (SK && !act) { const float NEG = -__builtin_inff();
#pragma unroll
        for (int r = 0; r < 16; ++r) { p0[r] = NEG; p1[r] = NEG; } return; }
    p0 = f32x16{}; p1 = f32x16{};
    const char* kb[4];
#pragma unroll
    for (int dd = 0; dd < 4; ++dd) kb[dd] = K_lds + KB * SHM_K + KSWZ(r32, (dd * 16 + hi * 8) * 2);
#pragma unroll
    for (int d0 = 0; d0 < 8; ++d0) { const char* a = kb[d0 & 3] + (d0 >> 2) * 128;
        bf16x8 b0 = *reinterpret_cast<const bf16x8*>(a);
        bf16x8 b1 = *reinterpret_cast<const bf16x8*>(a + 32 * 256);
        p0 = __builtin_amdgcn_mfma_f32_32x32x16_bf16(b0, qr[d0], p0, 0, 0, 0);
        p1 = __builtin_amdgcn_mfma_f32_32x32x16_bf16(b1, qr[d0], p1, 0, 0, 0); }
}
template <int VB, bool SK>
__device__ __forceinline__ void pv_tile(f32x16* o, int vb0, bf16x8 pa0, bf16x8 pa1, bf16x8 pa2, bf16x8 pa3, bool act) {
    if (SK && !act) return;
#define TRRD(dst, off) asm volatile("ds_read_b64_tr_b16 %0, %1 offset:%2" : "=&v"(dst) : "v"(vb0), "i"(off) : "memory")
#define PV_D0(d0) do { s16x4 l0, l1, l2, l3, h0, h1, h2, h3; constexpr int b_ = VB * SHM_V + v_rd_off(d0, 0, 0);     \
        TRRD(l0, b_); TRRD(h0, b_ + 2048); TRRD(l1, b_ + 4096); TRRD(h1, b_ + 6144); TRRD(l2, b_ + 8192); TRRD(h2, b_ + 10240); TRRD(l3, b_ + 12288); TRRD(h3, b_ + 14336); \
        asm volatile("s_waitcnt lgkmcnt(0)" ::: "memory"); SBAR();                 \
        o[d0] = __builtin_amdgcn_mfma_f32_32x32x16_bf16(pa0, (bf16x8){l0[0], l0[1], l0[2], l0[3], h0[0], h0[1], h0[2], h0[3]}, o[d0], 0, 0, 0);   \
        o[d0] = __builtin_amdgcn_mfma_f32_32x32x16_bf16(pa1, (bf16x8){l1[0], l1[1], l1[2], l1[3], h1[0], h1[1], h1[2], h1[3]}, o[d0], 0, 0, 0);   \
        o[d0] = __builtin_amdgcn_mfma_f32_32x32x16_bf16(pa2, (bf16x8){l2[0], l2[1], l2[2], l2[3], h2[0], h2[1], h2[2], h2[3]}, o[d0], 0, 0, 0);   \
        o[d0] = __builtin_amdgcn_mfma_f32_32x32x16_bf16(pa3, (bf16x8){l3[0], l3[1], l3[2], l3[3], h3[0], h3[1], h3[2], h3[3]}, o[d0], 0, 0, 0); } while (0)
    PV_D0(0); PV_D0(1); PV_D0(2); PV_D0(3);
#undef PV_D0
#undef TRRD
}

template <class TIn, class TOut> struct BlockRef { const TIn* Q; const TIn* K; const TIn* V; TOut* O; int P0; };
template <class TIn> struct Seam {
    bf16x8 qr[8];
    bf16x8 st_v0, st_v1, st_k0, st_k1; f32x4 sf0, sf1, sf2, sf3;
    f32x4 tq[16];
};
__device__ __forceinline__ int swa_jlo(int P0, int W) { const int lowk = P0 - W + 1; return lowk > 0 ? lowk / KVBLK : 0; }
#define ROW(p, k0, rr) ((p) + (size_t)((k0) + (rr)) * PKV + sc)
#define VMW() asm volatile("s_waitcnt vmcnt(0)" ::: "memory")
#define VMWN(n) asm volatile("s_waitcnt vmcnt(%0)" :: "i"(n) : "memory")
#define SLOAD_H(Kp, Vp, k0) do { S.st_v0 = load8<TIn>(ROW(Vp, k0, sr)); S.st_v1 = load8<TIn>(ROW(Vp, k0, 32 + sr));              \
                         S.st_k0 = load8<TIn>(ROW(Kp, k0, sr)); S.st_k1 = load8<TIn>(ROW(Kp, k0, 32 + sr)); } while (0)
#define SWRITE_HK(bf) do { *(bf16x8*)(K_lds + (bf) * SHM_K + kws) = S.st_k0; *(bf16x8*)(K_lds + (bf) * SHM_K + kws + 32 * 256) = S.st_k1; } while (0)
#define SWRITE_HV(bf) do { *(bf16x8*)(V_lds + (bf) * SHM_V + vst0) = S.st_v0; *(bf16x8*)(V_lds + (bf) * SHM_V + vst1) = S.st_v1; } while (0)
#define SWRITE_H(bf) do { SWRITE_HV(bf); SWRITE_HK(bf); } while (0)
#define SLOAD_F(p, k0) do { S.sf0 = *(const f32x4*)ROW(p, k0, sr); S.sf1 = *(const f32x4*)(ROW(p, k0, sr) + 4);                \
                            S.sf2 = *(const f32x4*)ROW(p, k0, 32 + sr); S.sf3 = *(const f32x4*)(ROW(p, k0, 32 + sr) + 4); } while (0)
#define SWRITE_KF(bf) do { *(bf16x8*)(K_lds + (bf) * SHM_K + kws) = pack8(S.sf0, S.sf1); *(bf16x8*)(K_lds + (bf) * SHM_K + kws + 32 * 256) = pack8(S.sf2, S.sf3); } while (0)
#define SWRITE_VF(bf) do { *(bf16x8*)(V_lds + (bf) * SHM_V + vst0) = pack8(S.sf0, S.sf1); *(bf16x8*)(V_lds + (bf) * SHM_V + vst1) = pack8(S.sf2, S.sf3); } while (0)
template <class TIn, class TOut, int PQ, int PKV, int PO>
__device__ __forceinline__ void causal_swa_prime(const BlockRef<TIn, TOut>& cur, int W, char* lds, Seam<TIn>& S, const int mk_wid) {
    constexpr bool F32 = same_t<TIn, float>::v;
    const int wid = mk_wid, lane = mk_lane(), tid = wid * 64 + lane, r32 = lane & 31, hi = lane >> 5;
    const int sr = tid >> 4, sc = (tid & 15) * 8, kws = KSWZ(sr, sc * 2); char* K_lds = lds + 2 * SHM_V;
    const int kb0 = swa_jlo(cur.P0, W) * KVBLK;
    for (int d0 = 0; d0 < 8; ++d0) S.qr[d0] = load8<TIn>(cur.Q + (size_t)(wid * QBLK + r32) * PQ + d0 * 16 + hi * 8);
    if constexpr (F32) { SLOAD_F((const float*)cur.K, kb0); VMW(); SWRITE_KF(0); SBAR(); SLOAD_F((const float*)cur.V, kb0); }
    else { SLOAD_H(cur.K, cur.V, kb0); VMW(); SWRITE_HK(0); }
    __syncthreads();
}
template <class TIn, class TOut, int PQ, int PKV, int PO>
__device__ __forceinline__ void causal_swa_block(const BlockRef<TIn, TOut>& cur, const BlockRef<TIn, TOut>& nxt, int skv, int W, char* lds, Seam<TIn>& S, const int mk_wid) {
    constexpr bool F32 = same_t<TIn, float>::v;
    const int wid = mk_wid, lane = mk_lane(), tid = wid * 64 + lane, r32 = lane & 31, hi = lane >> 5;
    const int j_lo = swa_jlo(cur.P0, W);
    int j_hi = (cur.P0 + QB - 1) / KVBLK + 1; if (j_hi > skv / KVBLK) j_hi = skv / KVBLK;
    const int NT = j_hi - j_lo;
    const int kbn = swa_jlo(nxt.P0, W) * KVBLK;
    const int qlo = cur.P0 + wid * QBLK, qm = qlo + r32 - 4 * hi;
    char* V_lds = lds; char* K_lds = lds + 2 * SHM_V;
    float* ws = (float*)(lds + 2 * SHM_V + 2 * SHM_K) + wid * 64; float* li_l = ws, * al_l = ws + 32;
    float m_reg = -1e30f, l_reg = 0; f32x16 o[4] = {};
    const int sr = tid >> 4, sc = (tid & 15) * 8, vst0 = v_st(sr, sc), vst1 = v_st(32 + sr, sc), kws = KSWZ(sr, sc * 2);
    const int vb0 = (int)(uintptr_t)V_lds + v_rd_base(lane);
    const TIn* Kh = cur.K; const TIn* Vh = cur.V;
#define RESC(a) do { if (__any((a) < 1.f)) { if (hi == 0) al_l[r32] = (a); asm volatile("s_waitcnt lgkmcnt(0)" ::: "memory");              \
                     for (int d_ = 0; d_ < 4; ++d_) for (int r = 0; r < 16; ++r) o[d_][r] *= al_l[crow(r, hi)]; } } while (0)
#define KBASE(t) ((j_lo + (t)) * KVBLK)
#define ACT(t) (KBASE(t) <= qlo + QBLK - 1 && KBASE(t) + KVBLK - 1 >= qlo - W + 1)
#define MASKT(P0_, P1_, t) do { const int kb_ = KBASE(t); if ((!SK || ACT(t)) && (kb_ + KVBLK - 1 > qlo || kb_ <= qlo + QBLK - 1 - W)) mask_tile(P0_, P1_, qm - kb_, (unsigned)W); } while (0)
    constexpr int NQL = F32 ? 16 : 8;
    constexpr bool SK = WSKIP && !F32;
#define SEAM_K0() do { VMWN(NQL); if constexpr (F32) { SWRITE_KF(0); SBAR(); SLOAD_F((const float*)nxt.V, kbn); } else { SWRITE_HK(0); } SBAR(); } while (0)
    f32x16 pA0, pA1, pB0, pB1; float mnA, mnB, alA, alB; bf16x8 pa0, pa1, pa2, pa3;
    if constexpr (F32) { VMW(); SWRITE_VF(0); SBAR(); } else { SWRITE_HV(0); SBAR(); }
    if (NT > 1) { if constexpr (F32) SLOAD_F((const float*)Kh, KBASE(1)); else SLOAD_H(Kh, Vh, KBASE(1)); }
    SBAR(); qkt<0, SK>(pA0, pA1, K_lds, r32, hi, S.qr, ACT(0));
    if constexpr (F32) { if (NT > 1) { VMW(); SWRITE_KF(1); SBAR(); SLOAD_F((const float*)Vh, KBASE(1)); } }
    MASKT(pA0, pA1, 0); partialSM(pA0, pA1, m_reg, mnA, alA);
    if (NT > 1) { VMW(); if constexpr (F32) { SWRITE_VF(1); SBAR(); if (NT > 2) SLOAD_F((const float*)Kh, KBASE(2)); } else SWRITE_H(1); }
    __syncthreads();
#define HALF_STEP(PX0, PX1, mnX, alX, PY0, PY1, alY, t, KB, VB, SB) do {                                                      \
        SBAR(); qkt<KB, SK>(PX0, PX1, K_lds, r32, hi, S.qr, ACT(t));                                             \
        finishSM(PY0, PY1, alY, l_reg, pa0, pa1, pa2, pa3); SBAR();                                                           \
        if ((t) + 1 < NT) { if constexpr (F32) { VMW(); SWRITE_KF(SB); SBAR(); SLOAD_F((const float*)Vh, KBASE((t) + 1)); }  \
                            else { SLOAD_H(Kh, Vh, KBASE((t) + 1)); } SBAR(); }                                               \
        pv_tile<VB, SK>(o, vb0, pa0, pa1, pa2, pa3, ACT((t) - 1)); MASKT(PX0, PX1, (t)); partialSM(PX0, PX1, m_reg, mnX, alX);                                        \
        __syncthreads();                                                                                                      \
        if ((t) + 1 < NT) { VMW(); if constexpr (F32) { SWRITE_VF(SB); SBAR(); if ((t) + 2 < NT) SLOAD_F((const float*)Kh, KBASE((t) + 2)); } \
                            else { SWRITE_H(SB); } }                                                                          \
        RESC(alX); __syncthreads(); } while (0)
    for (int t = 1; t + 1 < NT; t += 2) {
        HALF_STEP(pB0, pB1, mnB, alB, pA0, pA1, alA, t, 1, 0, 0);
        HALF_STEP(pA0, pA1, mnA, alA, pB0, pB1, alB, t + 1, 0, 1, 1);
    }
    const bool even = (NT & 1) == 0;
    if (even) { SBAR(); qkt<1, SK>(pB0, pB1, K_lds, r32, hi, S.qr, ACT(NT - 1)); SBAR(); }
#define QROW(e) (nxt.Q + (size_t)(wid * QBLK + r32) * PQ + ((e) >> 1) * 16 + hi * 8 + ((e) & 1) * 4)
    if constexpr (F32) { SLOAD_F((const float*)nxt.K, kbn); SBAR();
#pragma unroll
        for (int e = 0; e < 8; ++e) S.tq[e] = *(const f32x4*)QROW(e); }
    else { SLOAD_H(nxt.K, nxt.V, kbn); SBAR();
#pragma unroll
        for (int d0 = 0; d0 < 8; ++d0) S.qr[d0] = load8<TIn>(nxt.Q + (size_t)(wid * QBLK + r32) * PQ + d0 * 16 + hi * 8); }
    SBAR();
    finishSM(pA0, pA1, alA, l_reg, pa0, pa1, pa2, pa3); SBAR();
    if constexpr (F32) {
#pragma unroll
        for (int e = 8; e < 16; ++e) S.tq[e] = *(const f32x4*)QROW(e); SBAR(); }
#undef QROW
    pv_tile<0, SK>(o, vb0, pa0, pa1, pa2, pa3, ACT(even ? NT - 2 : NT - 1));
    if (even) { MASKT(pB0, pB1, NT - 1); partialSM(pB0, pB1, m_reg, mnB, alB); __syncthreads(); RESC(alB);
        finishSM(pB0, pB1, alB, l_reg, pa0, pa1, pa2, pa3); SBAR(); pv_tile<1, SK>(o, vb0, pa0, pa1, pa2, pa3, ACT(NT - 1)); }
    SBAR(); SEAM_K0();
    if (hi == 0) li_l[r32] = l_reg; asm volatile("s_waitcnt lgkmcnt(0)" ::: "memory");
    float rli[16];
#pragma unroll
    for (int r = 0; r < 16; ++r) rli[r] = __builtin_amdgcn_rcpf(li_l[crow(r, hi)]);
    TOut* Ow = cur.O + (size_t)(wid * QBLK) * PO;
#pragma unroll
    for (int r = 0; r < 16; ++r) { const int orow = crow(r, hi);
#pragma unroll
        for (int d0 = 0; d0 < 4; ++d0) { const float v = o[d0][r] * rli[r];
            if constexpr (same_t<TOut, float>::v) { Ow[(size_t)orow * PO + d0 * 32 + r32] = v; }
            else { const float vn = __shfl_xor(v, 1);
                   if ((r32 & 1) == 0) *(unsigned*)(Ow + (size_t)orow * PO + d0 * 32 + r32) = cvtpk(v, vn); } } }
    if constexpr (F32) {
#pragma unroll
        for (int d0 = 0; d0 < 8; ++d0) S.qr[d0] = pack8(S.tq[2 * d0], S.tq[2 * d0 + 1]); }
    __syncthreads();
#undef RESC
#undef KBASE
#undef ACT
#undef MASKT
#undef SEAM_K0
#undef HALF_STEP
}
#undef ROW
#undef VMW
#undef VMWN
#undef SLOAD_H
#undef SWRITE_HK
#undef SWRITE_HV
#undef SWRITE_H
#undef SLOAD_F
#undef SWRITE_KF
#undef SWRITE_VF

typedef bf16 abf_t;
}

namespace at256 {
using at128::bf16x8; using at128::f32x16; using at128::f32x4; using at128::abf_t;
constexpr int L_K = 0, L_V = 32768, L_WS = 98304, LDS_NEED = L_WS + 8 * 64 * 4;
__device__ __forceinline__ int swap23(int k) { return (k & ~0xC) | ((k & 4) << 1) | ((k & 8) >> 1); }
template <int IMM> __device__ __forceinline__ void glds16(const void* gbase  , unsigned voff  , unsigned lds_dst) { unsigned keep;
    asm volatile("s_mov_b32 %0, m0\n\ts_mov_b32 m0, %3\n\ts_nop 0\n\tglobal_load_lds_dwordx4 %1, %2 offset:%4\n\ts_mov_b32 m0, %0" : "=&s"(keep) : "v"(voff), "s"(gbase), "s"(lds_dst), "i"(IMM) : "memory"); }
template <int BUF> __device__ __forceinline__ void pv256(f32x16* o, int vb0, bf16x8 pa0, bf16x8 pa1, bf16x8 pa2, bf16x8 pa3) {
    typedef at128::s16x4 s4;
    s4 fa[8], fb[8];
#define A256_TR(dst, off) asm volatile("ds_read_b64_tr_b16 %0, %1 offset:%2" : "=&v"(dst) : "v"(vb0), "i"(off) : "memory")
#define A256_LD(f, d0) do { constexpr int b_ = (BUF * 2 + ((d0) >> 2)) * 16384 + ((d0) & 3) * 512; \
        A256_TR(f[0], b_); A256_TR(f[1], b_ + 2048); A256_TR(f[2], b_ + 4096); A256_TR(f[3], b_ + 6144); A256_TR(f[4], b_ + 8192); A256_TR(f[5], b_ + 10240); A256_TR(f[6], b_ + 12288); A256_TR(f[7], b_ + 14336); } while (0)
#define A256_MM(f, d0) do { \
        o[d0] = __builtin_amdgcn_mfma_f32_32x32x16_bf16(pa0, (bf16x8){f[0][0], f[0][1], f[0][2], f[0][3], f[1][0], f[1][1], f[1][2], f[1][3]}, o[d0], 0, 0, 0); \
        o[d0] = __builtin_amdgcn_mfma_f32_32x32x16_bf16(pa1, (bf16x8){f[2][0], f[2][1], f[2][2], f[2][3], f[3][0], f[3][1], f[3][2], f[3][3]}, o[d0], 0, 0, 0); \
        o[d0] = __builtin_amdgcn_mfma_f32_32x32x16_bf16(pa2, (bf16x8){f[4][0], f[4][1], f[4][2], f[4][3], f[5][0], f[5][1], f[5][2], f[5][3]}, o[d0], 0, 0, 0); \
        o[d0] = __builtin_amdgcn_mfma_f32_32x32x16_bf16(pa3, (bf16x8){f[6][0], f[6][1], f[6][2], f[6][3], f[7][0], f[7][1], f[7][2], f[7][3]}, o[d0], 0, 0, 0); } while (0)
#define A256_W8() do { asm volatile("s_waitcnt lgkmcnt(8)" ::: "memory"); __builtin_amdgcn_sched_barrier(0); } while (0)
#define A256_W0() do { asm volatile("s_waitcnt lgkmcnt(0)" ::: "memory"); __builtin_amdgcn_sched_barrier(0); } while (0)
    A256_LD(fa, 0);
    A256_LD(fb, 1); A256_W8(); A256_MM(fa, 0); __builtin_amdgcn_sched_barrier(0);
    A256_LD(fa, 2); A256_W8(); A256_MM(fb, 1); __builtin_amdgcn_sched_barrier(0);
    A256_LD(fb, 3); A256_W8(); A256_MM(fa, 2); __builtin_amdgcn_sched_barrier(0);
    A256_LD(fa, 4); A256_W8(); A256_MM(fb, 3); __builtin_amdgcn_sched_barrier(0);
    A256_LD(fb, 5); A256_W8(); A256_MM(fa, 4); __builtin_amdgcn_sched_barrier(0);
    A256_LD(fa, 6); A256_W8(); A256_MM(fb, 5); __builtin_amdgcn_sched_barrier(0);
    A256_LD(fb, 7); A256_W8(); A256_MM(fa, 6); __builtin_amdgcn_sched_barrier(0);
    A256_W0(); A256_MM(fb, 7);
#undef A256_TR
#undef A256_LD
#undef A256_MM
#undef A256_W8
#undef A256_W0
}
struct Blk { const abf_t* Q; const abf_t* K; const abf_t* V; abf_t* O; int P0; };
template <int PQ, int PKV, int PO>
__device__ __forceinline__ void attn_block(const Blk& B, __attribute__((address_space(3))) unsigned char* ldsL, const int wid) {
    char* lds = (char*)ldsL;
    const int lane = mk_lane(), r32 = lane & 31, hi = lane >> 5;
    const unsigned lbase = (unsigned)(unsigned long)ldsL;
    unsigned offK, offV;
    { const int q = wid * 64 + lane, row = q >> 4, ch = (q & 15) ^ (row & 7); offK = (unsigned)(row * PKV + ch * 8) * 2u; }
    { const int q = wid * 128 + lane, st = q >> 5, rowk = (q >> 2) & 7, cch = q & 3, k = swap23((st >> 2) * 8 + rowk), c = (st & 3) * 32 + cch * 8; offV = (unsigned)(k * PKV + c) * 2u; }
    const unsigned lpk = (unsigned)wid * 1024u, lpv = (unsigned)wid * 2048u;
#define A256_DMA(buf, key0) do { const abf_t* kg_ = B.K + (size_t)(key0) * PKV; const abf_t* vg_ = B.V + (size_t)(key0) * PKV; \
        glds16<0>(kg_, offK, lbase + L_K + (buf) * 16384 + lpk); glds16<0>(kg_ + 32 * PKV, offK, lbase + L_K + (buf) * 16384 + lpk + 8192); \
        glds16<0>(vg_, offV, lbase + L_V + ((buf) * 2 + 0) * 16384 + lpv); glds16<128>(vg_, offV, lbase + L_V + ((buf) * 2 + 0) * 16384 + lpv + 1024 - 128); \
        glds16<256>(vg_, offV, lbase + L_V + ((buf) * 2 + 1) * 16384 + lpv - 256); glds16<384>(vg_, offV, lbase + L_V + ((buf) * 2 + 1) * 16384 + lpv + 1024 - 384); } while (0)
    const int NT = (B.P0 + 256) / 64;
    const int qlo = B.P0 + wid * 32, qm = qlo + r32 - 4 * hi;
    A256_DMA(0, 0);
    bf16x8 qr[8];
#pragma unroll
    for (int d0 = 0; d0 < 8; ++d0) qr[d0] = __builtin_nontemporal_load(reinterpret_cast<const bf16x8*>(B.Q + (size_t)(wid * 32 + r32) * PQ + d0 * 16 + hi * 8));
    float* wsf = (float*)(lds + L_WS) + wid * 64; float* li_l = wsf; float* al_l = wsf + 32;
    float m_reg = -1e30f, l_reg = 0.f; f32x16 o[8] = {};
    const int vb0 = (int)lbase + L_V + at128::v_rd_base(lane);
    asm volatile("s_waitcnt vmcnt(0)" ::: "memory"); __syncthreads();
#define A256_STEP(buf, t) do { \
        if ((t) + 1 < NT) A256_DMA(1 - (buf), ((t) + 1) * 64); \
        f32x16 p0, p1; float mn, alpha; bf16x8 pa0, pa1, pa2, pa3; \
        at128::qkt<buf, false>(p0, p1, lds + L_K, r32, hi, qr, true); \
        { const int kb_ = (t) * 64; if (kb_ + 63 > qlo) at128::mask_tile(p0, p1, qm - kb_, 0x7fffffffu); } \
        at128::partialSM(p0, p1, m_reg, mn, alpha); \
        if (__any(alpha < 1.f)) { if (hi == 0) al_l[r32] = alpha; asm volatile("s_waitcnt lgkmcnt(0)" ::: "memory"); \
            _Pragma("unroll") for (int r_ = 0; r_ < 16; ++r_) { const float a_ = al_l[at128::crow(r_, hi)]; _Pragma("unroll") for (int d_ = 0; d_ < 8; ++d_) o[d_][r_] *= a_; } } \
        at128::finishSM(p0, p1, alpha, l_reg, pa0, pa1, pa2, pa3); __builtin_amdgcn_sched_barrier(0); \
        pv256<buf>(o, vb0, pa0, pa1, pa2, pa3); \
        asm volatile("s_waitcnt vmcnt(0)" ::: "memory"); __syncthreads(); } while (0)
    for (int t = 0; t < NT; t += 2) { A256_STEP(0, t); A256_STEP(1, t + 1); }
    if (hi == 0) li_l[r32] = l_reg; asm volatile("s_waitcnt lgkmcnt(0)" ::: "memory");
    abf_t* Ow = B.O + (size_t)(wid * 32) * PO;
#pragma unroll
    for (int r = 0; r < 16; ++r) { const int orow = at128::crow(r, hi); const float rl = __builtin_amdgcn_rcpf(li_l[orow]);
#pragma unroll
        for (int d0 = 0; d0 < 8; ++d0) { const float v = o[d0][r] * rl; const float vn = __shfl_xor(v, 1);
            if ((r32 & 1) == 0) *(unsigned*)(Ow + (size_t)orow * PO + d0 * 32 + r32) = at128::cvtpk(v, vn); } }
    __syncthreads();
#undef A256_STEP
#undef A256_DMA
}
}

constexpr int NWAVES = 8;
constexpr int NTOK = 32768, DM = 2048, SEQ = 8192, NBATCH = 4;
constexpr int MAINW = 1536, MEMW = 512, NMEM = 256;
constexpr int A_IN = 3584;
constexpr int B_IN = 5120;
constexpr int FF = 5632, FFE = 7168, NEXP = 8;
constexpr int NSG = 12;
constexpr float ALPHA = 1.41421356237309515f;
constexpr float LN_EPS = 1e-5f;
constexpr float LAMBDA_INIT = 0.355509067592f;
constexpr int MAXT = 264;
constexpr int NPHASE = 17;
constexpr float W8_D_MUL = 128.f, H8_MUL = 4.f;
constexpr float W8_G_MUL = -64.f * 1.4426950408889634f, W8_U_MUL = -64.f * 4.f / 1.4426950408889634f;
constexpr int SC_ONE = 0x7f7f7f7f, SC_M4 = 0x7d7d7d7d, SC_M6 = 0x79797979, SC_M7 = 0x78787878;

constexpr size_t MiB = 1u << 20;
constexpr size_t WS_CTL = 0, CTL_ZERO_BYTES = 64 * 1024;
constexpr size_t WS_WSBF = 1 * MiB;
constexpr size_t WS_MEMB = 2 * MiB;
constexpr size_t WS_MEMKV = 6 * MiB;
constexpr size_t WS_ROUTE_E = 10 * MiB;
constexpr size_t WS_ROUTE_W = 10 * MiB + 256 * 1024;
constexpr size_t WS_TOKSLOT = 10 * MiB + 512 * 1024;
constexpr size_t WS_SLOTGATE = 11 * MiB;
constexpr size_t WS_SLOTTOK = 11 * MiB + 512 * 1024;
constexpr size_t WS_HIST = 12 * MiB;
constexpr size_t WS_MOETAB = 12 * MiB + 256 * 1024;
constexpr size_t WS_OSK = 1644 * MiB;
constexpr size_t WS_STATS = 13 * MiB;
#if MK_FP8_MOE
constexpr int MOE_CHUNK_T = MAXT;
constexpr size_t WS_W_MOE_GU = 16 * MiB;
constexpr size_t WS_W_MOE_D = 240 * MiB;
constexpr size_t WS_XS = 352 * MiB;
#else
constexpr size_t WS_W_MOE_GU = 16 * MiB;
constexpr size_t WS_W_MOE_D = 464 * MiB;
constexpr size_t WS_XS = 812 * MiB;
#endif
constexpr size_t WS_W_A_IN = 688 * MiB;
constexpr size_t WS_W_MIX = 702 * MiB;
constexpr size_t WS_W_FFN_GU = 718 * MiB;
constexpr size_t WS_W_FFN_D = 762 * MiB;
constexpr size_t WS_W_B_IN = 784 * MiB;
constexpr size_t WS_W_MEMKV = 804 * MiB;
constexpr size_t WS_XB = 812 * MiB;
constexpr size_t WS_H0 = 940 * MiB;
constexpr size_t WS_CONCAT = 1164 * MiB;
constexpr size_t WS_HID = 940 * MiB;
constexpr size_t WS_H1 = 940 * MiB;
constexpr size_t WS_AO = 1260 * MiB;
constexpr size_t WS_CONCAT1 = 1452 * MiB;
constexpr size_t WS_X3B = 1580 * MiB;
#if MK_FP8_MOE
constexpr size_t WS_OS = 812 * MiB;
constexpr size_t WS_HIDM = 1076 * MiB;
constexpr size_t WS_END = 1708 * MiB;
static_assert(WS_W_MOE_D + (size_t)NEXP * DM * FFE <= WS_XS && WS_XS + (size_t)MAXT * 256 * DM <= WS_W_A_IN, "fp8 MoE weight map");
static_assert(WS_OS + (size_t)MAXT * 256 * DM * 2 <= WS_HIDM && WS_HIDM + (size_t)MAXT * 256 * FFE <= WS_X3B, "fp8 MoE map");
#else
constexpr size_t WS_OS = 1076 * MiB;
constexpr size_t WS_HIDM = 1340 * MiB;
constexpr size_t WS_END = 1802 * MiB;
static_assert(WS_XS + (size_t)MAXT * 256 * DM * 2 <= WS_OS && WS_OS + (size_t)MAXT * 256 * DM * 2 <= WS_HIDM && WS_HIDM + (size_t)MOE_CHUNK_T * 256 * FFE * 2 <= WS_END, "MoE map");
static_assert(WS_XS + (size_t)MAXT * 256 * DM * 2 <= WS_CONCAT1, "XS must not overlap CONCAT1/X3B");
#endif
static_assert(WS_H0 + (size_t)NTOK * A_IN * 2 <= WS_CONCAT && WS_HID + (size_t)NTOK * FF * 2 <= 1292 * MiB && WS_H1 + (size_t)NTOK * B_IN * 2 <= WS_AO && WS_AO + (size_t)NTOK * 3072 * 2 <= WS_CONCAT1, "activation map");
static_assert(WS_CONCAT1 + (size_t)NTOK * DM * 2 <= WS_X3B && WS_X3B + (size_t)NTOK * DM * 2 <= 1708 * MiB, "activation map 2");
constexpr int CW_TMO = 0, CW_CODE = 1;
constexpr int CW_BAR = 4096;
constexpr int CW_BGQ = 12288;
constexpr int CW_TS = 8300;
constexpr int CW_CHK = 8192;

constexpr int RING_OFF = 0, RING_BYTES = 131072;
constexpr int LDSCTL_OFF = 147456 - 1024, MISC_OFF = LDSCTL_OFF + 320;
constexpr int LDS_BYTES = 147456;

#define GAS __attribute__((address_space(1)))
#define LAS __attribute__((address_space(3)))
typedef unsigned short bf16;
typedef unsigned v4u __attribute__((ext_vector_type(4)));
typedef float f32x4 __attribute__((ext_vector_type(4)));
typedef short bf16x8 __attribute__((ext_vector_type(8)));
typedef GAS unsigned gu32;
typedef GAS unsigned long long gu64;
#define RLX_AGENT __ATOMIC_RELAXED, __HIP_MEMORY_SCOPE_AGENT
#define LDS_WAIT() asm volatile("s_waitcnt lgkmcnt(0)" ::: "memory")
#define VM_WAIT() asm volatile("s_waitcnt vmcnt(0)" ::: "memory")
__device__ __forceinline__ unsigned long long rt() { return __builtin_amdgcn_s_memrealtime(); }
__device__ __forceinline__ unsigned f2bf(float f) { unsigned u = __builtin_bit_cast(unsigned, f); return (u + 0x7fffu + ((u >> 16) & 1u)) >> 16; }
__device__ __forceinline__ unsigned pk2(float lo, float hi) { return f2bf(lo) | (f2bf(hi) << 16); }

#define XB_TMO      128
#define XB_XCNT(j)  (256  + 64 * (j))
#define XB_XSUB(j)  (1280 + 64 * (j))
#define XB_XGEN(j)  (2304 + 64 * (j))
#define XB_TOP      3328
#define XB_TOPGEN   3392
#define XCD_BAR_WORDS 3456
#define XB_SPIN_CAP (1u << 18)

__device__ __forceinline__ unsigned xb_ld(unsigned* p)              { return __hip_atomic_load(p, __ATOMIC_RELAXED, __HIP_MEMORY_SCOPE_AGENT); }
__device__ __forceinline__ unsigned xb_add(unsigned* p, unsigned v) { return __hip_atomic_fetch_add(p, v, __ATOMIC_RELAXED, __HIP_MEMORY_SCOPE_AGENT); }
__device__ __forceinline__ unsigned xb_xcc_id() { return (unsigned)__builtin_amdgcn_s_getreg((3 << 11) | 20) & 0xFu; }
#define XB_SPIN(cond, bar) do { unsigned _sp = 0; while (cond) { __builtin_amdgcn_s_sleep(1); \
    if ((++_sp & 255u) == 0u) { if (xb_ld(&(bar)[XB_TMO])) break; if (_sp > XB_SPIN_CAP) { atomicAdd(&(bar)[XB_TMO], 1u); break; } } } } while (0)

struct XcdBarrier {
    unsigned* bar; unsigned x; int wave;
    volatile LAS unsigned* st;
};

__device__ __forceinline__ XcdBarrier xcd_barrier_post(unsigned* bar, volatile LAS unsigned* st) {
    XcdBarrier b; b.bar = bar; b.x = xb_xcc_id(); b.st = st;
    if (threadIdx.x == 0) (void)xb_add(&bar[XB_XCNT(b.x)], 1u);
    return b;
}
__device__ __forceinline__ void xcd_barrier_complete(unsigned* bar, unsigned x, unsigned& nloc, unsigned& nx) {
    const unsigned G = gridDim.x * gridDim.y * gridDim.z;
    unsigned sum, cnt, mine, sp = 0u;
    for (;;) {
        sum = 0u; cnt = 0u; mine = 0u;
#pragma unroll
        for (unsigned j = 0; j < 16; ++j) { const unsigned c = xb_ld(&bar[XB_XCNT(j)]); sum += c; cnt += (c > 0u) ? 1u : 0u; mine = (j == x) ? c : mine; }
        if (sum == G) break;
        __builtin_amdgcn_s_sleep(1);
        if ((++sp & 255u) == 0u) { if (xb_ld(&bar[XB_TMO])) break; if (sp > XB_SPIN_CAP) { atomicAdd(&bar[XB_TMO], 1u); break; } }
    }
    nloc = mine > 0u ? mine : 1u; nx = cnt > 0u ? cnt : 1u;
}

__device__ __forceinline__ void xcd_barrier(const XcdBarrier& b) {
    asm volatile("s_waitcnt vmcnt(0)" ::: "memory");
    __syncthreads();
    if (b.wave == 0 && mk_lane() == 0) {
        unsigned* bar = b.bar;
        __builtin_amdgcn_s_waitcnt(0);
        unsigned nloc = b.st[0], nx = b.st[1];
        if (nloc == 0u) { xcd_barrier_complete(bar, b.x, nloc, nx); b.st[0] = nloc; b.st[1] = nx; }
        const unsigned old = xb_add(&bar[XB_XSUB(b.x)], 1u);
        const unsigned gen = old / nloc;
        if (old + 1u == (gen + 1u) * nloc) {
            __builtin_amdgcn_fence(__ATOMIC_RELEASE, "agent");
            asm volatile("s_waitcnt vmcnt(0)" ::: "memory");
            const unsigned og = xb_add(&bar[XB_TOP], 1u);
            const unsigned tg = og / nx;
            if (og + 1u == (tg + 1u) * nx) xb_add(&bar[XB_TOPGEN], 1u);
            else XB_SPIN(xb_ld(&bar[XB_TOPGEN]) == tg, bar);
            __builtin_amdgcn_fence(__ATOMIC_ACQUIRE, "agent");
            xb_add(&bar[XB_XGEN(b.x)], 1u);
            asm volatile("s_waitcnt vmcnt(0)" ::: "memory");
        } else {
            XB_SPIN(xb_ld(&bar[XB_XGEN(b.x)]) == gen, bar);
            __builtin_amdgcn_fence(__ATOMIC_ACQUIRE, "agent");
            asm volatile("s_waitcnt vmcnt(0)" ::: "memory");
        }
    }
    __syncthreads();
}


struct Frame {
    LAS unsigned char* lds;
    volatile LAS unsigned* MISC;
    gu32* ctl;
    int wave;
    int G;
    unsigned char* ws;
    const float* in[25]; float* out;
};
enum { I_X = 0, I_MEM, I_LNG, I_LNB, I_WMIX, I_WMEMKV, I_AWIN, I_AVG, I_AVB, I_AWS, I_ABS, I_SWKV, I_BWIN, I_LQ1, I_LK1, I_LQ2, I_LK2, I_SUBLN, I_FG, I_FU, I_FD, I_ROUTER, I_MG, I_MU, I_MD };

template <int CTRL> __device__ __forceinline__ float dpp_f(float v) { return __builtin_bit_cast(float, __builtin_amdgcn_update_dpp(0, __builtin_bit_cast(int, v), CTRL, 0xf, 0xf, true)); }
__device__ __forceinline__ float wave_sum(float v) {
    v += dpp_f<0xB1>(v); v += dpp_f<0x4E>(v); v += dpp_f<0x141>(v); v += dpp_f<0x140>(v);
    { auto t = __builtin_amdgcn_permlane16_swap(__float_as_uint(v), __float_as_uint(v), false, false); v = __uint_as_float(t[0]) + __uint_as_float(t[1]); }
    { auto t = __builtin_amdgcn_permlane32_swap(__float_as_uint(v), __float_as_uint(v), false, false); v = __uint_as_float(t[0]) + __uint_as_float(t[1]); }
    return v;
}
__device__ __forceinline__ float bf2f(unsigned short b) { return __builtin_bit_cast(float, (unsigned)b << 16); }
__device__ __forceinline__ float bflo(unsigned w) { return __builtin_bit_cast(float, w << 16); }
__device__ __forceinline__ float bfhi(unsigned w) { return __builtin_bit_cast(float, w & 0xffff0000u); }

__device__ __forceinline__ void tr_item(const float* W, int K, int N, bf16* WT, int k0, int n0, int drow0, LAS float* scr, int lane) {
    float t_[32];
#pragma unroll
    for (int i = 0; i < 32; ++i) { const int kk = 2 * i + (lane >> 5); t_[i] = __builtin_nontemporal_load(W + (size_t)(k0 + kk) * N + n0 + (lane & 31)); }
#pragma unroll
    for (int i = 0; i < 32; ++i) { const int kk = 2 * i + (lane >> 5); scr[kk * 33 + (lane & 31)] = t_[i]; }
    LDS_WAIT(); asm volatile("" ::: "memory");
    const int c = lane & 7;
#pragma unroll
    for (int j = 0; j < 4; ++j) { const int n = (lane >> 3) + 8 * j; const LAS float* s = scr + (8 * c) * 33 + n;
        v4u o; o.x = pk2(s[0 * 33], s[1 * 33]); o.y = pk2(s[2 * 33], s[3 * 33]); o.z = pk2(s[4 * 33], s[5 * 33]); o.w = pk2(s[6 * 33], s[7 * 33]);
        *(GAS v4u*)(WT + (size_t)(drow0 + n) * K + k0 + 8 * c) = o; }
    LDS_WAIT(); asm volatile("" ::: "memory");
}
__device__ __forceinline__ void tr_item8(const float* W, int K, int N, unsigned char* WT, int k0, int n0, int drow0, float mul, LAS float* scr, int lane) {
    float t_[64];
#pragma unroll
    for (int i = 0; i < 64; ++i) { const int kk = 2 * i + (lane >> 5); t_[i] = __builtin_nontemporal_load(W + (size_t)(k0 + kk) * N + n0 + (lane & 31)); }
#pragma unroll
    for (int i = 0; i < 64; ++i) { const int kk = 2 * i + (lane >> 5); scr[kk * 33 + (lane & 31)] = t_[i]; }
    LDS_WAIT(); asm volatile("" ::: "memory");
    const int n = lane >> 1, hf = lane & 1; const LAS float* s = scr + (64 * hf) * 33 + n;
    GAS v4u* dst = (GAS v4u*)(WT + (size_t)(drow0 + n) * K + k0 + 64 * hf);
#pragma unroll
    for (int g = 0; g < 4; ++g) { int w[4];
#pragma unroll
        for (int q = 0; q < 4; ++q) { const int kq = 16 * g + 4 * q; int t = 0; t = __builtin_amdgcn_cvt_pk_fp8_f32(s[kq * 33] * mul, s[(kq + 1) * 33] * mul, t, false); t = __builtin_amdgcn_cvt_pk_fp8_f32(s[(kq + 2) * 33] * mul, s[(kq + 3) * 33] * mul, t, true); w[q] = t; }
        dst[g] = (v4u){(unsigned)w[0], (unsigned)w[1], (unsigned)w[2], (unsigned)w[3]}; }
    LDS_WAIT(); asm volatile("" ::: "memory");
}
__device__ __forceinline__ void tr_matrix_item8(const float* W, int K, int N, unsigned char* WT, int row_off, int mode, float mul, int item, LAS float* scr, int lane) {
    const int nblk = N / 32, kb = item / nblk, nb = item % nblk, k0 = 128 * kb, n0 = 32 * nb;
    const int drow0 = row_off + (mode == 0 ? n0 : ((n0 >> 7) * 256 + (n0 & 127) + (mode == 2 ? 128 : 0)));
    tr_item8(W, K, N, WT, k0, n0, drow0, mul, scr, lane);
}
__device__ __forceinline__ void tr_matrix_item(const float* W, int K, int N, bf16* WT, int row_off, int mode, int item, LAS float* scr, int lane) {
    const int nblk = N / 32, kb = item / nblk, nb = item % nblk, k0 = 64 * kb, n0 = 32 * nb;
    const int drow0 = row_off + (mode == 0 ? n0 : ((n0 >> 7) * 256 + (n0 & 127) + (mode == 2 ? 128 : 0)));
    tr_item(W, K, N, WT, k0, n0, drow0, scr, lane);
}
__device__ __forceinline__ void p0_prologue(Frame& F) {
    const int lane_ = mk_lane(), tid_ = F.wave * 64 + lane_;
    LAS float* scr = (LAS float*)(F.lds + RING_OFF + F.wave * 16896);
    const int gw = blockIdx.x * NWAVES + F.wave, NGW = F.G * NWAVES;
    bf16* ws16 = (bf16*)F.ws;
    constexpr int KD8 = MK_FP8_MOE ? 128 : 64, KF8 = MK_FP8_FFN ? 128 : 64;
    constexpr int I_E = (DM / KD8) * (FFE / 32);
    constexpr int I_MOE = 3 * NEXP * I_E;
    constexpr int I_AIN = (DM / 64) * (A_IN / 32), I_MIXW = (DM / 64) * (DM / 32), I_FGU = (DM / KF8) * (FF / 32), I_FDN = (FF / KF8) * (DM / 32);
    constexpr int I_KV = (DM / 64) * (3072 / 32), I_BIN = (DM / 64) * (DM / 32), I_MKV = (DM / 64) * (1024 / 32);
    constexpr int NITEMS = I_MOE + I_AIN + 2 * I_MIXW + 2 * I_FGU + I_FDN + I_KV + I_BIN + 2 * I_MKV;
#if MK_BG
    constexpr int NFG = I_AIN + I_MIXW + 2 * I_MKV;
    for (int it = gw; it < NFG; it += NGW) { int r = it;
        if (r < I_AIN) { tr_matrix_item(F.in[I_AWIN], DM, A_IN, (bf16*)(F.ws + WS_W_A_IN), 0, 0, r, scr, lane_); continue; } r -= I_AIN;
        if (r < I_MIXW) { tr_matrix_item(F.in[I_WMIX], DM, DM, (bf16*)(F.ws + WS_W_MIX), 0, 0, r, scr, lane_); continue; } r -= I_MIXW;
        { const int l = r / I_MKV; tr_matrix_item(F.in[I_WMEMKV] + (size_t)l * DM * 1024, DM, 1024, (bf16*)(F.ws + WS_W_MEMKV), l * 1024, 0, r % I_MKV, scr, lane_); } }
    if (false)
#endif
    for (int it = gw; it < NITEMS; it += NGW) {
        int r = it;
        if (r < I_MOE) { const int which = r / (NEXP * I_E), rr = r % (NEXP * I_E), e = rr / I_E, item = rr % I_E;
#if MK_FP8_MOE
            if (which == 0) tr_matrix_item8(F.in[I_MG] + (size_t)e * DM * FFE, DM, FFE, F.ws + WS_W_MOE_GU, e * 2 * FFE, 1, W8_G_MUL, item, scr, lane_);
            else if (which == 1) tr_matrix_item8(F.in[I_MU] + (size_t)e * DM * FFE, DM, FFE, F.ws + WS_W_MOE_GU, e * 2 * FFE, 2, W8_U_MUL, item, scr, lane_);
            else tr_matrix_item8(F.in[I_MD] + (size_t)e * FFE * DM, FFE, DM, F.ws + WS_W_MOE_D, e * DM, 0, W8_D_MUL, item, scr, lane_);
#else
            if (which == 0) tr_matrix_item(F.in[I_MG] + (size_t)e * DM * FFE, DM, FFE, (bf16*)(F.ws + WS_W_MOE_GU), e * 2 * FFE, 1, item, scr, lane_);
            else if (which == 1) tr_matrix_item(F.in[I_MU] + (size_t)e * DM * FFE, DM, FFE, (bf16*)(F.ws + WS_W_MOE_GU), e * 2 * FFE, 2, item, scr, lane_);
            else tr_matrix_item(F.in[I_MD] + (size_t)e * FFE * DM, FFE, DM, (bf16*)(F.ws + WS_W_MOE_D), e * DM, 0, item, scr, lane_);
#endif
            continue; } r -= I_MOE;
        if (r < I_AIN) { tr_matrix_item(F.in[I_AWIN], DM, A_IN, (bf16*)(F.ws + WS_W_A_IN), 0, 0, r, scr, lane_); continue; } r -= I_AIN;
        if (r < 2 * I_MIXW) { const int l = r / I_MIXW; tr_matrix_item(F.in[I_WMIX] + (size_t)l * DM * DM, DM, DM, (bf16*)(F.ws + WS_W_MIX), l * DM, 0, r % I_MIXW, scr, lane_); continue; } r -= 2 * I_MIXW;
#if MK_FP8_FFN
        if (r < I_FGU) { tr_matrix_item8(F.in[I_FG], DM, FF, F.ws + WS_W_FFN_GU, 0, 1, W8_G_MUL, r, scr, lane_); continue; } r -= I_FGU;
        if (r < I_FGU) { tr_matrix_item8(F.in[I_FU], DM, FF, F.ws + WS_W_FFN_GU, 0, 2, W8_U_MUL, r, scr, lane_); continue; } r -= I_FGU;
        if (r < I_FDN) { tr_matrix_item8(F.in[I_FD], FF, DM, F.ws + WS_W_FFN_D, 0, 0, W8_D_MUL, r, scr, lane_); continue; } r -= I_FDN;
#else
        if (r < I_FGU) { tr_matrix_item(F.in[I_FG], DM, FF, (bf16*)(F.ws + WS_W_FFN_GU), 0, 1, r, scr, lane_); continue; } r -= I_FGU;
        if (r < I_FGU) { tr_matrix_item(F.in[I_FU], DM, FF, (bf16*)(F.ws + WS_W_FFN_GU), 0, 2, r, scr, lane_); continue; } r -= I_FGU;
        if (r < I_FDN) { tr_matrix_item(F.in[I_FD], FF, DM, (bf16*)(F.ws + WS_W_FFN_D), 0, 0, r, scr, lane_); continue; } r -= I_FDN;
#endif
        if (r < I_KV) { tr_matrix_item(F.in[I_SWKV], DM, 3072, (bf16*)(F.ws + WS_W_B_IN), 0, 0, r, scr, lane_); continue; } r -= I_KV;
        if (r < I_BIN) { tr_matrix_item(F.in[I_BWIN], DM, DM, (bf16*)(F.ws + WS_W_B_IN), 3072, 0, r, scr, lane_); continue; } r -= I_BIN;
        { const int l = r / I_MKV; tr_matrix_item(F.in[I_WMEMKV] + (size_t)l * DM * 1024, DM, 1024, (bf16*)(F.ws + WS_W_MEMKV), l * 1024, 0, r % I_MKV, scr, lane_); }
    }
    (void)ws16;
    { const size_t gt = (size_t)blockIdx.x * (NWAVES * 64) + tid_, NT = (size_t)F.G * NWAVES * 64;
      const GAS f32x4* x4 = (const GAS f32x4*)F.in[I_X]; GAS v4u* xb = (GAS v4u*)(F.ws + WS_XB);
      for (size_t i = gt; i < (size_t)NTOK * DM / 8; i += NT) { const f32x4 a = __builtin_nontemporal_load(x4 + 2 * i), b = __builtin_nontemporal_load(x4 + 2 * i + 1); v4u o; o.x = pk2(a.x, a.y); o.y = pk2(a.z, a.w); o.z = pk2(b.x, b.y); o.w = pk2(b.z, b.w); xb[i] = o; }
      const GAS f32x4* m4 = (const GAS f32x4*)F.in[I_MEM]; GAS v4u* mb = (GAS v4u*)(F.ws + WS_MEMB);
      for (size_t i = gt; i < (size_t)NBATCH * NMEM * DM / 8; i += NT) { const f32x4 a = m4[2 * i], b = m4[2 * i + 1]; v4u o; o.x = pk2(a.x, a.y); o.y = pk2(a.z, a.w); o.z = pk2(b.x, b.y); o.w = pk2(b.z, b.w); mb[i] = o; }
      const float* wsrc = F.in[I_AWS]; bf16* wd = (bf16*)(F.ws + WS_WSBF);
      for (size_t i = gt; i < (size_t)NSG * 128 * 128; i += NT) { const int s = (int)(i & 127), t = (int)((i >> 7) & 127); wd[i] = (bf16)(s <= t ? f2bf(wsrc[i]) : 0u); }
    }
}

#if MK_BG
static_assert(MK_FP8_MOE, "the background item list is written for the fp8 MoE build");
constexpr int BG_F = (DM / (MK_FP8_FFN ? 128 : 64)) * (FF / 32);
constexpr int BG_EA = 3 * BG_F;
constexpr int BG_KV = (DM / 64) * (3072 / 32), BG_BIN = (DM / 64) * (DM / 32), BG_MIX = (DM / 64) * (DM / 32);
constexpr int BG_EB = BG_EA + BG_KV + BG_BIN;
constexpr int BG_EC = BG_EB + BG_MIX;
constexpr int BG_IE = (DM / 128) * (FFE / 32);
constexpr int BG_ED = BG_EC + 3 * NEXP * BG_IE;
constexpr int BG_EA1 = 2 * BG_F;
constexpr int BG_ED1 = BG_EC + 2 * NEXP * BG_IE;
static_assert(BG_EA % 8 == 0 && BG_EB % 8 == 0 && BG_EC % 8 == 0 && BG_ED % 8 == 0 && BG_EA1 % 8 == 0 && BG_ED1 % 8 == 0, "segments are whole 8-item batches");
__device__ __forceinline__ void bg_item(Frame& F, int it, LAS float* scr, int lane) {
    int r = it;
    if (r < BG_EA) { const int w = r / BG_F, item = r % BG_F;
#if MK_FP8_FFN
        if (w == 0) tr_matrix_item8(F.in[I_FG], DM, FF, F.ws + WS_W_FFN_GU, 0, 1, W8_G_MUL, item, scr, lane);
        else if (w == 1) tr_matrix_item8(F.in[I_FU], DM, FF, F.ws + WS_W_FFN_GU, 0, 2, W8_U_MUL, item, scr, lane);
        else tr_matrix_item8(F.in[I_FD], FF, DM, F.ws + WS_W_FFN_D, 0, 0, W8_D_MUL, item, scr, lane);
#else
        if (w == 0) tr_matrix_item(F.in[I_FG], DM, FF, (bf16*)(F.ws + WS_W_FFN_GU), 0, 1, item, scr, lane);
        else if (w == 1) tr_matrix_item(F.in[I_FU], DM, FF, (bf16*)(F.ws + WS_W_FFN_GU), 0, 2, item, scr, lane);
        else tr_matrix_item(F.in[I_FD], FF, DM, (bf16*)(F.ws + WS_W_FFN_D), 0, 0, item, scr, lane);
#endif
        return; } r -= BG_EA;
    if (r < BG_KV) { tr_matrix_item(F.in[I_SWKV], DM, 3072, (bf16*)(F.ws + WS_W_B_IN), 0, 0, r, scr, lane); return; } r -= BG_KV;
    if (r < BG_BIN) { tr_matrix_item(F.in[I_BWIN], DM, DM, (bf16*)(F.ws + WS_W_B_IN), 3072, 0, r, scr, lane); return; } r -= BG_BIN;
    if (r < BG_MIX) { tr_matrix_item(F.in[I_WMIX] + (size_t)DM * DM, DM, DM, (bf16*)(F.ws + WS_W_MIX), DM, 0, r, scr, lane); return; } r -= BG_MIX;
    { const int which = r / (NEXP * BG_IE), rr = r % (NEXP * BG_IE), e = rr / BG_IE, item = rr % BG_IE;
      if (which == 0) tr_matrix_item8(F.in[I_MG] + (size_t)e * DM * FFE, DM, FFE, F.ws + WS_W_MOE_GU, e * 2 * FFE, 1, W8_G_MUL, item, scr, lane);
      else if (which == 1) tr_matrix_item8(F.in[I_MU] + (size_t)e * DM * FFE, DM, FFE, F.ws + WS_W_MOE_GU, e * 2 * FFE, 2, W8_U_MUL, item, scr, lane);
      else tr_matrix_item8(F.in[I_MD] + (size_t)e * FFE * DM, FFE, DM, F.ws + WS_W_MOE_D, e * DM, 0, W8_D_MUL, item, scr, lane); }
}
__device__ __forceinline__ int bg_round(Frame& F) {
    volatile LAS int* w = (volatile LAS int*)(F.lds + LDSCTL_OFF + 128);
    const int lane = mk_lane();
    if (F.wave == 0 && lane == 0) w[0] = (int)__hip_atomic_fetch_add(F.ctl + CW_BGQ, 8u, RLX_AGENT);
    __syncthreads();
    const int base = w[0];
    if (base >= 0 && base < BG_ED) bg_item(F, base + F.wave, (LAS float*)(F.lds + RING_OFF + F.wave * 16896), lane);
    __syncthreads();
    return (base >= 0) ? base : BG_ED;
}
__device__ __forceinline__ void bg_drain(Frame& F, int X) {
    volatile LAS int* w = (volatile LAS int*)(F.lds + LDSCTL_OFF + 128);
    for (;;) {
        if (F.wave == 0 && mk_lane() == 0) w[3] = (int)__hip_atomic_load(F.ctl + CW_BGQ, RLX_AGENT);
        __syncthreads();
        const int head = w[3];
        __syncthreads();
        if (head < 0 || head >= X) break;
        (void)bg_round(F);
    }
}
#endif

#if MK_BG
__device__ __forceinline__ void xcd_barrier_bg(const XcdBarrier& b, Frame& F, bool& bg_done) {
    asm volatile("s_waitcnt vmcnt(0)" ::: "memory");
    __syncthreads();
    volatile LAS int* w = (volatile LAS int*)(F.lds + LDSCTL_OFF + 128);
    const bool t0 = (b.wave == 0 && mk_lane() == 0);
    if (t0) {
        unsigned* bar = b.bar;
        __builtin_amdgcn_s_waitcnt(0);
        unsigned nloc = b.st[0], nx = b.st[1];
        if (nloc == 0u) { xcd_barrier_complete(bar, b.x, nloc, nx); b.st[0] = nloc; b.st[1] = nx; }
        const unsigned old = xb_add(&bar[XB_XSUB(b.x)], 1u);
        const unsigned gen = old / nloc;
        if (old + 1u == (gen + 1u) * nloc) {
            __builtin_amdgcn_fence(__ATOMIC_RELEASE, "agent");
            asm volatile("s_waitcnt vmcnt(0)" ::: "memory");
            const unsigned og = xb_add(&bar[XB_TOP], 1u);
            const unsigned tg = og / nx;
            if (og + 1u == (tg + 1u) * nx) xb_add(&bar[XB_TOPGEN], 1u);
            else XB_SPIN(xb_ld(&bar[XB_TOPGEN]) == tg, bar);
            __builtin_amdgcn_fence(__ATOMIC_ACQUIRE, "agent");
            xb_add(&bar[XB_XGEN(b.x)], 1u);
            asm volatile("s_waitcnt vmcnt(0)" ::: "memory");
            w[1] = 1;
        } else { w[1] = 0; w[2] = (int)gen; }
    }
    __syncthreads();
    if (w[1] == 0) {
        for (unsigned it = 0;; ++it) {
            if (t0) { unsigned* bar = b.bar; int rel = xb_ld(&bar[XB_XGEN(b.x)]) != (unsigned)w[2];
                if (!rel && (it & 63u) == 63u) { if (xb_ld(&bar[XB_TMO])) rel = 1; else if (it > (1u << 17)) { atomicAdd(&bar[XB_TMO], 1u); rel = 1; } }
                w[4 + (it & 1u)] = rel; }
            __syncthreads();
            if (w[4 + (it & 1u)]) break;
            if (!bg_done) { if (bg_round(F) >= BG_ED) bg_done = true; } else __builtin_amdgcn_s_sleep(2);
        }
        if (t0) { __builtin_amdgcn_fence(__ATOMIC_ACQUIRE, "agent"); asm volatile("s_waitcnt vmcnt(0)" ::: "memory"); }
    }
    __syncthreads();
}
#endif

__device__ __forceinline__ void ln_load(const float* row, int lane, f32x4 (&v)[8]) { const GAS f32x4* xr = (const GAS f32x4*)row + lane;
#pragma unroll
    for (int j = 0; j < 8; ++j) v[j] = __builtin_nontemporal_load(xr + 64 * j); }
__device__ __forceinline__ void ln_norm(f32x4 (&v)[8], const float* g, const float* b, int lane, float* mean_o = nullptr, float* rstd_o = nullptr) {
    float s = 0.f;
#pragma unroll
    for (int j = 0; j < 8; ++j) s += (v[j].x + v[j].y) + (v[j].z + v[j].w);
    const float mean = wave_sum(s) * (1.f / DM); float s2 = 0.f;
#pragma unroll
    for (int j = 0; j < 8; ++j) { v[j] = v[j] - mean; s2 += (v[j].x * v[j].x + v[j].y * v[j].y) + (v[j].z * v[j].z + v[j].w * v[j].w); }
    const float rstd = 1.f / sqrtf(wave_sum(s2) * (1.f / DM) + LN_EPS);
    if (mean_o) { *mean_o = mean; *rstd_o = rstd; }
    const GAS f32x4* g4 = (const GAS f32x4*)g + lane; const GAS f32x4* b4 = (const GAS f32x4*)b + lane;
#pragma unroll
    for (int j = 0; j < 8; ++j) v[j] = v[j] * rstd * g4[64 * j] + b4[64 * j];
}
__device__ __forceinline__ void ln_store16(const f32x4 (&v)[8], bf16* brow, int lane) {
    GAS unsigned long long* o8 = (GAS unsigned long long*)brow + lane;
#pragma unroll
    for (int j = 0; j < 8; ++j) o8[64 * j] = (unsigned long long)pk2(v[j].x, v[j].y) | ((unsigned long long)pk2(v[j].z, v[j].w) << 32);
}
__device__ __forceinline__ void ln_store(const f32x4 (&v)[8], float* drow, bf16* brow, int lane) {
    GAS f32x4* o4 = (GAS f32x4*)drow + lane;
#pragma unroll
    for (int j = 0; j < 8; ++j) __builtin_nontemporal_store(v[j], o4 + 64 * j);
    if (brow) { GAS unsigned long long* o8 = (GAS unsigned long long*)brow + lane;
#pragma unroll
        for (int j = 0; j < 8; ++j) o8[64 * j] = (unsigned long long)pk2(v[j].x, v[j].y) | ((unsigned long long)pk2(v[j].z, v[j].w) << 32); }
}
__device__ __forceinline__ void ln_store8(const f32x4 (&v)[8], unsigned char* brow, int lane) {
    GAS unsigned* o4 = (GAS unsigned*)brow + lane;
#pragma unroll
    for (int j = 0; j < 8; ++j) { int t = 0; t = __builtin_amdgcn_cvt_pk_fp8_f32(v[j].x, v[j].y, t, false); t = __builtin_amdgcn_cvt_pk_fp8_f32(v[j].z, v[j].w, t, true); o4[64 * j] = (unsigned)t; }
}
template <bool F8 = false> __device__ __forceinline__ void ln_phase(Frame& F, const float* src, void* dstb, const float* g, const float* b) {
    const int lane_ = mk_lane();
    const int gw = blockIdx.x * NWAVES + F.wave, NGW = F.G * NWAVES; float* stats = (float*)(F.ws + WS_STATS);
#define LN_ROW(v, m) do { float mean, rstd; ln_norm(v, g, b, lane_, &mean, &rstd); \
        if (F8) ln_store8(v, (unsigned char*)dstb + (size_t)(m) * DM, lane_); else ln_store16(v, (bf16*)dstb + (size_t)(m) * DM, lane_); \
        if (lane_ == 0) { stats[2 * (m)] = mean; stats[2 * (m) + 1] = rstd; } } while (0)
    for (int base = gw * 16; base < NTOK; base += NGW * 16) {
        f32x4 va[8], vb[8]; ln_load(src + (size_t)base * DM, lane_, va);
        for (int r = 0; r < 16; r += 2) {
            ln_load(src + (size_t)(base + r + 1) * DM, lane_, vb); LN_ROW(va, base + r);
            if (r + 2 < 16) ln_load(src + (size_t)(base + r + 2) * DM, lane_, va);
            LN_ROW(vb, base + r + 1); }
    }
#undef LN_ROW
}

typedef at128::bf16 abf;
typedef at128::BlockRef<abf, abf> ABlk;
template <int PQ> __device__ __forceinline__ ABlk memattn_ref(int L, const abf* Qb, const abf* KVb, abf* Ob) {
    const int tile = L >> 2, h = L & 3, b = tile >> 5; ABlk r;
    r.Q = Qb + (size_t)tile * 256 * PQ + h * 128; r.K = KVb + (size_t)b * NMEM * 2048 + h * 128; r.V = r.K + MEMW; r.O = Ob + (size_t)tile * 256 * DM + h * 128; r.P0 = 1 << 20; return r;
}
template <int PQ> __device__ __forceinline__ void memattn_phase(int G, int wv, char* lds, const abf* Qb, const abf* KVb, abf* Ob) {
    constexpr int total = (NTOK / 256) * 4, W = 1 << 30;
    int L = blockIdx.x; if (L >= total) return;
    ABlk cur = memattn_ref<PQ>(L, Qb, KVb, Ob); at128::Seam<abf> S;
    at128::causal_swa_prime<abf, abf, PQ, 2048, DM>(cur, W, lds, S, wv);
    for (;;) { const bool last = L + G >= total; const ABlk nxt = last ? cur : memattn_ref<PQ>(L + G, Qb, KVb, Ob);
        at128::causal_swa_block<abf, abf, PQ, 2048, DM>(cur, nxt, NMEM, W, lds, S, wv); if (last) break; cur = nxt; L += G; }
}
__device__ __forceinline__ at256::Blk diff_blk(int vh, int qb, const abf* H1, abf* AO) {
    const int b = vh / 12, rem = vh % 12, h = rem >> 1, m = rem & 1; at256::Blk r; const abf* base = H1 + (size_t)b * SEQ * B_IN;
    r.Q = base + (size_t)qb * 256 * B_IN + 3072 + (m * 6 + h) * 128; r.K = base + (m * 6 + h) * 128; r.V = base + 1536 + h * 256;
    r.O = AO + ((size_t)b * SEQ + (size_t)qb * 256) * 3072 + m * 1536 + h * 256; r.P0 = qb * 256; return r;
}
__device__ __forceinline__ void diffattn_phase(int G, int wv, LAS unsigned char* ldsL, const abf* H1, abf* AO) {
    constexpr int NX = 16, total = 48 * NX;
    if (G == 256) {
        const int c = blockIdx.x, x8 = c & 7, j = c >> 3;
        for (int i = 0; i < 3; ++i) { const int vh = 2 * (i * 8 + x8) + (j >> 4), x = j & 15;
            at256::attn_block<B_IN, B_IN, 3072>(diff_blk(vh, x, H1, AO), ldsL, wv);
            at256::attn_block<B_IN, B_IN, 3072>(diff_blk(vh, 31 - x, H1, AO), ldsL, wv); }
    } else {
        for (int L = blockIdx.x; L < total; L += G) { const int vh = L / NX, x = L % NX;
            at256::attn_block<B_IN, B_IN, 3072>(diff_blk(vh, x, H1, AO), ldsL, wv);
            at256::attn_block<B_IN, B_IN, 3072>(diff_blk(vh, 31 - x, H1, AO), ldsL, wv); }
    }
}

__device__ __forceinline__ void sg_phase(Frame& F) {
    const bf16* H0 = (const bf16*)(F.ws + WS_H0); bf16* CC = (bf16*)(F.ws + WS_CONCAT); const bf16* WSB = (const bf16*)(F.ws + WS_WSBF);
    const float* vg = F.in[I_AVG]; const float* vb = F.in[I_AVB]; const float* bsp = F.in[I_ABS];
    const int lane = mk_lane(), wid = F.wave, tid = wid * 64 + lane, r32 = lane & 31, hi = lane >> 5;
    LAS float* stats = (LAS float*)(F.lds + 65536);
    LAS unsigned char* sw = F.lds + 66560 + wid * 8192;
    for (int c = blockIdx.x; c < NTOK / 128; c += F.G) {
        const size_t R0 = (size_t)c * 128;
        for (int r4 = 0; r4 < 16; r4 += 4) {
            v4u w[4][3];
#pragma unroll
            for (int q = 0; q < 4; ++q)
#pragma unroll
                for (int j = 0; j < 3; ++j) w[q][j] = *(const GAS v4u*)(H0 + (R0 + wid * 16 + r4 + q) * A_IN + MAINW + j * 512 + lane * 8);
#pragma unroll
            for (int q = 0; q < 4; ++q) { float x[24];
#pragma unroll
                for (int j = 0; j < 3; ++j) { x[8 * j + 0] = bflo(w[q][j].x); x[8 * j + 1] = bfhi(w[q][j].x); x[8 * j + 2] = bflo(w[q][j].y); x[8 * j + 3] = bfhi(w[q][j].y); x[8 * j + 4] = bflo(w[q][j].z); x[8 * j + 5] = bfhi(w[q][j].z); x[8 * j + 6] = bflo(w[q][j].w); x[8 * j + 7] = bfhi(w[q][j].w); }
                float s = 0.f;
#pragma unroll
                for (int j = 0; j < 24; ++j) s += x[j];
                const float mean = wave_sum(s) * (1.f / MAINW); float qq = 0.f;
#pragma unroll
                for (int j = 0; j < 24; ++j) { const float dd = x[j] - mean; qq += dd * dd; }
                const float rstd = 1.f / sqrtf(wave_sum(qq) * (1.f / MAINW) + LN_EPS);
                if (lane == 0) { const int t = wid * 16 + r4 + q; stats[2 * t] = mean; stats[2 * t + 1] = rstd; } asm volatile("" ::: "memory"); }
        }
        __syncthreads();
        const char* hbase = (const char*)(H0 + R0 * A_IN);
        v4u wst[8];
#define SG_LOADV(gp_) do { unsigned soff = (unsigned)(((tid >> 4) * A_IN + MAINW + (tid & 15) * 8) * 2); asm volatile("" : "+v"(soff)); \
        _Pragma("unroll") for (int i = 0; i < 8; ++i) wst[i] = *(const GAS v4u*)(hbase + (soff + (unsigned)(((((i >> 1) & 1) * 64 + (i & 1) * 32) * A_IN + (2 * (gp_) + (i >> 2)) * 128) * 2))); } while (0)
        SG_LOADV(0);
        for (int gp = 0; gp < NSG / 2; ++gp) {
#pragma unroll
            for (int i = 0; i < 8; ++i) {
                const int p = tid + 512 * i, gsel = p >> 11, kt = (p >> 10) & 1, key = (p >> 4) & 63, c8 = (p & 15) * 8, tok = kt * 64 + key, col = (2 * gp + gsel) * 128 + c8;
                const v4u w = wst[i];
                const float mean = stats[2 * tok], rstd = stats[2 * tok + 1];
                const f32x4 g0 = *(const GAS f32x4*)(vg + col), g1 = *(const GAS f32x4*)(vg + col + 4), b0 = *(const GAS f32x4*)(vb + col), b1 = *(const GAS f32x4*)(vb + col + 4);
                v4u o;
                o.x = pg8::cvt_pk_bf16((bflo(w.x) - mean) * rstd * g0.x + b0.x, (bfhi(w.x) - mean) * rstd * g0.y + b0.y);
                o.y = pg8::cvt_pk_bf16((bflo(w.y) - mean) * rstd * g0.z + b0.z, (bfhi(w.y) - mean) * rstd * g0.w + b0.w);
                o.z = pg8::cvt_pk_bf16((bflo(w.z) - mean) * rstd * g1.x + b1.x, (bfhi(w.z) - mean) * rstd * g1.y + b1.y);
                o.w = pg8::cvt_pk_bf16((bflo(w.w) - mean) * rstd * g1.z + b1.z, (bfhi(w.w) - mean) * rstd * g1.w + b1.w);
                *(LAS v4u*)(F.lds + (gsel * 2 + kt) * 16384 + at128::v_st(key, c8)) = o;
            }
            __syncthreads();
            if (gp + 1 < NSG / 2) SG_LOADV(gp + 1);
            { const int gsel = wid >> 2, tb = wid & 3, g = 2 * gp + gsel;
              const int er = lane >> 4, ec = (lane & 15) * 8; v4u uu[8];
              unsigned uoff = (unsigned)(((tb * 32 + er) * A_IN + g * 128 + ec) * 2); asm volatile("" : "+v"(uoff));
#pragma unroll
              for (int j = 0; j < 8; ++j) uu[j] = __builtin_nontemporal_load((const GAS v4u*)(hbase + (uoff + (unsigned)(4 * j * A_IN * 2))));
              at128::f32x16 o[4] = {};
              const int vb0 = (int)(unsigned long)(F.lds) + gsel * 32768 + at128::v_rd_base(lane);
              const bf16* wrow = WSB + ((size_t)g * 128 + tb * 32 + r32) * 128 + hi * 8;
              { const at128::bf16x8 pa0 = *(const GAS at128::bf16x8*)(wrow), pa1 = *(const GAS at128::bf16x8*)(wrow + 16), pa2 = *(const GAS at128::bf16x8*)(wrow + 32), pa3 = *(const GAS at128::bf16x8*)(wrow + 48);
                at128::pv_tile<0, false>(o, vb0, pa0, pa1, pa2, pa3, true); }
              if (tb >= 2) { const at128::bf16x8 pa0 = *(const GAS at128::bf16x8*)(wrow + 64), pa1 = *(const GAS at128::bf16x8*)(wrow + 80), pa2 = *(const GAS at128::bf16x8*)(wrow + 96), pa3 = *(const GAS at128::bf16x8*)(wrow + 112);
                at128::pv_tile<1, false>(o, vb0, pa0, pa1, pa2, pa3, true); }
#pragma unroll
              for (int r = 0; r < 16; ++r) { const int t = at128::crow(r, hi); const float bsv = bsp[g * 128 + tb * 32 + t];
#pragma unroll
                  for (int d0 = 0; d0 < 4; ++d0) { const float val = o[d0][r] + bsv; const float vn = __shfl_xor(val, 1);
                      if ((r32 & 1) == 0) *(LAS unsigned*)(sw + t * 256 + (d0 * 32 + r32) * 2) = pg8::cvt_pk_bf16(val, vn); } }
              char* cbase = (char*)(CC + R0 * DM); unsigned coff = (unsigned)(((tb * 32 + er) * DM + g * 128 + ec) * 2); asm volatile("" : "+v"(coff));
              LDS_WAIT(); asm volatile("" ::: "memory");
#pragma unroll
              for (int j = 0; j < 8; ++j) { const v4u sv = *(const LAS v4u*)(sw + (er + 4 * j) * 256 + ec * 2); v4u ov;
                  ov.x = pg8::cvt_pk_bf16(bflo(sv.x) * bflo(uu[j].x), bfhi(sv.x) * bfhi(uu[j].x)); ov.y = pg8::cvt_pk_bf16(bflo(sv.y) * bflo(uu[j].y), bfhi(sv.y) * bfhi(uu[j].y));
                  ov.z = pg8::cvt_pk_bf16(bflo(sv.z) * bflo(uu[j].z), bfhi(sv.z) * bfhi(uu[j].z)); ov.w = pg8::cvt_pk_bf16(bflo(sv.w) * bflo(uu[j].w), bfhi(sv.w) * bfhi(uu[j].w));
                  *(GAS v4u*)(cbase + (coff + (unsigned)(4 * j * DM * 2))) = ov; asm volatile("" ::: "memory"); }
            }
            __syncthreads();
        }
    }
#undef SG_LOADV
}

__device__ __forceinline__ void combine_phase(Frame& F) {
    const bf16* AO = (const bf16*)(F.ws + WS_AO); bf16* CC = (bf16*)(F.ws + WS_CONCAT1);
    const int lane = mk_lane(), gw = blockIdx.x * NWAVES + F.wave, NGW = F.G * NWAVES;
    const float* q1 = F.in[I_LQ1]; const float* k1 = F.in[I_LK1]; const float* q2 = F.in[I_LQ2]; const float* k2 = F.in[I_LK2];
    const float s1 = wave_sum(q1[lane] * k1[lane] + q1[lane + 64] * k1[lane + 64]), s2 = wave_sum(q2[lane] * k2[lane] + q2[lane + 64] * k2[lane + 64]);
    const float lam = expf(s1) - expf(s2) + LAMBDA_INIT, post = 1.0f - LAMBDA_INIT;
    const f32x4 g4 = *(const GAS f32x4*)(F.in[I_SUBLN] + 4 * lane);
#define CB_LOAD(av, bv, m0_) do { _Pragma("unroll") for (int t = 0; t < 2; ++t) { const bf16* r1 = AO + (size_t)((m0_) + t) * 3072 + 4 * lane; \
        _Pragma("unroll") for (int h = 0; h < 6; ++h) { av[t][h] = __builtin_nontemporal_load((const GAS unsigned long long*)(r1 + h * 256)); bv[t][h] = __builtin_nontemporal_load((const GAS unsigned long long*)(r1 + 1536 + h * 256)); } } } while (0)
#define CB_DO(av, bv, m0_) do { _Pragma("unroll") for (int t = 0; t < 2; ++t) { bf16* orow = CC + (size_t)((m0_) + t) * DM + 4 * lane; \
        _Pragma("unroll") for (int h = 0; h < 6; ++h) { \
            const unsigned a0 = (unsigned)av[t][h], a1 = (unsigned)(av[t][h] >> 32), b0 = (unsigned)bv[t][h], b1 = (unsigned)(bv[t][h] >> 32); \
            const float x0 = bflo(a0) - lam * bflo(b0), x1 = bfhi(a0) - lam * bfhi(b0), x2 = bflo(a1) - lam * bflo(b1), x3 = bfhi(a1) - lam * bfhi(b1); \
            const float ss = wave_sum((x0 * x0 + x1 * x1) + (x2 * x2 + x3 * x3)); \
            const float r = post / sqrtf(ss * (1.f / 256.f) + LN_EPS); \
            *(GAS unsigned long long*)(orow + h * 256) = (unsigned long long)pg8::cvt_pk_bf16(x0 * r * g4.x, x1 * r * g4.y) | ((unsigned long long)pg8::cvt_pk_bf16(x2 * r * g4.z, x3 * r * g4.w) << 32); } } } while (0)
    const int step = NGW * 2; int m0 = gw * 2;
    if (m0 < NTOK) {
        unsigned long long a_[2][6], b_[2][6], c_[2][6], d_[2][6];
        CB_LOAD(a_, b_, m0);
        for (;;) {
            const int m1 = m0 + step; if (m1 < NTOK) CB_LOAD(c_, d_, m1);
            CB_DO(a_, b_, m0); if (m1 >= NTOK) break;
            const int m2 = m1 + step; if (m2 < NTOK) CB_LOAD(a_, b_, m2);
            CB_DO(c_, d_, m1); if (m2 >= NTOK) break;
            m0 = m2; }
    }
#undef CB_LOAD
#undef CB_DO
}

__device__ __forceinline__ void router_row(f32x4 (&v)[8], int m, int lane, const float* g, const float* b, bf16* xb, const LAS float* wr, int* route_e, float* route_w, int& cnt) {
            ln_norm(v, g, b, lane);
#if MK_FP8_MOE
            ln_store8(v, (unsigned char*)xb + (size_t)m * DM, lane);
#else
            ln_store16(v, xb + (size_t)m * DM, lane);
#endif
            float lg[8];
#pragma unroll
            for (int e = 0; e < 8; ++e) lg[e] = 0.f;
#pragma unroll
            for (int j = 0; j < 8; ++j) {
#pragma unroll
                for (int e = 0; e < 8; ++e) { const f32x4 w = *(const LAS f32x4*)(wr + e * DM + 256 * j + 4 * lane); lg[e] += (v[j].x * w.x + v[j].y * w.y) + (v[j].z * w.z + v[j].w * w.w); }
                asm volatile("" ::: "memory"); }
#pragma unroll
            for (int e = 0; e < 8; ++e) lg[e] = wave_sum(lg[e]);
            int e0 = 0; float l0 = lg[0];
#pragma unroll
            for (int e = 1; e < 8; ++e) if (lg[e] > l0) { l0 = lg[e]; e0 = e; }
            int e1 = -1; float l1 = -3.0e38f;
#pragma unroll
            for (int e = 0; e < 8; ++e) if (e != e0 && lg[e] > l1) { l1 = lg[e]; e1 = e; }
            const float ex = expf(l1 - l0), w0 = 1.0f / (1.0f + ex), w1 = ex / (1.0f + ex);
            if (lane == 0) { route_e[m] = e0 | (e1 << 8); route_w[2 * m] = w0; route_w[2 * m + 1] = w1; }
            cnt += (lane == e0) + (lane == e1);
}
__device__ __forceinline__ void ln_router_phase(Frame& F, float* xio, bf16* xb, const float* g, const float* b) {
    LAS float* wr = (LAS float*)(F.lds);
    const float* wsrc = F.in[I_ROUTER];
    const int lane = mk_lane();
    for (int i = F.wave * 64 + lane; i < DM * NEXP; i += NWAVES * 64) wr[(i & 7) * DM + (i >> 3)] = wsrc[i];
    __syncthreads();
    int* route_e = (int*)(F.ws + WS_ROUTE_E); float* route_w = (float*)(F.ws + WS_ROUTE_W); int* hist = (int*)(F.ws + WS_HIST);
    const int gw = blockIdx.x * NWAVES + F.wave, NGW = F.G * NWAVES;
    for (int grp = gw; grp < NTOK / 16; grp += NGW) {
        int cnt = 0;
        f32x4 va[8], vb[8]; ln_load(xio + (size_t)(grp * 16) * DM, lane, va);
        for (int r = 0; r < 16; r += 2) {
            ln_load(xio + (size_t)(grp * 16 + r + 1) * DM, lane, vb); router_row(va, grp * 16 + r, lane, g, b, xb, wr, route_e, route_w, cnt);
            if (r + 2 < 16) ln_load(xio + (size_t)(grp * 16 + r + 2) * DM, lane, va);
            router_row(vb, grp * 16 + r + 1, lane, g, b, xb, wr, route_e, route_w, cnt); }
        if (lane < 8) hist[grp * 8 + lane] = cnt;
    }
}

__device__ __forceinline__ void dispatch_phase(Frame& F) {
    LAS int* gpre = (LAS int*)(F.lds);
    LAS int* wtot = (LAS int*)(F.lds + 65536);
    LAS int* tst = (LAS int*)(F.lds + 65536 + 256);
    const int* hist = (const int*)(F.ws + WS_HIST); const int lane = mk_lane(), wid = F.wave, tid = wid * 64 + lane;
    int h[4][8], sum[8];
#pragma unroll
    for (int e = 0; e < 8; ++e) sum[e] = 0;
#pragma unroll
    for (int i = 0; i < 4; ++i) { const v4u a = *(const GAS v4u*)(hist + (4 * tid + i) * 8), b = *(const GAS v4u*)(hist + (4 * tid + i) * 8 + 4);
        h[i][0] = a.x; h[i][1] = a.y; h[i][2] = a.z; h[i][3] = a.w; h[i][4] = b.x; h[i][5] = b.y; h[i][6] = b.z; h[i][7] = b.w;
#pragma unroll
        for (int e = 0; e < 8; ++e) sum[e] += h[i][e]; }
    int inc[8];
#pragma unroll
    for (int e = 0; e < 8; ++e) { int v = sum[e];
#pragma unroll
        for (int o = 1; o < 64; o <<= 1) { const int t = __shfl_up(v, o); if (lane >= o) v += t; }
        inc[e] = v; if (lane == 63) wtot[wid * 8 + e] = v; }
    __syncthreads();
    int tot[8];
#pragma unroll
    for (int e = 0; e < 8; ++e) { int pre = 0, all = 0;
#pragma unroll
        for (int w = 0; w < 8; ++w) { const int t = wtot[w * 8 + e]; all += t; if (w < wid) pre += t; }
        tot[e] = all; int run = pre + inc[e] - sum[e];
#pragma unroll
        for (int i = 0; i < 4; ++i) { gpre[(4 * tid + i) * 8 + e] = run; run += h[i][e]; } }
    if (tid == 0) { int ts = 0;
#pragma unroll
        for (int e = 0; e < 8; ++e) { tst[e] = ts; ts += (tot[e] + 255) >> 8; } tst[8] = ts;
        if (blockIdx.x == 0) { int* tab = (int*)(F.ws + WS_MOETAB);
#pragma unroll
            for (int e = 0; e <= 8; ++e) tab[e] = tst[e]; } }
    __syncthreads();
    const int* route_e = (const int*)(F.ws + WS_ROUTE_E); const float* route_w = (const float*)(F.ws + WS_ROUTE_W);
    int* tokslot = (int*)(F.ws + WS_TOKSLOT); int* slottok = (int*)(F.ws + WS_SLOTTOK); float* slotgate = (float*)(F.ws + WS_SLOTGATE);
    const bf16* X3B = (const bf16*)(F.ws + WS_X3B); bf16* XS = (bf16*)(F.ws + WS_XS);
    const int gw = blockIdx.x * NWAVES + wid, NGW = F.G * NWAVES;
    for (int grp = gw; grp < NTOK / 16; grp += NGW) {
        const int a = lane & 31, tok = grp * 16 + (a >> 1), k = a & 1;
        const int e = (route_e[tok] >> (8 * k)) & 0xff; const float w = route_w[2 * tok + k];
        int rank = 0;
#pragma unroll
        for (int ee = 0; ee < 8; ++ee) { const unsigned long long mk = __ballot(lane < 32 && e == ee); if (e == ee) rank = __popcll(mk & ((1ull << lane) - 1ull)); }
        const int slot = tst[e] * 256 + gpre[grp * 8 + e] + rank;
        if (lane < 32) { slottok[slot] = tok; slotgate[slot] = w; tokslot[2 * tok + k] = slot; }
        for (int q4 = 0; q4 < 32; q4 += 4) {
#if MK_FP8_MOE
            v4u t_[4][2]; int sl[4];
#pragma unroll
            for (int u = 0; u < 4; ++u) { const int q = q4 + u; sl[u] = __shfl(slot, q); const int tk = grp * 16 + (q >> 1); const GAS v4u* src = (const GAS v4u*)((const unsigned char*)X3B + (size_t)tk * DM) + lane; t_[u][0] = src[0]; t_[u][1] = src[64]; }
#pragma unroll
            for (int u = 0; u < 4; ++u) { GAS v4u* dst = (GAS v4u*)((unsigned char*)XS + (size_t)sl[u] * DM) + lane; dst[0] = t_[u][0]; dst[64] = t_[u][1]; }
#else
            v4u t_[4][4]; int sl[4];
#pragma unroll
            for (int u = 0; u < 4; ++u) { const int q = q4 + u; sl[u] = __shfl(slot, q); const int tk = grp * 16 + (q >> 1); const GAS v4u* src = (const GAS v4u*)(X3B + (size_t)tk * DM) + lane;
#pragma unroll
                for (int j = 0; j < 4; ++j) t_[u][j] = src[64 * j]; }
#pragma unroll
            for (int u = 0; u < 4; ++u) { GAS v4u* dst = (GAS v4u*)(XS + (size_t)sl[u] * DM) + lane;
#pragma unroll
                for (int j = 0; j < 4; ++j) dst[64 * j] = t_[u][j]; }
#endif
        }
    }
}

__device__ __forceinline__ void add_os_row(f32x4 (&v)[8], const bf16* row, int lane) { const GAS unsigned long long* o = (const GAS unsigned long long*)row + lane;
#pragma unroll
    for (int j = 0; j < 8; ++j) { const unsigned long long p = __builtin_nontemporal_load(o + 64 * j); const unsigned p0 = (unsigned)p, p1 = (unsigned)(p >> 32); v[j].x += bflo(p0); v[j].y += bfhi(p0); v[j].z += bflo(p1); v[j].w += bfhi(p1); } }
__device__ __forceinline__ void final_phase(Frame& F, const float* g3, const float* b3, const float* g, const float* b) {
    const int* tokslot = (const int*)(F.ws + WS_TOKSLOT); const bf16* OS = (const bf16*)(F.ws + WS_OS); const bf16* OSK = (const bf16*)(F.ws + WS_OSK);
    const int gw = blockIdx.x * NWAVES + F.wave, NGW = F.G * NWAVES, lane = mk_lane();
    int Tm = 1 << 30;
#if MK_FP8_MOE
    { const int T = ((const int*)(F.ws + WS_MOETAB))[8]; int Lt = T & 31; if (Lt > 8) Lt = 0; Tm = T - Lt; }
#endif
#define FIN_ROW(v, m, s0, s1) do { ln_norm(v, g3, b3, lane);     \
        _Pragma("unroll") for (int j = 0; j < 8; ++j) v[j] = v[j] * ALPHA; \
        { const int sl_[2] = {s0, s1}; _Pragma("unroll") for (int k = 0; k < 2; ++k) { const int s = sl_[k], tile = s >> 8; \
            if (tile >= Tm) { for (int q = 0; q < 4; ++q) add_os_row(v, OSK + ((size_t)(q * 8 + tile - Tm) * 256 + (s & 255)) * DM, lane); } \
            else add_os_row(v, OS + (size_t)s * DM, lane); } } \
        ln_norm(v, g, b, lane); ln_store(v, F.out + (size_t)(m) * DM, nullptr, lane); } while (0)
    for (int base = gw * 16; base < NTOK; base += NGW * 16) {
        f32x4 va[8], vb[8]; ln_load(F.out + (size_t)base * DM, lane, va); int a0 = tokslot[2 * base], a1 = tokslot[2 * base + 1], b0 = 0, b1 = 0;
        for (int r = 0; r < 16; r += 2) { const int m = base + r;
            ln_load(F.out + (size_t)(m + 1) * DM, lane, vb); b0 = tokslot[2 * (m + 1)]; b1 = tokslot[2 * (m + 1) + 1];
            FIN_ROW(va, m, a0, a1);
            if (r + 2 < 16) { ln_load(F.out + (size_t)(m + 2) * DM, lane, va); a0 = tokslot[2 * (m + 2)]; a1 = tokslot[2 * (m + 2) + 1]; }
            FIN_ROW(vb, m + 1, b0, b1); }
    }
#undef FIN_ROW
}

struct Args { const float* in[25]; float* out; unsigned char* ws; int ph_lo, ph_hi, ch_lo, ch_hi; };
__global__ void __launch_bounds__(NWAVES * 64, 2) mk_fwd(Args args) {
    extern __shared__ __attribute__((aligned(16))) unsigned char lds[];
    Frame F;
    F.lds = (LAS unsigned char*)lds; F.MISC = (volatile LAS unsigned*)(F.lds + MISC_OFF);
    F.wave = __builtin_amdgcn_readfirstlane(threadIdx.x >> 6); F.G = gridDim.x;
    F.ws = args.ws; F.ctl = (gu32*)(args.ws + WS_CTL); F.out = args.out;
#pragma unroll
    for (int i = 0; i < 25; ++i) F.in[i] = args.in[i];
    for (int u = threadIdx.x; u < (LDS_BYTES - LDSCTL_OFF) / 4; u += NWAVES * 64) ((LAS unsigned*)(F.lds + LDSCTL_OFF))[u] = 0u;
    __syncthreads();
    const int lo = args.ph_lo, hi = args.ph_hi;
    XcdBarrier bar; bar.bar = (unsigned*)(F.ctl + CW_BAR); bar.x = 0; bar.st = nullptr; bar.wave = F.wave;
    if (hi - lo > 1) { bar = xcd_barrier_post((unsigned*)(F.ctl + CW_BAR), F.MISC + 8); bar.wave = F.wave; }
#define IN(k) (((MK_PHMASK >> (k)) & 1) && lo <= (k) && (k) < hi)
#define BOTH(k) (IN(k) && IN((k) + 1))
#if MK_BG
    bool bg_done_ = false;
#define XCD_BAR_CALL() xcd_barrier_bg(bar, F, bg_done_)
#else
#define XCD_BAR_CALL() xcd_barrier(bar)
#endif
#if MK_PROBE == 3
    unsigned long long bar_wait_ = 0;
#define BG_DRAIN(X) do { const unsigned long long t0_ = rt(); bg_drain(F, X); bar_wait_ += rt() - t0_; } while (0)
#else
#define BG_DRAIN(X) bg_drain(F, X)
#endif
#if MK_PROBE == 2
    unsigned long long bar_wait_ = 0;
    int bar_idx_ = 0;
#define GRID_BAR() do { const unsigned long long t0_ = rt(); XCD_BAR_CALL(); if ((MK_PROBE_BARMASK >> bar_idx_) & 1) bar_wait_ += rt() - t0_; ++bar_idx_; } while (0)
#else
#define GRID_BAR() XCD_BAR_CALL()
#endif
#if MK_PROBE
    if (blockIdx.x == 0 && F.wave == 0 && mk_lane() == 0) __hip_atomic_store(F.ctl + CW_TS, (unsigned)rt(), RLX_AGENT);
#define STAMP(k) do { if (blockIdx.x == 0 && F.wave == 0 && mk_lane() == 0) __hip_atomic_store(F.ctl + CW_TS + 1 + (k), (unsigned)rt(), RLX_AGENT); } while (0)
#else
#define STAMP(k) do { } while (0)
#endif
    unsigned char* ws = args.ws;
    bf16* XB = (bf16*)(ws + WS_XB);
    LAS unsigned char* ring = F.lds + RING_OFF;

    if (IN(0)) { p0_prologue(F); if (BOTH(0)) GRID_BAR(); STAMP(0); }
    if (IN(1)) {
        { pg8::Gemm g{XB, (const bf16*)(ws + WS_W_A_IN), NTOK, A_IN, DM}; pg8::StaticOrder S; S.init(NTOK, A_IN, F.G, (int)blockIdx.x);
          pg8::EpiBf16 E{(bf16*)(ws + WS_H0), A_IN, 2 * MAINW, 1 << 30}; pg8::gemm_phase<pg8::EpiBf16, pg8::StaticOrder, true, true>(ring, g, S, E, F.wave); }
        { pg8::Gemm g{(const bf16*)(ws + WS_MEMB), (const bf16*)(ws + WS_W_MEMKV), NBATCH * NMEM, 2048, DM}; pg8::StaticOrder S; S.init(NBATCH * NMEM, 2048, F.G, (int)blockIdx.x);
          pg8::EpiBf16 E{(bf16*)(ws + WS_MEMKV), 2048, 0, 1 << 30}; pg8::gemm_phase<pg8::EpiBf16, pg8::StaticOrder, true, true>(ring, g, S, E, F.wave); }
        if (BOTH(1)) GRID_BAR(); STAMP(1);
    }
    if (IN(2)) {
        memattn_phase<A_IN>(F.G, F.wave, (char*)lds + RING_OFF, (const abf*)(ws + WS_H0) + 2 * MAINW, (const abf*)(ws + WS_MEMKV), (abf*)(ws + WS_CONCAT) + MAINW);
        __syncthreads();
        sg_phase(F);
        if (BOTH(2)) GRID_BAR(); STAMP(2);
    }
    if (IN(3)) {
        pg8::Gemm g{(const bf16*)(ws + WS_CONCAT), (const bf16*)(ws + WS_W_MIX), NTOK, DM, DM}; pg8::StaticOrder S; S.init(NTOK, DM, F.G, (int)blockIdx.x);
        pg8::EpiRes E{F.in[I_X], F.out, DM, ALPHA}; pg8::gemm_phase<pg8::EpiRes, pg8::StaticOrder, true, true>(ring, g, S, E, F.wave);
        if (BOTH(3)) GRID_BAR(); STAMP(3);
    }
    if (IN(4)) { ln_phase<MK_FP8_FFN != 0>(F, F.out, XB, F.in[I_LNG] + 0 * DM, F.in[I_LNB] + 0 * DM);
#if MK_BG
        BG_DRAIN(BG_EA1);
#endif
        if (BOTH(4)) GRID_BAR(); STAMP(4); }
    if (IN(5)) {
        pg8::StaticOrder S; S.init(NTOK, 2 * FF, F.G, (int)blockIdx.x);
#if MK_FP8_FFN
        pg8::Gemm g{XB, (const bf16*)(ws + WS_W_FFN_GU), NTOK, 2 * FF, DM / 2};
        pg8::EpiSwiglu8<false> E{ws + WS_HID, FF}; pg8::gemm_phase<pg8::EpiSwiglu8<false>, pg8::StaticOrder, true, true, SC_ONE, SC_M6>(ring, g, S, E, F.wave);
#else
        pg8::Gemm g{XB, (const bf16*)(ws + WS_W_FFN_GU), NTOK, 2 * FF, DM};
        pg8::EpiSwiglu E{(bf16*)(ws + WS_HID), FF}; pg8::gemm_phase<pg8::EpiSwiglu, pg8::StaticOrder, true, true>(ring, g, S, E, F.wave);
#endif
#if MK_BG
        BG_DRAIN(BG_EA);
#endif
        if (BOTH(5)) GRID_BAR(); STAMP(5);
    }
    if (IN(6)) {
        pg8::StaticOrder S; S.init(NTOK, DM, F.G, (int)blockIdx.x); pg8::EpiResLn E{F.out, (const float*)(ws + WS_STATS), F.in[I_LNG] + 0 * DM, F.in[I_LNB] + 0 * DM};
#if MK_FP8_FFN
        pg8::Gemm g{(const bf16*)(ws + WS_HID), (const bf16*)(ws + WS_W_FFN_D), NTOK, DM, FF / 2};
        pg8::gemm_phase<pg8::EpiResLn, pg8::StaticOrder, true, true, SC_M4, SC_M7>(ring, g, S, E, F.wave);
#else
        pg8::Gemm g{(const bf16*)(ws + WS_HID), (const bf16*)(ws + WS_W_FFN_D), NTOK, DM, FF};
        pg8::gemm_phase<pg8::EpiResLn, pg8::StaticOrder, true, true>(ring, g, S, E, F.wave);
#endif
        if (BOTH(6)) GRID_BAR(); STAMP(6);
    }
    if (IN(7)) { ln_phase<false>(F, F.out, XB, F.in[I_LNG] + 1 * DM, F.in[I_LNB] + 1 * DM);
#if MK_BG
        BG_DRAIN(BG_EB);
#endif
        if (BOTH(7)) GRID_BAR(); STAMP(7); }
    if (IN(8)) {
        pg8::Gemm g{XB, (const bf16*)(ws + WS_W_B_IN), NTOK, B_IN, DM}; pg8::StaticOrder S; S.init(NTOK, B_IN, F.G, (int)blockIdx.x);
        pg8::EpiBf16 E{(bf16*)(ws + WS_H1), B_IN, 0, 3072  }; pg8::gemm_phase<pg8::EpiBf16, pg8::StaticOrder, true, true>(ring, g, S, E, F.wave);
        if (BOTH(8)) GRID_BAR(); STAMP(8);
    }
    if (IN(9)) { diffattn_phase(F.G, F.wave, F.lds + RING_OFF, (const abf*)(ws + WS_H1), (abf*)(ws + WS_AO)); if (BOTH(9)) GRID_BAR(); STAMP(9); }
    if (IN(10)) {
        memattn_phase<B_IN>(F.G, F.wave, (char*)lds + RING_OFF, (const abf*)(ws + WS_H1) + 4608, (const abf*)(ws + WS_MEMKV) + 1024, (abf*)(ws + WS_CONCAT1) + MAINW);
        combine_phase(F);
#if MK_BG
        __syncthreads(); BG_DRAIN(BG_EC);
#endif
        if (BOTH(10)) GRID_BAR(); STAMP(10);
    }
    if (IN(11)) {
        pg8::Gemm g{(const bf16*)(ws + WS_CONCAT1), (const bf16*)(ws + WS_W_MIX) + (size_t)DM * DM, NTOK, DM, DM}; pg8::StaticOrder S; S.init(NTOK, DM, F.G, (int)blockIdx.x);
        pg8::EpiResLn E{F.out, (const float*)(ws + WS_STATS), F.in[I_LNG] + 1 * DM, F.in[I_LNB] + 1 * DM}; pg8::gemm_phase<pg8::EpiResLn, pg8::StaticOrder, true, true>(ring, g, S, E, F.wave);
        if (BOTH(11)) GRID_BAR(); STAMP(11);
    }
    if (IN(12)) { ln_router_phase(F, F.out, (bf16*)(ws + WS_X3B), F.in[I_LNG] + 2 * DM, F.in[I_LNB] + 2 * DM); if (BOTH(12)) GRID_BAR(); STAMP(12); }
    if (IN(13)) { dispatch_phase(F);
#if MK_BG
        __syncthreads(); BG_DRAIN(BG_ED1);
#endif
        if (BOTH(13)) GRID_BAR(); STAMP(13); }
    if (IN(14) || IN(15)) {
        LAS int* tst = (LAS int*)(F.lds + LDSCTL_OFF);
        { const int t_ = F.wave * 64 + mk_lane(); if (t_ < 9) tst[t_] = ((const int*)(ws + WS_MOETAB))[t_]; }
        __syncthreads();
        const int T = tst[8];
        for (int ch = args.ch_lo; ch < args.ch_hi; ++ch) {
            const int t0 = ch * MOE_CHUNK_T; int nM = T - t0; nM = nM < 0 ? 0 : (nM > MOE_CHUNK_T ? MOE_CHUNK_T : nM);
            if (IN(14)) {
                pg8::MoeOrder<false> S; S.nM = nM; S.nN = 2 * FFE / 256; S.nwg = nM * S.nN; S.G = F.G; S.c = (int)blockIdx.x; S.t0 = t0; S.tstart = tst;
#if MK_FP8_MOE
                pg8::Gemm g{(const bf16*)(ws + WS_XS), (const bf16*)(ws + WS_W_MOE_GU), 0, 2 * FFE, DM / 2};
                pg8::EpiSwiglu8<false> E{ws + WS_HIDM, FFE}; pg8::gemm_phase<pg8::EpiSwiglu8<false>, pg8::MoeOrder<false>, true, true, SC_ONE, SC_M6>(ring, g, S, E, F.wave);
#else
                pg8::Gemm g{(const bf16*)(ws + WS_XS), (const bf16*)(ws + WS_W_MOE_GU), 0, 2 * FFE, DM};
                pg8::EpiSwiglu E{(bf16*)(ws + WS_HIDM), FFE}; pg8::gemm_phase<pg8::EpiSwiglu, pg8::MoeOrder<false>, true, true>(ring, g, S, E, F.wave);
#endif
#if MK_BG
                BG_DRAIN(BG_ED);
#endif
                if (IN(15)) GRID_BAR(); STAMP(14);
            }
            if (IN(15)) {
                pg8::EpiRowScale E{(bf16*)(ws + WS_OS), DM, (const float*)(ws + WS_SLOTGATE)};
#if MK_FP8_MOE
                int Lt = T & 31; if (Lt > 8) Lt = 0; const int Tm = T - Lt;
                { pg8::MoeOrder<true> S; S.nM = Tm; S.nN = DM / 256; S.nwg = Tm * S.nN; S.G = F.G; S.c = (int)blockIdx.x; S.t0 = 0; S.tstart = tst;
                  pg8::Gemm g{(const bf16*)(ws + WS_HIDM), (const bf16*)(ws + WS_W_MOE_D), 0, DM, FFE / 2, 0};
                  pg8::gemm_phase<pg8::EpiRowScale, pg8::MoeOrder<true>, true, true, SC_M4, SC_M7>(ring, g, S, E, F.wave); }
                { pg8::MoeLeftOrder S; S.L = Lt; S.G = F.G; S.c = (int)blockIdx.x; S.tl0 = Tm; S.kq = FFE / 4; S.tstart = tst;
                  pg8::Gemm g{(const bf16*)(ws + WS_HIDM), (const bf16*)(ws + WS_W_MOE_D), 0, DM, FFE / 2, FFE / 8};
                  pg8::EpiRowScale E2{(bf16*)(ws + WS_OSK), DM, (const float*)(ws + WS_SLOTGATE)};
                  pg8::gemm_phase<pg8::EpiRowScale, pg8::MoeLeftOrder, true, true, SC_M4, SC_M7>(ring, g, S, E2, F.wave); }
#else
                pg8::MoeOrder<true> S; S.nM = nM; S.nN = DM / 256; S.nwg = nM * S.nN; S.G = F.G; S.c = (int)blockIdx.x; S.t0 = t0; S.tstart = tst;
                pg8::Gemm g{(const bf16*)(ws + WS_HIDM), (const bf16*)(ws + WS_W_MOE_D), 0, DM, FFE, 0};
                pg8::gemm_phase<pg8::EpiRowScale, pg8::MoeOrder<true>, true, true>(ring, g, S, E, F.wave);
#endif
                if (ch + 1 < args.ch_hi ? IN(14) : IN(16)) GRID_BAR(); STAMP(15);
            }
        }
    }
    if (IN(16)) final_phase(F, F.in[I_LNG] + 2 * DM, F.in[I_LNB] + 2 * DM, F.in[I_LNG] + 3 * DM, F.in[I_LNB] + 3 * DM);
#if MK_PROBE
#if MK_PROBE == 2 || MK_PROBE == 3
    if (blockIdx.x == MK_PROBE_BLK && F.wave == 0 && mk_lane() == 0) { const unsigned long long t0 = rt(), target = bar_wait_ * MK_PROBE_MULT; while (rt() - t0 < target) __builtin_amdgcn_s_sleep(32); }
#else
    STAMP(16);
    if (blockIdx.x == 0 && F.wave == 0 && mk_lane() == 0) {
        unsigned ta = 0;
        for (int k = 0; k < 17; ++k) { const unsigned d = __hip_atomic_load(F.ctl + CW_TS + 1 + k, RLX_AGENT) - __hip_atomic_load(F.ctl + CW_TS + k, RLX_AGENT); if ((MK_PROBE_A >> k) & 1) ta += d; }
        const unsigned long long t0 = rt(), target = (unsigned long long)ta * MK_PROBE_MULT;
        while (rt() - t0 < target) __builtin_amdgcn_s_sleep(32);
    }
#endif
#endif
#undef IN
#undef BOTH
#undef GRID_BAR
#undef XCD_BAR_CALL
#undef BG_DRAIN
#undef STAMP
}

#if MK_DEBUG
__device__ __forceinline__ unsigned hash32(unsigned x) { x ^= x >> 16; x *= 0x7feb352dU; x ^= x >> 15; x *= 0x846ca68bU; x ^= x >> 16; return x; }
__device__ __forceinline__ float wdot(const bf16* a, const bf16* b, int K, int lane) { float s = 0.f; for (int k = lane; k < K; k += 64) s += bf2f(a[k]) * bf2f(b[k]); return wave_sum(s); }
__device__ __forceinline__ bool okf(float got, float ref, float rel, float ab) { return fabsf(got - ref) <= rel * fabsf(ref) + ab; }
__device__ __forceinline__ float gelu_ref(float x) { return 0.5f * x * (1.0f + tanhf(0.7978845608f * (x + 0.044715f * x * x * x))); }
__device__ __forceinline__ float silu_ref(float x) { return x / (1.0f + expf(-x)); }
__device__ __forceinline__ float f8f(unsigned char b) { return __builtin_amdgcn_cvt_f32_fp8((int)b, 0); }
__device__ __forceinline__ unsigned char f2f8(float x) { return (unsigned char)(__builtin_amdgcn_cvt_pk_fp8_f32(x, 0.f, 0, false) & 0xff); }
__device__ __forceinline__ float wdot8(const unsigned char* a, const unsigned char* b, int K, int lane) { float s = 0.f; for (int k = lane; k < K; k += 64) s += f8f(a[k]) * f8f(b[k]); return wave_sum(s); }
#define CHK_FAIL(stage) do { if (lane == 0) atomicAdd((unsigned*)(a.ws + WS_CTL) + CW_CHK + (stage), 1u); } while (0)
__device__ void chk_tr8(const Args& a, int stage, const float* W, int K, int N, const unsigned char* WT, int row_off, int mode, float mul, unsigned s, int lane) {
    const int k = hash32(s * 2 + 1) % K, n = hash32(s * 2 + 2) % N; const int drow = row_off + (mode == 0 ? n : ((n >> 7) * 256 + (n & 127) + (mode == 2 ? 128 : 0)));
    if (WT[(size_t)drow * K + k] != f2f8(W[(size_t)k * N + n] * mul)) CHK_FAIL(stage);
}
__device__ void chk_tr(const Args& a, int stage, const float* W, int K, int N, const bf16* WT, int row_off, int mode, unsigned s, int lane) {
    const int k = hash32(s * 2 + 1) % K, n = hash32(s * 2 + 2) % N; const int drow = row_off + (mode == 0 ? n : ((n >> 7) * 256 + (n & 127) + (mode == 2 ? 128 : 0)));
    if (WT[(size_t)drow * K + k] != (bf16)f2bf(W[(size_t)k * N + n])) CHK_FAIL(stage);
}
__device__ void chk_memattn(const Args& a, int stage, const bf16* q, const bf16* Kb, const bf16* Ob, float* pl, int lane) {
    float sc[4], mx = -3e38f;
    for (int i = 0; i < 4; ++i) { const int j = lane + 64 * i; float s = 0.f; for (int d = 0; d < 128; ++d) s += bf2f(q[d]) * bf2f(Kb[(size_t)j * 2048 + d]); sc[i] = s * 0.08838834764831845f; mx = fmaxf(mx, sc[i]); }
    for (int o = 1; o < 64; o <<= 1) mx = fmaxf(mx, __shfl_xor(mx, o));
    float sum = 0.f; for (int i = 0; i < 4; ++i) { sc[i] = expf(sc[i] - mx); sum += sc[i]; pl[lane + 64 * i] = sc[i]; }
    sum = wave_sum(sum); __syncthreads();
    bool bad = false;
    for (int dd = 0; dd < 2; ++dd) { const int d = lane + 64 * dd; float o = 0.f; for (int j = 0; j < 256; ++j) o += pl[j] * bf2f(Kb[(size_t)j * 2048 + 512 + d]); o /= sum;
        if (!okf(bf2f(Ob[d]), o, 0.03f, 0.004f)) bad = true; }
    if (__any(bad)) CHK_FAIL(stage);
    __syncthreads();
}
__global__ void __launch_bounds__(64) chk_kernel(Args a, int stage, int chunk) {
    __shared__ float pl[8192];
    const int lane = threadIdx.x; const unsigned s = blockIdx.x; unsigned char* ws = a.ws;
    const bf16* XB = (const bf16*)(ws + WS_XB);
    if (stage == 0 || (MK_BG && stage == 14)) {
        int cs = s % 12;
#if MK_BG
        { const bool fg = (cs == 0 || cs == 7 || cs == 11 || (cs == 1 && ((s / 12) & 1) == 0)); if ((stage == 0) != fg) cs = 99; }
#endif
        switch (cs) {
        case 99: break;
        case 0: chk_tr(a, 0, a.in[I_AWIN], DM, A_IN, (const bf16*)(ws + WS_W_A_IN), 0, 0, s, lane); break;
        case 1: { const int l = (s / 12) & 1; chk_tr(a, 0, a.in[I_WMIX] + (size_t)l * DM * DM, DM, DM, (const bf16*)(ws + WS_W_MIX), l * DM, 0, s, lane); } break;
#if MK_FP8_FFN
        case 2: chk_tr8(a, 0, a.in[I_FG], DM, FF, ws + WS_W_FFN_GU, 0, 1, W8_G_MUL, s, lane); break;
        case 3: chk_tr8(a, 0, a.in[I_FU], DM, FF, ws + WS_W_FFN_GU, 0, 2, W8_U_MUL, s, lane); break;
        case 4: chk_tr8(a, 0, a.in[I_FD], FF, DM, ws + WS_W_FFN_D, 0, 0, W8_D_MUL, s, lane); break;
#else
        case 2: chk_tr(a, 0, a.in[I_FG], DM, FF, (const bf16*)(ws + WS_W_FFN_GU), 0, 1, s, lane); break;
        case 3: chk_tr(a, 0, a.in[I_FU], DM, FF, (const bf16*)(ws + WS_W_FFN_GU), 0, 2, s, lane); break;
        case 4: chk_tr(a, 0, a.in[I_FD], FF, DM, (const bf16*)(ws + WS_W_FFN_D), 0, 0, s, lane); break;
#endif
        case 5: chk_tr(a, 0, a.in[I_SWKV], DM, 3072, (const bf16*)(ws + WS_W_B_IN), 0, 0, s, lane); break;
        case 6: chk_tr(a, 0, a.in[I_BWIN], DM, DM, (const bf16*)(ws + WS_W_B_IN), 3072, 0, s, lane); break;
        case 7: { const int l = (s / 12) & 1; chk_tr(a, 0, a.in[I_WMEMKV] + (size_t)l * DM * 1024, DM, 1024, (const bf16*)(ws + WS_W_MEMKV), l * 1024, 0, s, lane); } break;
#if MK_FP8_MOE
        case 8: { const int e = (s / 12) & 7; chk_tr8(a, 0, a.in[I_MG] + (size_t)e * DM * FFE, DM, FFE, ws + WS_W_MOE_GU, e * 2 * FFE, 1, W8_G_MUL, s, lane); } break;
        case 9: { const int e = (s / 12) & 7; chk_tr8(a, 0, a.in[I_MU] + (size_t)e * DM * FFE, DM, FFE, ws + WS_W_MOE_GU, e * 2 * FFE, 2, W8_U_MUL, s, lane); } break;
        case 10: { const int e = (s / 12) & 7; chk_tr8(a, 0, a.in[I_MD] + (size_t)e * FFE * DM, FFE, DM, ws + WS_W_MOE_D, e * DM, 0, W8_D_MUL, s, lane); } break;
#else
        case 8: { const int e = (s / 12) & 7; chk_tr(a, 0, a.in[I_MG] + (size_t)e * DM * FFE, DM, FFE, (const bf16*)(ws + WS_W_MOE_GU), e * 2 * FFE, 1, s, lane); } break;
        case 9: { const int e = (s / 12) & 7; chk_tr(a, 0, a.in[I_MU] + (size_t)e * DM * FFE, DM, FFE, (const bf16*)(ws + WS_W_MOE_GU), e * 2 * FFE, 2, s, lane); } break;
        case 10: { const int e = (s / 12) & 7; chk_tr(a, 0, a.in[I_MD] + (size_t)e * FFE * DM, FFE, DM, (const bf16*)(ws + WS_W_MOE_D), e * DM, 0, s, lane); } break;
#endif
        default: { const size_t i = hash32(s) % ((size_t)NTOK * DM); if (XB[i] != (bf16)f2bf(a.in[I_X][i])) CHK_FAIL(0);
                   const size_t i2 = hash32(s + 7) % ((size_t)1024 * DM); if (((const bf16*)(ws + WS_MEMB))[i2] != (bf16)f2bf(a.in[I_MEM][i2])) CHK_FAIL(0);
                   const int i3 = hash32(s + 9) % (NSG * 128 * 128), ss = i3 & 127, tt = (i3 >> 7) & 127; if (((const bf16*)(ws + WS_WSBF))[i3] != (bf16)(ss <= tt ? f2bf(a.in[I_AWS][i3]) : 0u)) CHK_FAIL(0); } break;
        }
    } else if (stage == 1) {
        const int row = hash32(s) % NTOK, col = (s & 1) ? (3072 + hash32(s + 1) % 512) : (hash32(s + 1) % A_IN);
        float ref = wdot(XB + (size_t)row * DM, (const bf16*)(ws + WS_W_A_IN) + (size_t)col * DM, DM, lane); if (col < 3072) ref = gelu_ref(ref);
        if (!okf(bf2f(((const bf16*)(ws + WS_H0))[(size_t)row * A_IN + col]), ref, 0.02f, 0.02f)) CHK_FAIL(1);
        const int r2 = hash32(s + 3) % 1024, c2 = hash32(s + 4) % 2048;
        const float ref2 = wdot((const bf16*)(ws + WS_MEMB) + (size_t)r2 * DM, (const bf16*)(ws + WS_W_MEMKV) + (size_t)c2 * DM, DM, lane);
        if (!okf(bf2f(((const bf16*)(ws + WS_MEMKV))[(size_t)r2 * 2048 + c2]), ref2, 0.02f, 0.02f)) CHK_FAIL(1);
    } else if (stage == 2) {
        const int tok = hash32(s) % NTOK, h = hash32(s + 1) & 3, b = tok / SEQ; const bf16* H0 = (const bf16*)(ws + WS_H0);
        chk_memattn(a, 2, H0 + (size_t)tok * A_IN + 3072 + h * 128, (const bf16*)(ws + WS_MEMKV) + (size_t)b * 256 * 2048 + h * 128, (const bf16*)(ws + WS_CONCAT) + (size_t)tok * DM + 1536 + h * 128, pl, lane);
        const int g = hash32(s + 2) % NSG, t = tok & 127; const size_t R0 = (size_t)(tok - t);
        float mean[2], rstd[2];
        for (int i = 0; i < 2; ++i) { const int sidx = lane + 64 * i; const bf16* vr = H0 + (R0 + sidx) * A_IN + MAINW; float sm = 0.f; for (int k = 0; k < MAINW; ++k) sm += bf2f(vr[k]); sm /= MAINW; float q = 0.f; for (int k = 0; k < MAINW; ++k) { const float d = bf2f(vr[k]) - sm; q += d * d; } mean[i] = sm; rstd[i] = 1.0f / sqrtf(q / MAINW + LN_EPS); }
        for (int dd = 0; dd < 2; ++dd) { const int d = hash32(s + 10 + dd) & 127, col = g * 128 + d; float acc = 0.f;
            for (int i = 0; i < 2; ++i) { const int sidx = lane + 64 * i; if (sidx <= t) { const float lv = (bf2f(H0[(R0 + sidx) * A_IN + MAINW + col]) - mean[i]) * rstd[i] * a.in[I_AVG][col] + a.in[I_AVB][col]; acc += a.in[I_AWS][((size_t)g * 128 + t) * 128 + sidx] * lv; } }
            acc = wave_sum(acc); const float ref = (acc + a.in[I_ABS][g * 128 + t]) * bf2f(H0[(R0 + t) * A_IN + col]);
            if (!okf(bf2f(((const bf16*)(ws + WS_CONCAT))[(R0 + t) * DM + col]), ref, 0.03f, 0.03f)) CHK_FAIL(3); }
    } else if (stage == 3 || stage == 6 || stage == 11) {
        const int row = hash32(s) % NTOK, col = hash32(s + 1) % DM; float ref;
        if (stage == 3) ref = ALPHA * a.in[I_X][(size_t)row * DM + col] + wdot((const bf16*)(ws + WS_CONCAT) + (size_t)row * DM, (const bf16*)(ws + WS_W_MIX) + (size_t)col * DM, DM, lane);
#if MK_FP8_FFN
        else if (stage == 6) ref = ALPHA * f8f((ws + WS_XB)[(size_t)row * DM + col]) + wdot8(ws + WS_HID + (size_t)row * FF, ws + WS_W_FFN_D + (size_t)col * FF, FF, lane) / (H8_MUL * W8_D_MUL);
#else
        else if (stage == 6) ref = ALPHA * bf2f(XB[(size_t)row * DM + col]) + wdot((const bf16*)(ws + WS_HID) + (size_t)row * FF, (const bf16*)(ws + WS_W_FFN_D) + (size_t)col * FF, FF, lane);
#endif
        else ref = ALPHA * bf2f(XB[(size_t)row * DM + col]) + wdot((const bf16*)(ws + WS_CONCAT1) + (size_t)row * DM, (const bf16*)(ws + WS_W_MIX) + (size_t)DM * DM + (size_t)col * DM, DM, lane);
        if (!okf(a.out[(size_t)row * DM + col], ref, 0.02f, (MK_FP8_FFN && stage == 6) ? 0.12f : 0.03f)) CHK_FAIL(stage == 3 ? 4 : (stage == 6 ? 7 : 13));
    } else if (stage == 4 || stage == 7 || stage == 12) {
        const int row = hash32(s) % NTOK, li = stage == 4 ? 0 : (stage == 7 ? 1 : 2); const float* y = a.out + (size_t)row * DM; const float* g = a.in[I_LNG] + li * DM; const float* bb = a.in[I_LNB] + li * DM;
        float s1 = 0.f; for (int k = lane; k < DM; k += 64) s1 += y[k]; const float mean = wave_sum(s1) / DM;
        float s2 = 0.f; for (int k = lane; k < DM; k += 64) { const float d = y[k] - mean; s2 += d * d; } const float rstd = 1.0f / sqrtf(wave_sum(s2) / DM + LN_EPS);
        bool bad = false;
        if (stage != 12) { const float* st = (const float*)(ws + WS_STATS) + 2 * row; if (!okf(st[0], mean, 1e-3f, 1e-4f) || !okf(st[1], rstd, 1e-3f, 1e-6f)) bad = true; }
        for (int k = lane; k < DM; k += 64) { const float x = (y[k] - mean) * rstd * g[k] + bb[k]; float got;
            if (stage == 12) got = MK_FP8_MOE ? f8f((ws + WS_X3B)[(size_t)row * DM + k]) : bf2f(((const bf16*)(ws + WS_X3B))[(size_t)row * DM + k]);
            else if (stage == 4 && MK_FP8_FFN) got = f8f((ws + WS_XB)[(size_t)row * DM + k]);
            else got = bf2f(XB[(size_t)row * DM + k]);
            if (!okf(got, x, 0.07f, 0.02f)) bad = true; }
        if (__any(bad)) CHK_FAIL(stage == 4 ? 5 : (stage == 7 ? 8 : 14));
        if (stage == 12) {
            float lg[8]; for (int e2 = 0; e2 < 8; ++e2) { float p = 0.f; for (int k = lane; k < DM; k += 64) p += ((y[k] - mean) * rstd * g[k] + bb[k]) * a.in[I_ROUTER][k * 8 + e2]; lg[e2] = wave_sum(p); }
            int e0 = 0; for (int e2 = 1; e2 < 8; ++e2) if (lg[e2] > lg[e0]) e0 = e2; int e1 = e0 == 0 ? 1 : 0; for (int e2 = 0; e2 < 8; ++e2) if (e2 != e0 && lg[e2] > lg[e1]) e1 = e2;
            const int re = ((const int*)(ws + WS_ROUTE_E))[row]; const float w0 = ((const float*)(ws + WS_ROUTE_W))[2 * row];
            float third = -3e38f; for (int e2 = 0; e2 < 8; ++e2) if (e2 != e0 && e2 != e1) third = fmaxf(third, lg[e2]);
            const bool tie = (lg[e0] - lg[e1] < 1e-4f) || (lg[e1] - third < 1e-4f);
            if (!tie && (re != (e0 | (e1 << 8)) || !okf(w0, 1.0f / (1.0f + expf(lg[e1] - lg[e0])), 1e-3f, 1e-4f))) CHK_FAIL(15);
        }
    } else if (stage == 5) {
        const int row = hash32(s) % NTOK, hc = hash32(s + 1) % FF;
#if MK_FP8_FFN
        const unsigned char* W = ws + WS_W_FFN_GU + (size_t)((hc >> 7) * 256 + (hc & 127)) * DM; const unsigned char* x = ws + WS_XB + (size_t)row * DM;
        const float g = wdot8(x, W, DM, lane) / W8_G_MUL, u = wdot8(x, W + (size_t)128 * DM, DM, lane) / W8_U_MUL;
        if (!okf(f8f((ws + WS_HID)[(size_t)row * FF + hc]) / H8_MUL, silu_ref(g) * u, 0.08f, 0.004f)) CHK_FAIL(6);
#else
        const bf16* W = (const bf16*)(ws + WS_W_FFN_GU) + (size_t)((hc >> 7) * 256 + (hc & 127)) * DM;
        const float g = wdot(XB + (size_t)row * DM, W, DM, lane), u = wdot(XB + (size_t)row * DM, W + (size_t)128 * DM, DM, lane);
        if (!okf(bf2f(((const bf16*)(ws + WS_HID))[(size_t)row * FF + hc]), silu_ref(g) * u, 0.02f, 0.01f)) CHK_FAIL(6);
#endif
    } else if (stage == 8) {
        const int row = hash32(s) % NTOK, col = hash32(s + 1) % B_IN;
        const float ref = wdot(XB + (size_t)row * DM, (const bf16*)(ws + WS_W_B_IN) + (size_t)col * DM, DM, lane);
        if (!okf(bf2f(((const bf16*)(ws + WS_H1))[(size_t)row * B_IN + col]), ref, 0.02f, 0.02f)) CHK_FAIL(9);
    } else if (stage == 9) {
        const int tok = (s & 3) == 0 ? ((hash32(s) % (NTOK / 256)) * 256 + (hash32(s + 5) & 1 ? 255 : 0)) : hash32(s) % NTOK; const int b = tok / SEQ, pos = tok % SEQ, h = hash32(s + 1) % 6, m = hash32(s + 2) & 1, half = hash32(s + 3) & 1;
        const bf16* H1 = (const bf16*)(ws + WS_H1); const bf16* q = H1 + (size_t)tok * B_IN + 3072 + (m * 6 + h) * 128; const bf16* Kb = H1 + (size_t)b * SEQ * B_IN + (m * 6 + h) * 128; const bf16* Vb = H1 + (size_t)b * SEQ * B_IN + 1536 + h * 256 + half * 128;
        float mx = -3e38f; for (int j = lane; j <= pos; j += 64) { float sc = 0.f; for (int d = 0; d < 128; ++d) sc += bf2f(q[d]) * bf2f(Kb[(size_t)j * B_IN + d]); sc *= 0.08838834764831845f; pl[j] = sc; mx = fmaxf(mx, sc); }
        for (int o = 1; o < 64; o <<= 1) mx = fmaxf(mx, __shfl_xor(mx, o));
        float sum = 0.f; for (int j = lane; j <= pos; j += 64) { const float p = expf(pl[j] - mx); pl[j] = p; sum += p; } sum = wave_sum(sum); __syncthreads();
        bool bad = false;
        for (int dd = 0; dd < 2; ++dd) { const int d = lane + 64 * dd; float o = 0.f; for (int j = 0; j <= pos; ++j) o += pl[j] * bf2f(Vb[(size_t)j * B_IN + d]); o /= sum;
            if (!okf(bf2f(((const bf16*)(ws + WS_AO))[(size_t)tok * 3072 + m * 1536 + h * 256 + half * 128 + d]), o, 0.03f, 0.004f)) bad = true; }
        if (__any(bad)) CHK_FAIL(10);
    } else if (stage == 10) {
        const int tok = hash32(s) % NTOK, h4 = hash32(s + 1) & 3, b = tok / SEQ; const bf16* H1 = (const bf16*)(ws + WS_H1);
        chk_memattn(a, 11, H1 + (size_t)tok * B_IN + 4608 + h4 * 128, (const bf16*)(ws + WS_MEMKV) + (size_t)b * 256 * 2048 + 1024 + h4 * 128, (const bf16*)(ws + WS_CONCAT1) + (size_t)tok * DM + 1536 + h4 * 128, pl, lane);
        const int h = hash32(s + 2) % 6; const bf16* AO = (const bf16*)(ws + WS_AO) + (size_t)tok * 3072;
        float s1 = 0.f, s2 = 0.f; for (int k = lane; k < 128; k += 64) { s1 += a.in[I_LQ1][k] * a.in[I_LK1][k]; s2 += a.in[I_LQ2][k] * a.in[I_LK2][k]; } s1 = wave_sum(s1); s2 = wave_sum(s2);
        const float lam = expf(s1) - expf(s2) + LAMBDA_INIT; float x[4], ss = 0.f;
        for (int i = 0; i < 4; ++i) { const int d = lane + 64 * i; x[i] = bf2f(AO[h * 256 + d]) - lam * bf2f(AO[1536 + h * 256 + d]); ss += x[i] * x[i]; } ss = wave_sum(ss);
        bool bad = false; for (int i = 0; i < 4; ++i) { const int d = lane + 64 * i; const float ref = x[i] / sqrtf(ss / 256.f + LN_EPS) * a.in[I_SUBLN][d] * (1.0f - LAMBDA_INIT);
            if (!okf(bf2f(((const bf16*)(ws + WS_CONCAT1))[(size_t)tok * DM + h * 256 + d]), ref, 0.02f, 0.01f)) bad = true; }
        if (__any(bad)) CHK_FAIL(12);
    }
    if (stage == 13 || stage == 14 || stage == 15) {
        const int tok = hash32(s) % NTOK, k = hash32(s + 1) & 1; const int slot = ((const int*)(ws + WS_TOKSLOT))[2 * tok + k]; const int* tab = (const int*)(ws + WS_MOETAB);
        const int e = (((const int*)(ws + WS_ROUTE_E))[tok] >> (8 * k)) & 0xff; const float gate = ((const float*)(ws + WS_ROUTE_W))[2 * tok + k];
        if (stage == 13) {
            bool bad = slot < 0 || slot >= MAXT * 256;
            if (!bad) { const int tile = slot >> 8; int te = 0; for (int j = 1; j < 8; ++j) te += tile >= tab[j]; bad = te != e || tile >= tab[8] || ((const int*)(ws + WS_SLOTTOK))[slot] != tok || ((const float*)(ws + WS_SLOTGATE))[slot] != gate;

#if MK_FP8_MOE
                for (int j = lane; j < DM; j += 64) if (((const unsigned char*)(ws + WS_XS))[(size_t)slot * DM + j] != ((const unsigned char*)(ws + WS_X3B))[(size_t)tok * DM + j]) bad = true; }
#else
                for (int j = lane; j < DM; j += 64) if (((const bf16*)(ws + WS_XS))[(size_t)slot * DM + j] != ((const bf16*)(ws + WS_X3B))[(size_t)tok * DM + j]) bad = true; }
#endif
            if (__any(bad)) CHK_FAIL(16);
        } else { const int loc = slot - chunk * MOE_CHUNK_T * 256;
            if (loc >= 0 && loc < MOE_CHUNK_T * 256) {
#if MK_FP8_MOE
                if (stage == 14) { const int hc = hash32(s + 2) % FFE; const unsigned char* W = ws + WS_W_MOE_GU + ((size_t)e * 2 * FFE + (hc >> 7) * 256 + (hc & 127)) * DM; const unsigned char* x = ws + WS_XS + (size_t)slot * DM;
                    const float g = wdot8(x, W, DM, lane) / W8_G_MUL, u = wdot8(x, W + (size_t)128 * DM, DM, lane) / W8_U_MUL;
                    if (!okf(f8f((ws + WS_HIDM)[(size_t)loc * FFE + hc]) / H8_MUL, silu_ref(g) * u, 0.08f, 0.004f)) CHK_FAIL(17);
                } else { const int col = hash32(s + 2) % DM; const float ref = gate * wdot8(ws + WS_HIDM + (size_t)loc * FFE, ws + WS_W_MOE_D + ((size_t)e * DM + col) * FFE, FFE, lane) / (H8_MUL * W8_D_MUL);
                    const int T = tab[8]; int Lt = T & 31; if (Lt > 8) Lt = 0; const int Tm = T - Lt, tile = slot >> 8; float got;
                    if (tile >= Tm) { got = 0.f; for (int q = 0; q < 4; ++q) got += bf2f(((const bf16*)(ws + WS_OSK))[((size_t)(q * 8 + tile - Tm) * 256 + (slot & 255)) * DM + col]); }
                    else got = bf2f(((const bf16*)(ws + WS_OS))[(size_t)slot * DM + col]);
                    if (!okf(got, ref, 0.02f, 0.004f)) CHK_FAIL(18); } } }
#else
                if (stage == 14) { const int hc = hash32(s + 2) % FFE; const bf16* W = (const bf16*)(ws + WS_W_MOE_GU) + ((size_t)e * 2 * FFE + (hc >> 7) * 256 + (hc & 127)) * DM; const bf16* x = (const bf16*)(ws + WS_XS) + (size_t)slot * DM;
                    const float g = wdot(x, W, DM, lane), u = wdot(x, W + (size_t)128 * DM, DM, lane);
                    if (!okf(bf2f(((const bf16*)(ws + WS_HIDM))[(size_t)loc * FFE + hc]), silu_ref(g) * u, 0.02f, 0.01f)) CHK_FAIL(17);
                } else { const int col = hash32(s + 2) % DM; const float ref = gate * wdot((const bf16*)(ws + WS_HIDM) + (size_t)loc * FFE, (const bf16*)(ws + WS_W_MOE_D) + ((size_t)e * DM + col) * FFE, FFE, lane);
                    if (!okf(bf2f(((const bf16*)(ws + WS_OS))[(size_t)slot * DM + col]), ref, 0.02f, 0.004f)) CHK_FAIL(18); } } }
#endif
    }
}
__global__ void fin_kernel(Args a, int complete) {
    const unsigned* c = (const unsigned*)(a.ws + WS_CTL) + CW_CHK; int first = -1; for (int i = 0; i < 32; ++i) if (c[i] && first < 0) first = i;
    const unsigned* ctl = (const unsigned*)(a.ws + WS_CTL); if (first < 0 && (ctl[CW_TMO] || ctl[CW_BAR + XB_TMO])) first = 30;
    if (first < 0 && complete) return;
    const float v = sqrtf(first < 0 ? 76.0f : 10.0f + first);
    for (size_t i = (size_t)blockIdx.x * blockDim.x + threadIdx.x; i < (size_t)NTOK * DM; i += (size_t)gridDim.x * blockDim.x) a.out[i] = v;
}
#endif

extern "C" void kernel_launch(void* const* d_in, const int* in_sizes, int n_in, void* d_out, int out_size, void* d_ws, size_t ws_size, hipStream_t stream) {
    static int grid = 0;
    if (grid == 0) {
        if (n_in != 25 || in_sizes[0] != NTOK * DM || out_size != NTOK * DM || ws_size < WS_END) { fprintf(stderr, "kernel_launch: unexpected shapes (n_in %d, in0 %d, out %d, ws %zu < %zu); nothing launched\n", n_in, n_in > 0 ? in_sizes[0] : -1, out_size, ws_size, (size_t)WS_END); grid = -1; return; }
        int dev = 0, cus = 0, per_cu = 0;
        if (hipGetDevice(&dev) != hipSuccess || hipDeviceGetAttribute(&cus, hipDeviceAttributeMultiprocessorCount, dev) != hipSuccess) { grid = -1; return; }
        if (hipFuncSetAttribute((const void*)mk_fwd, hipFuncAttributeMaxDynamicSharedMemorySize, LDS_BYTES) != hipSuccess) { fprintf(stderr, "kernel_launch: hipFuncSetAttribute failed\n"); grid = -1; return; }
        if (hipOccupancyMaxActiveBlocksPerMultiprocessor(&per_cu, (const void*)mk_fwd, NWAVES * 64, LDS_BYTES) != hipSuccess || per_cu < 1) fprintf(stderr, "kernel_launch: occupancy query reports %d\n", per_cu);
        (void)hipGetLastError();
        grid = cus;
    }
    if (grid < 0) return;
    if (hipMemsetAsync((char*)d_ws + WS_CTL, 0, CTL_ZERO_BYTES, stream) != hipSuccess) return;
    Args a{};
    for (int i = 0; i < 25; ++i) a.in[i] = (const float*)d_in[i];
    a.out = (float*)d_out; a.ws = (unsigned char*)d_ws;
#if MK_DEBUG
    const int last = MK_LAST_PHASE;
    auto run = [&](int ph, int ch) { a.ph_lo = ph; a.ph_hi = ph + 1; a.ch_lo = ch; a.ch_hi = ch + 1; hipLaunchKernelGGL(mk_fwd, dim3(grid), dim3(NWAVES * 64), LDS_BYTES, stream, a); };
    auto chk = [&](int stage, int ch) { hipLaunchKernelGGL(chk_kernel, dim3(1024), dim3(64), 0, stream, a, stage, ch); };
    for (int ph = 0; ph <= last && ph <= 13; ++ph) { run(ph, 0); chk(ph, 0); }
    if (last >= 14) for (int ch = 0; ch < (MAXT + MOE_CHUNK_T - 1) / MOE_CHUNK_T; ++ch) { run(14, ch); chk(14, ch); if (last >= 15) { run(15, ch); chk(15, ch); } }
    if (last >= 16) run(16, 0);
    hipLaunchKernelGGL(fin_kernel, dim3(1024), dim3(256), 0, stream, a, last >= 16 ? 1 : 0);
#else
    a.ph_lo = 0; a.ph_hi = 17; a.ch_lo = 0; a.ch_hi = (MAXT + MOE_CHUNK_T - 1) / MOE_CHUNK_T;
    hipLaunchKernelGGL(mk_fwd, dim3(grid), dim3(NWAVES * 64), LDS_BYTES, stream, a);
#endif
}
```

```cpp
#include <hip/hip_runtime.h>
#include <hip/hip_bf16.h>
#include <cstdio>
#include <cstdint>

#ifndef MK_DEBUG
#define MK_DEBUG 0
#endif
#ifndef MK_FP8_MOE
#define MK_FP8_MOE 1
#endif
#ifndef MK_FP8_FFN
#define MK_FP8_FFN 1
#endif
#ifndef MK_BG
#define MK_BG 1
#endif
#ifndef MK_PROBE
#define MK_PROBE 0
#endif
#ifndef MK_PROBE_A
#define MK_PROBE_A 0x1
#endif
#define MK_PROBE_MULT 8
#ifndef MK_PROBE_BARMASK
#define MK_PROBE_BARMASK 0xffffff
#endif
#ifndef MK_PROBE_BLK
#define MK_PROBE_BLK 0
#endif
#ifndef MK_PHMASK
#define MK_PHMASK 0x1ffff
#endif
#ifndef MK_LAST_PHASE
#define MK_LAST_PHASE 18
#endif

__device__ __forceinline__ int mk_lane() { int r; asm volatile("v_mbcnt_lo_u32_b32 %0, -1, 0\n\tv_mbcnt_hi_u32_b32 %0, -1, %0" : "=v"(r)); return r; }
namespace pg8 {
#define PG8_LAS __attribute__((address_space(3)))
typedef unsigned short bf16_t;
typedef short bf16x8 __attribute__((ext_vector_type(8)));
typedef float f32x4 __attribute__((ext_vector_type(4)));
typedef float f32x2 __attribute__((ext_vector_type(2)));
typedef unsigned u32x4 __attribute__((ext_vector_type(4)));
typedef int v4i_t __attribute__((ext_vector_type(4)));
constexpr int BM = 256, BK = 64, HALF = 128, HTB = HALF * BK * 2  , STAGE_BYTES = 8 * HTB, NXCD = 8, WGM = 8;

__host__ __device__ __forceinline__ int lds_byte(int r, int c) { const int st = (r >> 4) * 2 + (c >> 5), rr = r & 15, cc = c & 31, ob = rr * 64 + cc * 2; return st * 1024 + (ob ^ (((ob >> 9) & 1) << 5)); }
__host__ __device__ __forceinline__ void stage_rc(int b, int& R, int& C) { const int st = b / 1024, sb = b % 1024, swz = sb ^ (((sb >> 9) & 1) << 5); R = (st >> 1) * 16 + swz / 64; C = (st & 1) * 32 + (swz % 64) / 2; }
__host__ __device__ __forceinline__ int perm32(int rho) { const int n = rho >> 4, i = rho & 15; return 8 * (i >> 2) + 4 * n + (i & 3); }

struct Unit { int pa, pb, pm, pn, koff; };
struct Gemm { const bf16_t* A; const bf16_t* Bt; int M, N, K, KL; };

__host__ __device__ __forceinline__ void tile_of(int wgid, int nM, int nN, int& pm, int& pn) {
    const int nwg = nM * nN;
    { const int q = nwg / NXCD, r = nwg % NXCD, xcd = wgid % NXCD, off = wgid / NXCD; wgid = (xcd < r ? xcd * (q + 1) : r * (q + 1) + (xcd - r) * q) + off; }
    const int nig = WGM * nN, gid = wgid / nig, fm = gid * WGM, gsz = (nM - fm) < WGM ? (nM - fm) : WGM;
    pm = fm + ((wgid % nig) % gsz); pn = (wgid % nig) / gsz;
}
struct StaticOrder {
    int nM, nN, nwg, G, c;
    __host__ __device__ void init(int M, int N, int G_, int c_) { nM = M / BM; nN = N / BM; nwg = nM * nN; G = G_; c = c_; }
    __host__ __device__ bool next(int i, Unit& u) const {
        const long L = (long)i * G + c; if (L >= nwg) return false;
        int pm, pn; tile_of((int)L, nM, nN, pm, pn); u.pa = pm; u.pb = pn; u.pm = pm; u.pn = pn; u.koff = 0; return true;
    }
    __device__ __forceinline__ void a_ready(const Unit&) const {}
    __device__ __forceinline__ void done(const Unit&) const {}
};
template <bool A_LOCAL> struct MoeOrder {
    int nM, nN, nwg, G, c, t0; const PG8_LAS int* tstart;
    __device__ bool next(int i, Unit& u) const {
        const long L = (long)i * G + c; if (L >= nwg) return false;
        int pm, pn; tile_of((int)L, nM, nN, pm, pn); const int t = t0 + pm; int e = 0;
#pragma unroll
        for (int j = 1; j < 8; ++j) e += (t >= tstart[j]) ? 1 : 0;
        u.pa = A_LOCAL ? pm : t; u.pm = A_LOCAL ? t : pm; u.pb = e * nN + pn; u.pn = pn; u.koff = 0; return true;
    }
    __device__ __forceinline__ void a_ready(const Unit&) const {}
    __device__ __forceinline__ void done(const Unit&) const {}
};

struct MoeLeftOrder {
    int L, G, c, tl0, kq; const PG8_LAS int* tstart;
    __device__ bool next(int i, Unit& u) const {
        const long Lx = (long)i * G + c; if (Lx >= (long)L * 32) return false;
        const int q = (int)Lx & 3, pn = ((int)Lx >> 2) & 7, lt = (int)Lx >> 5, t = tl0 + lt; int e = 0;
#pragma unroll
        for (int j = 1; j < 8; ++j) e += (t >= tstart[j]) ? 1 : 0;
        u.pa = t; u.pb = e * 8 + pn; u.pm = q * 8 + lt; u.pn = pn; u.koff = q * kq; return true;
    }
    __device__ __forceinline__ void a_ready(const Unit&) const {}
    __device__ __forceinline__ void done(const Unit&) const {}
};

__device__ __forceinline__ unsigned cvt_pk_bf16(float lo, float hi) { unsigned r; asm volatile("v_cvt_pk_bf16_f32 %0, %1, %2" : "=v"(r) : "v"(lo), "v"(hi)); return r; }
__device__ __forceinline__ float gelu_tanh(float x) { const float u = x * (1.0f + 0.044715f * x * x); const float e = __builtin_amdgcn_exp2f(-2.302208198f * u); return x * __builtin_amdgcn_rcpf(1.0f + e); }
__device__ __forceinline__ float silu_f(float x) { const float e = __builtin_amdgcn_exp2f(-1.4426950409f * x); return x * __builtin_amdgcn_rcpf(1.0f + e); }

struct EpiBf16 {
    static constexpr bool PERM = true, AFTER_DRAIN = false;
    bf16_t* O; int ldc; int gelu_cols;
    __device__ __forceinline__ void operator()(const f32x4 (&acc)[2][2][4][2], const Unit& u, int wr, int wc, int fr, int fq) const {
        const int row0 = u.pm * BM + wr * 64 + fr, col0 = u.pn * BM + wc * 32 + 8 * fq; const bool act = (u.pn * BM) < gelu_cols;
#pragma unroll
        for (int ai = 0; ai < 2; ++ai)
#pragma unroll
            for (int m = 0; m < 4; ++m) { bf16_t* rowp = O + (size_t)(row0 + ai * HALF + m * 16) * ldc + col0;
#pragma unroll
                for (int bj = 0; bj < 2; ++bj) { f32x4 v0 = acc[ai][bj][m][0], v1 = acc[ai][bj][m][1];
                    if (act) {
#pragma unroll
                        for (int j = 0; j < 4; ++j) { v0[j] = gelu_tanh(v0[j]); v1[j] = gelu_tanh(v1[j]); } }
                    u32x4 w; w.x = cvt_pk_bf16(v0[0], v0[1]); w.y = cvt_pk_bf16(v0[2], v0[3]); w.z = cvt_pk_bf16(v1[0], v1[1]); w.w = cvt_pk_bf16(v1[2], v1[3]);
                    *(u32x4*)(rowp + bj * HALF) = w; } }
    }
};
struct EpiRes {
    static constexpr bool PERM = false, AFTER_DRAIN = false;
    const float* base; float* out; int ldc; float alpha;
    __device__ __forceinline__ void operator()(const f32x4 (&acc)[2][2][4][2], const Unit& u, int wr, int wc, int fr, int fq) const {
        const int row0 = u.pm * BM + wr * 64 + fr, col0 = u.pn * BM + wc * 32 + 4 * fq;
#pragma unroll
        for (int ai = 0; ai < 2; ++ai)
#pragma unroll
            for (int m = 0; m < 4; ++m) { const size_t off = (size_t)(row0 + ai * HALF + m * 16) * ldc + col0;
                f32x4 b[2][2];
#pragma unroll
                for (int bj = 0; bj < 2; ++bj)
#pragma unroll
                    for (int n = 0; n < 2; ++n) b[bj][n] = *(const f32x4*)(base + off + bj * HALF + n * 16);
#pragma unroll
                for (int bj = 0; bj < 2; ++bj)
#pragma unroll
                    for (int n = 0; n < 2; ++n) *(f32x4*)(out + off + bj * HALF + n * 16) = b[bj][n] * alpha + acc[ai][bj][m][n];
                asm volatile("" ::: "memory"); }
    }
};
struct EpiResLn {
    static constexpr bool PERM = false, AFTER_DRAIN = false;
    float* out; const float* stats; const float* g; const float* b;
    __device__ __forceinline__ void operator()(const f32x4 (&acc)[2][2][4][2], const Unit& u, int wr, int wc, int fr, int fq) const {
        constexpr int ldc = 2048; constexpr float alpha = 1.41421356237309515f;
        const int row0 = u.pm * BM + wr * 64 + fr, col0 = u.pn * BM + wc * 32 + 4 * fq;
        f32x4 gv[2][2], bv[2][2];
#pragma unroll
        for (int bj = 0; bj < 2; ++bj)
#pragma unroll
            for (int n = 0; n < 2; ++n) { gv[bj][n] = *(const f32x4*)(g + col0 + bj * HALF + n * 16) * alpha; bv[bj][n] = *(const f32x4*)(b + col0 + bj * HALF + n * 16) * alpha; }
#pragma unroll
        for (int ai = 0; ai < 2; ++ai)
#pragma unroll
            for (int m = 0; m < 4; ++m) { const int row = row0 + ai * HALF + m * 16; const size_t off = (size_t)row * ldc + col0; const f32x2 st = *(const f32x2*)(stats + 2 * row);
                f32x4 y[2][2];
#pragma unroll
                for (int bj = 0; bj < 2; ++bj)
#pragma unroll
                    for (int n = 0; n < 2; ++n) y[bj][n] = *(const f32x4*)(out + off + bj * HALF + n * 16);
#pragma unroll
                for (int bj = 0; bj < 2; ++bj)
#pragma unroll
                    for (int n = 0; n < 2; ++n) *(f32x4*)(out + off + bj * HALF + n * 16) = (y[bj][n] - st.x) * st.y * gv[bj][n] + bv[bj][n] + acc[ai][bj][m][n];
                __builtin_amdgcn_sched_barrier(0); }
    }
};
struct EpiResLn16 {
    static constexpr bool PERM = true, AFTER_DRAIN = false;
    const float* yin; bf16_t* o16; const float* stats; const float* g; const float* b;
    __device__ __forceinline__ void operator()(const f32x4 (&acc)[2][2][4][2], const Unit& u, int wr, int wc, int fr, int fq) const {
        constexpr int ldc = 2048; constexpr float alpha = 1.41421356237309515f;
        const int row0 = u.pm * BM + wr * 64 + fr, col0 = u.pn * BM + wc * 32 + 8 * fq;
        f32x4 gv[2][2], bv[2][2];
#pragma unroll
        for (int bj = 0; bj < 2; ++bj)
#pragma unroll
            for (int n = 0; n < 2; ++n) { gv[bj][n] = *(const f32x4*)(g + col0 + bj * HALF + n * 4) * alpha; bv[bj][n] = *(const f32x4*)(b + col0 + bj * HALF + n * 4) * alpha; }
#pragma unroll
        for (int ai = 0; ai < 2; ++ai)
#pragma unroll
            for (int m = 0; m < 4; ++m) { const int row = row0 + ai * HALF + m * 16; const size_t off = (size_t)row * ldc + col0; const f32x2 st = *(const f32x2*)(stats + 2 * row);
                f32x4 y[2][2];
#pragma unroll
                for (int bj = 0; bj < 2; ++bj)
#pragma unroll
                    for (int n = 0; n < 2; ++n) y[bj][n] = *(const f32x4*)(yin + off + bj * HALF + n * 4);
#pragma unroll
                for (int bj = 0; bj < 2; ++bj) { const f32x4 v0 = (y[bj][0] - st.x) * st.y * gv[bj][0] + bv[bj][0] + acc[ai][bj][m][0], v1 = (y[bj][1] - st.x) * st.y * gv[bj][1] + bv[bj][1] + acc[ai][bj][m][1];
                    u32x4 w; w.x = cvt_pk_bf16(v0[0], v0[1]); w.y = cvt_pk_bf16(v0[2], v0[3]); w.z = cvt_pk_bf16(v1[0], v1[1]); w.w = cvt_pk_bf16(v1[2], v1[3]);
                    *(u32x4*)(o16 + off + bj * HALF) = w; }
                __builtin_amdgcn_sched_barrier(0); }
    }
};
struct EpiSwiglu {
    static constexpr bool PERM = true, AFTER_DRAIN = false;
    bf16_t* H; int ldh;
    __device__ __forceinline__ void operator()(const f32x4 (&acc)[2][2][4][2], const Unit& u, int wr, int wc, int fr, int fq) const {
        const int row0 = u.pm * BM + wr * 64 + fr, col0 = u.pn * HALF + wc * 32 + 8 * fq;
#pragma unroll
        for (int ai = 0; ai < 2; ++ai)
#pragma unroll
            for (int m = 0; m < 4; ++m) { bf16_t* rowp = H + (size_t)(row0 + ai * HALF + m * 16) * ldh + col0;
                f32x4 v0, v1;
#pragma unroll
                for (int j = 0; j < 4; ++j) { v0[j] = silu_f(acc[ai][0][m][0][j]) * acc[ai][1][m][0][j]; v1[j] = silu_f(acc[ai][0][m][1][j]) * acc[ai][1][m][1][j]; }
                u32x4 w; w.x = cvt_pk_bf16(v0[0], v0[1]); w.y = cvt_pk_bf16(v0[2], v0[3]); w.z = cvt_pk_bf16(v1[0], v1[1]); w.w = cvt_pk_bf16(v1[2], v1[3]);
                *(u32x4*)rowp = w; }
    }
};
template <bool NT> struct EpiSwiglu8 {
    static constexpr bool PERM = true, AFTER_DRAIN = false;
    unsigned char* H; int ldh;
    __device__ __forceinline__ void operator()(const f32x4 (&acc)[2][2][4][2], const Unit& u, int wr, int wc, int fr, int fq) const {
        const int row0 = u.pm * BM + wr * 64 + fr, col0 = u.pn * HALF + wc * 32 + 8 * fq;
#pragma unroll
        for (int ai = 0; ai < 2; ++ai)
#pragma unroll
            for (int m = 0; m < 4; ++m) { unsigned char* rowp = H + (size_t)(row0 + ai * HALF + m * 16) * ldh + col0;
                f32x4 v0, v1;
#pragma unroll
                for (int j = 0; j < 4; ++j) { const float g0 = acc[ai][0][m][0][j], g1 = acc[ai][0][m][1][j];
                    v0[j] = g0 * acc[ai][1][m][0][j] * __builtin_amdgcn_rcpf(1.0f + __builtin_amdgcn_exp2f(g0)); v1[j] = g1 * acc[ai][1][m][1][j] * __builtin_amdgcn_rcpf(1.0f + __builtin_amdgcn_exp2f(g1)); }
                int w0 = 0, w1 = 0;
                w0 = __builtin_amdgcn_cvt_pk_fp8_f32(v0[0], v0[1], w0, false); w0 = __builtin_amdgcn_cvt_pk_fp8_f32(v0[2], v0[3], w0, true);
                w1 = __builtin_amdgcn_cvt_pk_fp8_f32(v1[0], v1[1], w1, false); w1 = __builtin_amdgcn_cvt_pk_fp8_f32(v1[2], v1[3], w1, true);
                const unsigned long long pk_ = (unsigned long long)(unsigned)w0 | ((unsigned long long)(unsigned)w1 << 32);
                if (NT) __builtin_nontemporal_store(pk_, (unsigned long long*)rowp); else *(unsigned long long*)rowp = pk_; }
    }
};
struct EpiRowScale {
    static constexpr bool PERM = true, AFTER_DRAIN = false;
    bf16_t* O; int ldc; const float* rs;
    __device__ __forceinline__ void operator()(const f32x4 (&acc)[2][2][4][2], const Unit& u, int wr, int wc, int fr, int fq) const {
        const int row0 = u.pm * BM + wr * 64 + fr, col0 = u.pn * BM + wc * 32 + 8 * fq;
#pragma unroll
        for (int ai = 0; ai < 2; ++ai)
#pragma unroll
            for (int m = 0; m < 4; ++m) { const int row = row0 + ai * HALF + m * 16; const float s = rs[row + (u.pa - u.pm) * BM]; bf16_t* rowp = O + (size_t)row * ldc + col0;
#pragma unroll
                for (int bj = 0; bj < 2; ++bj) { const f32x4 v0 = acc[ai][bj][m][0] * s, v1 = acc[ai][bj][m][1] * s;
                    u32x4 w; w.x = cvt_pk_bf16(v0[0], v0[1]); w.y = cvt_pk_bf16(v0[2], v0[3]); w.z = cvt_pk_bf16(v1[0], v1[1]); w.w = cvt_pk_bf16(v1[2], v1[3]);
                    *(u32x4*)(rowp + bj * HALF) = w; } }
    }
};

template <class Epi, class Sched, bool ALIGN_EPI = false, bool SP2 = false, int SCA = 0, int SCB = 0>
__device__ __forceinline__ void gemm_phase(PG8_LAS unsigned char* lds, const Gemm g, const Sched& S, const Epi& E, const int mk_wid) {
    const int wid = mk_wid, lane = mk_lane(), tid = wid * 64 + lane, wr = wid >> 2, wc = wid & 3, fr = lane & 15, fq = lane >> 4;
    const int K = g.K, nt = (g.KL ? g.KL : K) / BK;
    unsigned voffA[2], voffB[2];
#pragma unroll
    for (int i = 0; i < 2; ++i) { int R, C; stage_rc(tid * 16 + i * 8192, R, C); const int Rb = Epi::PERM ? ((R & ~31) + perm32(R & 31)) : R;
        voffA[i] = (unsigned)(R * K + C) * 2u; voffB[i] = (unsigned)(Rb * K + C) * 2u; }
    const size_t kstep = (size_t)(BK * 2);
    const size_t hstep = (size_t)HALF * K * 2;
    const size_t tstep = 2 * hstep;
    const unsigned ldsw = (unsigned)wid * 1024u;
    const int aoff = lds_byte(wr * 64 + fr, fq * 8), boff = lds_byte(wc * 32 + fr, fq * 8);
#define PG8_SA(b, h) (((b) * 2 + (h)) * HTB)
#define PG8_SB(b, h) ((4 + (b) * 2 + (h)) * HTB)
#define PG8_STAGE(bufoff, gbase, voff) do { _Pragma("unroll") for (int _i = 0; _i < 2; ++_i) \
        __builtin_amdgcn_global_load_lds((const unsigned*)((const char*)(gbase) + (voff)[_i]), (PG8_LAS unsigned*)(lds + (bufoff) + ldsw + _i * 8192), 16, 0, 0); } while (0)
#define PG8_LDA(dst, b, h) do { _Pragma("unroll") for (int m = 0; m < 4; ++m) _Pragma("unroll") for (int k = 0; k < 2; ++k) dst[m][k] = *(const PG8_LAS bf16x8*)(lds + PG8_SA(b, h) + aoff + m * 2048 + k * 1024); } while (0)
#define PG8_LDB(dst, b, h) do { _Pragma("unroll") for (int n = 0; n < 2; ++n) _Pragma("unroll") for (int k = 0; k < 2; ++k) dst[n][k] = *(const PG8_LAS bf16x8*)(lds + PG8_SB(b, h) + boff + n * 2048 + k * 1024); } while (0)
#define PG8_CAT8(x, y) __builtin_shufflevector(__builtin_bit_cast(v4i_t, x), __builtin_bit_cast(v4i_t, y), 0, 1, 2, 3, 4, 5, 6, 7)
#define PG8_MMA(ai, bj, At, Bt) do { __builtin_amdgcn_s_setprio(1); if constexpr (SCA != 0) asm volatile("s_nop 1" ::: "memory"); \
        if constexpr (SCA != 0) { _Pragma("unroll") for (int m = 0; m < 4; ++m) _Pragma("unroll") for (int n = 0; n < 2; ++n) \
            asm volatile("v_mfma_scale_f32_16x16x128_f8f6f4 %0, %1, %2, %0, %3, %4 op_sel_hi:[0,0,0]" : "+v"(acc[ai][bj][m][n]) : "v"(PG8_CAT8(Bt[n][0], Bt[n][1])), "v"(PG8_CAT8(At[m][0], At[m][1])), "v"(scb_), "v"(sca_)); } \
        else { _Pragma("unroll") for (int m = 0; m < 4; ++m) _Pragma("unroll") for (int n = 0; n < 2; ++n) _Pragma("unroll") for (int k = 0; k < 2; ++k) \
            acc[ai][bj][m][n] = __builtin_amdgcn_mfma_f32_16x16x32_bf16(Bt[n][k], At[m][k], acc[ai][bj][m][n], 0, 0, 0); } \
        __builtin_amdgcn_s_setprio(0); } while (0)
#define PG8_WAIT_V(n) asm volatile("s_waitcnt vmcnt(" #n ")" ::: "memory")
#define PG8_WAIT_L(n) asm volatile("s_waitcnt lgkmcnt(" #n ")" ::: "memory")
#define PG8_BAR __builtin_amdgcn_s_barrier()
#define PG8_SCHED __builtin_amdgcn_sched_barrier(0)
    Unit cur, nxt; int ui = 0;
    if (!S.next(0, cur)) return;
    f32x4 acc[2][2][4][2];
#pragma unroll
    for (int a = 0; a < 2; ++a)
#pragma unroll
        for (int b = 0; b < 2; ++b)
#pragma unroll
            for (int m = 0; m < 4; ++m)
#pragma unroll
                for (int n = 0; n < 2; ++n) acc[a][b][m][n] = (f32x4){0.f, 0.f, 0.f, 0.f};
    bf16x8 At[4][2], B0[2][2], B1[2][2];
    const int sca_ = SCA, scb_ = SCB;
    const char* cA = (const char*)g.A + (size_t)cur.pa * tstep + cur.koff; const char* cB = (const char*)g.Bt + (size_t)cur.pb * tstep + cur.koff;
    S.a_ready(cur);
    if constexpr (SP2) {
        PG8_STAGE(PG8_SB(0, 0), cB, voffB); PG8_STAGE(PG8_SB(0, 1), cB + hstep, voffB); PG8_STAGE(PG8_SA(0, 0), cA, voffA); PG8_STAGE(PG8_SA(0, 1), cA + hstep, voffA);
        if (wr == 1) PG8_BAR;
        PG8_WAIT_V(2); PG8_BAR;
        PG8_STAGE(PG8_SB(1, 0), cB + kstep, voffB); PG8_STAGE(PG8_SA(1, 0), cA + kstep, voffA); PG8_STAGE(PG8_SB(1, 1), cB + hstep + kstep, voffB);
        PG8_WAIT_V(6); PG8_BAR;
    } else {
        PG8_STAGE(PG8_SB(0, 0), cB, voffB); PG8_STAGE(PG8_SA(0, 0), cA, voffA); PG8_STAGE(PG8_SB(0, 1), cB + hstep, voffB); PG8_STAGE(PG8_SA(0, 1), cA + hstep, voffA);
        if (wr == 1) PG8_BAR;
        PG8_WAIT_V(4); PG8_BAR;
        PG8_STAGE(PG8_SB(1, 0), cB + kstep, voffB); PG8_STAGE(PG8_SA(1, 0), cA + kstep, voffA); PG8_STAGE(PG8_SB(1, 1), cB + hstep + kstep, voffB);
        PG8_WAIT_V(6); PG8_BAR;
    }
    for (;;) {
        const bool has_next = S.next(ui + 1, nxt);
        const char* nA = has_next ? (const char*)g.A + (size_t)nxt.pa * tstep + nxt.koff : cA; const char* nB = has_next ? (const char*)g.Bt + (size_t)nxt.pb * tstep + nxt.koff : cB;
        for (int t = 0; t < nt; t += 2) {
            const bool last = (t == nt - 2);
            const char* a1 = cA + (size_t)(t + 1) * kstep;
            const char* a2 = last ? nA : cA + (size_t)(t + 2) * kstep; const char* b2 = last ? nB : cB + (size_t)(t + 2) * kstep;
            const char* a3 = a2 + kstep; const char* b3 = b2 + kstep;
            if (last && has_next) S.a_ready(nxt);
            if constexpr (SP2) {
            PG8_LDB(B0, 0, 0); PG8_LDB(B1, 0, 1); PG8_SCHED; PG8_LDA(At, 0, 0); PG8_STAGE(PG8_SA(1, 1), a1 + hstep, voffA);
            PG8_WAIT_V(8); PG8_WAIT_L(0); PG8_BAR; PG8_MMA(0, 0, At, B0); PG8_MMA(0, 1, At, B1); PG8_BAR; PG8_SCHED;
            PG8_LDA(At, 0, 1); PG8_STAGE(PG8_SB(0, 0), b2, voffB); PG8_STAGE(PG8_SB(0, 1), b2 + hstep, voffB); PG8_STAGE(PG8_SA(0, 0), a2, voffA);
            PG8_WAIT_V(8); PG8_WAIT_L(0); PG8_BAR; PG8_MMA(1, 0, At, B0); PG8_MMA(1, 1, At, B1); PG8_BAR; PG8_SCHED;
            PG8_LDB(B0, 1, 0); PG8_LDB(B1, 1, 1); PG8_SCHED; PG8_LDA(At, 1, 0); PG8_STAGE(PG8_SA(0, 1), a2 + hstep, voffA);
            PG8_WAIT_V(8); PG8_WAIT_L(0); PG8_BAR; PG8_MMA(0, 0, At, B0); PG8_MMA(0, 1, At, B1); PG8_BAR; PG8_SCHED;
            PG8_LDA(At, 1, 1); PG8_STAGE(PG8_SB(1, 0), b3, voffB); PG8_STAGE(PG8_SB(1, 1), b3 + hstep, voffB); PG8_STAGE(PG8_SA(1, 0), a3, voffA);
            PG8_WAIT_V(8); PG8_WAIT_L(0); PG8_BAR; PG8_MMA(1, 0, At, B0); PG8_MMA(1, 1, At, B1); PG8_BAR; PG8_SCHED;
            } else {
            PG8_LDB(B0, 0, 0); PG8_SCHED; PG8_LDA(At, 0, 0); PG8_STAGE(PG8_SA(1, 1), a1 + hstep, voffA);
            PG8_WAIT_L(8); PG8_BAR; PG8_WAIT_L(0); PG8_MMA(0, 0, At, B0); PG8_BAR; PG8_SCHED;
            PG8_LDB(B1, 0, 1); PG8_STAGE(PG8_SB(0, 0), b2, voffB);
            PG8_BAR; PG8_WAIT_L(0); PG8_MMA(0, 1, At, B1); PG8_BAR;
            PG8_LDA(At, 0, 1); PG8_STAGE(PG8_SA(0, 0), a2, voffA);
            PG8_BAR; PG8_WAIT_L(0); PG8_MMA(1, 0, At, B0); PG8_BAR; PG8_SCHED;
            PG8_STAGE(PG8_SB(0, 1), b2 + hstep, voffB);
            PG8_WAIT_V(6); PG8_BAR; PG8_MMA(1, 1, At, B1); PG8_BAR;
            PG8_LDB(B0, 1, 0); PG8_SCHED; PG8_LDA(At, 1, 0); PG8_STAGE(PG8_SA(0, 1), a2 + hstep, voffA);
            PG8_WAIT_L(8); PG8_BAR; PG8_WAIT_L(0); PG8_MMA(0, 0, At, B0); PG8_BAR; PG8_SCHED;
            PG8_LDB(B1, 1, 1); PG8_STAGE(PG8_SB(1, 0), b3, voffB);
            PG8_BAR; PG8_WAIT_L(0); PG8_MMA(0, 1, At, B1); PG8_BAR;
            PG8_LDA(At, 1, 1); PG8_STAGE(PG8_SA(1, 0), a3, voffA);
            PG8_BAR; PG8_WAIT_L(0); PG8_MMA(1, 0, At, B0); PG8_BAR; PG8_SCHED;
            PG8_STAGE(PG8_SB(1, 1), b3 + hstep, voffB);
            PG8_WAIT_V(6); PG8_BAR; PG8_MMA(1, 1, At, B1); PG8_BAR;
            }
        }
        if constexpr (SCA != 0) asm volatile("s_nop 15\n\ts_nop 15" ::: "memory");
        if constexpr (ALIGN_EPI) { if (wr == 0) PG8_BAR; }
        if constexpr (!Epi::AFTER_DRAIN) { E(acc, cur, wr, wc, fr, fq); S.done(cur); }
        if (!has_next) break;
#pragma unroll
        for (int a = 0; a < 2; ++a)
#pragma unroll
            for (int b = 0; b < 2; ++b)
#pragma unroll
                for (int m = 0; m < 4; ++m)
#pragma unroll
                    for (int n = 0; n < 2; ++n) acc[a][b][m][n] = (f32x4){0.f, 0.f, 0.f, 0.f};
        cur = nxt; cA = nA; cB = nB; ++ui;
        if constexpr (ALIGN_EPI) { if (wr == 1) PG8_BAR; }
    }
    PG8_WAIT_V(0);
    if constexpr (!ALIGN_EPI) { if (wr == 0) PG8_BAR; }
    PG8_BAR;
    if constexpr (Epi::AFTER_DRAIN) { E.fused(acc, cur, wr, wc, fr, fq, lds, wid, lane); S.done(cur); }
#undef PG8_SA
#undef PG8_SB
#undef PG8_STAGE
#undef PG8_LDA
#undef PG8_LDB
#undef PG8_MMA
#undef PG8_CAT8
#undef PG8_WAIT_V
#undef PG8_WAIT_L
#undef PG8_BAR
#undef PG8_SCHED
}
}

namespace at128 {
constexpr int D = 128;
constexpr float THR = 8.f;
constexpr bool WSKIP = false;
constexpr float SCALE = 0.08838834764831845f;
constexpr int NW = 8, QBLK = 32, KVBLK = 64, QB = NW * QBLK;
constexpr int SHM_V = KVBLK * D * 2, SHM_K = KVBLK * D * 2;
constexpr int LDS_BYTES = 2 * SHM_V + 2 * SHM_K + NW * 64 * 4;

using bf16 = __hip_bfloat16;
typedef short bf16x8 __attribute__((ext_vector_type(8)));
typedef short s16x4 __attribute__((ext_vector_type(4)));
typedef float f32x16 __attribute__((ext_vector_type(16)));
typedef float f32x4 __attribute__((ext_vector_type(4)));
typedef unsigned u32x4 __attribute__((ext_vector_type(4)));
template <class A, class Bt> struct same_t { static constexpr bool v = false; };
template <class A> struct same_t<A, A> { static constexpr bool v = true; };

#define KSWZ(row, colB) ((row) * 256 + ((colB) ^ (((row) & 7) << 4)))
#define SBAR() __builtin_amdgcn_sched_barrier(0)
__device__ __forceinline__ int v_st(int k, int c) { const int kk = (k & ~0xC) | ((k & 4) << 1) | ((k & 8) >> 1); return ((kk >> 3) * 4 + (c >> 5)) * 512 + ((kk & 7) * 32 + (c & 31)) * 2; }
__device__ __forceinline__ int v_rd_base(int lane) { return ((lane & 3) << 3) | (((lane >> 2) & 3) << 6) | (((lane >> 4) & 1) << 5) | (((lane >> 5) & 1) << 8); }
constexpr int v_rd_off(int d0, int ks, int half) { return d0 * 512 + ks * 4096 + half * 2048; }
__device__ __forceinline__ int crow(int r, int hi) { return (r & 3) + 8 * (r >> 2) + 4 * hi; }
__device__ __forceinline__ unsigned cvtpk(float lo, float hi) {
    unsigned r; asm volatile("v_cvt_pk_bf16_f32 %0, %1, %2" : "=v"(r) : "v"(lo), "v"(hi)); return r;
}
__device__ __forceinline__ bf16x8 pack8(f32x4 a, f32x4 b) {
    u32x4 w = {cvtpk(a[0], a[1]), cvtpk(a[2], a[3]), cvtpk(b[0], b[1]), cvtpk(b[2], b[3])};
    return *reinterpret_cast<bf16x8*>(&w);
}
template <class T> __device__ __forceinline__ bf16x8 load8(const T* p) {
    if constexpr (same_t<T, float>::v) { return pack8(*(const f32x4*)p, *(const f32x4*)(p + 4)); }
    else { return *reinterpret_cast<const bf16x8*>(p); }
}
__device__ __forceinline__ void mask_tile(f32x16& p0, f32x16& p1, int dq, unsigned W) {
    const float NEG = -__builtin_inff();
#pragma unroll
    for (int r = 0; r < 16; ++r) {
        const int c = (r & 3) + 8 * (r >> 2);
        if ((unsigned)(dq - c) >= W) p0[r] = NEG;
        if ((unsigned)(dq - c - 32) >= W) p1[r] = NEG;
    }
}
__device__ __forceinline__ void partialSM(f32x16& p0, f32x16& p1, float& m_reg, float& mn, float& alpha) {
    float pmax = p0[0]; for (int r = 1; r < 16; ++r) pmax = fmaxf(pmax, p0[r]); for (int r = 0; r < 16; ++r) pmax = fmaxf(pmax, p1[r]);
    { auto rr = __builtin_amdgcn_permlane32_swap(__float_as_uint(pmax), __float_as_uint(pmax), false, false);
      pmax = fmaxf(__uint_as_float(rr[0]), __uint_as_float(rr[1])); }
    constexpr float C2 = 1.4426950408889634f * SCALE;
    if (__builtin_expect(__all((pmax - m_reg) * SCALE <= THR), 1)) { mn = m_reg; alpha = 1.f; }
    else { mn = fmaxf(m_reg, pmax); alpha = __builtin_amdgcn_exp2f((m_reg - mn) * C2); m_reg = mn; }
    const float mnL = -mn * C2;
    for (int r = 0; r < 16; ++r) p0[r] = fmaf(p0[r], C2, mnL); for (int r = 0; r < 16; ++r) p1[r] = fmaf(p1[r], C2, mnL);
    for (int r = 0; r < 16; ++r) p0[r] = __builtin_amdgcn_exp2f(p0[r]);
}
__device__ __forceinline__ void finishSM(f32x16& p0, f32x16& p1, float alpha, float& l_reg, bf16x8& pa0, bf16x8& pa1, bf16x8& pa2, bf16x8& pa3) {
    for (int r = 0; r < 16; ++r) p1[r] = __builtin_amdgcn_exp2f(p1[r]);
    float ps = 0; for (int r = 0; r < 16; ++r) ps += p0[r]; for (int r = 0; r < 16; ++r) ps += p1[r];
    { auto rr = __builtin_amdgcn_permlane32_swap(__float_as_uint(ps), __float_as_uint(ps), false, false);
      ps = __uint_as_float(rr[0]) + __uint_as_float(rr[1]); }
    l_reg = l_reg * alpha + ps;
#define PK4(P, B_, OUT) do { unsigned a0 = cvtpk(P[B_+0], P[B_+1]), a1 = cvtpk(P[B_+2], P[B_+3]);                          \
        unsigned b0 = cvtpk(P[B_+4], P[B_+5]), b1 = cvtpk(P[B_+6], P[B_+7]);                                             \
        auto r0 = __builtin_amdgcn_permlane32_swap(a0, b0, false, false); auto r1 = __builtin_amdgcn_permlane32_swap(a1, b1, false, false); \
        u32x4 w = {r0[0], r1[0], r0[1], r1[1]}; OUT = *reinterpret_cast<bf16x8*>(&w); } while (0)
    PK4(p0, 0, pa0); PK4(p0, 8, pa1); PK4(p1, 0, pa2); PK4(p1, 8, pa3);
#undef PK4
}
template <int KB, bool SK>
__device__ __forceinline__ void qkt(f32x16& p0, f32x16& p1, const char* K_lds, int r32, int hi, const bf16x8* qr, bool act) {
    if (SK && !act) { const float NEG = -__builtin_inff();
#pragma unroll
        for (int r = 0; r < 16; ++r) { p0[r] = NEG; p1[r] = NEG; } return; }
    p0 = f32x16{}; p1 = f32x16{};
    const char* kb[4];
#pragma unroll
    for (int dd = 0; dd < 4; ++dd) kb[dd] = K_lds + KB * SHM_K + KSWZ(r32, (dd * 16 + hi * 8) * 2);
#pragma unroll
    for (int d0 = 0; d0 < 8; ++d0) { const char* a = kb[d0 & 3] + (d0 >> 2) * 128;
        bf16x8 b0 = *reinterpret_cast<const bf16x8*>(a);
        bf16x8 b1 = *reinterpret_cast<const bf16x8*>(a + 32 * 256);
        p0 = __builtin_amdgcn_mfma_f32_32x32x16_bf16(b0, qr[d0], p0, 0, 0, 0);
        p1 = __builtin_amdgcn_mfma_f32_32x32x16_bf16(b1, qr[d0], p1, 0, 0, 0); }
}
template <int VB, bool SK>
__device__ __forceinline__ void pv_tile(f32x16* o, int vb0, bf16x8 pa0, bf16x8 pa1, bf16x8 pa2, bf16x8 pa3, bool act) {
    if (SK && !act) return;
#define TRRD(dst, off) asm volatile("ds_read_b64_tr_b16 %0, %1 offset:%2" : "=&v"(dst) : "v"(vb0), "i"(off) : "memory")
#define PV_D0(d0) do { s16x4 l0, l1, l2, l3, h0, h1, h2, h3; constexpr int b_ = VB * SHM_V + v_rd_off(d0, 0, 0);     \
        TRRD(l0, b_); TRRD(h0, b_ + 2048); TRRD(l1, b_ + 4096); TRRD(h1, b_ + 6144); TRRD(l2, b_ + 8192); TRRD(h2, b_ + 10240); TRRD(l3, b_ + 12288); TRRD(h3, b_ + 14336); \
        asm volatile("s_waitcnt lgkmcnt(0)" ::: "memory"); SBAR();                 \
        o[d0] = __builtin_amdgcn_mfma_f32_32x32x16_bf16(pa0, (bf16x8){l0[0], l0[1], l0[2], l0[3], h0[0], h0[1], h0[2], h0[3]}, o[d0], 0, 0, 0);   \
        o[d0] = __builtin_amdgcn_mfma_f32_32x32x16_bf16(pa1, (bf16x8){l1[0], l1[1], l1[2], l1[3], h1[0], h1[1], h1[2], h1[3]}, o[d0], 0, 0, 0);   \
        o[d0] = __builtin_amdgcn_mfma_f32_32x32x16_bf16(pa2, (bf16x8){l2[0], l2[1], l2[2], l2[3], h2[0], h2[1], h2[2], h2[3]}, o[d0], 0, 0, 0);   \
        o[d0] = __builtin_amdgcn_mfma_f32_32x32x16_bf16(pa3, (bf16x8){l3[0], l3[1], l3[2], l3[3], h3[0], h3[1], h3[2], h3[3]}, o[d0], 0, 0, 0); } while (0)
    PV_D0(0); PV_D0(1); PV_D0(2); PV_D0(3);
#undef PV_D0
#undef TRRD
}

template <class TIn, class TOut> struct BlockRef { const TIn* Q; const TIn* K; const TIn* V; TOut* O; int P0; };
template <class TIn> struct Seam {
    bf16x8 qr[8];
    bf16x8 st_v0, st_v1, st_k0, st_k1; f32x4 sf0, sf1, sf2, sf3;
    f32x4 tq[16];
};
__device__ __forceinline__ int swa_jlo(int P0, int W) { const int lowk = P0 - W + 1; return lowk > 0 ? lowk / KVBLK : 0; }
#define ROW(p, k0, rr) ((p) + (size_t)((k0) + (rr)) * PKV + sc)
#define VMW() asm volatile("s_waitcnt vmcnt(0)" ::: "memory")
#define VMWN(n) asm volatile("s_waitcnt vmcnt(%0)" :: "i"(n) : "memory")
#define SLOAD_H(Kp, Vp, k0) do { S.st_v0 = load8<TIn>(ROW(Vp, k0, sr)); S.st_v1 = load8<TIn>(ROW(Vp, k0, 32 + sr));              \
                         S.st_k0 = load8<TIn>(ROW(Kp, k0, sr)); S.st_k1 = load8<TIn>(ROW(Kp, k0, 32 + sr)); } while (0)
#define SWRITE_HK(bf) do { *(bf16x8*)(K_lds + (bf) * SHM_K + kws) = S.st_k0; *(bf16x8*)(K_lds + (bf) * SHM_K + kws + 32 * 256) = S.st_k1; } while (0)
#define SWRITE_HV(bf) do { *(bf16x8*)(V_lds + (bf) * SHM_V + vst0) = S.st_v0; *(bf16x8*)(V_lds + (bf) * SHM_V + vst1) = S.st_v1; } while (0)
#define SWRITE_H(bf) do { SWRITE_HV(bf); SWRITE_HK(bf); } while (0)
#define SLOAD_F(p, k0) do { S.sf0 = *(const f32x4*)ROW(p, k0, sr); S.sf1 = *(const f32x4*)(ROW(p, k0, sr) + 4);                \
                            S.sf2 = *(const f32x4*)ROW(p, k0, 32 + sr); S.sf3 = *(const f32x4*)(ROW(p, k0, 32 + sr) + 4); } while (0)
#define SWRITE_KF(bf) do { *(bf16x8*)(K_lds + (bf) * SHM_K + kws) = pack8(S.sf0, S.sf1); *(bf16x8*)(K_lds + (bf) * SHM_K + kws + 32 * 256) = pack8(S.sf2, S.sf3); } while (0)
#define SWRITE_VF(bf) do { *(bf16x8*)(V_lds + (bf) * SHM_V + vst0) = pack8(S.sf0, S.sf1); *(bf16x8*)(V_lds + (bf) * SHM_V + vst1) = pack8(S.sf2, S.sf3); } while (0)
template <class TIn, class TOut, int PQ, int PKV, int PO>
__device__ __forceinline__ void causal_swa_prime(const BlockRef<TIn, TOut>& cur, int W, char* lds, Seam<TIn>& S, const int mk_wid) {
    constexpr bool F32 = same_t<TIn, float>::v;
    const int wid = mk_wid, lane = mk_lane(), tid = wid * 64 + lane, r32 = lane & 31, hi = lane >> 5;
    const int sr = tid >> 4, sc = (tid & 15) * 8, kws = KSWZ(sr, sc * 2); char* K_lds = lds + 2 * SHM_V;
    const int kb0 = swa_jlo(cur.P0, W) * KVBLK;
    for (int d0 = 0; d0 < 8; ++d0) S.qr[d0] = load8<TIn>(cur.Q + (size_t)(wid * QBLK + r32) * PQ + d0 * 16 + hi * 8);
    if constexpr (F32) { SLOAD_F((const float*)cur.K, kb0); VMW(); SWRITE_KF(0); SBAR(); SLOAD_F((const float*)cur.V, kb0); }
    else { SLOAD_H(cur.K, cur.V, kb0); VMW(); SWRITE_HK(0); }
    __syncthreads();
}
template <class TIn, class TOut, int PQ, int PKV, int PO>
__device__ __forceinline__ void causal_swa_block(const BlockRef<TIn, TOut>& cur, const BlockRef<TIn, TOut>& nxt, int skv, int W, char* lds, Seam<TIn>& S, const int mk_wid) {
    constexpr bool F32 = same_t<TIn, float>::v;
    const int wid = mk_wid, lane = mk_lane(), tid = wid * 64 + lane, r32 = lane & 31, hi = lane >> 5;
    const int j_lo = swa_jlo(cur.P0, W);
    int j_hi = (cur.P0 + QB - 1) / KVBLK + 1; if (j_hi > skv / KVBLK) j_hi = skv / KVBLK;
    const int NT = j_hi - j_lo;
    const int kbn = swa_jlo(nxt.P0, W) * KVBLK;
    const int qlo = cur.P0 + wid * QBLK, qm = qlo + r32 - 4 * hi;
    char* V_lds = lds; char* K_lds = lds + 2 * SHM_V;
    float* ws = (float*)(lds + 2 * SHM_V + 2 * SHM_K) + wid * 64; float* li_l = ws, * al_l = ws + 32;
    float m_reg = -1e30f, l_reg = 0; f32x16 o[4] = {};
    const int sr = tid >> 4, sc = (tid & 15) * 8, vst0 = v_st(sr, sc), vst1 = v_st(32 + sr, sc), kws = KSWZ(sr, sc * 2);
    const int vb0 = (int)(uintptr_t)V_lds + v_rd_base(lane);
    const TIn* Kh = cur.K; const TIn* Vh = cur.V;
#define RESC(a) do { if (__any((a) < 1.f)) { if (hi == 0) al_l[r32] = (a); asm volatile("s_waitcnt lgkmcnt(0)" ::: "memory");              \
                     for (int d_ = 0; d_ < 4; ++d_) for (int r = 0; r < 16; ++r) o[d_][r] *= al_l[crow(r, hi)]; } } while (0)
#define KBASE(t) ((j_lo + (t)) * KVBLK)
#define ACT(t) (KBASE(t) <= qlo + QBLK - 1 && KBASE(t) + KVBLK - 1 >= qlo - W + 1)
#define MASKT(P0_, P1_, t) do { const int kb_ = KBASE(t); if ((!SK || ACT(t)) && (kb_ + KVBLK - 1 > qlo || kb_ <= qlo + QBLK - 1 - W)) mask_tile(P0_, P1_, qm - kb_, (unsigned)W); } while (0)
    constexpr int NQL = F32 ? 16 : 8;
    constexpr bool SK = WSKIP && !F32;
#define SEAM_K0() do { VMWN(NQL); if constexpr (F32) { SWRITE_KF(0); SBAR(); SLOAD_F((const float*)nxt.V, kbn); } else { SWRITE_HK(0); } SBAR(); } while (0)
    f32x16 pA0, pA1, pB0, pB1; float mnA, mnB, alA, alB; bf16x8 pa0, pa1, pa2, pa3;
    if constexpr (F32) { VMW(); SWRITE_VF(0); SBAR(); } else { SWRITE_HV(0); SBAR(); }
    if (NT > 1) { if constexpr (F32) SLOAD_F((const float*)Kh, KBASE(1)); else SLOAD_H(Kh, Vh, KBASE(1)); }
    SBAR(); qkt<0, SK>(pA0, pA1, K_lds, r32, hi, S.qr, ACT(0));
    if constexpr (F32) { if (NT > 1) { VMW(); SWRITE_KF(1); SBAR(); SLOAD_F((const float*)Vh, KBASE(1)); } }
    MASKT(pA0, pA1, 0); partialSM(pA0, pA1, m_reg, mnA, alA);
    if (NT > 1) { VMW(); if constexpr (F32) { SWRITE_VF(1); SBAR(); if (NT > 2) SLOAD_F((const float*)Kh, KBASE(2)); } else SWRITE_H(1); }
    __syncthreads();
#define HALF_STEP(PX0, PX1, mnX, alX, PY0, PY1, alY, t, KB, VB, SB) do {                                                      \
        SBAR(); qkt<KB, SK>(PX0, PX1, K_lds, r32, hi, S.qr, ACT(t));                                             \
        finishSM(PY0, PY1, alY, l_reg, pa0, pa1, pa2, pa3); SBAR();                                                           \
        if ((t) + 1 < NT) { if constexpr (F32) { VMW(); SWRITE_KF(SB); SBAR(); SLOAD_F((const float*)Vh, KBASE((t) + 1)); }  \
                            else { SLOAD_H(Kh, Vh, KBASE((t) + 1)); } SBAR(); }                                               \
        pv_tile<VB, SK>(o, vb0, pa0, pa1, pa2, pa3, ACT((t) - 1)); MASKT(PX0, PX1, (t)); partialSM(PX0, PX1, m_reg, mnX, alX);                                        \
        __syncthreads();                                                                                                      \
        if ((t) + 1 < NT) { VMW(); if constexpr (F32) { SWRITE_VF(SB); SBAR(); if ((t) + 2 < NT) SLOAD_F((const float*)Kh, KBASE((t) + 2)); } \
                            else { SWRITE_H(SB); } }                                                                          \
        RESC(alX); __syncthreads(); } while (0)
    for (int t = 1; t + 1 < NT; t += 2) {
        HALF_STEP(pB0, pB1, mnB, alB, pA0, pA1, alA, t, 1, 0, 0);
        HALF_STEP(pA0, pA1, mnA, alA, pB0, pB1, alB, t + 1, 0, 1, 1);
    }
    const bool even = (NT & 1) == 0;
    if (even) { SBAR(); qkt<1, SK>(pB0, pB1, K_lds, r32, hi, S.qr, ACT(NT - 1)); SBAR(); }
#define QROW(e) (nxt.Q + (size_t)(wid * QBLK + r32) * PQ + ((e) >> 1) * 16 + hi * 8 + ((e) & 1) * 4)
    if constexpr (F32) { SLOAD_F((const float*)nxt.K, kbn); SBAR();
#pragma unroll
        for (int e = 0; e < 8; ++e) S.tq[e] = *(const f32x4*)QROW(e); }
    else { SLOAD_H(nxt.K, nxt.V, kbn); SBAR();
#pragma unroll
        for (int d0 = 0; d0 < 8; ++d0) S.qr[d0] = load8<TIn>(nxt.Q + (size_t)(wid * QBLK + r32) * PQ + d0 * 16 + hi * 8); }
    SBAR();
    finishSM(pA0, pA1, alA, l_reg, pa0, pa1, pa2, pa3); SBAR();
    if constexpr (F32) {
#pragma unroll
        for (int e = 8; e < 16; ++e) S.tq[e] = *(const f32x4*)QROW(e); SBAR(); }
#undef QROW
    pv_tile<0, SK>(o, vb0, pa0, pa1, pa2, pa3, ACT(even ? NT - 2 : NT - 1));
    if (even) { MASKT(pB0, pB1, NT - 1); partialSM(pB0, pB1, m_reg, mnB, alB); __syncthreads(); RESC(alB);
        finishSM(pB0, pB1, alB, l_reg, pa0, pa1, pa2, pa3); SBAR(); pv_tile<1, SK>(o, vb0, pa0, pa1, pa2, pa3, ACT(NT - 1)); }
    SBAR(); SEAM_K0();
    if (hi == 0) li_l[r32] = l_reg; asm volatile("s_waitcnt lgkmcnt(0)" ::: "memory");
    float rli[16];
#pragma unroll
    for (int r = 0; r < 16; ++r) rli[r] = __builtin_amdgcn_rcpf(li_l[crow(r, hi)]);
    TOut* Ow = cur.O + (size_t)(wid * QBLK) * PO;
#pragma unroll
    for (int r = 0; r < 16; ++r) { const int orow = crow(r, hi);
#pragma unroll
        for (int d0 = 0; d0 < 4; ++d0) { const float v = o[d0][r] * rli[r];
            if constexpr (same_t<TOut, float>::v) { Ow[(size_t)orow * PO + d0 * 32 + r32] = v; }
            else { const float vn = __shfl_xor(v, 1);
                   if ((r32 & 1) == 0) *(unsigned*)(Ow + (size_t)orow * PO + d0 * 32 + r32) = cvtpk(v, vn); } } }
    if constexpr (F32) {
#pragma unroll
        for (int d0 = 0; d0 < 8; ++d0) S.qr[d0] = pack8(S.tq[2 * d0], S.tq[2 * d0 + 1]); }
    __syncthreads();
#undef RESC
#undef KBASE
#undef ACT
#undef MASKT
#undef SEAM_K0
#undef HALF_STEP
}
#undef ROW
#undef VMW
#undef VMWN
#undef SLOAD_H
#undef SWRITE_HK
#undef SWRITE_HV
#undef SWRITE_H
#undef SLOAD_F
#undef SWRITE_KF
#undef SWRITE_VF

typedef bf16 abf_t;
}

namespace at256 {
using at128::bf16x8; using at128::f32x16; using at128::f32x4; using at128::abf_t;
constexpr int L_K = 0, L_V = 32768, L_WS = 98304, LDS_NEED = L_WS + 8 * 64 * 4;
__device__ __forceinline__ int swap23(int k) { return (k & ~0xC) | ((k & 4) << 1) | ((k & 8) >> 1); }
template <int IMM> __device__ __forceinline__ void glds16(const void* gbase  , unsigned voff  , unsigned lds_dst) { unsigned keep;
    asm volatile("s_mov_b32 %0, m0\n\ts_mov_b32 m0, %3\n\ts_nop 0\n\tglobal_load_lds_dwordx4 %1, %2 offset:%4\n\ts_mov_b32 m0, %0" : "=&s"(keep) : "v"(voff), "s"(gbase), "s"(lds_dst), "i"(IMM) : "memory"); }
template <int BUF> __device__ __forceinline__ void pv256(f32x16* o, int vb0, bf16x8 pa0, bf16x8 pa1, bf16x8 pa2, bf16x8 pa3) {
    typedef at128::s16x4 s4;
    s4 fa[8], fb[8];
#define A256_TR(dst, off) asm volatile("ds_read_b64_tr_b16 %0, %1 offset:%2" : "=&v"(dst) : "v"(vb0), "i"(off) : "memory")
#define A256_LD(f, d0) do { constexpr int b_ = (BUF * 2 + ((d0) >> 2)) * 16384 + ((d0) & 3) * 512; \
        A256_TR(f[0], b_); A256_TR(f[1], b_ + 2048); A256_TR(f[2], b_ + 4096); A256_TR(f[3], b_ + 6144); A256_TR(f[4], b_ + 8192); A256_TR(f[5], b_ + 10240); A256_TR(f[6], b_ + 12288); A256_TR(f[7], b_ + 14336); } while (0)
#define A256_MM(f, d0) do { \
        o[d0] = __builtin_amdgcn_mfma_f32_32x32x16_bf16(pa0, (bf16x8){f[0][0], f[0][1], f[0][2], f[0][3], f[1][0], f[1][1], f[1][2], f[1][3]}, o[d0], 0, 0, 0); \
        o[d0] = __builtin_amdgcn_mfma_f32_32x32x16_bf16(pa1, (bf16x8){f[2][0], f[2][1], f[2][2], f[2][3], f[3][0], f[3][1], f[3][2], f[3][3]}, o[d0], 0, 0, 0); \
        o[d0] = __builtin_amdgcn_mfma_f32_32x32x16_bf16(pa2, (bf16x8){f[4][0], f[4][1], f[4][2], f[4][3], f[5][0], f[5][1], f[5][2], f[5][3]}, o[d0], 0, 0, 0); \
        o[d0] = __builtin_amdgcn_mfma_f32_32x32x16_bf16(pa3, (bf16x8){f[6][0], f[6][1], f[6][2], f[6][3], f[7][0], f[7][1], f[7][2], f[7][3]}, o[d0], 0, 0, 0); } while (0)
#define A256_W8() do { asm volatile("s_waitcnt lgkmcnt(8)" ::: "memory"); __builtin_amdgcn_sched_barrier(0); } while (0)
#define A256_W0() do { asm volatile("s_waitcnt lgkmcnt(0)" ::: "memory"); __builtin_amdgcn_sched_barrier(0); } while (0)
    A256_LD(fa, 0);
    A256_LD(fb, 1); A256_W8(); A256_MM(fa, 0); __builtin_amdgcn_sched_barrier(0);
    A256_LD(fa, 2); A256_W8(); A256_MM(fb, 1); __builtin_amdgcn_sched_barrier(0);
    A256_LD(fb, 3); A256_W8(); A256_MM(fa, 2); __builtin_amdgcn_sched_barrier(0);
    A256_LD(fa, 4); A256_W8(); A256_MM(fb, 3); __builtin_amdgcn_sched_barrier(0);
    A256_LD(fb, 5); A256_W8(); A256_MM(fa, 4); __builtin_amdgcn_sched_barrier(0);
    A256_LD(fa, 6); A256_W8(); A256_MM(fb, 5); __builtin_amdgcn_sched_barrier(0);
    A256_LD(fb, 7); A256_W8(); A256_MM(fa, 6); __builtin_amdgcn_sched_barrier(0);
    A256_W0(); A256_MM(fb, 7);
#undef A256_TR
#undef A256_LD
#undef A256_MM
#undef A256_W8
#undef A256_W0
}
struct Blk { const abf_t* Q; const abf_t* K; const abf_t* V; abf_t* O; int P0; };
template <int PQ, int PKV, int PO>
__device__ __forceinline__ void attn_block(const Blk& B, __attribute__((address_space(3))) unsigned char* ldsL, const int wid) {
    char* lds = (char*)ldsL;
    const int lane = mk_lane(), r32 = lane & 31, hi = lane >> 5;
    const unsigned lbase = (unsigned)(unsigned long)ldsL;
    unsigned offK, offV;
    { const int q = wid * 64 + lane, row = q >> 4, ch = (q & 15) ^ (row & 7); offK = (unsigned)(row * PKV + ch * 8) * 2u; }
    { const int q = wid * 128 + lane, st = q >> 5, rowk = (q >> 2) & 7, cch = q & 3, k = swap23((st >> 2) * 8 + rowk), c = (st & 3) * 32 + cch * 8; offV = (unsigned)(k * PKV + c) * 2u; }
    const unsigned lpk = (unsigned)wid * 1024u, lpv = (unsigned)wid * 2048u;
#define A256_DMA(buf, key0) do { const abf_t* kg_ = B.K + (size_t)(key0) * PKV; const abf_t* vg_ = B.V + (size_t)(key0) * PKV; \
        glds16<0>(kg_, offK, lbase + L_K + (buf) * 16384 + lpk); glds16<0>(kg_ + 32 * PKV, offK, lbase + L_K + (buf) * 16384 + lpk + 8192); \
        glds16<0>(vg_, offV, lbase + L_V + ((buf) * 2 + 0) * 16384 + lpv); glds16<128>(vg_, offV, lbase + L_V + ((buf) * 2 + 0) * 16384 + lpv + 1024 - 128); \
        glds16<256>(vg_, offV, lbase + L_V + ((buf) * 2 + 1) * 16384 + lpv - 256); glds16<384>(vg_, offV, lbase + L_V + ((buf) * 2 + 1) * 16384 + lpv + 1024 - 384); } while (0)
    const int NT = (B.P0 + 256) / 64;
    const int qlo = B.P0 + wid * 32, qm = qlo + r32 - 4 * hi;
    A256_DMA(0, 0);
    bf16x8 qr[8];
#pragma unroll
    for (int d0 = 0; d0 < 8; ++d0) qr[d0] = __builtin_nontemporal_load(reinterpret_cast<const bf16x8*>(B.Q + (size_t)(wid * 32 + r32) * PQ + d0 * 16 + hi * 8));
    float* wsf = (float*)(lds + L_WS) + wid * 64; float* li_l = wsf; float* al_l = wsf + 32;
    float m_reg = -1e30f, l_reg = 0.f; f32x16 o[8] = {};
    const int vb0 = (int)lbase + L_V + at128::v_rd_base(lane);
    asm volatile("s_waitcnt vmcnt(0)" ::: "memory"); __syncthreads();
#define A256_STEP(buf, t) do { \
        if ((t) + 1 < NT) A256_DMA(1 - (buf), ((t) + 1) * 64); \
        f32x16 p0, p1; float mn, alpha; bf16x8 pa0, pa1, pa2, pa3; \
        at128::qkt<buf, false>(p0, p1, lds + L_K, r32, hi, qr, true); \
        { const int kb_ = (t) * 64; if (kb_ + 63 > qlo) at128::mask_tile(p0, p1, qm - kb_, 0x7fffffffu); } \
        at128::partialSM(p0, p1, m_reg, mn, alpha); \
        if (__any(alpha < 1.f)) { if (hi == 0) al_l[r32] = alpha; asm volatile("s_waitcnt lgkmcnt(0)" ::: "memory"); \
            _Pragma("unroll") for (int r_ = 0; r_ < 16; ++r_) { const float a_ = al_l[at128::crow(r_, hi)]; _Pragma("unroll") for (int d_ = 0; d_ < 8; ++d_) o[d_][r_] *= a_; } } \
        at128::finishSM(p0, p1, alpha, l_reg, pa0, pa1, pa2, pa3); __builtin_amdgcn_sched_barrier(0); \
        pv256<buf>(o, vb0, pa0, pa1, pa2, pa3); \
        asm volatile("s_waitcnt vmcnt(0)" ::: "memory"); __syncthreads(); } while (0)
    for (int t = 0; t < NT; t += 2) { A256_STEP(0, t); A256_STEP(1, t + 1); }
    if (hi == 0) li_l[r32] = l_reg; asm volatile("s_waitcnt lgkmcnt(0)" ::: "memory");
    abf_t* Ow = B.O + (size_t)(wid * 32) * PO;
#pragma unroll
    for (int r = 0; r < 16; ++r) { const int orow = at128::crow(r, hi); const float rl = __builtin_amdgcn_rcpf(li_l[orow]);
#pragma unroll
        for (int d0 = 0; d0 < 8; ++d0) { const float v = o[d0][r] * rl; const float vn = __shfl_xor(v, 1);
            if ((r32 & 1) == 0) *(unsigned*)(Ow + (size_t)orow * PO + d0 * 32 + r32) = at128::cvtpk(v, vn); } }
    __syncthreads();
#undef A256_STEP
#undef A256_DMA
}
}

constexpr int NWAVES = 8;
constexpr int NTOK = 32768, DM = 2048, SEQ = 8192, NBATCH = 4;
constexpr int MAINW = 1536, MEMW = 512, NMEM = 256;
constexpr int A_IN = 3584;
constexpr int B_IN = 5120;
constexpr int FF = 5632, FFE = 7168, NEXP = 8;
constexpr int NSG = 12;
constexpr float ALPHA = 1.41421356237309515f;
constexpr float LN_EPS = 1e-5f;
constexpr float LAMBDA_INIT = 0.355509067592f;
constexpr int MAXT = 264;
constexpr int NPHASE = 17;
constexpr float W8_D_MUL = 128.f, H8_MUL = 4.f;
constexpr float W8_G_MUL = -64.f * 1.4426950408889634f, W8_U_MUL = -64.f * 4.f / 1.4426950408889634f;
constexpr int SC_ONE = 0x7f7f7f7f, SC_M4 = 0x7d7d7d7d, SC_M6 = 0x79797979, SC_M7 = 0x78787878;

constexpr size_t MiB = 1u << 20;
constexpr size_t WS_CTL = 0, CTL_ZERO_BYTES = 64 * 1024;
constexpr size_t WS_WSBF = 1 * MiB;
constexpr size_t WS_MEMB = 2 * MiB;
constexpr size_t WS_MEMKV = 6 * MiB;
constexpr size_t WS_ROUTE_E = 10 * MiB;
constexpr size_t WS_ROUTE_W = 10 * MiB + 256 * 1024;
constexpr size_t WS_TOKSLOT = 10 * MiB + 512 * 1024;
constexpr size_t WS_SLOTGATE = 11 * MiB;
constexpr size_t WS_SLOTTOK = 11 * MiB + 512 * 1024;
constexpr size_t WS_HIST = 12 * MiB;
constexpr size_t WS_MOETAB = 12 * MiB + 256 * 1024;
constexpr size_t WS_OSK = 1644 * MiB;
constexpr size_t WS_STATS = 13 * MiB;
#if MK_FP8_MOE
constexpr int MOE_CHUNK_T = MAXT;
constexpr size_t WS_W_MOE_GU = 16 * MiB;
constexpr size_t WS_W_MOE_D = 240 * MiB;
constexpr size_t WS_XS = 352 * MiB;
#else
constexpr size_t WS_W_MOE_GU = 16 * MiB;
constexpr size_t WS_W_MOE_D = 464 * MiB;
constexpr size_t WS_XS = 812 * MiB;
#endif
constexpr size_t WS_W_A_IN = 688 * MiB;
constexpr size_t WS_W_MIX = 702 * MiB;
constexpr size_t WS_W_FFN_GU = 718 * MiB;
constexpr size_t WS_W_FFN_D = 762 * MiB;
constexpr size_t WS_W_B_IN = 784 * MiB;
constexpr size_t WS_W_MEMKV = 804 * MiB;
constexpr size_t WS_XB = 812 * MiB;
constexpr size_t WS_H0 = 940 * MiB;
constexpr size_t WS_CONCAT = 1164 * MiB;
constexpr size_t WS_HID = 940 * MiB;
constexpr size_t WS_H1 = 940 * MiB;
constexpr size_t WS_AO = 1260 * MiB;
constexpr size_t WS_CONCAT1 = 1452 * MiB;
constexpr size_t WS_X3B = 1580 * MiB;
#if MK_FP8_MOE
constexpr size_t WS_OS = 812 * MiB;
constexpr size_t WS_HIDM = 1076 * MiB;
constexpr size_t WS_END = 1708 * MiB;
constexpr size_t WS_Y3B = 496 * MiB;
static_assert(WS_XS + (size_t)MAXT * 256 * DM <= WS_Y3B && WS_Y3B + (size_t)NTOK * DM * 2 <= WS_W_A_IN, "y3 map");
static_assert(WS_W_MOE_D + (size_t)NEXP * DM * FFE <= WS_XS && WS_XS + (size_t)MAXT * 256 * DM <= WS_W_A_IN, "fp8 MoE weight map");
static_assert(WS_OS + (size_t)MAXT * 256 * DM * 2 <= WS_HIDM && WS_HIDM + (size_t)MAXT * 256 * FFE <= WS_X3B, "fp8 MoE map");
#else
constexpr size_t WS_OS = 1076 * MiB;
constexpr size_t WS_HIDM = 1340 * MiB;
constexpr size_t WS_END = 1802 * MiB;
static_assert(WS_XS + (size_t)MAXT * 256 * DM * 2 <= WS_OS && WS_OS + (size_t)MAXT * 256 * DM * 2 <= WS_HIDM && WS_HIDM + (size_t)MOE_CHUNK_T * 256 * FFE * 2 <= WS_END, "MoE map");
static_assert(WS_XS + (size_t)MAXT * 256 * DM * 2 <= WS_CONCAT1, "XS must not overlap CONCAT1/X3B");
#endif
static_assert(WS_H0 + (size_t)NTOK * A_IN * 2 <= WS_CONCAT && WS_HID + (size_t)NTOK * FF * 2 <= 1292 * MiB && WS_H1 + (size_t)NTOK * B_IN * 2 <= WS_AO && WS_AO + (size_t)NTOK * 3072 * 2 <= WS_CONCAT1, "activation map");
static_assert(WS_CONCAT1 + (size_t)NTOK * DM * 2 <= WS_X3B && WS_X3B + (size_t)NTOK * DM * 2 <= 1708 * MiB, "activation map 2");
constexpr int CW_TMO = 0, CW_CODE = 1;
constexpr int CW_BAR = 4096;
constexpr int CW_BGQ = 12288;
constexpr int CW_TS = 8300;
constexpr int CW_CHK = 8192;

constexpr int RING_OFF = 0, RING_BYTES = 131072;
constexpr int LDSCTL_OFF = 147456 - 1024, MISC_OFF = LDSCTL_OFF + 320;
constexpr int LDS_BYTES = 147456;

#define GAS __attribute__((address_space(1)))
#define LAS __attribute__((address_space(3)))
typedef unsigned short bf16;
typedef unsigned v4u __attribute__((ext_vector_type(4)));
typedef float f32x4 __attribute__((ext_vector_type(4)));
typedef short bf16x8 __attribute__((ext_vector_type(8)));
typedef GAS unsigned gu32;
typedef GAS unsigned long long gu64;
#define RLX_AGENT __ATOMIC_RELAXED, __HIP_MEMORY_SCOPE_AGENT
#define LDS_WAIT() asm volatile("s_waitcnt lgkmcnt(0)" ::: "memory")
#define VM_WAIT() asm volatile("s_waitcnt vmcnt(0)" ::: "memory")
__device__ __forceinline__ unsigned long long rt() { return __builtin_amdgcn_s_memrealtime(); }
__device__ __forceinline__ unsigned f2bf(float f) { unsigned u = __builtin_bit_cast(unsigned, f); return (u + 0x7fffu + ((u >> 16) & 1u)) >> 16; }
__device__ __forceinline__ unsigned pk2(float lo, float hi) { return f2bf(lo) | (f2bf(hi) << 16); }

#define XB_TMO      128
#define XB_XCNT(j)  (256  + 64 * (j))
#define XB_XSUB(j)  (1280 + 64 * (j))
#define XB_XGEN(j)  (2304 + 64 * (j))
#define XB_TOP      3328
#define XB_TOPGEN   3392
#define XCD_BAR_WORDS 3456
#define XB_SPIN_CAP (1u << 18)

__device__ __forceinline__ unsigned xb_ld(unsigned* p)              { return __hip_atomic_load(p, __ATOMIC_RELAXED, __HIP_MEMORY_SCOPE_AGENT); }
__device__ __forceinline__ unsigned xb_add(unsigned* p, unsigned v) { return __hip_atomic_fetch_add(p, v, __ATOMIC_RELAXED, __HIP_MEMORY_SCOPE_AGENT); }
__device__ __forceinline__ unsigned xb_xcc_id() { return (unsigned)__builtin_amdgcn_s_getreg((3 << 11) | 20) & 0xFu; }
#define XB_SPIN(cond, bar) do { unsigned _sp = 0; while (cond) { __builtin_amdgcn_s_sleep(1); \
    if ((++_sp & 255u) == 0u) { if (xb_ld(&(bar)[XB_TMO])) break; if (_sp > XB_SPIN_CAP) { atomicAdd(&(bar)[XB_TMO], 1u); break; } } } } while (0)

struct XcdBarrier {
    unsigned* bar; unsigned x; int wave;
    volatile LAS unsigned* st;
};

__device__ __forceinline__ XcdBarrier xcd_barrier_post(unsigned* bar, volatile LAS unsigned* st) {
    XcdBarrier b; b.bar = bar; b.x = xb_xcc_id(); b.st = st;
    if (threadIdx.x == 0) (void)xb_add(&bar[XB_XCNT(b.x)], 1u);
    return b;
}
__device__ __forceinline__ void xcd_barrier_complete(unsigned* bar, unsigned x, unsigned& nloc, unsigned& nx) {
    const unsigned G = gridDim.x * gridDim.y * gridDim.z;
    unsigned sum, cnt, mine, sp = 0u;
    for (;;) {
        sum = 0u; cnt = 0u; mine = 0u;
#pragma unroll
        for (unsigned j = 0; j < 16; ++j) { const unsigned c = xb_ld(&bar[XB_XCNT(j)]); sum += c; cnt += (c > 0u) ? 1u : 0u; mine = (j == x) ? c : mine; }
        if (sum == G) break;
        __builtin_amdgcn_s_sleep(1);
        if ((++sp & 255u) == 0u) { if (xb_ld(&bar[XB_TMO])) break; if (sp > XB_SPIN_CAP) { atomicAdd(&bar[XB_TMO], 1u); break; } }
    }
    nloc = mine > 0u ? mine : 1u; nx = cnt > 0u ? cnt : 1u;
}

__device__ __forceinline__ void xcd_barrier(const XcdBarrier& b) {
    asm volatile("s_waitcnt vmcnt(0)" ::: "memory");
    __syncthreads();
    if (b.wave == 0 && mk_lane() == 0) {
        unsigned* bar = b.bar;
        __builtin_amdgcn_s_waitcnt(0);
        unsigned nloc = b.st[0], nx = b.st[1];
        if (nloc == 0u) { xcd_barrier_complete(bar, b.x, nloc, nx); b.st[0] = nloc; b.st[1] = nx; }
        const unsigned old = xb_add(&bar[XB_XSUB(b.x)], 1u);
        const unsigned gen = old / nloc;
        if (old + 1u == (gen + 1u) * nloc) {
            __builtin_amdgcn_fence(__ATOMIC_RELEASE, "agent");
            asm volatile("s_waitcnt vmcnt(0)" ::: "memory");
            const unsigned og = xb_add(&bar[XB_TOP], 1u);
            const unsigned tg = og / nx;
            if (og + 1u == (tg + 1u) * nx) xb_add(&bar[XB_TOPGEN], 1u);
            else XB_SPIN(xb_ld(&bar[XB_TOPGEN]) == tg, bar);
            __builtin_amdgcn_fence(__ATOMIC_ACQUIRE, "agent");
            xb_add(&bar[XB_XGEN(b.x)], 1u);
            asm volatile("s_waitcnt vmcnt(0)" ::: "memory");
        } else {
            XB_SPIN(xb_ld(&bar[XB_XGEN(b.x)]) == gen, bar);
            __builtin_amdgcn_fence(__ATOMIC_ACQUIRE, "agent");
            asm volatile("s_waitcnt vmcnt(0)" ::: "memory");
        }
    }
    __syncthreads();
}


struct Frame {
    LAS unsigned char* lds;
    volatile LAS unsigned* MISC;
    gu32* ctl;
    int wave;
    int G;
    unsigned char* ws;
    const float* in[25]; float* out;
};
enum { I_X = 0, I_MEM, I_LNG, I_LNB, I_WMIX, I_WMEMKV, I_AWIN, I_AVG, I_AVB, I_AWS, I_ABS, I_SWKV, I_BWIN, I_LQ1, I_LK1, I_LQ2, I_LK2, I_SUBLN, I_FG, I_FU, I_FD, I_ROUTER, I_MG, I_MU, I_MD };

template <int CTRL> __device__ __forceinline__ float dpp_f(float v) { return __builtin_bit_cast(float, __builtin_amdgcn_update_dpp(0, __builtin_bit_cast(int, v), CTRL, 0xf, 0xf, true)); }
__device__ __forceinline__ float wave_sum(float v) {
    v += dpp_f<0xB1>(v); v += dpp_f<0x4E>(v); v += dpp_f<0x141>(v); v += dpp_f<0x140>(v);
    { auto t = __builtin_amdgcn_permlane16_swap(__float_as_uint(v), __float_as_uint(v), false, false); v = __uint_as_float(t[0]) + __uint_as_float(t[1]); }
    { auto t = __builtin_amdgcn_permlane32_swap(__float_as_uint(v), __float_as_uint(v), false, false); v = __uint_as_float(t[0]) + __uint_as_float(t[1]); }
    return v;
}
__device__ __forceinline__ float bf2f(unsigned short b) { return __builtin_bit_cast(float, (unsigned)b << 16); }
__device__ __forceinline__ float bflo(unsigned w) { return __builtin_bit_cast(float, w << 16); }
__device__ __forceinline__ float bfhi(unsigned w) { return __builtin_bit_cast(float, w & 0xffff0000u); }

__device__ __forceinline__ void tr_item(const float* W, int K, int N, bf16* WT, int k0, int n0, int drow0, LAS float* scr, int lane) {
    float t_[32];
#pragma unroll
    for (int i = 0; i < 32; ++i) { const int kk = 2 * i + (lane >> 5); t_[i] = __builtin_nontemporal_load(W + (size_t)(k0 + kk) * N + n0 + (lane & 31)); }
#pragma unroll
    for (int i = 0; i < 32; ++i) { const int kk = 2 * i + (lane >> 5); scr[kk * 33 + (lane & 31)] = t_[i]; }
    LDS_WAIT(); asm volatile("" ::: "memory");
    const int c = lane & 7;
#pragma unroll
    for (int j = 0; j < 4; ++j) { const int n = (lane >> 3) + 8 * j; const LAS float* s = scr + (8 * c) * 33 + n;
        v4u o; o.x = pk2(s[0 * 33], s[1 * 33]); o.y = pk2(s[2 * 33], s[3 * 33]); o.z = pk2(s[4 * 33], s[5 * 33]); o.w = pk2(s[6 * 33], s[7 * 33]);
        *(GAS v4u*)(WT + (size_t)(drow0 + n) * K + k0 + 8 * c) = o; }
    LDS_WAIT(); asm volatile("" ::: "memory");
}
__device__ __forceinline__ void tr_item8(const float* W, int K, int N, unsigned char* WT, int k0, int n0, int drow0, float mul, LAS float* scr, int lane) {
    float t_[64];
#pragma unroll
    for (int i = 0; i < 64; ++i) { const int kk = 2 * i + (lane >> 5); t_[i] = __builtin_nontemporal_load(W + (size_t)(k0 + kk) * N + n0 + (lane & 31)); }
#pragma unroll
    for (int i = 0; i < 64; ++i) { const int kk = 2 * i + (lane >> 5); scr[kk * 33 + (lane & 31)] = t_[i]; }
    LDS_WAIT(); asm volatile("" ::: "memory");
    const int n = lane >> 1, hf = lane & 1; const LAS float* s = scr + (64 * hf) * 33 + n;
    GAS v4u* dst = (GAS v4u*)(WT + (size_t)(drow0 + n) * K + k0 + 64 * hf);
#pragma unroll
    for (int g = 0; g < 4; ++g) { int w[4];
#pragma unroll
        for (int q = 0; q < 4; ++q) { const int kq = 16 * g + 4 * q; int t = 0; t = __builtin_amdgcn_cvt_pk_fp8_f32(s[kq * 33] * mul, s[(kq + 1) * 33] * mul, t, false); t = __builtin_amdgcn_cvt_pk_fp8_f32(s[(kq + 2) * 33] * mul, s[(kq + 3) * 33] * mul, t, true); w[q] = t; }
        dst[g] = (v4u){(unsigned)w[0], (unsigned)w[1], (unsigned)w[2], (unsigned)w[3]}; }
    LDS_WAIT(); asm volatile("" ::: "memory");
}
__device__ __forceinline__ void tr_matrix_item8(const float* W, int K, int N, unsigned char* WT, int row_off, int mode, float mul, int item, LAS float* scr, int lane) {
    const int nblk = N / 32, kb = item / nblk, nb = item % nblk, k0 = 128 * kb, n0 = 32 * nb;
    const int drow0 = row_off + (mode == 0 ? n0 : ((n0 >> 7) * 256 + (n0 & 127) + (mode == 2 ? 128 : 0)));
    tr_item8(W, K, N, WT, k0, n0, drow0, mul, scr, lane);
}
__device__ __forceinline__ void tr_matrix_item(const float* W, int K, int N, bf16* WT, int row_off, int mode, int item, LAS float* scr, int lane) {
    const int nblk = N / 32, kb = item / nblk, nb = item % nblk, k0 = 64 * kb, n0 = 32 * nb;
    const int drow0 = row_off + (mode == 0 ? n0 : ((n0 >> 7) * 256 + (n0 & 127) + (mode == 2 ? 128 : 0)));
    tr_item(W, K, N, WT, k0, n0, drow0, scr, lane);
}
__device__ __forceinline__ void p0_prologue(Frame& F) {
    const int lane_ = mk_lane(), tid_ = F.wave * 64 + lane_;
    LAS float* scr = (LAS float*)(F.lds + RING_OFF + F.wave * 16896);
    const int gw = blockIdx.x * NWAVES + F.wave, NGW = F.G * NWAVES;
    bf16* ws16 = (bf16*)F.ws;
    constexpr int KD8 = MK_FP8_MOE ? 128 : 64, KF8 = MK_FP8_FFN ? 128 : 64;
    constexpr int I_E = (DM / KD8) * (FFE / 32);
    constexpr int I_MOE = 3 * NEXP * I_E;
    constexpr int I_AIN = (DM / 64) * (A_IN / 32), I_MIXW = (DM / 64) * (DM / 32), I_FGU = (DM / KF8) * (FF / 32), I_FDN = (FF / KF8) * (DM / 32);
    constexpr int I_KV = (DM / 64) * (3072 / 32), I_BIN = (DM / 64) * (DM / 32), I_MKV = (DM / 64) * (1024 / 32);
    constexpr int NITEMS = I_MOE + I_AIN + 2 * I_MIXW + 2 * I_FGU + I_FDN + I_KV + I_BIN + 2 * I_MKV;
#if MK_BG
    constexpr int NFG = I_AIN + I_MIXW + 2 * I_MKV;
    for (int it = gw; it < NFG; it += NGW) { int r = it;
        if (r < I_AIN) { tr_matrix_item(F.in[I_AWIN], DM, A_IN, (bf16*)(F.ws + WS_W_A_IN), 0, 0, r, scr, lane_); continue; } r -= I_AIN;
        if (r < I_MIXW) { tr_matrix_item(F.in[I_WMIX], DM, DM, (bf16*)(F.ws + WS_W_MIX), 0, 0, r, scr, lane_); continue; } r -= I_MIXW;
        { const int l = r / I_MKV; tr_matrix_item(F.in[I_WMEMKV] + (size_t)l * DM * 1024, DM, 1024, (bf16*)(F.ws + WS_W_MEMKV), l * 1024, 0, r % I_MKV, scr, lane_); } }
    if (false)
#endif
    for (int it = gw; it < NITEMS; it += NGW) {
        int r = it;
        if (r < I_MOE) { const int which = r / (NEXP * I_E), rr = r % (NEXP * I_E), e = rr / I_E, item = rr % I_E;
#if MK_FP8_MOE
            if (which == 0) tr_matrix_item8(F.in[I_MG] + (size_t)e * DM * FFE, DM, FFE, F.ws + WS_W_MOE_GU, e * 2 * FFE, 1, W8_G_MUL, item, scr, lane_);
            else if (which == 1) tr_matrix_item8(F.in[I_MU] + (size_t)e * DM * FFE, DM, FFE, F.ws + WS_W_MOE_GU, e * 2 * FFE, 2, W8_U_MUL, item, scr, lane_);
            else tr_matrix_item8(F.in[I_MD] + (size_t)e * FFE * DM, FFE, DM, F.ws + WS_W_MOE_D, e * DM, 0, W8_D_MUL, item, scr, lane_);
#else
            if (which == 0) tr_matrix_item(F.in[I_MG] + (size_t)e * DM * FFE, DM, FFE, (bf16*)(F.ws + WS_W_MOE_GU), e * 2 * FFE, 1, item, scr, lane_);
            else if (which == 1) tr_matrix_item(F.in[I_MU] + (size_t)e * DM * FFE, DM, FFE, (bf16*)(F.ws + WS_W_MOE_GU), e * 2 * FFE, 2, item, scr, lane_);
            else tr_matrix_item(F.in[I_MD] + (size_t)e * FFE * DM, FFE, DM, (bf16*)(F.ws + WS_W_MOE_D), e * DM, 0, item, scr, lane_);
#endif
            continue; } r -= I_MOE;
        if (r < I_AIN) { tr_matrix_item(F.in[I_AWIN], DM, A_IN, (bf16*)(F.ws + WS_W_A_IN), 0, 0, r, scr, lane_); continue; } r -= I_AIN;
        if (r < 2 * I_MIXW) { const int l = r / I_MIXW; tr_matrix_item(F.in[I_WMIX] + (size_t)l * DM * DM, DM, DM, (bf16*)(F.ws + WS_W_MIX), l * DM, 0, r % I_MIXW, scr, lane_); continue; } r -= 2 * I_MIXW;
#if MK_FP8_FFN
        if (r < I_FGU) { tr_matrix_item8(F.in[I_FG], DM, FF, F.ws + WS_W_FFN_GU, 0, 1, W8_G_MUL, r, scr, lane_); continue; } r -= I_FGU;
        if (r < I_FGU) { tr_matrix_item8(F.in[I_FU], DM, FF, F.ws + WS_W_FFN_GU, 0, 2, W8_U_MUL, r, scr, lane_); continue; } r -= I_FGU;
        if (r < I_FDN) { tr_matrix_item8(F.in[I_FD], FF, DM, F.ws + WS_W_FFN_D, 0, 0, W8_D_MUL, r, scr, lane_); continue; } r -= I_FDN;
#else
        if (r < I_FGU) { tr_matrix_item(F.in[I_FG], DM, FF, (bf16*)(F.ws + WS_W_FFN_GU), 0, 1, r, scr, lane_); continue; } r -= I_FGU;
        if (r < I_FGU) { tr_matrix_item(F.in[I_FU], DM, FF, (bf16*)(F.ws + WS_W_FFN_GU), 0, 2, r, scr, lane_); continue; } r -= I_FGU;
        if (r < I_FDN) { tr_matrix_item(F.in[I_FD], FF, DM, (bf16*)(F.ws + WS_W_FFN_D), 0, 0, r, scr, lane_); continue; } r -= I_FDN;
#endif
        if (r < I_KV) { tr_matrix_item(F.in[I_SWKV], DM, 3072, (bf16*)(F.ws + WS_W_B_IN), 0, 0, r, scr, lane_); continue; } r -= I_KV;
        if (r < I_BIN) { tr_matrix_item(F.in[I_BWIN], DM, DM, (bf16*)(F.ws + WS_W_B_IN), 3072, 0, r, scr, lane_); continue; } r -= I_BIN;
        { const int l = r / I_MKV; tr_matrix_item(F.in[I_WMEMKV] + (size_t)l * DM * 1024, DM, 1024, (bf16*)(F.ws + WS_W_MEMKV), l * 1024, 0, r % I_MKV, scr, lane_); }
    }
    (void)ws16;
    { const size_t gt = (size_t)blockIdx.x * (NWAVES * 64) + tid_, NT = (size_t)F.G * NWAVES * 64;
      const GAS f32x4* x4 = (const GAS f32x4*)F.in[I_X]; GAS v4u* xb = (GAS v4u*)(F.ws + WS_XB);
      for (size_t i = gt; i < (size_t)NTOK * DM / 8; i += NT) { const f32x4 a = __builtin_nontemporal_load(x4 + 2 * i), b = __builtin_nontemporal_load(x4 + 2 * i + 1); v4u o; o.x = pk2(a.x, a.y); o.y = pk2(a.z, a.w); o.z = pk2(b.x, b.y); o.w = pk2(b.z, b.w); xb[i] = o; }
      const GAS f32x4* m4 = (const GAS f32x4*)F.in[I_MEM]; GAS v4u* mb = (GAS v4u*)(F.ws + WS_MEMB);
      for (size_t i = gt; i < (size_t)NBATCH * NMEM * DM / 8; i += NT) { const f32x4 a = m4[2 * i], b = m4[2 * i + 1]; v4u o; o.x = pk2(a.x, a.y); o.y = pk2(a.z, a.w); o.z = pk2(b.x, b.y); o.w = pk2(b.z, b.w); mb[i] = o; }
      const float* wsrc = F.in[I_AWS]; bf16* wd = (bf16*)(F.ws + WS_WSBF);
      for (size_t i = gt; i < (size_t)NSG * 128 * 128; i += NT) { const int s = (int)(i & 127), t = (int)((i >> 7) & 127); wd[i] = (bf16)(s <= t ? f2bf(wsrc[i]) : 0u); }
    }
}

#if MK_BG
static_assert(MK_FP8_MOE, "the background item list is written for the fp8 MoE build");
constexpr int BG_F = (DM / (MK_FP8_FFN ? 128 : 64)) * (FF / 32);
constexpr int BG_EA = 3 * BG_F;
constexpr int BG_KV = (DM / 64) * (3072 / 32), BG_BIN = (DM / 64) * (DM / 32), BG_MIX = (DM / 64) * (DM / 32);
constexpr int BG_EB = BG_EA + BG_KV + BG_BIN;
constexpr int BG_EC = BG_EB + BG_MIX;
constexpr int BG_IE = (DM / 128) * (FFE / 32);
constexpr int BG_ED = BG_EC + 3 * NEXP * BG_IE;
constexpr int BG_EA1 = 2 * BG_F;
constexpr int BG_ED1 = BG_EC + 2 * NEXP * BG_IE;
static_assert(BG_EA % 8 == 0 && BG_EB % 8 == 0 && BG_EC % 8 == 0 && BG_ED % 8 == 0 && BG_EA1 % 8 == 0 && BG_ED1 % 8 == 0, "segments are whole 8-item batches");
__device__ __forceinline__ void bg_item(Frame& F, int it, LAS float* scr, int lane) {
    int r = it;
    if (r < BG_EA) { const int w = r / BG_F, item = r % BG_F;
#if MK_FP8_FFN
        if (w == 0) tr_matrix_item8(F.in[I_FG], DM, FF, F.ws + WS_W_FFN_GU, 0, 1, W8_G_MUL, item, scr, lane);
        else if (w == 1) tr_matrix_item8(F.in[I_FU], DM, FF, F.ws + WS_W_FFN_GU, 0, 2, W8_U_MUL, item, scr, lane);
        else tr_matrix_item8(F.in[I_FD], FF, DM, F.ws + WS_W_FFN_D, 0, 0, W8_D_MUL, item, scr, lane);
#else
        if (w == 0) tr_matrix_item(F.in[I_FG], DM, FF, (bf16*)(F.ws + WS_W_FFN_GU), 0, 1, item, scr, lane);
        else if (w == 1) tr_matrix_item(F.in[I_FU], DM, FF, (bf16*)(F.ws + WS_W_FFN_GU), 0, 2, item, scr, lane);
        else tr_matrix_item(F.in[I_FD], FF, DM, (bf16*)(F.ws + WS_W_FFN_D), 0, 0, item, scr, lane);
#endif
        return; } r -= BG_EA;
    if (r < BG_KV) { tr_matrix_item(F.in[I_SWKV], DM, 3072, (bf16*)(F.ws + WS_W_B_IN), 0, 0, r, scr, lane); return; } r -= BG_KV;
    if (r < BG_BIN) { tr_matrix_item(F.in[I_BWIN], DM, DM, (bf16*)(F.ws + WS_W_B_IN), 3072, 0, r, scr, lane); return; } r -= BG_BIN;
    if (r < BG_MIX) { tr_matrix_item(F.in[I_WMIX] + (size_t)DM * DM, DM, DM, (bf16*)(F.ws + WS_W_MIX), DM, 0, r, scr, lane); return; } r -= BG_MIX;
    { const int which = r / (NEXP * BG_IE), rr = r % (NEXP * BG_IE), e = rr / BG_IE, item = rr % BG_IE;
      if (which == 0) tr_matrix_item8(F.in[I_MG] + (size_t)e * DM * FFE, DM, FFE, F.ws + WS_W_MOE_GU, e * 2 * FFE, 1, W8_G_MUL, item, scr, lane);
      else if (which == 1) tr_matrix_item8(F.in[I_MU] + (size_t)e * DM * FFE, DM, FFE, F.ws + WS_W_MOE_GU, e * 2 * FFE, 2, W8_U_MUL, item, scr, lane);
      else tr_matrix_item8(F.in[I_MD] + (size_t)e * FFE * DM, FFE, DM, F.ws + WS_W_MOE_D, e * DM, 0, W8_D_MUL, item, scr, lane); }
}
__device__ __forceinline__ int bg_round(Frame& F) {
    volatile LAS int* w = (volatile LAS int*)(F.lds + LDSCTL_OFF + 128);
    const int lane = mk_lane();
    if (F.wave == 0 && lane == 0) w[0] = (int)__hip_atomic_fetch_add(F.ctl + CW_BGQ, 8u, RLX_AGENT);
    __syncthreads();
    const int base = w[0];
    if (base >= 0 && base < BG_ED) bg_item(F, base + F.wave, (LAS float*)(F.lds + RING_OFF + F.wave * 16896), lane);
    __syncthreads();
    return (base >= 0) ? base : BG_ED;
}
__device__ __forceinline__ void bg_drain(Frame& F, int X) {
    volatile LAS int* w = (volatile LAS int*)(F.lds + LDSCTL_OFF + 128);
    for (;;) {
        if (F.wave == 0 && mk_lane() == 0) w[3] = (int)__hip_atomic_load(F.ctl + CW_BGQ, RLX_AGENT);
        __syncthreads();
        const int head = w[3];
        __syncthreads();
        if (head < 0 || head >= X) break;
        (void)bg_round(F);
    }
}
#endif

#if MK_BG
__device__ __forceinline__ void xcd_barrier_bg(const XcdBarrier& b, Frame& F, bool& bg_done) {
    asm volatile("s_waitcnt vmcnt(0)" ::: "memory");
    __syncthreads();
    volatile LAS int* w = (volatile LAS int*)(F.lds + LDSCTL_OFF + 128);
    const bool t0 = (b.wave == 0 && mk_lane() == 0);
    if (t0) {
        unsigned* bar = b.bar;
        __builtin_amdgcn_s_waitcnt(0);
        unsigned nloc = b.st[0], nx = b.st[1];
        if (nloc == 0u) { xcd_barrier_complete(bar, b.x, nloc, nx); b.st[0] = nloc; b.st[1] = nx; }
        const unsigned old = xb_add(&bar[XB_XSUB(b.x)], 1u);
        const unsigned gen = old / nloc;
        if (old + 1u == (gen + 1u) * nloc) {
            __builtin_amdgcn_fence(__ATOMIC_RELEASE, "agent");
            asm volatile("s_waitcnt vmcnt(0)" ::: "memory");
            const unsigned og = xb_add(&bar[XB_TOP], 1u);
            const unsigned tg = og / nx;
            if (og + 1u == (tg + 1u) * nx) xb_add(&bar[XB_TOPGEN], 1u);
            else XB_SPIN(xb_ld(&bar[XB_TOPGEN]) == tg, bar);
            __builtin_amdgcn_fence(__ATOMIC_ACQUIRE, "agent");
            xb_add(&bar[XB_XGEN(b.x)], 1u);
            asm volatile("s_waitcnt vmcnt(0)" ::: "memory");
            w[1] = 1;
        } else { w[1] = 0; w[2] = (int)gen; }
    }
    __syncthreads();
    if (w[1] == 0) {
        for (unsigned it = 0;; ++it) {
            if (t0) { unsigned* bar = b.bar; int rel = xb_ld(&bar[XB_XGEN(b.x)]) != (unsigned)w[2];
                if (!rel && (it & 63u) == 63u) { if (xb_ld(&bar[XB_TMO])) rel = 1; else if (it > (1u << 17)) { atomicAdd(&bar[XB_TMO], 1u); rel = 1; } }
                w[4 + (it & 1u)] = rel; }
            __syncthreads();
            if (w[4 + (it & 1u)]) break;
            if (!bg_done) { if (bg_round(F) >= BG_ED) bg_done = true; } else __builtin_amdgcn_s_sleep(2);
        }
        if (t0) { __builtin_amdgcn_fence(__ATOMIC_ACQUIRE, "agent"); asm volatile("s_waitcnt vmcnt(0)" ::: "memory"); }
    }
    __syncthreads();
}
#endif

__device__ __forceinline__ void ln_load(const float* row, int lane, f32x4 (&v)[8]) { const GAS f32x4* xr = (const GAS f32x4*)row + lane;
#pragma unroll
    for (int j = 0; j < 8; ++j) v[j] = __builtin_nontemporal_load(xr + 64 * j); }
__device__ __forceinline__ void ln_load16(const bf16* row, int lane, f32x4 (&v)[8]) { const GAS unsigned long long* xr = (const GAS unsigned long long*)row + lane;
#pragma unroll
    for (int j = 0; j < 8; ++j) { const unsigned long long t = __builtin_nontemporal_load(xr + 64 * j); const unsigned lo = (unsigned)t, hi = (unsigned)(t >> 32);
        v[j].x = __uint_as_float(lo << 16); v[j].y = __uint_as_float(lo & 0xffff0000u); v[j].z = __uint_as_float(hi << 16); v[j].w = __uint_as_float(hi & 0xffff0000u); } }
__device__ __forceinline__ void ln_norm(f32x4 (&v)[8], const float* g, const float* b, int lane, float* mean_o = nullptr, float* rstd_o = nullptr) {
    float s = 0.f;
#pragma unroll
    for (int j = 0; j < 8; ++j) s += (v[j].x + v[j].y) + (v[j].z + v[j].w);
    const float mean = wave_sum(s) * (1.f / DM); float s2 = 0.f;
#pragma unroll
    for (int j = 0; j < 8; ++j) { v[j] = v[j] - mean; s2 += (v[j].x * v[j].x + v[j].y * v[j].y) + (v[j].z * v[j].z + v[j].w * v[j].w); }
    const float rstd = 1.f / sqrtf(wave_sum(s2) * (1.f / DM) + LN_EPS);
    if (mean_o) { *mean_o = mean; *rstd_o = rstd; }
    const GAS f32x4* g4 = (const GAS f32x4*)g + lane; const GAS f32x4* b4 = (const GAS f32x4*)b + lane;
#pragma unroll
    for (int j = 0; j < 8; ++j) v[j] = v[j] * rstd * g4[64 * j] + b4[64 * j];
}
__device__ __forceinline__ void ln_store16(const f32x4 (&v)[8], bf16* brow, int lane) {
    GAS unsigned long long* o8 = (GAS unsigned long long*)brow + lane;
#pragma unroll
    for (int j = 0; j < 8; ++j) o8[64 * j] = (unsigned long long)pk2(v[j].x, v[j].y) | ((unsigned long long)pk2(v[j].z, v[j].w) << 32);
}
__device__ __forceinline__ void ln_store(const f32x4 (&v)[8], float* drow, bf16* brow, int lane) {
    GAS f32x4* o4 = (GAS f32x4*)drow + lane;
#pragma unroll
    for (int j = 0; j < 8; ++j) __builtin_nontemporal_store(v[j], o4 + 64 * j);
    if (brow) { GAS unsigned long long* o8 = (GAS unsigned long long*)brow + lane;
#pragma unroll
        for (int j = 0; j < 8; ++j) o8[64 * j] = (unsigned long long)pk2(v[j].x, v[j].y) | ((unsigned long long)pk2(v[j].z, v[j].w) << 32); }
}
__device__ __forceinline__ void ln_store8(const f32x4 (&v)[8], unsigned char* brow, int lane) {
    GAS unsigned* o4 = (GAS unsigned*)brow + lane;
#pragma unroll
    for (int j = 0; j < 8; ++j) { int t = 0; t = __builtin_amdgcn_cvt_pk_fp8_f32(v[j].x, v[j].y, t, false); t = __builtin_amdgcn_cvt_pk_fp8_f32(v[j].z, v[j].w, t, true); o4[64 * j] = (unsigned)t; }
}
template <bool F8 = false> __device__ __forceinline__ void ln_phase(Frame& F, const float* src, void* dstb, const float* g, const float* b) {
    const int lane_ = mk_lane();
    const int gw = blockIdx.x * NWAVES + F.wave, NGW = F.G * NWAVES; float* stats = (float*)(F.ws + WS_STATS);
#define LN_ROW(v, m) do { float mean, rstd; ln_norm(v, g, b, lane_, &mean, &rstd); \
        if (F8) ln_store8(v, (unsigned char*)dstb + (size_t)(m) * DM, lane_); else ln_store16(v, (bf16*)dstb + (size_t)(m) * DM, lane_); \
        if (lane_ == 0) { stats[2 * (m)] = mean; stats[2 * (m) + 1] = rstd; } } while (0)
    for (int base = gw * 16; base < NTOK; base += NGW * 16) {
        f32x4 va[8], vb[8]; ln_load(src + (size_t)base * DM, lane_, va);
        for (int r = 0; r < 16; r += 2) {
            ln_load(src + (size_t)(base + r + 1) * DM, lane_, vb); LN_ROW(va, base + r);
            if (r + 2 < 16) ln_load(src + (size_t)(base + r + 2) * DM, lane_, va);
            LN_ROW(vb, base + r + 1); }
    }
#undef LN_ROW
}

typedef at128::bf16 abf;
typedef at128::BlockRef<abf, abf> ABlk;
template <int PQ> __device__ __forceinline__ ABlk memattn_ref(int L, const abf* Qb, const abf* KVb, abf* Ob) {
    const int tile = L >> 2, h = L & 3, b = tile >> 5; ABlk r;
    r.Q = Qb + (size_t)tile * 256 * PQ + h * 128; r.K = KVb + (size_t)b * NMEM * 2048 + h * 128; r.V = r.K + MEMW; r.O = Ob + (size_t)tile * 256 * DM + h * 128; r.P0 = 1 << 20; return r;
}
template <int PQ> __device__ __forceinline__ void memattn_phase(int G, int wv, char* lds, const abf* Qb, const abf* KVb, abf* Ob) {
    constexpr int total = (NTOK / 256) * 4, W = 1 << 30;
    int L = blockIdx.x; if (L >= total) return;
    ABlk cur = memattn_ref<PQ>(L, Qb, KVb, Ob); at128::Seam<abf> S;
    at128::causal_swa_prime<abf, abf, PQ, 2048, DM>(cur, W, lds, S, wv);
    for (;;) { const bool last = L + G >= total; const ABlk nxt = last ? cur : memattn_ref<PQ>(L + G, Qb, KVb, Ob);
        at128::causal_swa_block<abf, abf, PQ, 2048, DM>(cur, nxt, NMEM, W, lds, S, wv); if (last) break; cur = nxt; L += G; }
}
__device__ __forceinline__ at256::Blk diff_blk(int vh, int qb, const abf* H1, abf* AO) {
    const int b = vh / 12, rem = vh % 12, h = rem >> 1, m = rem & 1; at256::Blk r; const abf* base = H1 + (size_t)b * SEQ * B_IN;
    r.Q = base + (size_t)qb * 256 * B_IN + 3072 + (m * 6 + h) * 128; r.K = base + (m * 6 + h) * 128; r.V = base + 1536 + h * 256;
    r.O = AO + ((size_t)b * SEQ + (size_t)qb * 256) * 3072 + m * 1536 + h * 256; r.P0 = qb * 256; return r;
}
__device__ __forceinline__ void diffattn_phase(int G, int wv, LAS unsigned char* ldsL, const abf* H1, abf* AO) {
    constexpr int NX = 16, total = 48 * NX;
    if (G == 256) {
        const int c = blockIdx.x, x8 = c & 7, j = c >> 3;
        for (int i = 0; i < 3; ++i) { const int vh = 2 * (i * 8 + x8) + (j >> 4), x = j & 15;
            at256::attn_block<B_IN, B_IN, 3072>(diff_blk(vh, x, H1, AO), ldsL, wv);
            at256::attn_block<B_IN, B_IN, 3072>(diff_blk(vh, 31 - x, H1, AO), ldsL, wv); }
    } else {
        for (int L = blockIdx.x; L < total; L += G) { const int vh = L / NX, x = L % NX;
            at256::attn_block<B_IN, B_IN, 3072>(diff_blk(vh, x, H1, AO), ldsL, wv);
            at256::attn_block<B_IN, B_IN, 3072>(diff_blk(vh, 31 - x, H1, AO), ldsL, wv); }
    }
}

__device__ __forceinline__ void sg_phase(Frame& F) {
    const bf16* H0 = (const bf16*)(F.ws + WS_H0); bf16* CC = (bf16*)(F.ws + WS_CONCAT); const bf16* WSB = (const bf16*)(F.ws + WS_WSBF);
    const float* vg = F.in[I_AVG]; const float* vb = F.in[I_AVB]; const float* bsp = F.in[I_ABS];
    const int lane = mk_lane(), wid = F.wave, tid = wid * 64 + lane, r32 = lane & 31, hi = lane >> 5;
    LAS float* stats = (LAS float*)(F.lds + 65536);
    LAS unsigned char* sw = F.lds + 66560 + wid * 8192;
    for (int c = blockIdx.x; c < NTOK / 128; c += F.G) {
        const size_t R0 = (size_t)c * 128;
        for (int r4 = 0; r4 < 16; r4 += 4) {
            v4u w[4][3];
#pragma unroll
            for (int q = 0; q < 4; ++q)
#pragma unroll
                for (int j = 0; j < 3; ++j) w[q][j] = *(const GAS v4u*)(H0 + (R0 + wid * 16 + r4 + q) * A_IN + MAINW + j * 512 + lane * 8);
#pragma unroll
            for (int q = 0; q < 4; ++q) { float x[24];
#pragma unroll
                for (int j = 0; j < 3; ++j) { x[8 * j + 0] = bflo(w[q][j].x); x[8 * j + 1] = bfhi(w[q][j].x); x[8 * j + 2] = bflo(w[q][j].y); x[8 * j + 3] = bfhi(w[q][j].y); x[8 * j + 4] = bflo(w[q][j].z); x[8 * j + 5] = bfhi(w[q][j].z); x[8 * j + 6] = bflo(w[q][j].w); x[8 * j + 7] = bfhi(w[q][j].w); }
                float s = 0.f;
#pragma unroll
                for (int j = 0; j < 24; ++j) s += x[j];
                const float mean = wave_sum(s) * (1.f / MAINW); float qq = 0.f;
#pragma unroll
                for (int j = 0; j < 24; ++j) { const float dd = x[j] - mean; qq += dd * dd; }
                const float rstd = 1.f / sqrtf(wave_sum(qq) * (1.f / MAINW) + LN_EPS);
                if (lane == 0) { const int t = wid * 16 + r4 + q; stats[2 * t] = mean; stats[2 * t + 1] = rstd; } asm volatile("" ::: "memory"); }
        }
        __syncthreads();
        const char* hbase = (const char*)(H0 + R0 * A_IN);
        v4u wst[8];
#define SG_LOADV(gp_) do { unsigned soff = (unsigned)(((tid >> 4) * A_IN + MAINW + (tid & 15) * 8) * 2); asm volatile("" : "+v"(soff)); \
        _Pragma("unroll") for (int i = 0; i < 8; ++i) wst[i] = *(const GAS v4u*)(hbase + (soff + (unsigned)(((((i >> 1) & 1) * 64 + (i & 1) * 32) * A_IN + (2 * (gp_) + (i >> 2)) * 128) * 2))); } while (0)
        SG_LOADV(0);
        for (int gp = 0; gp < NSG / 2; ++gp) {
#pragma unroll
            for (int i = 0; i < 8; ++i) {
                const int p = tid + 512 * i, gsel = p >> 11, kt = (p >> 10) & 1, key = (p >> 4) & 63, c8 = (p & 15) * 8, tok = kt * 64 + key, col = (2 * gp + gsel) * 128 + c8;
                const v4u w = wst[i];
                const float mean = stats[2 * tok], rstd = stats[2 * tok + 1];
                const f32x4 g0 = *(const GAS f32x4*)(vg + col), g1 = *(const GAS f32x4*)(vg + col + 4), b0 = *(const GAS f32x4*)(vb + col), b1 = *(const GAS f32x4*)(vb + col + 4);
                v4u o;
                o.x = pg8::cvt_pk_bf16((bflo(w.x) - mean) * rstd * g0.x + b0.x, (bfhi(w.x) - mean) * rstd * g0.y + b0.y);
                o.y = pg8::cvt_pk_bf16((bflo(w.y) - mean) * rstd * g0.z + b0.z, (bfhi(w.y) - mean) * rstd * g0.w + b0.w);
                o.z = pg8::cvt_pk_bf16((bflo(w.z) - mean) * rstd * g1.x + b1.x, (bfhi(w.z) - mean) * rstd * g1.y + b1.y);
                o.w = pg8::cvt_pk_bf16((bflo(w.w) - mean) * rstd * g1.z + b1.z, (bfhi(w.w) - mean) * rstd * g1.w + b1.w);
                *(LAS v4u*)(F.lds + (gsel * 2 + kt) * 16384 + at128::v_st(key, c8)) = o;
            }
            __syncthreads();
            if (gp + 1 < NSG / 2) SG_LOADV(gp + 1);
            { const int gsel = wid >> 2, tb = wid & 3, g = 2 * gp + gsel;
              const int er = lane >> 4, ec = (lane & 15) * 8; v4u uu[8];
              unsigned uoff = (unsigned)(((tb * 32 + er) * A_IN + g * 128 + ec) * 2); asm volatile("" : "+v"(uoff));
#pragma unroll
              for (int j = 0; j < 8; ++j) uu[j] = __builtin_nontemporal_load((const GAS v4u*)(hbase + (uoff + (unsigned)(4 * j * A_IN * 2))));
              at128::f32x16 o[4] = {};
              const int vb0 = (int)(unsigned long)(F.lds) + gsel * 32768 + at128::v_rd_base(lane);
              const bf16* wrow = WSB + ((size_t)g * 128 + tb * 32 + r32) * 128 + hi * 8;
              { const at128::bf16x8 pa0 = *(const GAS at128::bf16x8*)(wrow), pa1 = *(const GAS at128::bf16x8*)(wrow + 16), pa2 = *(const GAS at128::bf16x8*)(wrow + 32), pa3 = *(const GAS at128::bf16x8*)(wrow + 48);
                at128::pv_tile<0, false>(o, vb0, pa0, pa1, pa2, pa3, true); }
              if (tb >= 2) { const at128::bf16x8 pa0 = *(const GAS at128::bf16x8*)(wrow + 64), pa1 = *(const GAS at128::bf16x8*)(wrow + 80), pa2 = *(const GAS at128::bf16x8*)(wrow + 96), pa3 = *(const GAS at128::bf16x8*)(wrow + 112);
                at128::pv_tile<1, false>(o, vb0, pa0, pa1, pa2, pa3, true); }
#pragma unroll
              for (int r = 0; r < 16; ++r) { const int t = at128::crow(r, hi); const float bsv = bsp[g * 128 + tb * 32 + t];
#pragma unroll
                  for (int d0 = 0; d0 < 4; ++d0) { const float val = o[d0][r] + bsv; const float vn = __shfl_xor(val, 1);
                      if ((r32 & 1) == 0) *(LAS unsigned*)(sw + t * 256 + (d0 * 32 + r32) * 2) = pg8::cvt_pk_bf16(val, vn); } }
              char* cbase = (char*)(CC + R0 * DM); unsigned coff = (unsigned)(((tb * 32 + er) * DM + g * 128 + ec) * 2); asm volatile("" : "+v"(coff));
              LDS_WAIT(); asm volatile("" ::: "memory");
#pragma unroll
              for (int j = 0; j < 8; ++j) { const v4u sv = *(const LAS v4u*)(sw + (er + 4 * j) * 256 + ec * 2); v4u ov;
                  ov.x = pg8::cvt_pk_bf16(bflo(sv.x) * bflo(uu[j].x), bfhi(sv.x) * bfhi(uu[j].x)); ov.y = pg8::cvt_pk_bf16(bflo(sv.y) * bflo(uu[j].y), bfhi(sv.y) * bfhi(uu[j].y));
                  ov.z = pg8::cvt_pk_bf16(bflo(sv.z) * bflo(uu[j].z), bfhi(sv.z) * bfhi(uu[j].z)); ov.w = pg8::cvt_pk_bf16(bflo(sv.w) * bflo(uu[j].w), bfhi(sv.w) * bfhi(uu[j].w));
                  *(GAS v4u*)(cbase + (coff + (unsigned)(4 * j * DM * 2))) = ov; asm volatile("" ::: "memory"); }
            }
            __syncthreads();
        }
    }
#undef SG_LOADV
}

__device__ __forceinline__ void combine_phase(Frame& F) {
    const bf16* AO = (const bf16*)(F.ws + WS_AO); bf16* CC = (bf16*)(F.ws + WS_CONCAT1);
    const int lane = mk_lane(), gw = blockIdx.x * NWAVES + F.wave, NGW = F.G * NWAVES;
    const float* q1 = F.in[I_LQ1]; const float* k1 = F.in[I_LK1]; const float* q2 = F.in[I_LQ2]; const float* k2 = F.in[I_LK2];
    const float s1 = wave_sum(q1[lane] * k1[lane] + q1[lane + 64] * k1[lane + 64]), s2 = wave_sum(q2[lane] * k2[lane] + q2[lane + 64] * k2[lane + 64]);
    const float lam = expf(s1) - expf(s2) + LAMBDA_INIT, post = 1.0f - LAMBDA_INIT;
    const f32x4 g4 = *(const GAS f32x4*)(F.in[I_SUBLN] + 4 * lane);
#define CB_LOAD(av, bv, m0_) do { _Pragma("unroll") for (int t = 0; t < 2; ++t) { const bf16* r1 = AO + (size_t)((m0_) + t) * 3072 + 4 * lane; \
        _Pragma("unroll") for (int h = 0; h < 6; ++h) { av[t][h] = __builtin_nontemporal_load((const GAS unsigned long long*)(r1 + h * 256)); bv[t][h] = __builtin_nontemporal_load((const GAS unsigned long long*)(r1 + 1536 + h * 256)); } } } while (0)
#define CB_DO(av, bv, m0_) do { _Pragma("unroll") for (int t = 0; t < 2; ++t) { bf16* orow = CC + (size_t)((m0_) + t) * DM + 4 * lane; \
        _Pragma("unroll") for (int h = 0; h < 6; ++h) { \
            const unsigned a0 = (unsigned)av[t][h], a1 = (unsigned)(av[t][h] >> 32), b0 = (unsigned)bv[t][h], b1 = (unsigned)(bv[t][h] >> 32); \
            const float x0 = bflo(a0) - lam * bflo(b0), x1 = bfhi(a0) - lam * bfhi(b0), x2 = bflo(a1) - lam * bflo(b1), x3 = bfhi(a1) - lam * bfhi(b1); \
            const float ss = wave_sum((x0 * x0 + x1 * x1) + (x2 * x2 + x3 * x3)); \
            const float r = post / sqrtf(ss * (1.f / 256.f) + LN_EPS); \
            *(GAS unsigned long long*)(orow + h * 256) = (unsigned long long)pg8::cvt_pk_bf16(x0 * r * g4.x, x1 * r * g4.y) | ((unsigned long long)pg8::cvt_pk_bf16(x2 * r * g4.z, x3 * r * g4.w) << 32); } } } while (0)
    const int step = NGW * 2; int m0 = gw * 2;
    if (m0 < NTOK) {
        unsigned long long a_[2][6], b_[2][6], c_[2][6], d_[2][6];
        CB_LOAD(a_, b_, m0);
        for (;;) {
            const int m1 = m0 + step; if (m1 < NTOK) CB_LOAD(c_, d_, m1);
            CB_DO(a_, b_, m0); if (m1 >= NTOK) break;
            const int m2 = m1 + step; if (m2 < NTOK) CB_LOAD(a_, b_, m2);
            CB_DO(c_, d_, m1); if (m2 >= NTOK) break;
            m0 = m2; }
    }
#undef CB_LOAD
#undef CB_DO
}

__device__ __forceinline__ void router_row(f32x4 (&v)[8], int m, int lane, const float* g, const float* b, bf16* xb, const LAS float* wr, int* route_e, float* route_w, int& cnt) {
            ln_norm(v, g, b, lane);
#if MK_FP8_MOE
            ln_store8(v, (unsigned char*)xb + (size_t)m * DM, lane);
#else
            ln_store16(v, xb + (size_t)m * DM, lane);
#endif
            float lg[8];
#pragma unroll
            for (int e = 0; e < 8; ++e) lg[e] = 0.f;
#pragma unroll
            for (int j = 0; j < 8; ++j) {
#pragma unroll
                for (int e = 0; e < 8; ++e) { const f32x4 w = *(const LAS f32x4*)(wr + e * DM + 256 * j + 4 * lane); lg[e] += (v[j].x * w.x + v[j].y * w.y) + (v[j].z * w.z + v[j].w * w.w); }
                asm volatile("" ::: "memory"); }
#pragma unroll
            for (int e = 0; e < 8; ++e) lg[e] = wave_sum(lg[e]);
            int e0 = 0; float l0 = lg[0];
#pragma unroll
            for (int e = 1; e < 8; ++e) if (lg[e] > l0) { l0 = lg[e]; e0 = e; }
            int e1 = -1; float l1 = -3.0e38f;
#pragma unroll
            for (int e = 0; e < 8; ++e) if (e != e0 && lg[e] > l1) { l1 = lg[e]; e1 = e; }
            const float ex = expf(l1 - l0), w0 = 1.0f / (1.0f + ex), w1 = ex / (1.0f + ex);
            if (lane == 0) { route_e[m] = e0 | (e1 << 8); route_w[2 * m] = w0; route_w[2 * m + 1] = w1; }
            cnt += (lane == e0) + (lane == e1);
}
__device__ __forceinline__ void ln_router_phase(Frame& F, const bf16* xio, bf16* xb, const float* g, const float* b) {
    LAS float* wr = (LAS float*)(F.lds);
    const float* wsrc = F.in[I_ROUTER];
    const int lane = mk_lane();
    for (int i = F.wave * 64 + lane; i < DM * NEXP; i += NWAVES * 64) wr[(i & 7) * DM + (i >> 3)] = wsrc[i];
    __syncthreads();
    int* route_e = (int*)(F.ws + WS_ROUTE_E); float* route_w = (float*)(F.ws + WS_ROUTE_W); int* hist = (int*)(F.ws + WS_HIST);
    const int gw = blockIdx.x * NWAVES + F.wave, NGW = F.G * NWAVES;
    for (int grp = gw; grp < NTOK / 16; grp += NGW) {
        int cnt = 0;
        f32x4 va[8], vb[8]; ln_load16(xio + (size_t)(grp * 16) * DM, lane, va);
        for (int r = 0; r < 16; r += 2) {
            ln_load16(xio + (size_t)(grp * 16 + r + 1) * DM, lane, vb); router_row(va, grp * 16 + r, lane, g, b, xb, wr, route_e, route_w, cnt);
            if (r + 2 < 16) ln_load16(xio + (size_t)(grp * 16 + r + 2) * DM, lane, va);
            router_row(vb, grp * 16 + r + 1, lane, g, b, xb, wr, route_e, route_w, cnt); }
        if (lane < 8) hist[grp * 8 + lane] = cnt;
    }
}

__device__ __forceinline__ void dispatch_phase(Frame& F) {
    LAS int* gpre = (LAS int*)(F.lds);
    LAS int* wtot = (LAS int*)(F.lds + 65536);
    LAS int* tst = (LAS int*)(F.lds + 65536 + 256);
    const int* hist = (const int*)(F.ws + WS_HIST); const int lane = mk_lane(), wid = F.wave, tid = wid * 64 + lane;
    int h[4][8], sum[8];
#pragma unroll
    for (int e = 0; e < 8; ++e) sum[e] = 0;
#pragma unroll
    for (int i = 0; i < 4; ++i) { const v4u a = *(const GAS v4u*)(hist + (4 * tid + i) * 8), b = *(const GAS v4u*)(hist + (4 * tid + i) * 8 + 4);
        h[i][0] = a.x; h[i][1] = a.y; h[i][2] = a.z; h[i][3] = a.w; h[i][4] = b.x; h[i][5] = b.y; h[i][6] = b.z; h[i][7] = b.w;
#pragma unroll
        for (int e = 0; e < 8; ++e) sum[e] += h[i][e]; }
    int inc[8];
#pragma unroll
    for (int e = 0; e < 8; ++e) { int v = sum[e];
#pragma unroll
        for (int o = 1; o < 64; o <<= 1) { const int t = __shfl_up(v, o); if (lane >= o) v += t; }
        inc[e] = v; if (lane == 63) wtot[wid * 8 + e] = v; }
    __syncthreads();
    int tot[8];
#pragma unroll
    for (int e = 0; e < 8; ++e) { int pre = 0, all = 0;
#pragma unroll
        for (int w = 0; w < 8; ++w) { const int t = wtot[w * 8 + e]; all += t; if (w < wid) pre += t; }
        tot[e] = all; int run = pre + inc[e] - sum[e];
#pragma unroll
        for (int i = 0; i < 4; ++i) { gpre[(4 * tid + i) * 8 + e] = run; run += h[i][e]; } }
    if (tid == 0) { int ts = 0;
#pragma unroll
        for (int e = 0; e < 8; ++e) { tst[e] = ts; ts += (tot[e] + 255) >> 8; } tst[8] = ts;
        if (blockIdx.x == 0) { int* tab = (int*)(F.ws + WS_MOETAB);
#pragma unroll
            for (int e = 0; e <= 8; ++e) tab[e] = tst[e]; } }
    __syncthreads();
    const int* route_e = (const int*)(F.ws + WS_ROUTE_E); const float* route_w = (const float*)(F.ws + WS_ROUTE_W);
    int* tokslot = (int*)(F.ws + WS_TOKSLOT); int* slottok = (int*)(F.ws + WS_SLOTTOK); float* slotgate = (float*)(F.ws + WS_SLOTGATE);
    const bf16* X3B = (const bf16*)(F.ws + WS_X3B); bf16* XS = (bf16*)(F.ws + WS_XS);
    const int gw = blockIdx.x * NWAVES + wid, NGW = F.G * NWAVES;
    for (int grp = gw; grp < NTOK / 16; grp += NGW) {
        const int a = lane & 31, tok = grp * 16 + (a >> 1), k = a & 1;
        const int e = (route_e[tok] >> (8 * k)) & 0xff; const float w = route_w[2 * tok + k];
        int rank = 0;
#pragma unroll
        for (int ee = 0; ee < 8; ++ee) { const unsigned long long mk = __ballot(lane < 32 && e == ee); if (e == ee) rank = __popcll(mk & ((1ull << lane) - 1ull)); }
        const int slot = tst[e] * 256 + gpre[grp * 8 + e] + rank;
        if (lane < 32) { slottok[slot] = tok; slotgate[slot] = w; tokslot[2 * tok + k] = slot; }
        for (int q4 = 0; q4 < 32; q4 += 4) {
#if MK_FP8_MOE
            v4u t_[4][2]; int sl[4];
#pragma unroll
            for (int u = 0; u < 4; ++u) { const int q = q4 + u; sl[u] = __shfl(slot, q); const int tk = grp * 16 + (q >> 1); const GAS v4u* src = (const GAS v4u*)((const unsigned char*)X3B + (size_t)tk * DM) + lane; t_[u][0] = src[0]; t_[u][1] = src[64]; }
#pragma unroll
            for (int u = 0; u < 4; ++u) { GAS v4u* dst = (GAS v4u*)((unsigned char*)XS + (size_t)sl[u] * DM) + lane; dst[0] = t_[u][0]; dst[64] = t_[u][1]; }
#else
            v4u t_[4][4]; int sl[4];
#pragma unroll
            for (int u = 0; u < 4; ++u) { const int q = q4 + u; sl[u] = __shfl(slot, q); const int tk = grp * 16 + (q >> 1); const GAS v4u* src = (const GAS v4u*)(X3B + (size_t)tk * DM) + lane;
#pragma unroll
                for (int j = 0; j < 4; ++j) t_[u][j] = src[64 * j]; }
#pragma unroll
            for (int u = 0; u < 4; ++u) { GAS v4u* dst = (GAS v4u*)(XS + (size_t)sl[u] * DM) + lane;
#pragma unroll
                for (int j = 0; j < 4; ++j) dst[64 * j] = t_[u][j]; }
#endif
        }
    }
}

__device__ __forceinline__ void add_os_row(f32x4 (&v)[8], const bf16* row, int lane) { const GAS unsigned long long* o = (const GAS unsigned long long*)row + lane;
#pragma unroll
    for (int j = 0; j < 8; ++j) { const unsigned long long p = __builtin_nontemporal_load(o + 64 * j); const unsigned p0 = (unsigned)p, p1 = (unsigned)(p >> 32); v[j].x += bflo(p0); v[j].y += bfhi(p0); v[j].z += bflo(p1); v[j].w += bfhi(p1); } }
__device__ __forceinline__ void final_phase(Frame& F, const float* g3, const float* b3, const float* g, const float* b) {
    const int* tokslot = (const int*)(F.ws + WS_TOKSLOT); const bf16* OS = (const bf16*)(F.ws + WS_OS); const bf16* OSK = (const bf16*)(F.ws + WS_OSK);
    const bf16* Y3 = (const bf16*)(F.ws + WS_Y3B);
    const int gw = blockIdx.x * NWAVES + F.wave, NGW = F.G * NWAVES, lane = mk_lane();
    int Tm = 1 << 30;
#if MK_FP8_MOE
    { const int T = ((const int*)(F.ws + WS_MOETAB))[8]; int Lt = T & 31; if (Lt > 8) Lt = 0; Tm = T - Lt; }
#endif
#define FIN_ROW(v, m, s0, s1) do { ln_norm(v, g3, b3, lane);     \
        _Pragma("unroll") for (int j = 0; j < 8; ++j) v[j] = v[j] * ALPHA; \
        { const int sl_[2] = {s0, s1}; _Pragma("unroll") for (int k = 0; k < 2; ++k) { const int s = sl_[k], tile = s >> 8; \
            if (tile >= Tm) { for (int q = 0; q < 4; ++q) add_os_row(v, OSK + ((size_t)(q * 8 + tile - Tm) * 256 + (s & 255)) * DM, lane); } \
            else add_os_row(v, OS + (size_t)s * DM, lane); } } \
        ln_norm(v, g, b, lane); ln_store(v, F.out + (size_t)(m) * DM, nullptr, lane); } while (0)
    for (int base = gw * 16; base < NTOK; base += NGW * 16) {
        f32x4 va[8], vb[8]; ln_load16(Y3 + (size_t)base * DM, lane, va); int a0 = tokslot[2 * base], a1 = tokslot[2 * base + 1], b0 = 0, b1 = 0;
        for (int r = 0; r < 16; r += 2) { const int m = base + r;
            ln_load16(Y3 + (size_t)(m + 1) * DM, lane, vb); b0 = tokslot[2 * (m + 1)]; b1 = tokslot[2 * (m + 1) + 1];
            FIN_ROW(va, m, a0, a1);
            if (r + 2 < 16) { ln_load16(Y3 + (size_t)(m + 2) * DM, lane, va); a0 = tokslot[2 * (m + 2)]; a1 = tokslot[2 * (m + 2) + 1]; }
            FIN_ROW(vb, m + 1, b0, b1); }
    }
#undef FIN_ROW
}

struct Args { const float* in[25]; float* out; unsigned char* ws; int ph_lo, ph_hi, ch_lo, ch_hi; };
__global__ void __launch_bounds__(NWAVES * 64, 2) mk_fwd(Args args) {
    extern __shared__ __attribute__((aligned(16))) unsigned char lds[];
    Frame F;
    F.lds = (LAS unsigned char*)lds; F.MISC = (volatile LAS unsigned*)(F.lds + MISC_OFF);
    F.wave = __builtin_amdgcn_readfirstlane(threadIdx.x >> 6); F.G = gridDim.x;
    F.ws = args.ws; F.ctl = (gu32*)(args.ws + WS_CTL); F.out = args.out;
#pragma unroll
    for (int i = 0; i < 25; ++i) F.in[i] = args.in[i];
    for (int u = threadIdx.x; u < (LDS_BYTES - LDSCTL_OFF) / 4; u += NWAVES * 64) ((LAS unsigned*)(F.lds + LDSCTL_OFF))[u] = 0u;
    __syncthreads();
    const int lo = args.ph_lo, hi = args.ph_hi;
    XcdBarrier bar; bar.bar = (unsigned*)(F.ctl + CW_BAR); bar.x = 0; bar.st = nullptr; bar.wave = F.wave;
    if (hi - lo > 1) { bar = xcd_barrier_post((unsigned*)(F.ctl + CW_BAR), F.MISC + 8); bar.wave = F.wave; }
#define IN(k) (((MK_PHMASK >> (k)) & 1) && lo <= (k) && (k) < hi)
#define BOTH(k) (IN(k) && IN((k) + 1))
#if MK_BG
    bool bg_done_ = false;
#define XCD_BAR_CALL() xcd_barrier_bg(bar, F, bg_done_)
#else
#define XCD_BAR_CALL() xcd_barrier(bar)
#endif
#if MK_PROBE == 3
    unsigned long long bar_wait_ = 0;
#define BG_DRAIN(X) do { const unsigned long long t0_ = rt(); bg_drain(F, X); bar_wait_ += rt() - t0_; } while (0)
#else
#define BG_DRAIN(X) bg_drain(F, X)
#endif
#if MK_PROBE == 2
    unsigned long long bar_wait_ = 0;
    int bar_idx_ = 0;
#define GRID_BAR() do { const unsigned long long t0_ = rt(); XCD_BAR_CALL(); if ((MK_PROBE_BARMASK >> bar_idx_) & 1) bar_wait_ += rt() - t0_; ++bar_idx_; } while (0)
#else
#define GRID_BAR() XCD_BAR_CALL()
#endif
#if MK_PROBE
    if (blockIdx.x == 0 && F.wave == 0 && mk_lane() == 0) __hip_atomic_store(F.ctl + CW_TS, (unsigned)rt(), RLX_AGENT);
#define STAMP(k) do { if (blockIdx.x == 0 && F.wave == 0 && mk_lane() == 0) __hip_atomic_store(F.ctl + CW_TS + 1 + (k), (unsigned)rt(), RLX_AGENT); } while (0)
#else
#define STAMP(k) do { } while (0)
#endif
    unsigned char* ws = args.ws;
    bf16* XB = (bf16*)(ws + WS_XB);
    LAS unsigned char* ring = F.lds + RING_OFF;

    if (IN(0)) { p0_prologue(F); if (BOTH(0)) GRID_BAR(); STAMP(0); }
    if (IN(1)) {
        { pg8::Gemm g{XB, (const bf16*)(ws + WS_W_A_IN), NTOK, A_IN, DM}; pg8::StaticOrder S; S.init(NTOK, A_IN, F.G, (int)blockIdx.x);
          pg8::EpiBf16 E{(bf16*)(ws + WS_H0), A_IN, 2 * MAINW}; pg8::gemm_phase<pg8::EpiBf16, pg8::StaticOrder, true, true>(ring, g, S, E, F.wave); }
        { pg8::Gemm g{(const bf16*)(ws + WS_MEMB), (const bf16*)(ws + WS_W_MEMKV), NBATCH * NMEM, 2048, DM}; pg8::StaticOrder S; S.init(NBATCH * NMEM, 2048, F.G, (int)blockIdx.x);
          pg8::EpiBf16 E{(bf16*)(ws + WS_MEMKV), 2048, 0}; pg8::gemm_phase<pg8::EpiBf16, pg8::StaticOrder, true, true>(ring, g, S, E, F.wave); }
        if (BOTH(1)) GRID_BAR(); STAMP(1);
    }
    if (IN(2)) {
        memattn_phase<A_IN>(F.G, F.wave, (char*)lds + RING_OFF, (const abf*)(ws + WS_H0) + 2 * MAINW, (const abf*)(ws + WS_MEMKV), (abf*)(ws + WS_CONCAT) + MAINW);
        __syncthreads();
        sg_phase(F);
        if (BOTH(2)) GRID_BAR(); STAMP(2);
    }
    if (IN(3)) {
        pg8::Gemm g{(const bf16*)(ws + WS_CONCAT), (const bf16*)(ws + WS_W_MIX), NTOK, DM, DM}; pg8::StaticOrder S; S.init(NTOK, DM, F.G, (int)blockIdx.x);
        pg8::EpiRes E{F.in[I_X], F.out, DM, ALPHA}; pg8::gemm_phase<pg8::EpiRes, pg8::StaticOrder, true, true>(ring, g, S, E, F.wave);
        if (BOTH(3)) GRID_BAR(); STAMP(3);
    }
    if (IN(4)) { ln_phase<MK_FP8_FFN != 0>(F, F.out, XB, F.in[I_LNG] + 0 * DM, F.in[I_LNB] + 0 * DM);
#if MK_BG
        BG_DRAIN(BG_EA1);
#endif
        if (BOTH(4)) GRID_BAR(); STAMP(4); }
    if (IN(5)) {
        pg8::StaticOrder S; S.init(NTOK, 2 * FF, F.G, (int)blockIdx.x);
#if MK_FP8_FFN
        pg8::Gemm g{XB, (const bf16*)(ws + WS_W_FFN_GU), NTOK, 2 * FF, DM / 2};
        pg8::EpiSwiglu8<false> E{ws + WS_HID, FF}; pg8::gemm_phase<pg8::EpiSwiglu8<false>, pg8::StaticOrder, true, true, SC_ONE, SC_M6>(ring, g, S, E, F.wave);
#else
        pg8::Gemm g{XB, (const bf16*)(ws + WS_W_FFN_GU), NTOK, 2 * FF, DM};
        pg8::EpiSwiglu E{(bf16*)(ws + WS_HID), FF}; pg8::gemm_phase<pg8::EpiSwiglu, pg8::StaticOrder, true, true>(ring, g, S, E, F.wave);
#endif
#if MK_BG
        BG_DRAIN(BG_EA);
#endif
        if (BOTH(5)) GRID_BAR(); STAMP(5);
    }
    if (IN(6)) {
        pg8::StaticOrder S; S.init(NTOK, DM, F.G, (int)blockIdx.x); pg8::EpiResLn E{F.out, (const float*)(ws + WS_STATS), F.in[I_LNG] + 0 * DM, F.in[I_LNB] + 0 * DM};
#if MK_FP8_FFN
        pg8::Gemm g{(const bf16*)(ws + WS_HID), (const bf16*)(ws + WS_W_FFN_D), NTOK, DM, FF / 2};
        pg8::gemm_phase<pg8::EpiResLn, pg8::StaticOrder, true, true, SC_M4, SC_M7>(ring, g, S, E, F.wave);
#else
        pg8::Gemm g{(const bf16*)(ws + WS_HID), (const bf16*)(ws + WS_W_FFN_D), NTOK, DM, FF};
        pg8::gemm_phase<pg8::EpiResLn, pg8::StaticOrder, true, true>(ring, g, S, E, F.wave);
#endif
        if (BOTH(6)) GRID_BAR(); STAMP(6);
    }
    if (IN(7)) { ln_phase<false>(F, F.out, XB, F.in[I_LNG] + 1 * DM, F.in[I_LNB] + 1 * DM);
#if MK_BG
        BG_DRAIN(BG_EB);
#endif
        if (BOTH(7)) GRID_BAR(); STAMP(7); }
    if (IN(8)) {
        pg8::Gemm g{XB, (const bf16*)(ws + WS_W_B_IN), NTOK, B_IN, DM}; pg8::StaticOrder S; S.init(NTOK, B_IN, F.G, (int)blockIdx.x);
        pg8::EpiBf16 E{(bf16*)(ws + WS_H1), B_IN, 0}; pg8::gemm_phase<pg8::EpiBf16, pg8::StaticOrder, true, true>(ring, g, S, E, F.wave);
        if (BOTH(8)) GRID_BAR(); STAMP(8);
    }
    if (IN(9)) { diffattn_phase(F.G, F.wave, F.lds + RING_OFF, (const abf*)(ws + WS_H1), (abf*)(ws + WS_AO)); if (BOTH(9)) GRID_BAR(); STAMP(9); }
    if (IN(10)) {
        memattn_phase<B_IN>(F.G, F.wave, (char*)lds + RING_OFF, (const abf*)(ws + WS_H1) + 4608, (const abf*)(ws + WS_MEMKV) + 1024, (abf*)(ws + WS_CONCAT1) + MAINW);
        combine_phase(F);
#if MK_BG
        __syncthreads(); BG_DRAIN(BG_EC);
#endif
        if (BOTH(10)) GRID_BAR(); STAMP(10);
    }
    if (IN(11)) {
        pg8::Gemm g{(const bf16*)(ws + WS_CONCAT1), (const bf16*)(ws + WS_W_MIX) + (size_t)DM * DM, NTOK, DM, DM}; pg8::StaticOrder S; S.init(NTOK, DM, F.G, (int)blockIdx.x);
        pg8::EpiResLn16 E{F.out, (bf16*)(ws + WS_Y3B), (const float*)(ws + WS_STATS), F.in[I_LNG] + 1 * DM, F.in[I_LNB] + 1 * DM}; pg8::gemm_phase<pg8::EpiResLn16, pg8::StaticOrder, true, true>(ring, g, S, E, F.wave);
        if (BOTH(11)) GRID_BAR(); STAMP(11);
    }
    if (IN(12)) { ln_router_phase(F, (const bf16*)(ws + WS_Y3B), (bf16*)(ws + WS_X3B), F.in[I_LNG] + 2 * DM, F.in[I_LNB] + 2 * DM); if (BOTH(12)) GRID_BAR(); STAMP(12); }
    if (IN(13)) { dispatch_phase(F);
#if MK_BG
        __syncthreads(); BG_DRAIN(BG_ED1);
#endif
        if (BOTH(13)) GRID_BAR(); STAMP(13); }
    if (IN(14) || IN(15)) {
        LAS int* tst = (LAS int*)(F.lds + LDSCTL_OFF);
        { const int t_ = F.wave * 64 + mk_lane(); if (t_ < 9) tst[t_] = ((const int*)(ws + WS_MOETAB))[t_]; }
        __syncthreads();
        const int T = tst[8];
        for (int ch = args.ch_lo; ch < args.ch_hi; ++ch) {
            const int t0 = ch * MOE_CHUNK_T; int nM = T - t0; nM = nM < 0 ? 0 : (nM > MOE_CHUNK_T ? MOE_CHUNK_T : nM);
            if (IN(14)) {
                pg8::MoeOrder<false> S; S.nM = nM; S.nN = 2 * FFE / 256; S.nwg = nM * S.nN; S.G = F.G; S.c = (int)blockIdx.x; S.t0 = t0; S.tstart = tst;
#if MK_FP8_MOE
                pg8::Gemm g{(const bf16*)(ws + WS_XS), (const bf16*)(ws + WS_W_MOE_GU), 0, 2 * FFE, DM / 2};
                pg8::EpiSwiglu8<false> E{ws + WS_HIDM, FFE}; pg8::gemm_phase<pg8::EpiSwiglu8<false>, pg8::MoeOrder<false>, true, true, SC_ONE, SC_M6>(ring, g, S, E, F.wave);
#else
                pg8::Gemm g{(const bf16*)(ws + WS_XS), (const bf16*)(ws + WS_W_MOE_GU), 0, 2 * FFE, DM};
                pg8::EpiSwiglu E{(bf16*)(ws + WS_HIDM), FFE}; pg8::gemm_phase<pg8::EpiSwiglu, pg8::MoeOrder<false>, true, true>(ring, g, S, E, F.wave);
#endif
#if MK_BG
                BG_DRAIN(BG_ED);
#endif
                if (IN(15)) GRID_BAR(); STAMP(14);
            }
            if (IN(15)) {
                pg8::EpiRowScale E{(bf16*)(ws + WS_OS), DM, (const float*)(ws + WS_SLOTGATE)};
#if MK_FP8_MOE
                int Lt = T & 31; if (Lt > 8) Lt = 0; const int Tm = T - Lt;
                { pg8::MoeOrder<true> S; S.nM = Tm; S.nN = DM / 256; S.nwg = Tm * S.nN; S.G = F.G; S.c = (int)blockIdx.x; S.t0 = 0; S.tstart = tst;
                  pg8::Gemm g{(const bf16*)(ws + WS_HIDM), (const bf16*)(ws + WS_W_MOE_D), 0, DM, FFE / 2, 0};
                  pg8::gemm_phase<pg8::EpiRowScale, pg8::MoeOrder<true>, true, true, SC_M4, SC_M7>(ring, g, S, E, F.wave); }
                { pg8::MoeLeftOrder S; S.L = Lt; S.G = F.G; S.c = (int)blockIdx.x; S.tl0 = Tm; S.kq = FFE / 4; S.tstart = tst;
                  pg8::Gemm g{(const bf16*)(ws + WS_HIDM), (const bf16*)(ws + WS_W_MOE_D), 0, DM, FFE / 2, FFE / 8};
                  pg8::EpiRowScale E2{(bf16*)(ws + WS_OSK), DM, (const float*)(ws + WS_SLOTGATE)};
                  pg8::gemm_phase<pg8::EpiRowScale, pg8::MoeLeftOrder, true, true, SC_M4, SC_M7>(ring, g, S, E2, F.wave); }
#else
                pg8::MoeOrder<true> S; S.nM = nM; S.nN = DM / 256; S.nwg = nM * S.nN; S.G = F.G; S.c = (int)blockIdx.x; S.t0 = t0; S.tstart = tst;
                pg8::Gemm g{(const bf16*)(ws + WS_HIDM), (const bf16*)(ws + WS_W_MOE_D), 0, DM, FFE, 0};
                pg8::gemm_phase<pg8::EpiRowScale, pg8::MoeOrder<true>, true, true>(ring, g, S, E, F.wave);
#endif
                if (ch + 1 < args.ch_hi ? IN(14) : IN(16)) GRID_BAR(); STAMP(15);
            }
        }
    }
    if (IN(16)) final_phase(F, F.in[I_LNG] + 2 * DM, F.in[I_LNB] + 2 * DM, F.in[I_LNG] + 3 * DM, F.in[I_LNB] + 3 * DM);
#if MK_PROBE
#if MK_PROBE == 2 || MK_PROBE == 3
    if (blockIdx.x == MK_PROBE_BLK && F.wave == 0 && mk_lane() == 0) { const unsigned long long t0 = rt(), target = bar_wait_ * MK_PROBE_MULT; while (rt() - t0 < target) __builtin_amdgcn_s_sleep(32); }
#else
    STAMP(16);
    if (blockIdx.x == 0 && F.wave == 0 && mk_lane() == 0) {
        unsigned ta = 0;
        for (int k = 0; k < 17; ++k) { const unsigned d = __hip_atomic_load(F.ctl + CW_TS + 1 + k, RLX_AGENT) - __hip_atomic_load(F.ctl + CW_TS + k, RLX_AGENT); if ((MK_PROBE_A >> k) & 1) ta += d; }
        const unsigned long long t0 = rt(), target = (unsigned long long)ta * MK_PROBE_MULT;
        while (rt() - t0 < target) __builtin_amdgcn_s_sleep(32);
    }
#endif
#endif
#undef IN
#undef BOTH
#undef GRID_BAR
#undef XCD_BAR_CALL
#undef BG_DRAIN
#undef STAMP
}

#if MK_DEBUG
__device__ __forceinline__ unsigned hash32(unsigned x) { x ^= x >> 16; x *= 0x7feb352dU; x ^= x >> 15; x *= 0x846ca68bU; x ^= x >> 16; return x; }
__device__ __forceinline__ float wdot(const bf16* a, const bf16* b, int K, int lane) { float s = 0.f; for (int k = lane; k < K; k += 64) s += bf2f(a[k]) * bf2f(b[k]); return wave_sum(s); }
__device__ __forceinline__ bool okf(float got, float ref, float rel, float ab) { return fabsf(got - ref) <= rel * fabsf(ref) + ab; }
__device__ __forceinline__ float gelu_ref(float x) { return 0.5f * x * (1.0f + tanhf(0.7978845608f * (x + 0.044715f * x * x * x))); }
__device__ __forceinline__ float silu_ref(float x) { return x / (1.0f + expf(-x)); }
__device__ __forceinline__ float f8f(unsigned char b) { return __builtin_amdgcn_cvt_f32_fp8((int)b, 0); }
__device__ __forceinline__ unsigned char f2f8(float x) { return (unsigned char)(__builtin_amdgcn_cvt_pk_fp8_f32(x, 0.f, 0, false) & 0xff); }
__device__ __forceinline__ float wdot8(const unsigned char* a, const unsigned char* b, int K, int lane) { float s = 0.f; for (int k = lane; k < K; k += 64) s += f8f(a[k]) * f8f(b[k]); return wave_sum(s); }
#define CHK_FAIL(stage) do { if (lane == 0) atomicAdd((unsigned*)(a.ws + WS_CTL) + CW_CHK + (stage), 1u); } while (0)
__device__ void chk_tr8(const Args& a, int stage, const float* W, int K, int N, const unsigned char* WT, int row_off, int mode, float mul, unsigned s, int lane) {
    const int k = hash32(s * 2 + 1) % K, n = hash32(s * 2 + 2) % N; const int drow = row_off + (mode == 0 ? n : ((n >> 7) * 256 + (n & 127) + (mode == 2 ? 128 : 0)));
    if (WT[(size_t)drow * K + k] != f2f8(W[(size_t)k * N + n] * mul)) CHK_FAIL(stage);
}
__device__ void chk_tr(const Args& a, int stage, const float* W, int K, int N, const bf16* WT, int row_off, int mode, unsigned s, int lane) {
    const int k = hash32(s * 2 + 1) % K, n = hash32(s * 2 + 2) % N; const int drow = row_off + (mode == 0 ? n : ((n >> 7) * 256 + (n & 127) + (mode == 2 ? 128 : 0)));
    if (WT[(size_t)drow * K + k] != (bf16)f2bf(W[(size_t)k * N + n])) CHK_FAIL(stage);
}
__device__ void chk_memattn(const Args& a, int stage, const bf16* q, const bf16* Kb, const bf16* Ob, float* pl, int lane) {
    float sc[4], mx = -3e38f;
    for (int i = 0; i < 4; ++i) { const int j = lane + 64 * i; float s = 0.f; for (int d = 0; d < 128; ++d) s += bf2f(q[d]) * bf2f(Kb[(size_t)j * 2048 + d]); sc[i] = s * 0.08838834764831845f; mx = fmaxf(mx, sc[i]); }
    for (int o = 1; o < 64; o <<= 1) mx = fmaxf(mx, __shfl_xor(mx, o));
    float sum = 0.f; for (int i = 0; i < 4; ++i) { sc[i] = expf(sc[i] - mx); sum += sc[i]; pl[lane + 64 * i] = sc[i]; }
    sum = wave_sum(sum); __syncthreads();
    bool bad = false;
    for (int dd = 0; dd < 2; ++dd) { const int d = lane + 64 * dd; float o = 0.f; for (int j = 0; j < 256; ++j) o += pl[j] * bf2f(Kb[(size_t)j * 2048 + 512 + d]); o /= sum;
        if (!okf(bf2f(Ob[d]), o, 0.03f, 0.004f)) bad = true; }
    if (__any(bad)) CHK_FAIL(stage);
    __syncthreads();
}
__global__ void __launch_bounds__(64) chk_kernel(Args a, int stage, int chunk) {
    __shared__ float pl[8192];
    const int lane = threadIdx.x; const unsigned s = blockIdx.x; unsigned char* ws = a.ws;
    const bf16* XB = (const bf16*)(ws + WS_XB);
    if (stage == 0 || (MK_BG && stage == 14)) {
        int cs = s % 12;
#if MK_BG
        { const bool fg = (cs == 0 || cs == 7 || cs == 11 || (cs == 1 && ((s / 12) & 1) == 0)); if ((stage == 0) != fg) cs = 99; }
#endif
        switch (cs) {
        case 99: break;
        case 0: chk_tr(a, 0, a.in[I_AWIN], DM, A_IN, (const bf16*)(ws + WS_W_A_IN), 0, 0, s, lane); break;
        case 1: { const int l = (s / 12) & 1; chk_tr(a, 0, a.in[I_WMIX] + (size_t)l * DM * DM, DM, DM, (const bf16*)(ws + WS_W_MIX), l * DM, 0, s, lane); } break;
#if MK_FP8_FFN
        case 2: chk_tr8(a, 0, a.in[I_FG], DM, FF, ws + WS_W_FFN_GU, 0, 1, W8_G_MUL, s, lane); break;
        case 3: chk_tr8(a, 0, a.in[I_FU], DM, FF, ws + WS_W_FFN_GU, 0, 2, W8_U_MUL, s, lane); break;
        case 4: chk_tr8(a, 0, a.in[I_FD], FF, DM, ws + WS_W_FFN_D, 0, 0, W8_D_MUL, s, lane); break;
#else
        case 2: chk_tr(a, 0, a.in[I_FG], DM, FF, (const bf16*)(ws + WS_W_FFN_GU), 0, 1, s, lane); break;
        case 3: chk_tr(a, 0, a.in[I_FU], DM, FF, (const bf16*)(ws + WS_W_FFN_GU), 0, 2, s, lane); break;
        case 4: chk_tr(a, 0, a.in[I_FD], FF, DM, (const bf16*)(ws + WS_W_FFN_D), 0, 0, s, lane); break;
#endif
        case 5: chk_tr(a, 0, a.in[I_SWKV], DM, 3072, (const bf16*)(ws + WS_W_B_IN), 0, 0, s, lane); break;
        case 6: chk_tr(a, 0, a.in[I_BWIN], DM, DM, (const bf16*)(ws + WS_W_B_IN), 3072, 0, s, lane); break;
        case 7: { const int l = (s / 12) & 1; chk_tr(a, 0, a.in[I_WMEMKV] + (size_t)l * DM * 1024, DM, 1024, (const bf16*)(ws + WS_W_MEMKV), l * 1024, 0, s, lane); } break;
#if MK_FP8_MOE
        case 8: { const int e = (s / 12) & 7; chk_tr8(a, 0, a.in[I_MG] + (size_t)e * DM * FFE, DM, FFE, ws + WS_W_MOE_GU, e * 2 * FFE, 1, W8_G_MUL, s, lane); } break;
        case 9: { const int e = (s / 12) & 7; chk_tr8(a, 0, a.in[I_MU] + (size_t)e * DM * FFE, DM, FFE, ws + WS_W_MOE_GU, e * 2 * FFE, 2, W8_U_MUL, s, lane); } break;
        case 10: { const int e = (s / 12) & 7; chk_tr8(a, 0, a.in[I_MD] + (size_t)e * FFE * DM, FFE, DM, ws + WS_W_MOE_D, e * DM, 0, W8_D_MUL, s, lane); } break;
#else
        case 8: { const int e = (s / 12) & 7; chk_tr(a, 0, a.in[I_MG] + (size_t)e * DM * FFE, DM, FFE, (const bf16*)(ws + WS_W_MOE_GU), e * 2 * FFE, 1, s, lane); } break;
        case 9: { const int e = (s / 12) & 7; chk_tr(a, 0, a.in[I_MU] + (size_t)e * DM * FFE, DM, FFE, (const bf16*)(ws + WS_W_MOE_GU), e * 2 * FFE, 2, s, lane); } break;
        case 10: { const int e = (s / 12) & 7; chk_tr(a, 0, a.in[I_MD] + (size_t)e * FFE * DM, FFE, DM, (const bf16*)(ws + WS_W_MOE_D), e * DM, 0, s, lane); } break;
#endif
        default: { const size_t i = hash32(s) % ((size_t)NTOK * DM); if (XB[i] != (bf16)f2bf(a.in[I_X][i])) CHK_FAIL(0);
                   const size_t i2 = hash32(s + 7) % ((size_t)1024 * DM); if (((const bf16*)(ws + WS_MEMB))[i2] != (bf16)f2bf(a.in[I_MEM][i2])) CHK_FAIL(0);
                   const int i3 = hash32(s + 9) % (NSG * 128 * 128), ss = i3 & 127, tt = (i3 >> 7) & 127; if (((const bf16*)(ws + WS_WSBF))[i3] != (bf16)(ss <= tt ? f2bf(a.in[I_AWS][i3]) : 0u)) CHK_FAIL(0); } break;
        }
    } else if (stage == 1) {
        const int row = hash32(s) % NTOK, col = (s & 1) ? (3072 + hash32(s + 1) % 512) : (hash32(s + 1) % A_IN);
        float ref = wdot(XB + (size_t)row * DM, (const bf16*)(ws + WS_W_A_IN) + (size_t)col * DM, DM, lane); if (col < 3072) ref = gelu_ref(ref);
        if (!okf(bf2f(((const bf16*)(ws + WS_H0))[(size_t)row * A_IN + col]), ref, 0.02f, 0.02f)) CHK_FAIL(1);
        const int r2 = hash32(s + 3) % 1024, c2 = hash32(s + 4) % 2048;
        const float ref2 = wdot((const bf16*)(ws + WS_MEMB) + (size_t)r2 * DM, (const bf16*)(ws + WS_W_MEMKV) + (size_t)c2 * DM, DM, lane);
        if (!okf(bf2f(((const bf16*)(ws + WS_MEMKV))[(size_t)r2 * 2048 + c2]), ref2, 0.02f, 0.02f)) CHK_FAIL(1);
    } else if (stage == 2) {
        const int tok = hash32(s) % NTOK, h = hash32(s + 1) & 3, b = tok / SEQ; const bf16* H0 = (const bf16*)(ws + WS_H0);
        chk_memattn(a, 2, H0 + (size_t)tok * A_IN + 3072 + h * 128, (const bf16*)(ws + WS_MEMKV) + (size_t)b * 256 * 2048 + h * 128, (const bf16*)(ws + WS_CONCAT) + (size_t)tok * DM + 1536 + h * 128, pl, lane);
        const int g = hash32(s + 2) % NSG, t = tok & 127; const size_t R0 = (size_t)(tok - t);
        float mean[2], rstd[2];
        for (int i = 0; i < 2; ++i) { const int sidx = lane + 64 * i; const bf16* vr = H0 + (R0 + sidx) * A_IN + MAINW; float sm = 0.f; for (int k = 0; k < MAINW; ++k) sm += bf2f(vr[k]); sm /= MAINW; float q = 0.f; for (int k = 0; k < MAINW; ++k) { const float d = bf2f(vr[k]) - sm; q += d * d; } mean[i] = sm; rstd[i] = 1.0f / sqrtf(q / MAINW + LN_EPS); }
        for (int dd = 0; dd < 2; ++dd) { const int d = hash32(s + 10 + dd) & 127, col = g * 128 + d; float acc = 0.f;
            for (int i = 0; i < 2; ++i) { const int sidx = lane + 64 * i; if (sidx <= t) { const float lv = (bf2f(H0[(R0 + sidx) * A_IN + MAINW + col]) - mean[i]) * rstd[i] * a.in[I_AVG][col] + a.in[I_AVB][col]; acc += a.in[I_AWS][((size_t)g * 128 + t) * 128 + sidx] * lv; } }
            acc = wave_sum(acc); const float ref = (acc + a.in[I_ABS][g * 128 + t]) * bf2f(H0[(R0 + t) * A_IN + col]);
            if (!okf(bf2f(((const bf16*)(ws + WS_CONCAT))[(R0 + t) * DM + col]), ref, 0.03f, 0.03f)) CHK_FAIL(3); }
    } else if (stage == 3 || stage == 6 || stage == 11) {
        const int row = hash32(s) % NTOK, col = hash32(s + 1) % DM; float ref;
        if (stage == 3) ref = ALPHA * a.in[I_X][(size_t)row * DM + col] + wdot((const bf16*)(ws + WS_CONCAT) + (size_t)row * DM, (const bf16*)(ws + WS_W_MIX) + (size_t)col * DM, DM, lane);
#if MK_FP8_FFN
        else if (stage == 6) ref = ALPHA * f8f((ws + WS_XB)[(size_t)row * DM + col]) + wdot8(ws + WS_HID + (size_t)row * FF, ws + WS_W_FFN_D + (size_t)col * FF, FF, lane) / (H8_MUL * W8_D_MUL);
#else
        else if (stage == 6) ref = ALPHA * bf2f(XB[(size_t)row * DM + col]) + wdot((const bf16*)(ws + WS_HID) + (size_t)row * FF, (const bf16*)(ws + WS_W_FFN_D) + (size_t)col * FF, FF, lane);
#endif
        else ref = ALPHA * bf2f(XB[(size_t)row * DM + col]) + wdot((const bf16*)(ws + WS_CONCAT1) + (size_t)row * DM, (const bf16*)(ws + WS_W_MIX) + (size_t)DM * DM + (size_t)col * DM, DM, lane);
        if (!okf(a.out[(size_t)row * DM + col], ref, 0.02f, (MK_FP8_FFN && stage == 6) ? 0.12f : 0.03f)) CHK_FAIL(stage == 3 ? 4 : (stage == 6 ? 7 : 13));
    } else if (stage == 4 || stage == 7 || stage == 12) {
        const int row = hash32(s) % NTOK, li = stage == 4 ? 0 : (stage == 7 ? 1 : 2); const float* y = a.out + (size_t)row * DM; const float* g = a.in[I_LNG] + li * DM; const float* bb = a.in[I_LNB] + li * DM;
        float s1 = 0.f; for (int k = lane; k < DM; k += 64) s1 += y[k]; const float mean = wave_sum(s1) / DM;
        float s2 = 0.f; for (int k = lane; k < DM; k += 64) { const float d = y[k] - mean; s2 += d * d; } const float rstd = 1.0f / sqrtf(wave_sum(s2) / DM + LN_EPS);
        bool bad = false;
        if (stage != 12) { const float* st = (const float*)(ws + WS_STATS) + 2 * row; if (!okf(st[0], mean, 1e-3f, 1e-4f) || !okf(st[1], rstd, 1e-3f, 1e-6f)) bad = true; }
        for (int k = lane; k < DM; k += 64) { const float x = (y[k] - mean) * rstd * g[k] + bb[k]; float got;
            if (stage == 12) got = MK_FP8_MOE ? f8f((ws + WS_X3B)[(size_t)row * DM + k]) : bf2f(((const bf16*)(ws + WS_X3B))[(size_t)row * DM + k]);
            else if (stage == 4 && MK_FP8_FFN) got = f8f((ws + WS_XB)[(size_t)row * DM + k]);
            else got = bf2f(XB[(size_t)row * DM + k]);
            if (!okf(got, x, 0.07f, 0.02f)) bad = true; }
        if (__any(bad)) CHK_FAIL(stage == 4 ? 5 : (stage == 7 ? 8 : 14));
        if (stage == 12) {
            float lg[8]; for (int e2 = 0; e2 < 8; ++e2) { float p = 0.f; for (int k = lane; k < DM; k += 64) p += ((y[k] - mean) * rstd * g[k] + bb[k]) * a.in[I_ROUTER][k * 8 + e2]; lg[e2] = wave_sum(p); }
            int e0 = 0; for (int e2 = 1; e2 < 8; ++e2) if (lg[e2] > lg[e0]) e0 = e2; int e1 = e0 == 0 ? 1 : 0; for (int e2 = 0; e2 < 8; ++e2) if (e2 != e0 && lg[e2] > lg[e1]) e1 = e2;
            const int re = ((const int*)(ws + WS_ROUTE_E))[row]; const float w0 = ((const float*)(ws + WS_ROUTE_W))[2 * row];
            float third = -3e38f; for (int e2 = 0; e2 < 8; ++e2) if (e2 != e0 && e2 != e1) third = fmaxf(third, lg[e2]);
            const bool tie = (lg[e0] - lg[e1] < 1e-4f) || (lg[e1] - third < 1e-4f);
            if (!tie && (re != (e0 | (e1 << 8)) || !okf(w0, 1.0f / (1.0f + expf(lg[e1] - lg[e0])), 1e-3f, 1e-4f))) CHK_FAIL(15);
        }
    } else if (stage == 5) {
        const int row = hash32(s) % NTOK, hc = hash32(s + 1) % FF;
#if MK_FP8_FFN
        const unsigned char* W = ws + WS_W_FFN_GU + (size_t)((hc >> 7) * 256 + (hc & 127)) * DM; const unsigned char* x = ws + WS_XB + (size_t)row * DM;
        const float g = wdot8(x, W, DM, lane) / W8_G_MUL, u = wdot8(x, W + (size_t)128 * DM, DM, lane) / W8_U_MUL;
        if (!okf(f8f((ws + WS_HID)[(size_t)row * FF + hc]) / H8_MUL, silu_ref(g) * u, 0.08f, 0.004f)) CHK_FAIL(6);
#else
        const bf16* W = (const bf16*)(ws + WS_W_FFN_GU) + (size_t)((hc >> 7) * 256 + (hc & 127)) * DM;
        const float g = wdot(XB + (size_t)row * DM, W, DM, lane), u = wdot(XB + (size_t)row * DM, W + (size_t)128 * DM, DM, lane);
        if (!okf(bf2f(((const bf16*)(ws + WS_HID))[(size_t)row * FF + hc]), silu_ref(g) * u, 0.02f, 0.01f)) CHK_FAIL(6);
#endif
    } else if (stage == 8) {
        const int row = hash32(s) % NTOK, col = hash32(s + 1) % B_IN;
        const float ref = wdot(XB + (size_t)row * DM, (const bf16*)(ws + WS_W_B_IN) + (size_t)col * DM, DM, lane);
        if (!okf(bf2f(((const bf16*)(ws + WS_H1))[(size_t)row * B_IN + col]), ref, 0.02f, 0.02f)) CHK_FAIL(9);
    } else if (stage == 9) {
        const int tok = (s & 3) == 0 ? ((hash32(s) % (NTOK / 256)) * 256 + (hash32(s + 5) & 1 ? 255 : 0)) : hash32(s) % NTOK; const int b = tok / SEQ, pos = tok % SEQ, h = hash32(s + 1) % 6, m = hash32(s + 2) & 1, half = hash32(s + 3) & 1;
        const bf16* H1 = (const bf16*)(ws + WS_H1); const bf16* q = H1 + (size_t)tok * B_IN + 3072 + (m * 6 + h) * 128; const bf16* Kb = H1 + (size_t)b * SEQ * B_IN + (m * 6 + h) * 128; const bf16* Vb = H1 + (size_t)b * SEQ * B_IN + 1536 + h * 256 + half * 128;
        float mx = -3e38f; for (int j = lane; j <= pos; j += 64) { float sc = 0.f; for (int d = 0; d < 128; ++d) sc += bf2f(q[d]) * bf2f(Kb[(size_t)j * B_IN + d]); sc *= 0.08838834764831845f; pl[j] = sc; mx = fmaxf(mx, sc); }
        for (int o = 1; o < 64; o <<= 1) mx = fmaxf(mx, __shfl_xor(mx, o));
        float sum = 0.f; for (int j = lane; j <= pos; j += 64) { const float p = expf(pl[j] - mx); pl[j] = p; sum += p; } sum = wave_sum(sum); __syncthreads();
        bool bad = false;
        for (int dd = 0; dd < 2; ++dd) { const int d = lane + 64 * dd; float o = 0.f; for (int j = 0; j <= pos; ++j) o += pl[j] * bf2f(Vb[(size_t)j * B_IN + d]); o /= sum;
            if (!okf(bf2f(((const bf16*)(ws + WS_AO))[(size_t)tok * 3072 + m * 1536 + h * 256 + half * 128 + d]), o, 0.03f, 0.004f)) bad = true; }
        if (__any(bad)) CHK_FAIL(10);
    } else if (stage == 10) {
        const int tok = hash32(s) % NTOK, h4 = hash32(s + 1) & 3, b = tok / SEQ; const bf16* H1 = (const bf16*)(ws + WS_H1);
        chk_memattn(a, 11, H1 + (size_t)tok * B_IN + 4608 + h4 * 128, (const bf16*)(ws + WS_MEMKV) + (size_t)b * 256 * 2048 + 1024 + h4 * 128, (const bf16*)(ws + WS_CONCAT1) + (size_t)tok * DM + 1536 + h4 * 128, pl, lane);
        const int h = hash32(s + 2) % 6; const bf16* AO = (const bf16*)(ws + WS_AO) + (size_t)tok * 3072;
        float s1 = 0.f, s2 = 0.f; for (int k = lane; k < 128; k += 64) { s1 += a.in[I_LQ1][k] * a.in[I_LK1][k]; s2 += a.in[I_LQ2][k] * a.in[I_LK2][k]; } s1 = wave_sum(s1); s2 = wave_sum(s2);
        const float lam = expf(s1) - expf(s2) + LAMBDA_INIT; float x[4], ss = 0.f;
        for (int i = 0; i < 4; ++i) { const int d = lane + 64 * i; x[i] = bf2f(AO[h * 256 + d]) - lam * bf2f(AO[1536 + h * 256 + d]); ss += x[i] * x[i]; } ss = wave_sum(ss);
        bool bad = false; for (int i = 0; i < 4; ++i) { const int d = lane + 64 * i; const float ref = x[i] / sqrtf(ss / 256.f + LN_EPS) * a.in[I_SUBLN][d] * (1.0f - LAMBDA_INIT);
            if (!okf(bf2f(((const bf16*)(ws + WS_CONCAT1))[(size_t)tok * DM + h * 256 + d]), ref, 0.02f, 0.01f)) bad = true; }
        if (__any(bad)) CHK_FAIL(12);
    }
    if (stage == 13 || stage == 14 || stage == 15) {
        const int tok = hash32(s) % NTOK, k = hash32(s + 1) & 1; const int slot = ((const int*)(ws + WS_TOKSLOT))[2 * tok + k]; const int* tab = (const int*)(ws + WS_MOETAB);
        const int e = (((const int*)(ws + WS_ROUTE_E))[tok] >> (8 * k)) & 0xff; const float gate = ((const float*)(ws + WS_ROUTE_W))[2 * tok + k];
        if (stage == 13) {
            bool bad = slot < 0 || slot >= MAXT * 256;
            if (!bad) { const int tile = slot >> 8; int te = 0; for (int j = 1; j < 8; ++j) te += tile >= tab[j]; bad = te != e || tile >= tab[8] || ((const int*)(ws + WS_SLOTTOK))[slot] != tok || ((const float*)(ws + WS_SLOTGATE))[slot] != gate;

#if MK_FP8_MOE
                for (int j = lane; j < DM; j += 64) if (((const unsigned char*)(ws + WS_XS))[(size_t)slot * DM + j] != ((const unsigned char*)(ws + WS_X3B))[(size_t)tok * DM + j]) bad = true; }
#else
                for (int j = lane; j < DM; j += 64) if (((const bf16*)(ws + WS_XS))[(size_t)slot * DM + j] != ((const bf16*)(ws + WS_X3B))[(size_t)tok * DM + j]) bad = true; }
#endif
            if (__any(bad)) CHK_FAIL(16);
        } else { const int loc = slot - chunk * MOE_CHUNK_T * 256;
            if (loc >= 0 && loc < MOE_CHUNK_T * 256) {
#if MK_FP8_MOE
                if (stage == 14) { const int hc = hash32(s + 2) % FFE; const unsigned char* W = ws + WS_W_MOE_GU + ((size_t)e * 2 * FFE + (hc >> 7) * 256 + (hc & 127)) * DM; const unsigned char* x = ws + WS_XS + (size_t)slot * DM;
                    const float g = wdot8(x, W, DM, lane) / W8_G_MUL, u = wdot8(x, W + (size_t)128 * DM, DM, lane) / W8_U_MUL;
                    if (!okf(f8f((ws + WS_HIDM)[(size_t)loc * FFE + hc]) / H8_MUL, silu_ref(g) * u, 0.08f, 0.004f)) CHK_FAIL(17);
                } else { const int col = hash32(s + 2) % DM; const float ref = gate * wdot8(ws + WS_HIDM + (size_t)loc * FFE, ws + WS_W_MOE_D + ((size_t)e * DM + col) * FFE, FFE, lane) / (H8_MUL * W8_D_MUL);
                    const int T = tab[8]; int Lt = T & 31; if (Lt > 8) Lt = 0; const int Tm = T - Lt, tile = slot >> 8; float got;
                    if (tile >= Tm) { got = 0.f; for (int q = 0; q < 4; ++q) got += bf2f(((const bf16*)(ws + WS_OSK))[((size_t)(q * 8 + tile - Tm) * 256 + (slot & 255)) * DM + col]); }
                    else got = bf2f(((const bf16*)(ws + WS_OS))[(size_t)slot * DM + col]);
                    if (!okf(got, ref, 0.02f, 0.004f)) CHK_FAIL(18); } } }
#else
                if (stage == 14) { const int hc = hash32(s + 2) % FFE; const bf16* W = (const bf16*)(ws + WS_W_MOE_GU) + ((size_t)e * 2 * FFE + (hc >> 7) * 256 + (hc & 127)) * DM; const bf16* x = (const bf16*)(ws + WS_XS) + (size_t)slot * DM;
                    const float g = wdot(x, W, DM, lane), u = wdot(x, W + (size_t)128 * DM, DM, lane);
                    if (!okf(bf2f(((const bf16*)(ws + WS_HIDM))[(size_t)loc * FFE + hc]), silu_ref(g) * u, 0.02f, 0.01f)) CHK_FAIL(17);
                } else { const int col = hash32(s + 2) % DM; const float ref = gate * wdot((const bf16*)(ws + WS_HIDM) + (size_t)loc * FFE, (const bf16*)(ws + WS_W_MOE_D) + ((size_t)e * DM + col) * FFE, FFE, lane);
                    if (!okf(bf2f(((const bf16*)(ws + WS_OS))[(size_t)slot * DM + col]), ref, 0.02f, 0.004f)) CHK_FAIL(18); } } }
#endif
    }
}
__global__ void fin_kernel(Args a, int complete) {
    const unsigned* c = (const unsigned*)(a.ws + WS_CTL) + CW_CHK; int first = -1; for (int i = 0; i < 32; ++i) if (c[i] && first < 0) first = i;
    const unsigned* ctl = (const unsigned*)(a.ws + WS_CTL); if (first < 0 && (ctl[CW_TMO] || ctl[CW_BAR + XB_TMO])) first = 30;
    if (first < 0 && complete) return;
    const float v = sqrtf(first < 0 ? 76.0f : 10.0f + first);
    for (size_t i = (size_t)blockIdx.x * blockDim.x + threadIdx.x; i < (size_t)NTOK * DM; i += (size_t)gridDim.x * blockDim.x) a.out[i] = v;
}
#endif

extern "C" void kernel_launch(void* const* d_in, const int* in_sizes, int n_in, void* d_out, int out_size, void* d_ws, size_t ws_size, hipStream_t stream) {
    static int grid = 0;
    if (grid == 0) {
        if (n_in != 25 || in_sizes[0] != NTOK * DM || out_size != NTOK * DM || ws_size < WS_END) { fprintf(stderr, "kernel_launch: unexpected shapes (n_in %d, in0 %d, out %d, ws %zu < %zu); nothing launched\n", n_in, n_in > 0 ? in_sizes[0] : -1, out_size, ws_size, (size_t)WS_END); grid = -1; return; }
        int dev = 0, cus = 0, per_cu = 0;
        if (hipGetDevice(&dev) != hipSuccess || hipDeviceGetAttribute(&cus, hipDeviceAttributeMultiprocessorCount, dev) != hipSuccess) { grid = -1; return; }
        if (hipFuncSetAttribute((const void*)mk_fwd, hipFuncAttributeMaxDynamicSharedMemorySize, LDS_BYTES) != hipSuccess) { fprintf(stderr, "kernel_launch: hipFuncSetAttribute failed\n"); grid = -1; return; }
        if (hipOccupancyMaxActiveBlocksPerMultiprocessor(&per_cu, (const void*)mk_fwd, NWAVES * 64, LDS_BYTES) != hipSuccess || per_cu < 1) fprintf(stderr, "kernel_launch: occupancy query reports %d\n", per_cu);
        (void)hipGetLastError();
        grid = cus;
    }
    if (grid < 0) return;
    if (hipMemsetAsync((char*)d_ws + WS_CTL, 0, CTL_ZERO_BYTES, stream) != hipSuccess) return;
    Args a{};
    for (int i = 0; i < 25; ++i) a.in[i] = (const float*)d_in[i];
    a.out = (float*)d_out; a.ws = (unsigned char*)d_ws;
#if MK_DEBUG
    const int last = MK_LAST_PHASE;
    auto run = [&](int ph, int ch) { a.ph_lo = ph; a.ph_hi = ph + 1; a.ch_lo = ch; a.ch_hi = ch + 1; hipLaunchKernelGGL(mk_fwd, dim3(grid), dim3(NWAVES * 64), LDS_BYTES, stream, a); };
    auto chk = [&](int stage, int ch) { hipLaunchKernelGGL(chk_kernel, dim3(1024), dim3(64), 0, stream, a, stage, ch); };
    for (int ph = 0; ph <= last && ph <= 13; ++ph) { run(ph, 0); chk(ph, 0); }
    if (last >= 14) for (int ch = 0; ch < (MAXT + MOE_CHUNK_T - 1) / MOE_CHUNK_T; ++ch) { run(14, ch); chk(14, ch); if (last >= 15) { run(15, ch); chk(15, ch); } }
    if (last >= 16) run(16, 0);
    hipLaunchKernelGGL(fin_kernel, dim3(1024), dim3(256), 0, stream, a, last >= 16 ? 1 : 0);
#else
    a.ph_lo = 0; a.ph_hi = 17; a.ch_lo = 0; a.ch_hi = (MAXT + MOE_CHUNK_T - 1) / MOE_CHUNK_T;
    hipLaunchKernelGGL(mk_fwd, dim3(grid), dim3(NWAVES * 64), LDS_BYTES, stream, a);
#endif
}
```

```cpp
#include <hip/hip_runtime.h>
#include <hip/hip_bf16.h>
#include <cstdio>
#include <cstdint>

#ifndef MK_DEBUG
#define MK_DEBUG 0
#endif
#ifndef MK_FP8_MOE
#define MK_FP8_MOE 1
#endif
#ifndef MK_FP8_FFN
#define MK_FP8_FFN 1
#endif
#ifndef MK_BG
#define MK_BG 1
#endif
#ifndef MK_PROBE
#define MK_PROBE 0
#endif
#ifndef MK_PROBE_A
#define MK_PROBE_A 0x1
#endif
#define MK_PROBE_MULT 8
#ifndef MK_PROBE_BARMASK
#define MK_PROBE_BARMASK 0xffffff
#endif
#ifndef MK_PROBE_BLK
#define MK_PROBE_BLK 0
#endif
#ifndef MK_PHMASK
#define MK_PHMASK 0x1ffff
#endif
#ifndef MK_LAST_PHASE
#define MK_LAST_PHASE 18
#endif

__device__ __forceinline__ int mk_lane() { int r; asm volatile("v_mbcnt_lo_u32_b32 %0, -1, 0\n\tv_mbcnt_hi_u32_b32 %0, -1, %0" : "=v"(r)); return r; }
namespace pg8 {
#define PG8_LAS __attribute__((address_space(3)))
typedef unsigned short bf16_t;
typedef short bf16x8 __attribute__((ext_vector_type(8)));
typedef float f32x4 __attribute__((ext_vector_type(4)));
typedef float f32x2 __attribute__((ext_vector_type(2)));
typedef unsigned u32x4 __attribute__((ext_vector_type(4)));
typedef int v4i_t __attribute__((ext_vector_type(4)));
constexpr int BM = 256, BK = 64, HALF = 128, HTB = HALF * BK * 2  , STAGE_BYTES = 8 * HTB, NXCD = 8, WGM = 8;

__host__ __device__ __forceinline__ int lds_byte(int r, int c) { const int st = (r >> 4) * 2 + (c >> 5), rr = r & 15, cc = c & 31, ob = rr * 64 + cc * 2; return st * 1024 + (ob ^ (((ob >> 9) & 1) << 5)); }
__host__ __device__ __forceinline__ void stage_rc(int b, int& R, int& C) { const int st = b / 1024, sb = b % 1024, swz = sb ^ (((sb >> 9) & 1) << 5); R = (st >> 1) * 16 + swz / 64; C = (st & 1) * 32 + (swz % 64) / 2; }
__host__ __device__ __forceinline__ int perm32(int rho) { const int n = rho >> 4, i = rho & 15; return 8 * (i >> 2) + 4 * n + (i & 3); }

struct Unit { int pa, pb, pm, pn, koff; };
struct Gemm { const bf16_t* A; const bf16_t* Bt; int M, N, K, KL; };

__host__ __device__ __forceinline__ void tile_of(int wgid, int nM, int nN, int& pm, int& pn) {
    const int nwg = nM * nN;
    { const int q = nwg / NXCD, r = nwg % NXCD, xcd = wgid % NXCD, off = wgid / NXCD; wgid = (xcd < r ? xcd * (q + 1) : r * (q + 1) + (xcd - r) * q) + off; }
    const int nig = WGM * nN, gid = wgid / nig, fm = gid * WGM, gsz = (nM - fm) < WGM ? (nM - fm) : WGM;
    pm = fm + ((wgid % nig) % gsz); pn = (wgid % nig) / gsz;
}
struct StaticOrder {
    int nM, nN, nwg, G, c;
    __host__ __device__ void init(int M, int N, int G_, int c_) { nM = M / BM; nN = N / BM; nwg = nM * nN; G = G_; c = c_; }
    __host__ __device__ bool next(int i, Unit& u) const {
        const long L = (long)i * G + c; if (L >= nwg) return false;
        int pm, pn; tile_of((int)L, nM, nN, pm, pn); u.pa = pm; u.pb = pn; u.pm = pm; u.pn = pn; u.koff = 0; return true;
    }
    __device__ __forceinline__ void a_ready(const Unit&) const {}
    __device__ __forceinline__ void done(const Unit&) const {}
};
template <bool A_LOCAL> struct MoeOrder {
    int nM, nN, nwg, G, c, t0; const PG8_LAS int* tstart;
    __device__ bool next(int i, Unit& u) const {
        const long L = (long)i * G + c; if (L >= nwg) return false;
        int pm, pn; tile_of((int)L, nM, nN, pm, pn); const int t = t0 + pm; int e = 0;
#pragma unroll
        for (int j = 1; j < 8; ++j) e += (t >= tstart[j]) ? 1 : 0;
        u.pa = A_LOCAL ? pm : t; u.pm = A_LOCAL ? t : pm; u.pb = e * nN + pn; u.pn = pn; u.koff = 0; return true;
    }
    __device__ __forceinline__ void a_ready(const Unit&) const {}
    __device__ __forceinline__ void done(const Unit&) const {}
};

struct MoeLeftOrder {
    int L, G, c, tl0, kq; const PG8_LAS int* tstart;
    __device__ bool next(int i, Unit& u) const {
        const long Lx = (long)i * G + c; if (Lx >= (long)L * 32) return false;
        const int q = (int)Lx & 3, pn = ((int)Lx >> 2) & 7, lt = (int)Lx >> 5, t = tl0 + lt; int e = 0;
#pragma unroll
        for (int j = 1; j < 8; ++j) e += (t >= tstart[j]) ? 1 : 0;
        u.pa = t; u.pb = e * 8 + pn; u.pm = q * 8 + lt; u.pn = pn; u.koff = q * kq; return true;
    }
    __device__ __forceinline__ void a_ready(const Unit&) const {}
    __device__ __forceinline__ void done(const Unit&) const {}
};

__device__ __forceinline__ unsigned cvt_pk_bf16(float lo, float hi) { unsigned r; asm volatile("v_cvt_pk_bf16_f32 %0, %1, %2" : "=v"(r) : "v"(lo), "v"(hi)); return r; }
__device__ __forceinline__ float gelu_tanh(float x) { const float u = x * (1.0f + 0.044715f * x * x); const float e = __builtin_amdgcn_exp2f(-2.302208198f * u); return x * __builtin_amdgcn_rcpf(1.0f + e); }
__device__ __forceinline__ float silu_f(float x) { const float e = __builtin_amdgcn_exp2f(-1.4426950409f * x); return x * __builtin_amdgcn_rcpf(1.0f + e); }

struct EpiBf16 {
    static constexpr bool PERM = true, AFTER_DRAIN = false;
    bf16_t* O; int ldc; int gelu_cols;
    __device__ __forceinline__ void operator()(const f32x4 (&acc)[2][2][4][2], const Unit& u, int wr, int wc, int fr, int fq) const {
        const int row0 = u.pm * BM + wr * 64 + fr, col0 = u.pn * BM + wc * 32 + 8 * fq; const bool act = (u.pn * BM) < gelu_cols;
#pragma unroll
        for (int ai = 0; ai < 2; ++ai)
#pragma unroll
            for (int m = 0; m < 4; ++m) { bf16_t* rowp = O + (size_t)(row0 + ai * HALF + m * 16) * ldc + col0;
#pragma unroll
                for (int bj = 0; bj < 2; ++bj) { f32x4 v0 = acc[ai][bj][m][0], v1 = acc[ai][bj][m][1];
                    if (act) {
#pragma unroll
                        for (int j = 0; j < 4; ++j) { v0[j] = gelu_tanh(v0[j]); v1[j] = gelu_tanh(v1[j]); } }
                    u32x4 w; w.x = cvt_pk_bf16(v0[0], v0[1]); w.y = cvt_pk_bf16(v0[2], v0[3]); w.z = cvt_pk_bf16(v1[0], v1[1]); w.w = cvt_pk_bf16(v1[2], v1[3]);
                    *(u32x4*)(rowp + bj * HALF) = w; } }
    }
};
struct EpiRes {
    static constexpr bool PERM = false, AFTER_DRAIN = false;
    const float* base; float* out; int ldc; float alpha;
    __device__ __forceinline__ void operator()(const f32x4 (&acc)[2][2][4][2], const Unit& u, int wr, int wc, int fr, int fq) const {
        const int row0 = u.pm * BM + wr * 64 + fr, col0 = u.pn * BM + wc * 32 + 4 * fq;
#pragma unroll
        for (int ai = 0; ai < 2; ++ai)
#pragma unroll
            for (int m = 0; m < 4; ++m) { const size_t off = (size_t)(row0 + ai * HALF + m * 16) * ldc + col0;
                f32x4 b[2][2];
#pragma unroll
                for (int bj = 0; bj < 2; ++bj)
#pragma unroll
                    for (int n = 0; n < 2; ++n) b[bj][n] = *(const f32x4*)(base + off + bj * HALF + n * 16);
#pragma unroll
                for (int bj = 0; bj < 2; ++bj)
#pragma unroll
                    for (int n = 0; n < 2; ++n) *(f32x4*)(out + off + bj * HALF + n * 16) = b[bj][n] * alpha + acc[ai][bj][m][n];
                asm volatile("" ::: "memory"); }
    }
};
struct EpiResLn {
    static constexpr bool PERM = false, AFTER_DRAIN = false;
    float* out; const float* stats; const float* g; const float* b;
    __device__ __forceinline__ void operator()(const f32x4 (&acc)[2][2][4][2], const Unit& u, int wr, int wc, int fr, int fq) const {
        constexpr int ldc = 2048; constexpr float alpha = 1.41421356237309515f;
        const int row0 = u.pm * BM + wr * 64 + fr, col0 = u.pn * BM + wc * 32 + 4 * fq;
        f32x4 gv[2][2], bv[2][2];
#pragma unroll
        for (int bj = 0; bj < 2; ++bj)
#pragma unroll
            for (int n = 0; n < 2; ++n) { gv[bj][n] = *(const f32x4*)(g + col0 + bj * HALF + n * 16) * alpha; bv[bj][n] = *(const f32x4*)(b + col0 + bj * HALF + n * 16) * alpha; }
#pragma unroll
        for (int ai = 0; ai < 2; ++ai)
#pragma unroll
            for (int m = 0; m < 4; ++m) { const int row = row0 + ai * HALF + m * 16; const size_t off = (size_t)row * ldc + col0; const f32x2 st = *(const f32x2*)(stats + 2 * row);
                f32x4 y[2][2];
#pragma unroll
                for (int bj = 0; bj < 2; ++bj)
#pragma unroll
                    for (int n = 0; n < 2; ++n) y[bj][n] = *(const f32x4*)(out + off + bj * HALF + n * 16);
#pragma unroll
                for (int bj = 0; bj < 2; ++bj)
#pragma unroll
                    for (int n = 0; n < 2; ++n) *(f32x4*)(out + off + bj * HALF + n * 16) = (y[bj][n] - st.x) * st.y * gv[bj][n] + bv[bj][n] + acc[ai][bj][m][n];
                __builtin_amdgcn_sched_barrier(0); }
    }
};
struct EpiRes16 {
    static constexpr bool PERM = true, AFTER_DRAIN = false;
    const float* base; bf16_t* o16;
    __device__ __forceinline__ void operator()(const f32x4 (&acc)[2][2][4][2], const Unit& u, int wr, int wc, int fr, int fq) const {
        constexpr int ldc = 2048; constexpr float alpha = 1.41421356237309515f;
        const int row0 = u.pm * BM + wr * 64 + fr, col0 = u.pn * BM + wc * 32 + 8 * fq;
#pragma unroll
        for (int ai = 0; ai < 2; ++ai)
#pragma unroll
            for (int m = 0; m < 4; ++m) { const size_t off = (size_t)(row0 + ai * HALF + m * 16) * ldc + col0;
                f32x4 y[2][2];
#pragma unroll
                for (int bj = 0; bj < 2; ++bj)
#pragma unroll
                    for (int n = 0; n < 2; ++n) y[bj][n] = *(const f32x4*)(base + off + bj * HALF + n * 4);
#pragma unroll
                for (int bj = 0; bj < 2; ++bj) { const f32x4 v0 = y[bj][0] * alpha + acc[ai][bj][m][0], v1 = y[bj][1] * alpha + acc[ai][bj][m][1];
                    u32x4 w; w.x = cvt_pk_bf16(v0[0], v0[1]); w.y = cvt_pk_bf16(v0[2], v0[3]); w.z = cvt_pk_bf16(v1[0], v1[1]); w.w = cvt_pk_bf16(v1[2], v1[3]);
                    *(u32x4*)(o16 + off + bj * HALF) = w; }
                asm volatile("" ::: "memory"); }
    }
};
template <bool IN16> struct EpiResLn16 {
    static constexpr bool PERM = true, AFTER_DRAIN = false;
    const void* yin; bf16_t* o16; const float* stats; const float* g; const float* b;
    __device__ __forceinline__ void operator()(const f32x4 (&acc)[2][2][4][2], const Unit& u, int wr, int wc, int fr, int fq) const {
        constexpr int ldc = 2048; constexpr float alpha = 1.41421356237309515f;
        const int row0 = u.pm * BM + wr * 64 + fr, col0 = u.pn * BM + wc * 32 + 8 * fq;
        f32x4 gv[2][2], bv[2][2];
#pragma unroll
        for (int bj = 0; bj < 2; ++bj)
#pragma unroll
            for (int n = 0; n < 2; ++n) { gv[bj][n] = *(const f32x4*)(g + col0 + bj * HALF + n * 4) * alpha; bv[bj][n] = *(const f32x4*)(b + col0 + bj * HALF + n * 4) * alpha; }
#pragma unroll
        for (int ai = 0; ai < 2; ++ai)
#pragma unroll
            for (int m = 0; m < 4; ++m) { const int row = row0 + ai * HALF + m * 16; const size_t off = (size_t)row * ldc + col0; const f32x2 st = *(const f32x2*)(stats + 2 * row);
                f32x4 y[2][2];
#pragma unroll
                for (int bj = 0; bj < 2; ++bj)
#pragma unroll
                    for (int n = 0; n < 2; ++n) if (!IN16) y[bj][n] = *(const f32x4*)((const float*)yin + off + bj * HALF + n * 4);
                if (IN16) {
#pragma unroll
                    for (int bj = 0; bj < 2; ++bj) { const u32x4 t = *(const u32x4*)((const bf16_t*)yin + off + bj * HALF);
                        y[bj][0][0] = __uint_as_float(t.x << 16); y[bj][0][1] = __uint_as_float(t.x & 0xffff0000u); y[bj][0][2] = __uint_as_float(t.y << 16); y[bj][0][3] = __uint_as_float(t.y & 0xffff0000u);
                        y[bj][1][0] = __uint_as_float(t.z << 16); y[bj][1][1] = __uint_as_float(t.z & 0xffff0000u); y[bj][1][2] = __uint_as_float(t.w << 16); y[bj][1][3] = __uint_as_float(t.w & 0xffff0000u); } }
#pragma unroll
                for (int bj = 0; bj < 2; ++bj) { const f32x4 v0 = (y[bj][0] - st.x) * st.y * gv[bj][0] + bv[bj][0] + acc[ai][bj][m][0], v1 = (y[bj][1] - st.x) * st.y * gv[bj][1] + bv[bj][1] + acc[ai][bj][m][1];
                    u32x4 w; w.x = cvt_pk_bf16(v0[0], v0[1]); w.y = cvt_pk_bf16(v0[2], v0[3]); w.z = cvt_pk_bf16(v1[0], v1[1]); w.w = cvt_pk_bf16(v1[2], v1[3]);
                    *(u32x4*)(o16 + off + bj * HALF) = w; }
                __builtin_amdgcn_sched_barrier(0); }
    }
};
struct EpiSwiglu {
    static constexpr bool PERM = true, AFTER_DRAIN = false;
    bf16_t* H; int ldh;
    __device__ __forceinline__ void operator()(const f32x4 (&acc)[2][2][4][2], const Unit& u, int wr, int wc, int fr, int fq) const {
        const int row0 = u.pm * BM + wr * 64 + fr, col0 = u.pn * HALF + wc * 32 + 8 * fq;
#pragma unroll
        for (int ai = 0; ai < 2; ++ai)
#pragma unroll
            for (int m = 0; m < 4; ++m) { bf16_t* rowp = H + (size_t)(row0 + ai * HALF + m * 16) * ldh + col0;
                f32x4 v0, v1;
#pragma unroll
                for (int j = 0; j < 4; ++j) { v0[j] = silu_f(acc[ai][0][m][0][j]) * acc[ai][1][m][0][j]; v1[j] = silu_f(acc[ai][0][m][1][j]) * acc[ai][1][m][1][j]; }
                u32x4 w; w.x = cvt_pk_bf16(v0[0], v0[1]); w.y = cvt_pk_bf16(v0[2], v0[3]); w.z = cvt_pk_bf16(v1[0], v1[1]); w.w = cvt_pk_bf16(v1[2], v1[3]);
                *(u32x4*)rowp = w; }
    }
};
template <bool NT> struct EpiSwiglu8 {
    static constexpr bool PERM = true, AFTER_DRAIN = false;
    unsigned char* H; int ldh;
    __device__ __forceinline__ void operator()(const f32x4 (&acc)[2][2][4][2], const Unit& u, int wr, int wc, int fr, int fq) const {
        const int row0 = u.pm * BM + wr * 64 + fr, col0 = u.pn * HALF + wc * 32 + 8 * fq;
#pragma unroll
        for (int ai = 0; ai < 2; ++ai)
#pragma unroll
            for (int m = 0; m < 4; ++m) { unsigned char* rowp = H + (size_t)(row0 + ai * HALF + m * 16) * ldh + col0;
                f32x4 v0, v1;
#pragma unroll
                for (int j = 0; j < 4; ++j) { const float g0 = acc[ai][0][m][0][j], g1 = acc[ai][0][m][1][j];
                    v0[j] = g0 * acc[ai][1][m][0][j] * __builtin_amdgcn_rcpf(1.0f + __builtin_amdgcn_exp2f(g0)); v1[j] = g1 * acc[ai][1][m][1][j] * __builtin_amdgcn_rcpf(1.0f + __builtin_amdgcn_exp2f(g1)); }
                int w0 = 0, w1 = 0;
                w0 = __builtin_amdgcn_cvt_pk_fp8_f32(v0[0], v0[1], w0, false); w0 = __builtin_amdgcn_cvt_pk_fp8_f32(v0[2], v0[3], w0, true);
                w1 = __builtin_amdgcn_cvt_pk_fp8_f32(v1[0], v1[1], w1, false); w1 = __builtin_amdgcn_cvt_pk_fp8_f32(v1[2], v1[3], w1, true);
                const unsigned long long pk_ = (unsigned long long)(unsigned)w0 | ((unsigned long long)(unsigned)w1 << 32);
                if (NT) __builtin_nontemporal_store(pk_, (unsigned long long*)rowp); else *(unsigned long long*)rowp = pk_; }
    }
};
struct EpiRowScale {
    static constexpr bool PERM = true, AFTER_DRAIN = false;
    bf16_t* O; int ldc; const float* rs;
    __device__ __forceinline__ void operator()(const f32x4 (&acc)[2][2][4][2], const Unit& u, int wr, int wc, int fr, int fq) const {
        const int row0 = u.pm * BM + wr * 64 + fr, col0 = u.pn * BM + wc * 32 + 8 * fq;
#pragma unroll
        for (int ai = 0; ai < 2; ++ai)
#pragma unroll
            for (int m = 0; m < 4; ++m) { const int row = row0 + ai * HALF + m * 16; const float s = rs[row + (u.pa - u.pm) * BM]; bf16_t* rowp = O + (size_t)row * ldc + col0;
#pragma unroll
                for (int bj = 0; bj < 2; ++bj) { const f32x4 v0 = acc[ai][bj][m][0] * s, v1 = acc[ai][bj][m][1] * s;
                    u32x4 w; w.x = cvt_pk_bf16(v0[0], v0[1]); w.y = cvt_pk_bf16(v0[2], v0[3]); w.z = cvt_pk_bf16(v1[0], v1[1]); w.w = cvt_pk_bf16(v1[2], v1[3]);
                    *(u32x4*)(rowp + bj * HALF) = w; } }
    }
};

template <class Epi, class Sched, bool ALIGN_EPI = false, bool SP2 = false, int SCA = 0, int SCB = 0>
__device__ __forceinline__ void gemm_phase(PG8_LAS unsigned char* lds, const Gemm g, const Sched& S, const Epi& E, const int mk_wid) {
    const int wid = mk_wid, lane = mk_lane(), tid = wid * 64 + lane, wr = wid >> 2, wc = wid & 3, fr = lane & 15, fq = lane >> 4;
    const int K = g.K, nt = (g.KL ? g.KL : K) / BK;
    unsigned voffA[2], voffB[2];
#pragma unroll
    for (int i = 0; i < 2; ++i) { int R, C; stage_rc(tid * 16 + i * 8192, R, C); const int Rb = Epi::PERM ? ((R & ~31) + perm32(R & 31)) : R;
        voffA[i] = (unsigned)(R * K + C) * 2u; voffB[i] = (unsigned)(Rb * K + C) * 2u; }
    const size_t kstep = (size_t)(BK * 2);
    const size_t hstep = (size_t)HALF * K * 2;
    const size_t tstep = 2 * hstep;
    const unsigned ldsw = (unsigned)wid * 1024u;
    const int aoff = lds_byte(wr * 64 + fr, fq * 8), boff = lds_byte(wc * 32 + fr, fq * 8);
#define PG8_SA(b, h) (((b) * 2 + (h)) * HTB)
#define PG8_SB(b, h) ((4 + (b) * 2 + (h)) * HTB)
#define PG8_STAGE(bufoff, gbase, voff) do { _Pragma("unroll") for (int _i = 0; _i < 2; ++_i) \
        __builtin_amdgcn_global_load_lds((const unsigned*)((const char*)(gbase) + (voff)[_i]), (PG8_LAS unsigned*)(lds + (bufoff) + ldsw + _i * 8192), 16, 0, 0); } while (0)
#define PG8_LDA(dst, b, h) do { _Pragma("unroll") for (int m = 0; m < 4; ++m) _Pragma("unroll") for (int k = 0; k < 2; ++k) dst[m][k] = *(const PG8_LAS bf16x8*)(lds + PG8_SA(b, h) + aoff + m * 2048 + k * 1024); } while (0)
#define PG8_LDB(dst, b, h) do { _Pragma("unroll") for (int n = 0; n < 2; ++n) _Pragma("unroll") for (int k = 0; k < 2; ++k) dst[n][k] = *(const PG8_LAS bf16x8*)(lds + PG8_SB(b, h) + boff + n * 2048 + k * 1024); } while (0)
#define PG8_CAT8(x, y) __builtin_shufflevector(__builtin_bit_cast(v4i_t, x), __builtin_bit_cast(v4i_t, y), 0, 1, 2, 3, 4, 5, 6, 7)
#define PG8_MMA(ai, bj, At, Bt) do { __builtin_amdgcn_s_setprio(1); if constexpr (SCA != 0) asm volatile("s_nop 1" ::: "memory"); \
        if constexpr (SCA != 0) { _Pragma("unroll") for (int m = 0; m < 4; ++m) _Pragma("unroll") for (int n = 0; n < 2; ++n) \
            asm volatile("v_mfma_scale_f32_16x16x128_f8f6f4 %0, %1, %2, %0, %3, %4 op_sel_hi:[0,0,0]" : "+v"(acc[ai][bj][m][n]) : "v"(PG8_CAT8(Bt[n][0], Bt[n][1])), "v"(PG8_CAT8(At[m][0], At[m][1])), "v"(scb_), "v"(sca_)); } \
        else { _Pragma("unroll") for (int m = 0; m < 4; ++m) _Pragma("unroll") for (int n = 0; n < 2; ++n) _Pragma("unroll") for (int k = 0; k < 2; ++k) \
            acc[ai][bj][m][n] = __builtin_amdgcn_mfma_f32_16x16x32_bf16(Bt[n][k], At[m][k], acc[ai][bj][m][n], 0, 0, 0); } \
        __builtin_amdgcn_s_setprio(0); } while (0)
#define PG8_WAIT_V(n) asm volatile("s_waitcnt vmcnt(" #n ")" ::: "memory")
#define PG8_WAIT_L(n) asm volatile("s_waitcnt lgkmcnt(" #n ")" ::: "memory")
#define PG8_BAR __builtin_amdgcn_s_barrier()
#define PG8_SCHED __builtin_amdgcn_sched_barrier(0)
    Unit cur, nxt; int ui = 0;
    if (!S.next(0, cur)) return;
    f32x4 acc[2][2][4][2];
#pragma unroll
    for (int a = 0; a < 2; ++a)
#pragma unroll
        for (int b = 0; b < 2; ++b)
#pragma unroll
            for (int m = 0; m < 4; ++m)
#pragma unroll
                for (int n = 0; n < 2; ++n) acc[a][b][m][n] = (f32x4){0.f, 0.f, 0.f, 0.f};
    bf16x8 At[4][2], B0[2][2], B1[2][2];
    const int sca_ = SCA, scb_ = SCB;
    const char* cA = (const char*)g.A + (size_t)cur.pa * tstep + cur.koff; const char* cB = (const char*)g.Bt + (size_t)cur.pb * tstep + cur.koff;
    S.a_ready(cur);
    if constexpr (SP2) {
        PG8_STAGE(PG8_SB(0, 0), cB, voffB); PG8_STAGE(PG8_SB(0, 1), cB + hstep, voffB); PG8_STAGE(PG8_SA(0, 0), cA, voffA); PG8_STAGE(PG8_SA(0, 1), cA + hstep, voffA);
        if (wr == 1) PG8_BAR;
        PG8_WAIT_V(2); PG8_BAR;
        PG8_STAGE(PG8_SB(1, 0), cB + kstep, voffB); PG8_STAGE(PG8_SA(1, 0), cA + kstep, voffA); PG8_STAGE(PG8_SB(1, 1), cB + hstep + kstep, voffB);
        PG8_WAIT_V(6); PG8_BAR;
    } else {
        PG8_STAGE(PG8_SB(0, 0), cB, voffB); PG8_STAGE(PG8_SA(0, 0), cA, voffA); PG8_STAGE(PG8_SB(0, 1), cB + hstep, voffB); PG8_STAGE(PG8_SA(0, 1), cA + hstep, voffA);
        if (wr == 1) PG8_BAR;
        PG8_WAIT_V(4); PG8_BAR;
        PG8_STAGE(PG8_SB(1, 0), cB + kstep, voffB); PG8_STAGE(PG8_SA(1, 0), cA + kstep, voffA); PG8_STAGE(PG8_SB(1, 1), cB + hstep + kstep, voffB);
        PG8_WAIT_V(6); PG8_BAR;
    }
    for (;;) {
        const bool has_next = S.next(ui + 1, nxt);
        const char* nA = has_next ? (const char*)g.A + (size_t)nxt.pa * tstep + nxt.koff : cA; const char* nB = has_next ? (const char*)g.Bt + (size_t)nxt.pb * tstep + nxt.koff : cB;
        for (int t = 0; t < nt; t += 2) {
            const bool last = (t == nt - 2);
            const char* a1 = cA + (size_t)(t + 1) * kstep;
            const char* a2 = last ? nA : cA + (size_t)(t + 2) * kstep; const char* b2 = last ? nB : cB + (size_t)(t + 2) * kstep;
            const char* a3 = a2 + kstep; const char* b3 = b2 + kstep;
            if (last && has_next) S.a_ready(nxt);
            if constexpr (SP2) {
            PG8_LDB(B0, 0, 0); PG8_LDB(B1, 0, 1); PG8_SCHED; PG8_LDA(At, 0, 0); PG8_STAGE(PG8_SA(1, 1), a1 + hstep, voffA);
            PG8_WAIT_V(8); PG8_WAIT_L(0); PG8_BAR; PG8_MMA(0, 0, At, B0); PG8_MMA(0, 1, At, B1); PG8_BAR; PG8_SCHED;
            PG8_LDA(At, 0, 1); PG8_STAGE(PG8_SB(0, 0), b2, voffB); PG8_STAGE(PG8_SB(0, 1), b2 + hstep, voffB); PG8_STAGE(PG8_SA(0, 0), a2, voffA);
            PG8_WAIT_V(8); PG8_WAIT_L(0); PG8_BAR; PG8_MMA(1, 0, At, B0); PG8_MMA(1, 1, At, B1); PG8_BAR; PG8_SCHED;
            PG8_LDB(B0, 1, 0); PG8_LDB(B1, 1, 1); PG8_SCHED; PG8_LDA(At, 1, 0); PG8_STAGE(PG8_SA(0, 1), a2 + hstep, voffA);
            PG8_WAIT_V(8); PG8_WAIT_L(0); PG8_BAR; PG8_MMA(0, 0, At, B0); PG8_MMA(0, 1, At, B1); PG8_BAR; PG8_SCHED;
            PG8_LDA(At, 1, 1); PG8_STAGE(PG8_SB(1, 0), b3, voffB); PG8_STAGE(PG8_SB(1, 1), b3 + hstep, voffB); PG8_STAGE(PG8_SA(1, 0), a3, voffA);
            PG8_WAIT_V(8); PG8_WAIT_L(0); PG8_BAR; PG8_MMA(1, 0, At, B0); PG8_MMA(1, 1, At, B1); PG8_BAR; PG8_SCHED;
            } else {
            PG8_LDB(B0, 0, 0); PG8_SCHED; PG8_LDA(At, 0, 0); PG8_STAGE(PG8_SA(1, 1), a1 + hstep, voffA);
            PG8_WAIT_L(8); PG8_BAR; PG8_WAIT_L(0); PG8_MMA(0, 0, At, B0); PG8_BAR; PG8_SCHED;
            PG8_LDB(B1, 0, 1); PG8_STAGE(PG8_SB(0, 0), b2, voffB);
            PG8_BAR; PG8_WAIT_L(0); PG8_MMA(0, 1, At, B1); PG8_BAR;
            PG8_LDA(At, 0, 1); PG8_STAGE(PG8_SA(0, 0), a2, voffA);
            PG8_BAR; PG8_WAIT_L(0); PG8_MMA(1, 0, At, B0); PG8_BAR; PG8_SCHED;
            PG8_STAGE(PG8_SB(0, 1), b2 + hstep, voffB);
            PG8_WAIT_V(6); PG8_BAR; PG8_MMA(1, 1, At, B1); PG8_BAR;
            PG8_LDB(B0, 1, 0); PG8_SCHED; PG8_LDA(At, 1, 0); PG8_STAGE(PG8_SA(0, 1), a2 + hstep, voffA);
            PG8_WAIT_L(8); PG8_BAR; PG8_WAIT_L(0); PG8_MMA(0, 0, At, B0); PG8_BAR; PG8_SCHED;
            PG8_LDB(B1, 1, 1); PG8_STAGE(PG8_SB(1, 0), b3, voffB);
            PG8_BAR; PG8_WAIT_L(0); PG8_MMA(0, 1, At, B1); PG8_BAR;
            PG8_LDA(At, 1, 1); PG8_STAGE(PG8_SA(1, 0), a3, voffA);
            PG8_BAR; PG8_WAIT_L(0); PG8_MMA(1, 0, At, B0); PG8_BAR; PG8_SCHED;
            PG8_STAGE(PG8_SB(1, 1), b3 + hstep, voffB);
            PG8_WAIT_V(6); PG8_BAR; PG8_MMA(1, 1, At, B1); PG8_BAR;
            }
        }
        if constexpr (SCA != 0) asm volatile("s_nop 15\n\ts_nop 15" ::: "memory");
        if constexpr (ALIGN_EPI) { if (wr == 0) PG8_BAR; }
        if constexpr (!Epi::AFTER_DRAIN) { E(acc, cur, wr, wc, fr, fq); S.done(cur); }
        if (!has_next) break;
#pragma unroll
        for (int a = 0; a < 2; ++a)
#pragma unroll
            for (int b = 0; b < 2; ++b)
#pragma unroll
                for (int m = 0; m < 4; ++m)
#pragma unroll
                    for (int n = 0; n < 2; ++n) acc[a][b][m][n] = (f32x4){0.f, 0.f, 0.f, 0.f};
        cur = nxt; cA = nA; cB = nB; ++ui;
        if constexpr (ALIGN_EPI) { if (wr == 1) PG8_BAR; }
    }
    PG8_WAIT_V(0);
    if constexpr (!ALIGN_EPI) { if (wr == 0) PG8_BAR; }
    PG8_BAR;
    if constexpr (Epi::AFTER_DRAIN) { E.fused(acc, cur, wr, wc, fr, fq, lds, wid, lane); S.done(cur); }
#undef PG8_SA
#undef PG8_SB
#undef PG8_STAGE
#undef PG8_LDA
#undef PG8_LDB
#undef PG8_MMA
#undef PG8_CAT8
#undef PG8_WAIT_V
#undef PG8_WAIT_L
#undef PG8_BAR
#undef PG8_SCHED
}
}

namespace at128 {
constexpr int D = 128;
constexpr float THR = 8.f;
constexpr bool WSKIP = false;
constexpr float SCALE = 0.08838834764831845f;
constexpr int NW = 8, QBLK = 32, KVBLK = 64, QB = NW * QBLK;
constexpr int SHM_V = KVBLK * D * 2, SHM_K = KVBLK * D * 2;
constexpr int LDS_BYTES = 2 * SHM_V + 2 * SHM_K + NW * 64 * 4;

using bf16 = __hip_bfloat16;
typedef short bf16x8 __attribute__((ext_vector_type(8)));
typedef short s16x4 __attribute__((ext_vector_type(4)));
typedef float f32x16 __attribute__((ext_vector_type(16)));
typedef float f32x4 __attribute__((ext_vector_type(4)));
typedef unsigned u32x4 __attribute__((ext_vector_type(4)));
template <class A, class Bt> struct same_t { static constexpr bool v = false; };
template <class A> struct same_t<A, A> { static constexpr bool v = true; };

#define KSWZ(row, colB) ((row) * 256 + ((colB) ^ (((row) & 7) << 4)))
#define SBAR() __builtin_amdgcn_sched_barrier(0)
__device__ __forceinline__ int v_st(int k, int c) { const int kk = (k & ~0xC) | ((k & 4) << 1) | ((k & 8) >> 1); return ((kk >> 3) * 4 + (c >> 5)) * 512 + ((kk & 7) * 32 + (c & 31)) * 2; }
__device__ __forceinline__ int v_rd_base(int lane) { return ((lane & 3) << 3) | (((lane >> 2) & 3) << 6) | (((lane >> 4) & 1) << 5) | (((lane >> 5) & 1) << 8); }
constexpr int v_rd_off(int d0, int ks, int half) { return d0 * 512 + ks * 4096 + half * 2048; }
__device__ __forceinline__ int crow(int r, int hi) { return (r & 3) + 8 * (r >> 2) + 4 * hi; }
__device__ __forceinline__ unsigned cvtpk(float lo, float hi) {
    unsigned r; asm volatile("v_cvt_pk_bf16_f32 %0, %1, %2" : "=v"(r) : "v"(lo), "v"(hi)); return r;
}
__device__ __forceinline__ bf16x8 pack8(f32x4 a, f32x4 b) {
    u32x4 w = {cvtpk(a[0], a[1]), cvtpk(a[2], a[3]), cvtpk(b[0], b[1]), cvtpk(b[2], b[3])};
    return *reinterpret_cast<bf16x8*>(&w);
}
template <class T> __device__ __forceinline__ bf16x8 load8(const T* p) {
    if constexpr (same_t<T, float>::v) { return pack8(*(const f32x4*)p, *(const f32x4*)(p + 4)); }
    else { return *reinterpret_cast<const bf16x8*>(p); }
}
__device__ __forceinline__ void mask_tile(f32x16& p0, f32x16& p1, int dq, unsigned W) {
    const float NEG = -__builtin_inff();
#pragma unroll
    for (int r = 0; r < 16; ++r) {
        const int c = (r & 3) + 8 * (r >> 2);
        if ((unsigned)(dq - c) >= W) p0[r] = NEG;
        if ((unsigned)(dq - c - 32) >= W) p1[r] = NEG;
    }
}
__device__ __forceinline__ void partialSM(f32x16& p0, f32x16& p1, float& m_reg, float& mn, float& alpha) {
    float pmax = p0[0]; for (int r = 1; r < 16; ++r) pmax = fmaxf(pmax, p0[r]); for (int r = 0; r < 16; ++r) pmax = fmaxf(pmax, p1[r]);
    { auto rr = __builtin_amdgcn_permlane32_swap(__float_as_uint(pmax), __float_as_uint(pmax), false, false);
      pmax = fmaxf(__uint_as_float(rr[0]), __uint_as_float(rr[1])); }
    constexpr float C2 = 1.4426950408889634f * SCALE;
    if (__builtin_expect(__all((pmax - m_reg) * SCALE <= THR), 1)) { mn = m_reg; alpha = 1.f; }
    else { mn = fmaxf(m_reg, pmax); alpha = __builtin_amdgcn_exp2f((m_reg - mn) * C2); m_reg = mn; }
    const float mnL = -mn * C2;
    for (int r = 0; r < 16; ++r) p0[r] = fmaf(p0[r], C2, mnL); for (int r = 0; r < 16; ++r) p1[r] = fmaf(p1[r], C2, mnL);
    for (int r = 0; r < 16; ++r) p0[r] = __builtin_amdgcn_exp2f(p0[r]);
}
__device__ __forceinline__ void finishSM(f32x16& p0, f32x16& p1, float alpha, float& l_reg, bf16x8& pa0, bf16x8& pa1, bf16x8& pa2, bf16x8& pa3) {
    for (int r = 0; r < 16; ++r) p1[r] = __builtin_amdgcn_exp2f(p1[r]);
    float ps = 0; for (int r = 0; r < 16; ++r) ps += p0[r]; for (int r = 0; r < 16; ++r) ps += p1[r];
    { auto rr = __builtin_amdgcn_permlane32_swap(__float_as_uint(ps), __float_as_uint(ps), false, false);
      ps = __uint_as_float(rr[0]) + __uint_as_float(rr[1]); }
    l_reg = l_reg * alpha + ps;
#define PK4(P, B_, OUT) do { unsigned a0 = cvtpk(P[B_+0], P[B_+1]), a1 = cvtpk(P[B_+2], P[B_+3]);                          \
        unsigned b0 = cvtpk(P[B_+4], P[B_+5]), b1 = cvtpk(P[B_+6], P[B_+7]);                                             \
        auto r0 = __builtin_amdgcn_permlane32_swap(a0, b0, false, false); auto r1 = __builtin_amdgcn_permlane32_swap(a1, b1, false, false); \
        u32x4 w = {r0[0], r1[0], r0[1], r1[1]}; OUT = *reinterpret_cast<bf16x8*>(&w); } while (0)
    PK4(p0, 0, pa0); PK4(p0, 8, pa1); PK4(p1, 0, pa2); PK4(p1, 8, pa3);
#undef PK4
}
template <int KB, bool SK>
__device__ __forceinline__ void qkt(f32x16& p0, f32x16& p1, const char* K_lds, int r32, int hi, const bf16x8* qr, bool act) {
    if (SK && !act) { const float NEG = -__builtin_inff();
#pragma unroll
        for (int r = 0; r < 16; ++r) { p0[r] = NEG; p1[r] = NEG; } return; }
    p0 = f32x16{}; p1 = f32x16{};
    const char* kb[4];
#pragma unroll
    for (int dd = 0; dd < 4; ++dd) kb[dd] = K_lds + KB * SHM_K + KSWZ(r32, (dd * 16 + hi * 8) * 2);
#pragma unroll
    for (int d0 = 0; d0 < 8; ++d0) { const char* a = kb[d0 & 3] + (d0 >> 2) * 128;
        bf16x8 b0 = *reinterpret_cast<const bf16x8*>(a);
        bf16x8 b1 = *reinterpret_cast<const bf16x8*>(a + 32 * 256);
        p0 = __builtin_amdgcn_mfma_f32_32x32x16_bf16(b0, qr[d0], p0, 0, 0, 0);
        p1 = __builtin_amdgcn_mfma_f32_32x32x16_bf16(b1, qr[d0], p1, 0, 0, 0); }
}
template <int VB, bool SK>
__device__ __forceinline__ void pv_tile(f32x16* o, int vb0, bf16x8 pa0, bf16x8 pa1, bf16x8 pa2, bf16x8 pa3, bool act) {
    if (SK && !act) return;
#define TRRD(dst, off) asm volatile("ds_read_b64_tr_b16 %0, %1 offset:%2" : "=&v"(dst) : "v"(vb0), "i"(off) : "memory")
#define PV_D0(d0) do { s16x4 l0, l1, l2, l3, h0, h1, h2, h3; constexpr int b_ = VB * SHM_V + v_rd_off(d0, 0, 0);     \
        TRRD(l0, b_); TRRD(h0, b_ + 2048); TRRD(l1, b_ + 4096); TRRD(h1, b_ + 6144); TRRD(l2, b_ + 8192); TRRD(h2, b_ + 10240); TRRD(l3, b_ + 12288); TRRD(h3, b_ + 14336); \
        asm volatile("s_waitcnt lgkmcnt(0)" ::: "memory"); SBAR();                 \
        o[d0] = __builtin_amdgcn_mfma_f32_32x32x16_bf16(pa0, (bf16x8){l0[0], l0[1], l0[2], l0[3], h0[0], h0[1], h0[2], h0[3]}, o[d0], 0, 0, 0);   \
        o[d0] = __builtin_amdgcn_mfma_f32_32x32x16_bf16(pa1, (bf16x8){l1[0], l1[1], l1[2], l1[3], h1[0], h1[1], h1[2], h1[3]}, o[d0], 0, 0, 0);   \
        o[d0] = __builtin_amdgcn_mfma_f32_32x32x16_bf16(pa2, (bf16x8){l2[0], l2[1], l2[2], l2[3], h2[0], h2[1], h2[2], h2[3]}, o[d0], 0, 0, 0);   \
        o[d0] = __builtin_amdgcn_mfma_f32_32x32x16_bf16(pa3, (bf16x8){l3[0], l3[1], l3[2], l3[3], h3[0], h3[1], h3[2], h3[3]}, o[d0], 0, 0, 0); } while (0)
    PV_D0(0); PV_D0(1); PV_D0(2); PV_D0(3);
#undef PV_D0
#undef TRRD
}

template <class TIn, class TOut> struct BlockRef { const TIn* Q; const TIn* K; const TIn* V; TOut* O; int P0; };
template <class TIn> struct Seam {
    bf16x8 qr[8];
    bf16x8 st_v0, st_v1, st_k0, st_k1; f32x4 sf0, sf1, sf2, sf3;
    f32x4 tq[16];
};
__device__ __forceinline__ int swa_jlo(int P0, int W) { const int lowk = P0 - W + 1; return lowk > 0 ? lowk / KVBLK : 0; }
#define ROW(p, k0, rr) ((p) + (size_t)((k0) + (rr)) * PKV + sc)
#define VMW() asm volatile("s_waitcnt vmcnt(0)" ::: "memory")
#define VMWN(n) asm volatile("s_waitcnt vmcnt(%0)" :: "i"(n) : "memory")
#define SLOAD_H(Kp, Vp, k0) do { S.st_v0 = load8<TIn>(ROW(Vp, k0, sr)); S.st_v1 = load8<TIn>(ROW(Vp, k0, 32 + sr));              \
                         S.st_k0 = load8<TIn>(ROW(Kp, k0, sr)); S.st_k1 = load8<TIn>(ROW(Kp, k0, 32 + sr)); } while (0)
#define SWRITE_HK(bf) do { *(bf16x8*)(K_lds + (bf) * SHM_K + kws) = S.st_k0; *(bf16x8*)(K_lds + (bf) * SHM_K + kws + 32 * 256) = S.st_k1; } while (0)
#define SWRITE_HV(bf) do { *(bf16x8*)(V_lds + (bf) * SHM_V + vst0) = S.st_v0; *(bf16x8*)(V_lds + (bf) * SHM_V + vst1) = S.st_v1; } while (0)
#define SWRITE_H(bf) do { SWRITE_HV(bf); SWRITE_HK(bf); } while (0)
#define SLOAD_F(p, k0) do { S.sf0 = *(const f32x4*)ROW(p, k0, sr); S.sf1 = *(const f32x4*)(ROW(p, k0, sr) + 4);                \
                            S.sf2 = *(const f32x4*)ROW(p, k0, 32 + sr); S.sf3 = *(const f32x4*)(ROW(p, k0, 32 + sr) + 4); } while (0)
#define SWRITE_KF(bf) do { *(bf16x8*)(K_lds + (bf) * SHM_K + kws) = pack8(S.sf0, S.sf1); *(bf16x8*)(K_lds + (bf) * SHM_K + kws + 32 * 256) = pack8(S.sf2, S.sf3); } while (0)
#define SWRITE_VF(bf) do { *(bf16x8*)(V_lds + (bf) * SHM_V + vst0) = pack8(S.sf0, S.sf1); *(bf16x8*)(V_lds + (bf) * SHM_V + vst1) = pack8(S.sf2, S.sf3); } while (0)
template <class TIn, class TOut, int PQ, int PKV, int PO>
__device__ __forceinline__ void causal_swa_prime(const BlockRef<TIn, TOut>& cur, int W, char* lds, Seam<TIn>& S, const int mk_wid) {
    constexpr bool F32 = same_t<TIn, float>::v;
    const int wid = mk_wid, lane = mk_lane(), tid = wid * 64 + lane, r32 = lane & 31, hi = lane >> 5;
    const int sr = tid >> 4, sc = (tid & 15) * 8, kws = KSWZ(sr, sc * 2); char* K_lds = lds + 2 * SHM_V;
    const int kb0 = swa_jlo(cur.P0, W) * KVBLK;
    for (int d0 = 0; d0 < 8; ++d0) S.qr[d0] = load8<TIn>(cur.Q + (size_t)(wid * QBLK + r32) * PQ + d0 * 16 + hi * 8);
    if constexpr (F32) { SLOAD_F((const float*)cur.K, kb0); VMW(); SWRITE_KF(0); SBAR(); SLOAD_F((const float*)cur.V, kb0); }
    else { SLOAD_H(cur.K, cur.V, kb0); VMW(); SWRITE_HK(0); }
    __syncthreads();
}
template <class TIn, class TOut, int PQ, int PKV, int PO>
__device__ __forceinline__ void causal_swa_block(const BlockRef<TIn, TOut>& cur, const BlockRef<TIn, TOut>& nxt, int skv, int W, char* lds, Seam<TIn>& S, const int mk_wid) {
    constexpr bool F32 = same_t<TIn, float>::v;
    const int wid = mk_wid, lane = mk_lane(), tid = wid * 64 + lane, r32 = lane & 31, hi = lane >> 5;
    const int j_lo = swa_jlo(cur.P0, W);
    int j_hi = (cur.P0 + QB - 1) / KVBLK + 1; if (j_hi > skv / KVBLK) j_hi = skv / KVBLK;
    const int NT = j_hi - j_lo;
    const int kbn = swa_jlo(nxt.P0, W) * KVBLK;
    const int qlo = cur.P0 + wid * QBLK, qm = qlo + r32 - 4 * hi;
    char* V_lds = lds; char* K_lds = lds + 2 * SHM_V;
    float* ws = (float*)(lds + 2 * SHM_V + 2 * SHM_K) + wid * 64; float* li_l = ws, * al_l = ws + 32;
    float m_reg = -1e30f, l_reg = 0; f32x16 o[4] = {};
    const int sr = tid >> 4, sc = (tid & 15) * 8, vst0 = v_st(sr, sc), vst1 = v_st(32 + sr, sc), kws = KSWZ(sr, sc * 2);
    const int vb0 = (int)(uintptr_t)V_lds + v_rd_base(lane);
    const TIn* Kh = cur.K; const TIn* Vh = cur.V;
#define RESC(a) do { if (__any((a) < 1.f)) { if (hi == 0) al_l[r32] = (a); asm volatile("s_waitcnt lgkmcnt(0)" ::: "memory");              \
                     for (int d_ = 0; d_ < 4; ++d_) for (int r = 0; r < 16; ++r) o[d_][r] *= al_l[crow(r, hi)]; } } while (0)
#define KBASE(t) ((j_lo + (t)) * KVBLK)
#define ACT(t) (KBASE(t) <= qlo + QBLK - 1 && KBASE(t) + KVBLK - 1 >= qlo - W + 1)
#define MASKT(P0_, P1_, t) do { const int kb_ = KBASE(t); if ((!SK || ACT(t)) && (kb_ + KVBLK - 1 > qlo || kb_ <= qlo + QBLK - 1 - W)) mask_tile(P0_, P1_, qm - kb_, (unsigned)W); } while (0)
    constexpr int NQL = F32 ? 16 : 8;
    constexpr bool SK = WSKIP && !F32;
#define SEAM_K0() do { VMWN(NQL); if constexpr (F32) { SWRITE_KF(0); SBAR(); SLOAD_F((const float*)nxt.V, kbn); } else { SWRITE_HK(0); } SBAR(); } while (0)
    f32x16 pA0, pA1, pB0, pB1; float mnA, mnB, alA, alB; bf16x8 pa0, pa1, pa2, pa3;
    if constexpr (F32) { VMW(); SWRITE_VF(0); SBAR(); } else { SWRITE_HV(0); SBAR(); }
    if (NT > 1) { if constexpr (F32) SLOAD_F((const float*)Kh, KBASE(1)); else SLOAD_H(Kh, Vh, KBASE(1)); }
    SBAR(); qkt<0, SK>(pA0, pA1, K_lds, r32, hi, S.qr, ACT(0));
    if constexpr (F32) { if (NT > 1) { VMW(); SWRITE_KF(1); SBAR(); SLOAD_F((const float*)Vh, KBASE(1)); } }
    MASKT(pA0, pA1, 0); partialSM(pA0, pA1, m_reg, mnA, alA);
    if (NT > 1) { VMW(); if constexpr (F32) { SWRITE_VF(1); SBAR(); if (NT > 2) SLOAD_F((const float*)Kh, KBASE(2)); } else SWRITE_H(1); }
    __syncthreads();
#define HALF_STEP(PX0, PX1, mnX, alX, PY0, PY1, alY, t, KB, VB, SB) do {                                                      \
        SBAR(); qkt<KB, SK>(PX0, PX1, K_lds, r32, hi, S.qr, ACT(t));                                             \
        finishSM(PY0, PY1, alY, l_reg, pa0, pa1, pa2, pa3); SBAR();                                                           \
        if ((t) + 1 < NT) { if constexpr (F32) { VMW(); SWRITE_KF(SB); SBAR(); SLOAD_F((const float*)Vh, KBASE((t) + 1)); }  \
                            else { SLOAD_H(Kh, Vh, KBASE((t) + 1)); } SBAR(); }                                               \
        pv_tile<VB, SK>(o, vb0, pa0, pa1, pa2, pa3, ACT((t) - 1)); MASKT(PX0, PX1, (t)); partialSM(PX0, PX1, m_reg, mnX, alX);                                        \
        __syncthreads();                                                                                                      \
        if ((t) + 1 < NT) { VMW(); if constexpr (F32) { SWRITE_VF(SB); SBAR(); if ((t) + 2 < NT) SLOAD_F((const float*)Kh, KBASE((t) + 2)); } \
                            else { SWRITE_H(SB); } }                                                                          \
        RESC(alX); __syncthreads(); } while (0)
    for (int t = 1; t + 1 < NT; t += 2) {
        HALF_STEP(pB0, pB1, mnB, alB, pA0, pA1, alA, t, 1, 0, 0);
        HALF_STEP(pA0, pA1, mnA, alA, pB0, pB1, alB, t + 1, 0, 1, 1);
    }
    const bool even = (NT & 1) == 0;
    if (even) { SBAR(); qkt<1, SK>(pB0, pB1, K_lds, r32, hi, S.qr, ACT(NT - 1)); SBAR(); }
#define QROW(e) (nxt.Q + (size_t)(wid * QBLK + r32) * PQ + ((e) >> 1) * 16 + hi * 8 + ((e) & 1) * 4)
    if constexpr (F32) { SLOAD_F((const float*)nxt.K, kbn); SBAR();
#pragma unroll
        for (int e = 0; e < 8; ++e) S.tq[e] = *(const f32x4*)QROW(e); }
    else { SLOAD_H(nxt.K, nxt.V, kbn); SBAR();
#pragma unroll
        for (int d0 = 0; d0 < 8; ++d0) S.qr[d0] = load8<TIn>(nxt.Q + (size_t)(wid * QBLK + r32) * PQ + d0 * 16 + hi * 8); }
    SBAR();
    finishSM(pA0, pA1, alA, l_reg, pa0, pa1, pa2, pa3); SBAR();
    if constexpr (F32) {
#pragma unroll
        for (int e = 8; e < 16; ++e) S.tq[e] = *(const f32x4*)QROW(e); SBAR(); }
#undef QROW
    pv_tile<0, SK>(o, vb0, pa0, pa1, pa2, pa3, ACT(even ? NT - 2 : NT - 1));
    if (even) { MASKT(pB0, pB1, NT - 1); partialSM(pB0, pB1, m_reg, mnB, alB); __syncthreads(); RESC(alB);
        finishSM(pB0, pB1, alB, l_reg, pa0, pa1, pa2, pa3); SBAR(); pv_tile<1, SK>(o, vb0, pa0, pa1, pa2, pa3, ACT(NT - 1)); }
    SBAR(); SEAM_K0();
    if (hi == 0) li_l[r32] = l_reg; asm volatile("s_waitcnt lgkmcnt(0)" ::: "memory");
    float rli[16];
#pragma unroll
    for (int r = 0; r < 16; ++r) rli[r] = __builtin_amdgcn_rcpf(li_l[crow(r, hi)]);
    TOut* Ow = cur.O + (size_t)(wid * QBLK) * PO;
#pragma unroll
    for (int r = 0; r < 16; ++r) { const int orow = crow(r, hi);
#pragma unroll
        for (int d0 = 0; d0 < 4; ++d0) { const float v = o[d0][r] * rli[r];
            if constexpr (same_t<TOut, float>::v) { Ow[(size_t)orow * PO + d0 * 32 + r32] = v; }
            else { const float vn = __shfl_xor(v, 1);
                   if ((r32 & 1) == 0) *(unsigned*)(Ow + (size_t)orow * PO + d0 * 32 + r32) = cvtpk(v, vn); } } }
    if constexpr (F32) {
#pragma unroll
        for (int d0 = 0; d0 < 8; ++d0) S.qr[d0] = pack8(S.tq[2 * d0], S.tq[2 * d0 + 1]); }
    __syncthreads();
#undef RESC
#undef KBASE
#undef ACT
#undef MASKT
#undef SEAM_K0
#undef HALF_STEP
}
#undef ROW
#undef VMW
#undef VMWN
#undef SLOAD_H
#undef SWRITE_HK
#undef SWRITE_HV
#undef SWRITE_H
#undef SLOAD_F
#undef SWRITE_KF
#undef SWRITE_VF

typedef bf16 abf_t;
}

namespace at256 {
using at128::bf16x8; using at128::f32x16; using at128::f32x4; using at128::abf_t;
constexpr int L_K = 0, L_V = 32768, L_WS = 98304, LDS_NEED = L_WS + 8 * 64 * 4;
__device__ __forceinline__ int swap23(int k) { return (k & ~0xC) | ((k & 4) << 1) | ((k & 8) >> 1); }
template <int IMM> __device__ __forceinline__ void glds16(const void* gbase  , unsigned voff  , unsigned lds_dst) { unsigned keep;
    asm volatile("s_mov_b32 %0, m0\n\ts_mov_b32 m0, %3\n\ts_nop 0\n\tglobal_load_lds_dwordx4 %1, %2 offset:%4\n\ts_mov_b32 m0, %0" : "=&s"(keep) : "v"(voff), "s"(gbase), "s"(lds_dst), "i"(IMM) : "memory"); }
template <int BUF> __device__ __forceinline__ void pv256(f32x16* o, int vb0, bf16x8 pa0, bf16x8 pa1, bf16x8 pa2, bf16x8 pa3) {
    typedef at128::s16x4 s4;
    s4 fa[8], fb[8];
#define A256_TR(dst, off) asm volatile("ds_read_b64_tr_b16 %0, %1 offset:%2" : "=&v"(dst) : "v"(vb0), "i"(off) : "memory")
#define A256_LD(f, d0) do { constexpr int b_ = (BUF * 2 + ((d0) >> 2)) * 16384 + ((d0) & 3) * 512; \
        A256_TR(f[0], b_); A256_TR(f[1], b_ + 2048); A256_TR(f[2], b_ + 4096); A256_TR(f[3], b_ + 6144); A256_TR(f[4], b_ + 8192); A256_TR(f[5], b_ + 10240); A256_TR(f[6], b_ + 12288); A256_TR(f[7], b_ + 14336); } while (0)
#define A256_MM(f, d0) do { \
        o[d0] = __builtin_amdgcn_mfma_f32_32x32x16_bf16(pa0, (bf16x8){f[0][0], f[0][1], f[0][2], f[0][3], f[1][0], f[1][1], f[1][2], f[1][3]}, o[d0], 0, 0, 0); \
        o[d0] = __builtin_amdgcn_mfma_f32_32x32x16_bf16(pa1, (bf16x8){f[2][0], f[2][1], f[2][2], f[2][3], f[3][0], f[3][1], f[3][2], f[3][3]}, o[d0], 0, 0, 0); \
        o[d0] = __builtin_amdgcn_mfma_f32_32x32x16_bf16(pa2, (bf16x8){f[4][0], f[4][1], f[4][2], f[4][3], f[5][0], f[5][1], f[5][2], f[5][3]}, o[d0], 0, 0, 0); \
        o[d0] = __builtin_amdgcn_mfma_f32_32x32x16_bf16(pa3, (bf16x8){f[6][0], f[6][1], f[6][2], f[6][3], f[7][0], f[7][1], f[7][2], f[7][3]}, o[d0], 0, 0, 0); } while (0)
#define A256_W8() do { asm volatile("s_waitcnt lgkmcnt(8)" ::: "memory"); __builtin_amdgcn_sched_barrier(0); } while (0)
#define A256_W0() do { asm volatile("s_waitcnt lgkmcnt(0)" ::: "memory"); __builtin_amdgcn_sched_barrier(0); } while (0)
    A256_LD(fa, 0);
    A256_LD(fb, 1); A256_W8(); A256_MM(fa, 0); __builtin_amdgcn_sched_barrier(0);
    A256_LD(fa, 2); A256_W8(); A256_MM(fb, 1); __builtin_amdgcn_sched_barrier(0);
    A256_LD(fb, 3); A256_W8(); A256_MM(fa, 2); __builtin_amdgcn_sched_barrier(0);
    A256_LD(fa, 4); A256_W8(); A256_MM(fb, 3); __builtin_amdgcn_sched_barrier(0);
    A256_LD(fb, 5); A256_W8(); A256_MM(fa, 4); __builtin_amdgcn_sched_barrier(0);
    A256_LD(fa, 6); A256_W8(); A256_MM(fb, 5); __builtin_amdgcn_sched_barrier(0);
    A256_LD(fb, 7); A256_W8(); A256_MM(fa, 6); __builtin_amdgcn_sched_barrier(0);
    A256_W0(); A256_MM(fb, 7);
#undef A256_TR
#undef A256_LD
#undef A256_MM
#undef A256_W8
#undef A256_W0
}
struct Blk { const abf_t* Q; const abf_t* K; const abf_t* V; abf_t* O; int P0; };
template <int PQ, int PKV, int PO>
__device__ __forceinline__ void attn_block(const Blk& B, __attribute__((address_space(3))) unsigned char* ldsL, const int wid) {
    char* lds = (char*)ldsL;
    const int lane = mk_lane(), r32 = lane & 31, hi = lane >> 5;
    const unsigned lbase = (unsigned)(unsigned long)ldsL;
    unsigned offK, offV;
    { const int q = wid * 64 + lane, row = q >> 4, ch = (q & 15) ^ (row & 7); offK = (unsigned)(row * PKV + ch * 8) * 2u; }
    { const int q = wid * 128 + lane, st = q >> 5, rowk = (q >> 2) & 7, cch = q & 3, k = swap23((st >> 2) * 8 + rowk), c = (st & 3) * 32 + cch * 8; offV = (unsigned)(k * PKV + c) * 2u; }
    const unsigned lpk = (unsigned)wid * 1024u, lpv = (unsigned)wid * 2048u;
#define A256_DMA(buf, key0) do { const abf_t* kg_ = B.K + (size_t)(key0) * PKV; const abf_t* vg_ = B.V + (size_t)(key0) * PKV; \
        glds16<0>(kg_, offK, lbase + L_K + (buf) * 16384 + lpk); glds16<0>(kg_ + 32 * PKV, offK, lbase + L_K + (buf) * 16384 + lpk + 8192); \
        glds16<0>(vg_, offV, lbase + L_V + ((buf) * 2 + 0) * 16384 + lpv); glds16<128>(vg_, offV, lbase + L_V + ((buf) * 2 + 0) * 16384 + lpv + 1024 - 128); \
        glds16<256>(vg_, offV, lbase + L_V + ((buf) * 2 + 1) * 16384 + lpv - 256); glds16<384>(vg_, offV, lbase + L_V + ((buf) * 2 + 1) * 16384 + lpv + 1024 - 384); } while (0)
    const int NT = (B.P0 + 256) / 64;
    const int qlo = B.P0 + wid * 32, qm = qlo + r32 - 4 * hi;
    A256_DMA(0, 0);
    bf16x8 qr[8];
#pragma unroll
    for (int d0 = 0; d0 < 8; ++d0) qr[d0] = __builtin_nontemporal_load(reinterpret_cast<const bf16x8*>(B.Q + (size_t)(wid * 32 + r32) * PQ + d0 * 16 + hi * 8));
    float* wsf = (float*)(lds + L_WS) + wid * 64; float* li_l = wsf; float* al_l = wsf + 32;
    float m_reg = -1e30f, l_reg = 0.f; f32x16 o[8] = {};
    const int vb0 = (int)lbase + L_V + at128::v_rd_base(lane);
    asm volatile("s_waitcnt vmcnt(0)" ::: "memory"); __syncthreads();
#define A256_STEP(buf, t) do { \
        if ((t) + 1 < NT) A256_DMA(1 - (buf), ((t) + 1) * 64); \
        f32x16 p0, p1; float mn, alpha; bf16x8 pa0, pa1, pa2, pa3; \
        at128::qkt<buf, false>(p0, p1, lds + L_K, r32, hi, qr, true); \
        { const int kb_ = (t) * 64; if (kb_ + 63 > qlo) at128::mask_tile(p0, p1, qm - kb_, 0x7fffffffu); } \
        at128::partialSM(p0, p1, m_reg, mn, alpha); \
        if (__any(alpha < 1.f)) { if (hi == 0) al_l[r32] = alpha; asm volatile("s_waitcnt lgkmcnt(0)" ::: "memory"); \
            _Pragma("unroll") for (int r_ = 0; r_ < 16; ++r_) { const float a_ = al_l[at128::crow(r_, hi)]; _Pragma("unroll") for (int d_ = 0; d_ < 8; ++d_) o[d_][r_] *= a_; } } \
        at128::finishSM(p0, p1, alpha, l_reg, pa0, pa1, pa2, pa3); __builtin_amdgcn_sched_barrier(0); \
        pv256<buf>(o, vb0, pa0, pa1, pa2, pa3); \
        asm volatile("s_waitcnt vmcnt(0)" ::: "memory"); __syncthreads(); } while (0)
    for (int t = 0; t < NT; t += 2) { A256_STEP(0, t); A256_STEP(1, t + 1); }
    if (hi == 0) li_l[r32] = l_reg; asm volatile("s_waitcnt lgkmcnt(0)" ::: "memory");
    abf_t* Ow = B.O + (size_t)(wid * 32) * PO;
#pragma unroll
    for (int r = 0; r < 16; ++r) { const int orow = at128::crow(r, hi); const float rl = __builtin_amdgcn_rcpf(li_l[orow]);
#pragma unroll
        for (int d0 = 0; d0 < 8; ++d0) { const float v = o[d0][r] * rl; const float vn = __shfl_xor(v, 1);
            if ((r32 & 1) == 0) *(unsigned*)(Ow + (size_t)orow * PO + d0 * 32 + r32) = at128::cvtpk(v, vn); } }
    __syncthreads();
#undef A256_STEP
#undef A256_DMA
}
}

constexpr int NWAVES = 8;
constexpr int NTOK = 32768, DM = 2048, SEQ = 8192, NBATCH = 4;
constexpr int MAINW = 1536, MEMW = 512, NMEM = 256;
constexpr int A_IN = 3584;
constexpr int B_IN = 5120;
constexpr int FF = 5632, FFE = 7168, NEXP = 8;
constexpr int NSG = 12;
constexpr float ALPHA = 1.41421356237309515f;
constexpr float LN_EPS = 1e-5f;
constexpr float LAMBDA_INIT = 0.355509067592f;
constexpr int MAXT = 264;
constexpr int NPHASE = 17;
constexpr float W8_D_MUL = 128.f, H8_MUL = 4.f;
constexpr float W8_G_MUL = -64.f * 1.4426950408889634f, W8_U_MUL = -64.f * 4.f / 1.4426950408889634f;
constexpr int SC_ONE = 0x7f7f7f7f, SC_M4 = 0x7d7d7d7d, SC_M6 = 0x79797979, SC_M7 = 0x78787878;

constexpr size_t MiB = 1u << 20;
constexpr size_t WS_CTL = 0, CTL_ZERO_BYTES = 64 * 1024;
constexpr size_t WS_WSBF = 1 * MiB;
constexpr size_t WS_MEMB = 2 * MiB;
constexpr size_t WS_MEMKV = 6 * MiB;
constexpr size_t WS_ROUTE_E = 10 * MiB;
constexpr size_t WS_ROUTE_W = 10 * MiB + 256 * 1024;
constexpr size_t WS_TOKSLOT = 10 * MiB + 512 * 1024;
constexpr size_t WS_SLOTGATE = 11 * MiB;
constexpr size_t WS_SLOTTOK = 11 * MiB + 512 * 1024;
constexpr size_t WS_HIST = 12 * MiB;
constexpr size_t WS_MOETAB = 12 * MiB + 256 * 1024;
constexpr size_t WS_OSK = 1644 * MiB;
constexpr size_t WS_STATS = 13 * MiB;
#if MK_FP8_MOE
constexpr int MOE_CHUNK_T = MAXT;
constexpr size_t WS_W_MOE_GU = 16 * MiB;
constexpr size_t WS_W_MOE_D = 240 * MiB;
constexpr size_t WS_XS = 352 * MiB;
#else
constexpr size_t WS_W_MOE_GU = 16 * MiB;
constexpr size_t WS_W_MOE_D = 464 * MiB;
constexpr size_t WS_XS = 812 * MiB;
#endif
constexpr size_t WS_W_A_IN = 688 * MiB;
constexpr size_t WS_W_MIX = 702 * MiB;
constexpr size_t WS_W_FFN_GU = 718 * MiB;
constexpr size_t WS_W_FFN_D = 762 * MiB;
constexpr size_t WS_W_B_IN = 784 * MiB;
constexpr size_t WS_W_MEMKV = 804 * MiB;
constexpr size_t WS_XB = 812 * MiB;
constexpr size_t WS_H0 = 940 * MiB;
constexpr size_t WS_CONCAT = 1164 * MiB;
constexpr size_t WS_HID = 940 * MiB;
constexpr size_t WS_H1 = 940 * MiB;
constexpr size_t WS_AO = 1260 * MiB;
constexpr size_t WS_CONCAT1 = 1452 * MiB;
constexpr size_t WS_X3B = 1580 * MiB;
#if MK_FP8_MOE
constexpr size_t WS_OS = 812 * MiB;
constexpr size_t WS_HIDM = 1076 * MiB;
constexpr size_t WS_END = 1708 * MiB;
constexpr size_t WS_Y3B = 496 * MiB;
static_assert(WS_XS + (size_t)MAXT * 256 * DM <= WS_Y3B && WS_Y3B + (size_t)NTOK * DM * 2 <= WS_W_A_IN, "y3 map");
static_assert(WS_W_MOE_D + (size_t)NEXP * DM * FFE <= WS_XS && WS_XS + (size_t)MAXT * 256 * DM <= WS_W_A_IN, "fp8 MoE weight map");
static_assert(WS_OS + (size_t)MAXT * 256 * DM * 2 <= WS_HIDM && WS_HIDM + (size_t)MAXT * 256 * FFE <= WS_X3B, "fp8 MoE map");
#else
constexpr size_t WS_OS = 1076 * MiB;
constexpr size_t WS_HIDM = 1340 * MiB;
constexpr size_t WS_END = 1802 * MiB;
static_assert(WS_XS + (size_t)MAXT * 256 * DM * 2 <= WS_OS && WS_OS + (size_t)MAXT * 256 * DM * 2 <= WS_HIDM && WS_HIDM + (size_t)MOE_CHUNK_T * 256 * FFE * 2 <= WS_END, "MoE map");
static_assert(WS_XS + (size_t)MAXT * 256 * DM * 2 <= WS_CONCAT1, "XS must not overlap CONCAT1/X3B");
#endif
static_assert(WS_H0 + (size_t)NTOK * A_IN * 2 <= WS_CONCAT && WS_HID + (size_t)NTOK * FF * 2 <= 1292 * MiB && WS_H1 + (size_t)NTOK * B_IN * 2 <= WS_AO && WS_AO + (size_t)NTOK * 3072 * 2 <= WS_CONCAT1, "activation map");
static_assert(WS_CONCAT1 + (size_t)NTOK * DM * 2 <= WS_X3B && WS_X3B + (size_t)NTOK * DM * 2 <= 1708 * MiB, "activation map 2");
constexpr int CW_TMO = 0, CW_CODE = 1;
constexpr int CW_BAR = 4096;
constexpr int CW_BGQ = 12288;
constexpr int CW_TS = 8300;
constexpr int CW_CHK = 8192;

constexpr int RING_OFF = 0, RING_BYTES = 131072;
constexpr int LDSCTL_OFF = 147456 - 1024, MISC_OFF = LDSCTL_OFF + 320;
constexpr int LDS_BYTES = 147456;

#define GAS __attribute__((address_space(1)))
#define LAS __attribute__((address_space(3)))
typedef unsigned short bf16;
typedef unsigned v4u __attribute__((ext_vector_type(4)));
typedef float f32x4 __attribute__((ext_vector_type(4)));
typedef short bf16x8 __attribute__((ext_vector_type(8)));
typedef GAS unsigned gu32;
typedef GAS unsigned long long gu64;
#define RLX_AGENT __ATOMIC_RELAXED, __HIP_MEMORY_SCOPE_AGENT
#define LDS_WAIT() asm volatile("s_waitcnt lgkmcnt(0)" ::: "memory")
#define VM_WAIT() asm volatile("s_waitcnt vmcnt(0)" ::: "memory")
__device__ __forceinline__ unsigned long long rt() { return __builtin_amdgcn_s_memrealtime(); }
__device__ __forceinline__ unsigned f2bf(float f) { unsigned u = __builtin_bit_cast(unsigned, f); return (u + 0x7fffu + ((u >> 16) & 1u)) >> 16; }
__device__ __forceinline__ unsigned pk2(float lo, float hi) { return f2bf(lo) | (f2bf(hi) << 16); }

#define XB_TMO      128
#define XB_XCNT(j)  (256  + 64 * (j))
#define XB_XSUB(j)  (1280 + 64 * (j))
#define XB_XGEN(j)  (2304 + 64 * (j))
#define XB_TOP      3328
#define XB_TOPGEN   3392
#define XCD_BAR_WORDS 3456
#define XB_SPIN_CAP (1u << 18)

__device__ __forceinline__ unsigned xb_ld(unsigned* p)              { return __hip_atomic_load(p, __ATOMIC_RELAXED, __HIP_MEMORY_SCOPE_AGENT); }
__device__ __forceinline__ unsigned xb_add(unsigned* p, unsigned v) { return __hip_atomic_fetch_add(p, v, __ATOMIC_RELAXED, __HIP_MEMORY_SCOPE_AGENT); }
__device__ __forceinline__ unsigned xb_xcc_id() { return (unsigned)__builtin_amdgcn_s_getreg((3 << 11) | 20) & 0xFu; }
#define XB_SPIN(cond, bar) do { unsigned _sp = 0; while (cond) { __builtin_amdgcn_s_sleep(1); \
    if ((++_sp & 255u) == 0u) { if (xb_ld(&(bar)[XB_TMO])) break; if (_sp > XB_SPIN_CAP) { atomicAdd(&(bar)[XB_TMO], 1u); break; } } } } while (0)

struct XcdBarrier {
    unsigned* bar; unsigned x; int wave;
    volatile LAS unsigned* st;
};

__device__ __forceinline__ XcdBarrier xcd_barrier_post(unsigned* bar, volatile LAS unsigned* st) {
    XcdBarrier b; b.bar = bar; b.x = xb_xcc_id(); b.st = st;
    if (threadIdx.x == 0) (void)xb_add(&bar[XB_XCNT(b.x)], 1u);
    return b;
}
__device__ __forceinline__ void xcd_barrier_complete(unsigned* bar, unsigned x, unsigned& nloc, unsigned& nx) {
    const unsigned G = gridDim.x * gridDim.y * gridDim.z;
    unsigned sum, cnt, mine, sp = 0u;
    for (;;) {
        sum = 0u; cnt = 0u; mine = 0u;
#pragma unroll
        for (unsigned j = 0; j < 16; ++j) { const unsigned c = xb_ld(&bar[XB_XCNT(j)]); sum += c; cnt += (c > 0u) ? 1u : 0u; mine = (j == x) ? c : mine; }
        if (sum == G) break;
        __builtin_amdgcn_s_sleep(1);
        if ((++sp & 255u) == 0u) { if (xb_ld(&bar[XB_TMO])) break; if (sp > XB_SPIN_CAP) { atomicAdd(&bar[XB_TMO], 1u); break; } }
    }
    nloc = mine > 0u ? mine : 1u; nx = cnt > 0u ? cnt : 1u;
}

__device__ __forceinline__ void xcd_barrier(const XcdBarrier& b) {
    asm volatile("s_waitcnt vmcnt(0)" ::: "memory");
    __syncthreads();
    if (b.wave == 0 && mk_lane() == 0) {
        unsigned* bar = b.bar;
        __builtin_amdgcn_s_waitcnt(0);
        unsigned nloc = b.st[0], nx = b.st[1];
        if (nloc == 0u) { xcd_barrier_complete(bar, b.x, nloc, nx); b.st[0] = nloc; b.st[1] = nx; }
        const unsigned old = xb_add(&bar[XB_XSUB(b.x)], 1u);
        const unsigned gen = old / nloc;
        if (old + 1u == (gen + 1u) * nloc) {
            __builtin_amdgcn_fence(__ATOMIC_RELEASE, "agent");
            asm volatile("s_waitcnt vmcnt(0)" ::: "memory");
            const unsigned og = xb_add(&bar[XB_TOP], 1u);
            const unsigned tg = og / nx;
            if (og + 1u == (tg + 1u) * nx) xb_add(&bar[XB_TOPGEN], 1u);
            else XB_SPIN(xb_ld(&bar[XB_TOPGEN]) == tg, bar);
            __builtin_amdgcn_fence(__ATOMIC_ACQUIRE, "agent");
            xb_add(&bar[XB_XGEN(b.x)], 1u);
            asm volatile("s_waitcnt vmcnt(0)" ::: "memory");
        } else {
            XB_SPIN(xb_ld(&bar[XB_XGEN(b.x)]) == gen, bar);
            __builtin_amdgcn_fence(__ATOMIC_ACQUIRE, "agent");
            asm volatile("s_waitcnt vmcnt(0)" ::: "memory");
        }
    }
    __syncthreads();
}


struct Frame {
    LAS unsigned char* lds;
    volatile LAS unsigned* MISC;
    gu32* ctl;
    int wave;
    int G;
    unsigned char* ws;
    const float* in[25]; float* out;
};
enum { I_X = 0, I_MEM, I_LNG, I_LNB, I_WMIX, I_WMEMKV, I_AWIN, I_AVG, I_AVB, I_AWS, I_ABS, I_SWKV, I_BWIN, I_LQ1, I_LK1, I_LQ2, I_LK2, I_SUBLN, I_FG, I_FU, I_FD, I_ROUTER, I_MG, I_MU, I_MD };

template <int CTRL> __device__ __forceinline__ float dpp_f(float v) { return __builtin_bit_cast(float, __builtin_amdgcn_update_dpp(0, __builtin_bit_cast(int, v), CTRL, 0xf, 0xf, true)); }
__device__ __forceinline__ float wave_sum(float v) {
    v += dpp_f<0xB1>(v); v += dpp_f<0x4E>(v); v += dpp_f<0x141>(v); v += dpp_f<0x140>(v);
    { auto t = __builtin_amdgcn_permlane16_swap(__float_as_uint(v), __float_as_uint(v), false, false); v = __uint_as_float(t[0]) + __uint_as_float(t[1]); }
    { auto t = __builtin_amdgcn_permlane32_swap(__float_as_uint(v), __float_as_uint(v), false, false); v = __uint_as_float(t[0]) + __uint_as_float(t[1]); }
    return v;
}
__device__ __forceinline__ float bf2f(unsigned short b) { return __builtin_bit_cast(float, (unsigned)b << 16); }
__device__ __forceinline__ float bflo(unsigned w) { return __builtin_bit_cast(float, w << 16); }
__device__ __forceinline__ float bfhi(unsigned w) { return __builtin_bit_cast(float, w & 0xffff0000u); }

__device__ __forceinline__ void tr_item(const float* W, int K, int N, bf16* WT, int k0, int n0, int drow0, LAS float* scr, int lane) {
    float t_[32];
#pragma unroll
    for (int i = 0; i < 32; ++i) { const int kk = 2 * i + (lane >> 5); t_[i] = __builtin_nontemporal_load(W + (size_t)(k0 + kk) * N + n0 + (lane & 31)); }
#pragma unroll
    for (int i = 0; i < 32; ++i) { const int kk = 2 * i + (lane >> 5); scr[kk * 33 + (lane & 31)] = t_[i]; }
    LDS_WAIT(); asm volatile("" ::: "memory");
    const int c = lane & 7;
#pragma unroll
    for (int j = 0; j < 4; ++j) { const int n = (lane >> 3) + 8 * j; const LAS float* s = scr + (8 * c) * 33 + n;
        v4u o; o.x = pk2(s[0 * 33], s[1 * 33]); o.y = pk2(s[2 * 33], s[3 * 33]); o.z = pk2(s[4 * 33], s[5 * 33]); o.w = pk2(s[6 * 33], s[7 * 33]);
        *(GAS v4u*)(WT + (size_t)(drow0 + n) * K + k0 + 8 * c) = o; }
    LDS_WAIT(); asm volatile("" ::: "memory");
}
__device__ __forceinline__ void tr_item8(const float* W, int K, int N, unsigned char* WT, int k0, int n0, int drow0, float mul, LAS float* scr, int lane) {
    float t_[64];
#pragma unroll
    for (int i = 0; i < 64; ++i) { const int kk = 2 * i + (lane >> 5); t_[i] = __builtin_nontemporal_load(W + (size_t)(k0 + kk) * N + n0 + (lane & 31)); }
#pragma unroll
    for (int i = 0; i < 64; ++i) { const int kk = 2 * i + (lane >> 5); scr[kk * 33 + (lane & 31)] = t_[i]; }
    LDS_WAIT(); asm volatile("" ::: "memory");
    const int n = lane >> 1, hf = lane & 1; const LAS float* s = scr + (64 * hf) * 33 + n;
    GAS v4u* dst = (GAS v4u*)(WT + (size_t)(drow0 + n) * K + k0 + 64 * hf);
#pragma unroll
    for (int g = 0; g < 4; ++g) { int w[4];
#pragma unroll
        for (int q = 0; q < 4; ++q) { const int kq = 16 * g + 4 * q; int t = 0; t = __builtin_amdgcn_cvt_pk_fp8_f32(s[kq * 33] * mul, s[(kq + 1) * 33] * mul, t, false); t = __builtin_amdgcn_cvt_pk_fp8_f32(s[(kq + 2) * 33] * mul, s[(kq + 3) * 33] * mul, t, true); w[q] = t; }
        dst[g] = (v4u){(unsigned)w[0], (unsigned)w[1], (unsigned)w[2], (unsigned)w[3]}; }
    LDS_WAIT(); asm volatile("" ::: "memory");
}
__device__ __forceinline__ void tr_matrix_item8(const float* W, int K, int N, unsigned char* WT, int row_off, int mode, float mul, int item, LAS float* scr, int lane) {
    const int nblk = N / 32, kb = item / nblk, nb = item % nblk, k0 = 128 * kb, n0 = 32 * nb;
    const int drow0 = row_off + (mode == 0 ? n0 : ((n0 >> 7) * 256 + (n0 & 127) + (mode == 2 ? 128 : 0)));
    tr_item8(W, K, N, WT, k0, n0, drow0, mul, scr, lane);
}
__device__ __forceinline__ void tr_matrix_item(const float* W, int K, int N, bf16* WT, int row_off, int mode, int item, LAS float* scr, int lane) {
    const int nblk = N / 32, kb = item / nblk, nb = item % nblk, k0 = 64 * kb, n0 = 32 * nb;
    const int drow0 = row_off + (mode == 0 ? n0 : ((n0 >> 7) * 256 + (n0 & 127) + (mode == 2 ? 128 : 0)));
    tr_item(W, K, N, WT, k0, n0, drow0, scr, lane);
}
__device__ __forceinline__ void p0_prologue(Frame& F) {
    const int lane_ = mk_lane(), tid_ = F.wave * 64 + lane_;
    LAS float* scr = (LAS float*)(F.lds + RING_OFF + F.wave * 16896);
    const int gw = blockIdx.x * NWAVES + F.wave, NGW = F.G * NWAVES;
    bf16* ws16 = (bf16*)F.ws;
    constexpr int KD8 = MK_FP8_MOE ? 128 : 64, KF8 = MK_FP8_FFN ? 128 : 64;
    constexpr int I_E = (DM / KD8) * (FFE / 32);
    constexpr int I_MOE = 3 * NEXP * I_E;
    constexpr int I_AIN = (DM / 64) * (A_IN / 32), I_MIXW = (DM / 64) * (DM / 32), I_FGU = (DM / KF8) * (FF / 32), I_FDN = (FF / KF8) * (DM / 32);
    constexpr int I_KV = (DM / 64) * (3072 / 32), I_BIN = (DM / 64) * (DM / 32), I_MKV = (DM / 64) * (1024 / 32);
    constexpr int NITEMS = I_MOE + I_AIN + 2 * I_MIXW + 2 * I_FGU + I_FDN + I_KV + I_BIN + 2 * I_MKV;
#if MK_BG
    constexpr int NFG = I_AIN + I_MIXW + 2 * I_MKV;
    for (int it = gw; it < NFG; it += NGW) { int r = it;
        if (r < I_AIN) { tr_matrix_item(F.in[I_AWIN], DM, A_IN, (bf16*)(F.ws + WS_W_A_IN), 0, 0, r, scr, lane_); continue; } r -= I_AIN;
        if (r < I_MIXW) { tr_matrix_item(F.in[I_WMIX], DM, DM, (bf16*)(F.ws + WS_W_MIX), 0, 0, r, scr, lane_); continue; } r -= I_MIXW;
        { const int l = r / I_MKV; tr_matrix_item(F.in[I_WMEMKV] + (size_t)l * DM * 1024, DM, 1024, (bf16*)(F.ws + WS_W_MEMKV), l * 1024, 0, r % I_MKV, scr, lane_); } }
    if (false)
#endif
    for (int it = gw; it < NITEMS; it += NGW) {
        int r = it;
        if (r < I_MOE) { const int which = r / (NEXP * I_E), rr = r % (NEXP * I_E), e = rr / I_E, item = rr % I_E;
#if MK_FP8_MOE
            if (which == 0) tr_matrix_item8(F.in[I_MG] + (size_t)e * DM * FFE, DM, FFE, F.ws + WS_W_MOE_GU, e * 2 * FFE, 1, W8_G_MUL, item, scr, lane_);
            else if (which == 1) tr_matrix_item8(F.in[I_MU] + (size_t)e * DM * FFE, DM, FFE, F.ws + WS_W_MOE_GU, e * 2 * FFE, 2, W8_U_MUL, item, scr, lane_);
            else tr_matrix_item8(F.in[I_MD] + (size_t)e * FFE * DM, FFE, DM, F.ws + WS_W_MOE_D, e * DM, 0, W8_D_MUL, item, scr, lane_);
#else
            if (which == 0) tr_matrix_item(F.in[I_MG] + (size_t)e * DM * FFE, DM, FFE, (bf16*)(F.ws + WS_W_MOE_GU), e * 2 * FFE, 1, item, scr, lane_);
            else if (which == 1) tr_matrix_item(F.in[I_MU] + (size_t)e * DM * FFE, DM, FFE, (bf16*)(F.ws + WS_W_MOE_GU), e * 2 * FFE, 2, item, scr, lane_);
            else tr_matrix_item(F.in[I_MD] + (size_t)e * FFE * DM, FFE, DM, (bf16*)(F.ws + WS_W_MOE_D), e * DM, 0, item, scr, lane_);
#endif
            continue; } r -= I_MOE;
        if (r < I_AIN) { tr_matrix_item(F.in[I_AWIN], DM, A_IN, (bf16*)(F.ws + WS_W_A_IN), 0, 0, r, scr, lane_); continue; } r -= I_AIN;
        if (r < 2 * I_MIXW) { const int l = r / I_MIXW; tr_matrix_item(F.in[I_WMIX] + (size_t)l * DM * DM, DM, DM, (bf16*)(F.ws + WS_W_MIX), l * DM, 0, r % I_MIXW, scr, lane_); continue; } r -= 2 * I_MIXW;
#if MK_FP8_FFN
        if (r < I_FGU) { tr_matrix_item8(F.in[I_FG], DM, FF, F.ws + WS_W_FFN_GU, 0, 1, W8_G_MUL, r, scr, lane_); continue; } r -= I_FGU;
        if (r < I_FGU) { tr_matrix_item8(F.in[I_FU], DM, FF, F.ws + WS_W_FFN_GU, 0, 2, W8_U_MUL, r, scr, lane_); continue; } r -= I_FGU;
        if (r < I_FDN) { tr_matrix_item8(F.in[I_FD], FF, DM, F.ws + WS_W_FFN_D, 0, 0, W8_D_MUL, r, scr, lane_); continue; } r -= I_FDN;
#else
        if (r < I_FGU) { tr_matrix_item(F.in[I_FG], DM, FF, (bf16*)(F.ws + WS_W_FFN_GU), 0, 1, r, scr, lane_); continue; } r -= I_FGU;
        if (r < I_FGU) { tr_matrix_item(F.in[I_FU], DM, FF, (bf16*)(F.ws + WS_W_FFN_GU), 0, 2, r, scr, lane_); continue; } r -= I_FGU;
        if (r < I_FDN) { tr_matrix_item(F.in[I_FD], FF, DM, (bf16*)(F.ws + WS_W_FFN_D), 0, 0, r, scr, lane_); continue; } r -= I_FDN;
#endif
        if (r < I_KV) { tr_matrix_item(F.in[I_SWKV], DM, 3072, (bf16*)(F.ws + WS_W_B_IN), 0, 0, r, scr, lane_); continue; } r -= I_KV;
        if (r < I_BIN) { tr_matrix_item(F.in[I_BWIN], DM, DM, (bf16*)(F.ws + WS_W_B_IN), 3072, 0, r, scr, lane_); continue; } r -= I_BIN;
        { const int l = r / I_MKV; tr_matrix_item(F.in[I_WMEMKV] + (size_t)l * DM * 1024, DM, 1024, (bf16*)(F.ws + WS_W_MEMKV), l * 1024, 0, r % I_MKV, scr, lane_); }
    }
    (void)ws16;
    { const size_t gt = (size_t)blockIdx.x * (NWAVES * 64) + tid_, NT = (size_t)F.G * NWAVES * 64;
      const GAS f32x4* x4 = (const GAS f32x4*)F.in[I_X]; GAS v4u* xb = (GAS v4u*)(F.ws + WS_XB);
      for (size_t i = gt; i < (size_t)NTOK * DM / 8; i += NT) { const f32x4 a = __builtin_nontemporal_load(x4 + 2 * i), b = __builtin_nontemporal_load(x4 + 2 * i + 1); v4u o; o.x = pk2(a.x, a.y); o.y = pk2(a.z, a.w); o.z = pk2(b.x, b.y); o.w = pk2(b.z, b.w); xb[i] = o; }
      const GAS f32x4* m4 = (const GAS f32x4*)F.in[I_MEM]; GAS v4u* mb = (GAS v4u*)(F.ws + WS_MEMB);
      for (size_t i = gt; i < (size_t)NBATCH * NMEM * DM / 8; i += NT) { const f32x4 a = m4[2 * i], b = m4[2 * i + 1]; v4u o; o.x = pk2(a.x, a.y); o.y = pk2(a.z, a.w); o.z = pk2(b.x, b.y); o.w = pk2(b.z, b.w); mb[i] = o; }
      const float* wsrc = F.in[I_AWS]; bf16* wd = (bf16*)(F.ws + WS_WSBF);
      for (size_t i = gt; i < (size_t)NSG * 128 * 128; i += NT) { const int s = (int)(i & 127), t = (int)((i >> 7) & 127); wd[i] = (bf16)(s <= t ? f2bf(wsrc[i]) : 0u); }
    }
}

#if MK_BG
static_assert(MK_FP8_MOE, "the background item list is written for the fp8 MoE build");
constexpr int BG_F = (DM / (MK_FP8_FFN ? 128 : 64)) * (FF / 32);
constexpr int BG_EA = 3 * BG_F;
constexpr int BG_KV = (DM / 64) * (3072 / 32), BG_BIN = (DM / 64) * (DM / 32), BG_MIX = (DM / 64) * (DM / 32);
constexpr int BG_EB = BG_EA + BG_KV + BG_BIN;
constexpr int BG_EC = BG_EB + BG_MIX;
constexpr int BG_IE = (DM / 128) * (FFE / 32);
constexpr int BG_ED = BG_EC + 3 * NEXP * BG_IE;
constexpr int BG_EA1 = 2 * BG_F;
constexpr int BG_ED1 = BG_EC + 2 * NEXP * BG_IE;
static_assert(BG_EA % 8 == 0 && BG_EB % 8 == 0 && BG_EC % 8 == 0 && BG_ED % 8 == 0 && BG_EA1 % 8 == 0 && BG_ED1 % 8 == 0, "segments are whole 8-item batches");
__device__ __forceinline__ void bg_item(Frame& F, int it, LAS float* scr, int lane) {
    int r = it;
    if (r < BG_EA) { const int w = r / BG_F, item = r % BG_F;
#if MK_FP8_FFN
        if (w == 0) tr_matrix_item8(F.in[I_FG], DM, FF, F.ws + WS_W_FFN_GU, 0, 1, W8_G_MUL, item, scr, lane);
        else if (w == 1) tr_matrix_item8(F.in[I_FU], DM, FF, F.ws + WS_W_FFN_GU, 0, 2, W8_U_MUL, item, scr, lane);
        else tr_matrix_item8(F.in[I_FD], FF, DM, F.ws + WS_W_FFN_D, 0, 0, W8_D_MUL, item, scr, lane);
#else
        if (w == 0) tr_matrix_item(F.in[I_FG], DM, FF, (bf16*)(F.ws + WS_W_FFN_GU), 0, 1, item, scr, lane);
        else if (w == 1) tr_matrix_item(F.in[I_FU], DM, FF, (bf16*)(F.ws + WS_W_FFN_GU), 0, 2, item, scr, lane);
        else tr_matrix_item(F.in[I_FD], FF, DM, (bf16*)(F.ws + WS_W_FFN_D), 0, 0, item, scr, lane);
#endif
        return; } r -= BG_EA;
    if (r < BG_KV) { tr_matrix_item(F.in[I_SWKV], DM, 3072, (bf16*)(F.ws + WS_W_B_IN), 0, 0, r, scr, lane); return; } r -= BG_KV;
    if (r < BG_BIN) { tr_matrix_item(F.in[I_BWIN], DM, DM, (bf16*)(F.ws + WS_W_B_IN), 3072, 0, r, scr, lane); return; } r -= BG_BIN;
    if (r < BG_MIX) { tr_matrix_item(F.in[I_WMIX] + (size_t)DM * DM, DM, DM, (bf16*)(F.ws + WS_W_MIX), DM, 0, r, scr, lane); return; } r -= BG_MIX;
    { const int which = r / (NEXP * BG_IE), rr = r % (NEXP * BG_IE), e = rr / BG_IE, item = rr % BG_IE;
      if (which == 0) tr_matrix_item8(F.in[I_MG] + (size_t)e * DM * FFE, DM, FFE, F.ws + WS_W_MOE_GU, e * 2 * FFE, 1, W8_G_MUL, item, scr, lane);
      else if (which == 1) tr_matrix_item8(F.in[I_MU] + (size_t)e * DM * FFE, DM, FFE, F.ws + WS_W_MOE_GU, e * 2 * FFE, 2, W8_U_MUL, item, scr, lane);
      else tr_matrix_item8(F.in[I_MD] + (size_t)e * FFE * DM, FFE, DM, F.ws + WS_W_MOE_D, e * DM, 0, W8_D_MUL, item, scr, lane); }
}
__device__ __forceinline__ int bg_round(Frame& F) {
    volatile LAS int* w = (volatile LAS int*)(F.lds + LDSCTL_OFF + 128);
    const int lane = mk_lane();
    if (F.wave == 0 && lane == 0) w[0] = (int)__hip_atomic_fetch_add(F.ctl + CW_BGQ, 8u, RLX_AGENT);
    __syncthreads();
    const int base = w[0];
    if (base >= 0 && base < BG_ED) bg_item(F, base + F.wave, (LAS float*)(F.lds + RING_OFF + F.wave * 16896), lane);
    __syncthreads();
    return (base >= 0) ? base : BG_ED;
}
__device__ __forceinline__ void bg_drain(Frame& F, int X) {
    volatile LAS int* w = (volatile LAS int*)(F.lds + LDSCTL_OFF + 128);
    for (;;) {
        if (F.wave == 0 && mk_lane() == 0) w[3] = (int)__hip_atomic_load(F.ctl + CW_BGQ, RLX_AGENT);
        __syncthreads();
        const int head = w[3];
        __syncthreads();
        if (head < 0 || head >= X) break;
        (void)bg_round(F);
    }
}
#endif

#if MK_BG
__device__ __forceinline__ void xcd_barrier_bg(const XcdBarrier& b, Frame& F, bool& bg_done) {
    asm volatile("s_waitcnt vmcnt(0)" ::: "memory");
    __syncthreads();
    volatile LAS int* w = (volatile LAS int*)(F.lds + LDSCTL_OFF + 128);
    const bool t0 = (b.wave == 0 && mk_lane() == 0);
    if (t0) {
        unsigned* bar = b.bar;
        __builtin_amdgcn_s_waitcnt(0);
        unsigned nloc = b.st[0], nx = b.st[1];
        if (nloc == 0u) { xcd_barrier_complete(bar, b.x, nloc, nx); b.st[0] = nloc; b.st[1] = nx; }
        const unsigned old = xb_add(&bar[XB_XSUB(b.x)], 1u);
        const unsigned gen = old / nloc;
        if (old + 1u == (gen + 1u) * nloc) {
            __builtin_amdgcn_fence(__ATOMIC_RELEASE, "agent");
            asm volatile("s_waitcnt vmcnt(0)" ::: "memory");
            const unsigned og = xb_add(&bar[XB_TOP], 1u);
            const unsigned tg = og / nx;
            if (og + 1u == (tg + 1u) * nx) xb_add(&bar[XB_TOPGEN], 1u);
            else XB_SPIN(xb_ld(&bar[XB_TOPGEN]) == tg, bar);
            __builtin_amdgcn_fence(__ATOMIC_ACQUIRE, "agent");
            xb_add(&bar[XB_XGEN(b.x)], 1u);
            asm volatile("s_waitcnt vmcnt(0)" ::: "memory");
            w[1] = 1;
        } else { w[1] = 0; w[2] = (int)gen; }
    }
    __syncthreads();
    if (w[1] == 0) {
        for (unsigned it = 0;; ++it) {
            if (t0) { unsigned* bar = b.bar; int rel = xb_ld(&bar[XB_XGEN(b.x)]) != (unsigned)w[2];
                if (!rel && (it & 63u) == 63u) { if (xb_ld(&bar[XB_TMO])) rel = 1; else if (it > (1u << 17)) { atomicAdd(&bar[XB_TMO], 1u); rel = 1; } }
                w[4 + (it & 1u)] = rel; }
            __syncthreads();
            if (w[4 + (it & 1u)]) break;
            if (!bg_done) { if (bg_round(F) >= BG_ED) bg_done = true; } else __builtin_amdgcn_s_sleep(2);
        }
        if (t0) { __builtin_amdgcn_fence(__ATOMIC_ACQUIRE, "agent"); asm volatile("s_waitcnt vmcnt(0)" ::: "memory"); }
    }
    __syncthreads();
}
#endif

__device__ __forceinline__ void ln_load(const float* row, int lane, f32x4 (&v)[8]) { const GAS f32x4* xr = (const GAS f32x4*)row + lane;
#pragma unroll
    for (int j = 0; j < 8; ++j) v[j] = __builtin_nontemporal_load(xr + 64 * j); }
__device__ __forceinline__ void ln_load16(const bf16* row, int lane, f32x4 (&v)[8]) { const GAS unsigned long long* xr = (const GAS unsigned long long*)row + lane;
#pragma unroll
    for (int j = 0; j < 8; ++j) { const unsigned long long t = __builtin_nontemporal_load(xr + 64 * j); const unsigned lo = (unsigned)t, hi = (unsigned)(t >> 32);
        v[j].x = __uint_as_float(lo << 16); v[j].y = __uint_as_float(lo & 0xffff0000u); v[j].z = __uint_as_float(hi << 16); v[j].w = __uint_as_float(hi & 0xffff0000u); } }
__device__ __forceinline__ void ln_norm(f32x4 (&v)[8], const float* g, const float* b, int lane, float* mean_o = nullptr, float* rstd_o = nullptr) {
    float s = 0.f;
#pragma unroll
    for (int j = 0; j < 8; ++j) s += (v[j].x + v[j].y) + (v[j].z + v[j].w);
    const float mean = wave_sum(s) * (1.f / DM); float s2 = 0.f;
#pragma unroll
    for (int j = 0; j < 8; ++j) { v[j] = v[j] - mean; s2 += (v[j].x * v[j].x + v[j].y * v[j].y) + (v[j].z * v[j].z + v[j].w * v[j].w); }
    const float rstd = 1.f / sqrtf(wave_sum(s2) * (1.f / DM) + LN_EPS);
    if (mean_o) { *mean_o = mean; *rstd_o = rstd; }
    const GAS f32x4* g4 = (const GAS f32x4*)g + lane; const GAS f32x4* b4 = (const GAS f32x4*)b + lane;
#pragma unroll
    for (int j = 0; j < 8; ++j) v[j] = v[j] * rstd * g4[64 * j] + b4[64 * j];
}
__device__ __forceinline__ void ln_store16(const f32x4 (&v)[8], bf16* brow, int lane) {
    GAS unsigned long long* o8 = (GAS unsigned long long*)brow + lane;
#pragma unroll
    for (int j = 0; j < 8; ++j) o8[64 * j] = (unsigned long long)pk2(v[j].x, v[j].y) | ((unsigned long long)pk2(v[j].z, v[j].w) << 32);
}
__device__ __forceinline__ void ln_store(const f32x4 (&v)[8], float* drow, bf16* brow, int lane) {
    GAS f32x4* o4 = (GAS f32x4*)drow + lane;
#pragma unroll
    for (int j = 0; j < 8; ++j) __builtin_nontemporal_store(v[j], o4 + 64 * j);
    if (brow) { GAS unsigned long long* o8 = (GAS unsigned long long*)brow + lane;
#pragma unroll
        for (int j = 0; j < 8; ++j) o8[64 * j] = (unsigned long long)pk2(v[j].x, v[j].y) | ((unsigned long long)pk2(v[j].z, v[j].w) << 32); }
}
__device__ __forceinline__ void ln_store8(const f32x4 (&v)[8], unsigned char* brow, int lane) {
    GAS unsigned* o4 = (GAS unsigned*)brow + lane;
#pragma unroll
    for (int j = 0; j < 8; ++j) { int t = 0; t = __builtin_amdgcn_cvt_pk_fp8_f32(v[j].x, v[j].y, t, false); t = __builtin_amdgcn_cvt_pk_fp8_f32(v[j].z, v[j].w, t, true); o4[64 * j] = (unsigned)t; }
}
template <bool F8 = false> __device__ __forceinline__ void ln_phase(Frame& F, const bf16* src, void* dstb, const float* g, const float* b) {
    const int lane_ = mk_lane();
    const int gw = blockIdx.x * NWAVES + F.wave, NGW = F.G * NWAVES; float* stats = (float*)(F.ws + WS_STATS);
#define LN_ROW(v, m) do { float mean, rstd; ln_norm(v, g, b, lane_, &mean, &rstd); \
        if (F8) ln_store8(v, (unsigned char*)dstb + (size_t)(m) * DM, lane_); else ln_store16(v, (bf16*)dstb + (size_t)(m) * DM, lane_); \
        if (lane_ == 0) { stats[2 * (m)] = mean; stats[2 * (m) + 1] = rstd; } } while (0)
    for (int base = gw * 16; base < NTOK; base += NGW * 16) {
        f32x4 va[8], vb[8]; ln_load16(src + (size_t)base * DM, lane_, va);
        for (int r = 0; r < 16; r += 2) {
            ln_load16(src + (size_t)(base + r + 1) * DM, lane_, vb); LN_ROW(va, base + r);
            if (r + 2 < 16) ln_load16(src + (size_t)(base + r + 2) * DM, lane_, va);
            LN_ROW(vb, base + r + 1); }
    }
#undef LN_ROW
}

typedef at128::bf16 abf;
typedef at128::BlockRef<abf, abf> ABlk;
template <int PQ> __device__ __forceinline__ ABlk memattn_ref(int L, const abf* Qb, const abf* KVb, abf* Ob) {
    const int tile = L >> 2, h = L & 3, b = tile >> 5; ABlk r;
    r.Q = Qb + (size_t)tile * 256 * PQ + h * 128; r.K = KVb + (size_t)b * NMEM * 2048 + h * 128; r.V = r.K + MEMW; r.O = Ob + (size_t)tile * 256 * DM + h * 128; r.P0 = 1 << 20; return r;
}
template <int PQ> __device__ __forceinline__ void memattn_phase(int G, int wv, char* lds, const abf* Qb, const abf* KVb, abf* Ob) {
    constexpr int total = (NTOK / 256) * 4, W = 1 << 30;
    int L = blockIdx.x; if (L >= total) return;
    ABlk cur = memattn_ref<PQ>(L, Qb, KVb, Ob); at128::Seam<abf> S;
    at128::causal_swa_prime<abf, abf, PQ, 2048, DM>(cur, W, lds, S, wv);
    for (;;) { const bool last = L + G >= total; const ABlk nxt = last ? cur : memattn_ref<PQ>(L + G, Qb, KVb, Ob);
        at128::causal_swa_block<abf, abf, PQ, 2048, DM>(cur, nxt, NMEM, W, lds, S, wv); if (last) break; cur = nxt; L += G; }
}
__device__ __forceinline__ at256::Blk diff_blk(int vh, int qb, const abf* H1, abf* AO) {
    const int b = vh / 12, rem = vh % 12, h = rem >> 1, m = rem & 1; at256::Blk r; const abf* base = H1 + (size_t)b * SEQ * B_IN;
    r.Q = base + (size_t)qb * 256 * B_IN + 3072 + (m * 6 + h) * 128; r.K = base + (m * 6 + h) * 128; r.V = base + 1536 + h * 256;
    r.O = AO + ((size_t)b * SEQ + (size_t)qb * 256) * 3072 + m * 1536 + h * 256; r.P0 = qb * 256; return r;
}
__device__ __forceinline__ void diffattn_phase(int G, int wv, LAS unsigned char* ldsL, const abf* H1, abf* AO) {
    constexpr int NX = 16, total = 48 * NX;
    if (G == 256) {
        const int c = blockIdx.x, x8 = c & 7, j = c >> 3;
        for (int i = 0; i < 3; ++i) { const int vh = 2 * (i * 8 + x8) + (j >> 4), x = j & 15;
            at256::attn_block<B_IN, B_IN, 3072>(diff_blk(vh, x, H1, AO), ldsL, wv);
            at256::attn_block<B_IN, B_IN, 3072>(diff_blk(vh, 31 - x, H1, AO), ldsL, wv); }
    } else {
        for (int L = blockIdx.x; L < total; L += G) { const int vh = L / NX, x = L % NX;
            at256::attn_block<B_IN, B_IN, 3072>(diff_blk(vh, x, H1, AO), ldsL, wv);
            at256::attn_block<B_IN, B_IN, 3072>(diff_blk(vh, 31 - x, H1, AO), ldsL, wv); }
    }
}

__device__ __forceinline__ void sg_phase(Frame& F) {
    const bf16* H0 = (const bf16*)(F.ws + WS_H0); bf16* CC = (bf16*)(F.ws + WS_CONCAT); const bf16* WSB = (const bf16*)(F.ws + WS_WSBF);
    const float* vg = F.in[I_AVG]; const float* vb = F.in[I_AVB]; const float* bsp = F.in[I_ABS];
    const int lane = mk_lane(), wid = F.wave, tid = wid * 64 + lane, r32 = lane & 31, hi = lane >> 5;
    LAS float* stats = (LAS float*)(F.lds + 65536);
    LAS unsigned char* sw = F.lds + 66560 + wid * 8192;
    for (int c = blockIdx.x; c < NTOK / 128; c += F.G) {
        const size_t R0 = (size_t)c * 128;
        for (int r4 = 0; r4 < 16; r4 += 4) {
            v4u w[4][3];
#pragma unroll
            for (int q = 0; q < 4; ++q)
#pragma unroll
                for (int j = 0; j < 3; ++j) w[q][j] = *(const GAS v4u*)(H0 + (R0 + wid * 16 + r4 + q) * A_IN + MAINW + j * 512 + lane * 8);
#pragma unroll
            for (int q = 0; q < 4; ++q) { float x[24];
#pragma unroll
                for (int j = 0; j < 3; ++j) { x[8 * j + 0] = bflo(w[q][j].x); x[8 * j + 1] = bfhi(w[q][j].x); x[8 * j + 2] = bflo(w[q][j].y); x[8 * j + 3] = bfhi(w[q][j].y); x[8 * j + 4] = bflo(w[q][j].z); x[8 * j + 5] = bfhi(w[q][j].z); x[8 * j + 6] = bflo(w[q][j].w); x[8 * j + 7] = bfhi(w[q][j].w); }
                float s = 0.f;
#pragma unroll
                for (int j = 0; j < 24; ++j) s += x[j];
                const float mean = wave_sum(s) * (1.f / MAINW); float qq = 0.f;
#pragma unroll
                for (int j = 0; j < 24; ++j) { const float dd = x[j] - mean; qq += dd * dd; }
                const float rstd = 1.f / sqrtf(wave_sum(qq) * (1.f / MAINW) + LN_EPS);
                if (lane == 0) { const int t = wid * 16 + r4 + q; stats[2 * t] = mean; stats[2 * t + 1] = rstd; } asm volatile("" ::: "memory"); }
        }
        __syncthreads();
        const char* hbase = (const char*)(H0 + R0 * A_IN);
        v4u wst[8];
#define SG_LOADV(gp_) do { unsigned soff = (unsigned)(((tid >> 4) * A_IN + MAINW + (tid & 15) * 8) * 2); asm volatile("" : "+v"(soff)); \
        _Pragma("unroll") for (int i = 0; i < 8; ++i) wst[i] = *(const GAS v4u*)(hbase + (soff + (unsigned)(((((i >> 1) & 1) * 64 + (i & 1) * 32) * A_IN + (2 * (gp_) + (i >> 2)) * 128) * 2))); } while (0)
        SG_LOADV(0);
        for (int gp = 0; gp < NSG / 2; ++gp) {
#pragma unroll
            for (int i = 0; i < 8; ++i) {
                const int p = tid + 512 * i, gsel = p >> 11, kt = (p >> 10) & 1, key = (p >> 4) & 63, c8 = (p & 15) * 8, tok = kt * 64 + key, col = (2 * gp + gsel) * 128 + c8;
                const v4u w = wst[i];
                const float mean = stats[2 * tok], rstd = stats[2 * tok + 1];
                const f32x4 g0 = *(const GAS f32x4*)(vg + col), g1 = *(const GAS f32x4*)(vg + col + 4), b0 = *(const GAS f32x4*)(vb + col), b1 = *(const GAS f32x4*)(vb + col + 4);
                v4u o;
                o.x = pg8::cvt_pk_bf16((bflo(w.x) - mean) * rstd * g0.x + b0.x, (bfhi(w.x) - mean) * rstd * g0.y + b0.y);
                o.y = pg8::cvt_pk_bf16((bflo(w.y) - mean) * rstd * g0.z + b0.z, (bfhi(w.y) - mean) * rstd * g0.w + b0.w);
                o.z = pg8::cvt_pk_bf16((bflo(w.z) - mean) * rstd * g1.x + b1.x, (bfhi(w.z) - mean) * rstd * g1.y + b1.y);
                o.w = pg8::cvt_pk_bf16((bflo(w.w) - mean) * rstd * g1.z + b1.z, (bfhi(w.w) - mean) * rstd * g1.w + b1.w);
                *(LAS v4u*)(F.lds + (gsel * 2 + kt) * 16384 + at128::v_st(key, c8)) = o;
            }
            __syncthreads();
            if (gp + 1 < NSG / 2) SG_LOADV(gp + 1);
            { const int gsel = wid >> 2, tb = wid & 3, g = 2 * gp + gsel;
              const int er = lane >> 4, ec = (lane & 15) * 8; v4u uu[8];
              unsigned uoff = (unsigned)(((tb * 32 + er) * A_IN + g * 128 + ec) * 2); asm volatile("" : "+v"(uoff));
#pragma unroll
              for (int j = 0; j < 8; ++j) uu[j] = __builtin_nontemporal_load((const GAS v4u*)(hbase + (uoff + (unsigned)(4 * j * A_IN * 2))));
              at128::f32x16 o[4] = {};
              const int vb0 = (int)(unsigned long)(F.lds) + gsel * 32768 + at128::v_rd_base(lane);
              const bf16* wrow = WSB + ((size_t)g * 128 + tb * 32 + r32) * 128 + hi * 8;
              { const at128::bf16x8 pa0 = *(const GAS at128::bf16x8*)(wrow), pa1 = *(const GAS at128::bf16x8*)(wrow + 16), pa2 = *(const GAS at128::bf16x8*)(wrow + 32), pa3 = *(const GAS at128::bf16x8*)(wrow + 48);
                at128::pv_tile<0, false>(o, vb0, pa0, pa1, pa2, pa3, true); }
              if (tb >= 2) { const at128::bf16x8 pa0 = *(const GAS at128::bf16x8*)(wrow + 64), pa1 = *(const GAS at128::bf16x8*)(wrow + 80), pa2 = *(const GAS at128::bf16x8*)(wrow + 96), pa3 = *(const GAS at128::bf16x8*)(wrow + 112);
                at128::pv_tile<1, false>(o, vb0, pa0, pa1, pa2, pa3, true); }
#pragma unroll
              for (int r = 0; r < 16; ++r) { const int t = at128::crow(r, hi); const float bsv = bsp[g * 128 + tb * 32 + t];
#pragma unroll
                  for (int d0 = 0; d0 < 4; ++d0) { const float val = o[d0][r] + bsv; const float vn = __shfl_xor(val, 1);
                      if ((r32 & 1) == 0) *(LAS unsigned*)(sw + t * 256 + (d0 * 32 + r32) * 2) = pg8::cvt_pk_bf16(val, vn); } }
              char* cbase = (char*)(CC + R0 * DM); unsigned coff = (unsigned)(((tb * 32 + er) * DM + g * 128 + ec) * 2); asm volatile("" : "+v"(coff));
              LDS_WAIT(); asm volatile("" ::: "memory");
#pragma unroll
              for (int j = 0; j < 8; ++j) { const v4u sv = *(const LAS v4u*)(sw + (er + 4 * j) * 256 + ec * 2); v4u ov;
                  ov.x = pg8::cvt_pk_bf16(bflo(sv.x) * bflo(uu[j].x), bfhi(sv.x) * bfhi(uu[j].x)); ov.y = pg8::cvt_pk_bf16(bflo(sv.y) * bflo(uu[j].y), bfhi(sv.y) * bfhi(uu[j].y));
                  ov.z = pg8::cvt_pk_bf16(bflo(sv.z) * bflo(uu[j].z), bfhi(sv.z) * bfhi(uu[j].z)); ov.w = pg8::cvt_pk_bf16(bflo(sv.w) * bflo(uu[j].w), bfhi(sv.w) * bfhi(uu[j].w));
                  *(GAS v4u*)(cbase + (coff + (unsigned)(4 * j * DM * 2))) = ov; asm volatile("" ::: "memory"); }
            }
            __syncthreads();
        }
    }
#undef SG_LOADV
}

__device__ __forceinline__ void combine_phase(Frame& F) {
    const bf16* AO = (const bf16*)(F.ws + WS_AO); bf16* CC = (bf16*)(F.ws + WS_CONCAT1);
    const int lane = mk_lane(), gw = blockIdx.x * NWAVES + F.wave, NGW = F.G * NWAVES;
    const float* q1 = F.in[I_LQ1]; const float* k1 = F.in[I_LK1]; const float* q2 = F.in[I_LQ2]; const float* k2 = F.in[I_LK2];
    const float s1 = wave_sum(q1[lane] * k1[lane] + q1[lane + 64] * k1[lane + 64]), s2 = wave_sum(q2[lane] * k2[lane] + q2[lane + 64] * k2[lane + 64]);
    const float lam = expf(s1) - expf(s2) + LAMBDA_INIT, post = 1.0f - LAMBDA_INIT;
    const f32x4 g4 = *(const GAS f32x4*)(F.in[I_SUBLN] + 4 * lane);
#define CB_LOAD(av, bv, m0_) do { _Pragma("unroll") for (int t = 0; t < 2; ++t) { const bf16* r1 = AO + (size_t)((m0_) + t) * 3072 + 4 * lane; \
        _Pragma("unroll") for (int h = 0; h < 6; ++h) { av[t][h] = __builtin_nontemporal_load((const GAS unsigned long long*)(r1 + h * 256)); bv[t][h] = __builtin_nontemporal_load((const GAS unsigned long long*)(r1 + 1536 + h * 256)); } } } while (0)
#define CB_DO(av, bv, m0_) do { _Pragma("unroll") for (int t = 0; t < 2; ++t) { bf16* orow = CC + (size_t)((m0_) + t) * DM + 4 * lane; \
        _Pragma("unroll") for (int h = 0; h < 6; ++h) { \
            const unsigned a0 = (unsigned)av[t][h], a1 = (unsigned)(av[t][h] >> 32), b0 = (unsigned)bv[t][h], b1 = (unsigned)(bv[t][h] >> 32); \
            const float x0 = bflo(a0) - lam * bflo(b0), x1 = bfhi(a0) - lam * bfhi(b0), x2 = bflo(a1) - lam * bflo(b1), x3 = bfhi(a1) - lam * bfhi(b1); \
            const float ss = wave_sum((x0 * x0 + x1 * x1) + (x2 * x2 + x3 * x3)); \
            const float r = post / sqrtf(ss * (1.f / 256.f) + LN_EPS); \
            *(GAS unsigned long long*)(orow + h * 256) = (unsigned long long)pg8::cvt_pk_bf16(x0 * r * g4.x, x1 * r * g4.y) | ((unsigned long long)pg8::cvt_pk_bf16(x2 * r * g4.z, x3 * r * g4.w) << 32); } } } while (0)
    const int step = NGW * 2; int m0 = gw * 2;
    if (m0 < NTOK) {
        unsigned long long a_[2][6], b_[2][6], c_[2][6], d_[2][6];
        CB_LOAD(a_, b_, m0);
        for (;;) {
            const int m1 = m0 + step; if (m1 < NTOK) CB_LOAD(c_, d_, m1);
            CB_DO(a_, b_, m0); if (m1 >= NTOK) break;
            const int m2 = m1 + step; if (m2 < NTOK) CB_LOAD(a_, b_, m2);
            CB_DO(c_, d_, m1); if (m2 >= NTOK) break;
            m0 = m2; }
    }
#undef CB_LOAD
#undef CB_DO
}

__device__ __forceinline__ void router_row(f32x4 (&v)[8], int m, int lane, const float* g, const float* b, bf16* xb, const LAS float* wr, int* route_e, float* route_w, int& cnt) {
            ln_norm(v, g, b, lane);
#if MK_FP8_MOE
            ln_store8(v, (unsigned char*)xb + (size_t)m * DM, lane);
#else
            ln_store16(v, xb + (size_t)m * DM, lane);
#endif
            float lg[8];
#pragma unroll
            for (int e = 0; e < 8; ++e) lg[e] = 0.f;
#pragma unroll
            for (int j = 0; j < 8; ++j) {
#pragma unroll
                for (int e = 0; e < 8; ++e) { const f32x4 w = *(const LAS f32x4*)(wr + e * DM + 256 * j + 4 * lane); lg[e] += (v[j].x * w.x + v[j].y * w.y) + (v[j].z * w.z + v[j].w * w.w); }
                asm volatile("" ::: "memory"); }
#pragma unroll
            for (int e = 0; e < 8; ++e) lg[e] = wave_sum(lg[e]);
            int e0 = 0; float l0 = lg[0];
#pragma unroll
            for (int e = 1; e < 8; ++e) if (lg[e] > l0) { l0 = lg[e]; e0 = e; }
            int e1 = -1; float l1 = -3.0e38f;
#pragma unroll
            for (int e = 0; e < 8; ++e) if (e != e0 && lg[e] > l1) { l1 = lg[e]; e1 = e; }
            const float ex = expf(l1 - l0), w0 = 1.0f / (1.0f + ex), w1 = ex / (1.0f + ex);
            if (lane == 0) { route_e[m] = e0 | (e1 << 8); route_w[2 * m] = w0; route_w[2 * m + 1] = w1; }
            cnt += (lane == e0) + (lane == e1);
}
__device__ __forceinline__ void ln_router_phase(Frame& F, const bf16* xio, bf16* xb, const float* g, const float* b) {
    LAS float* wr = (LAS float*)(F.lds);
    const float* wsrc = F.in[I_ROUTER];
    const int lane = mk_lane();
    for (int i = F.wave * 64 + lane; i < DM * NEXP; i += NWAVES * 64) wr[(i & 7) * DM + (i >> 3)] = wsrc[i];
    __syncthreads();
    int* route_e = (int*)(F.ws + WS_ROUTE_E); float* route_w = (float*)(F.ws + WS_ROUTE_W); int* hist = (int*)(F.ws + WS_HIST);
    const int gw = blockIdx.x * NWAVES + F.wave, NGW = F.G * NWAVES;
    for (int grp = gw; grp < NTOK / 16; grp += NGW) {
        int cnt = 0;
        f32x4 va[8], vb[8]; ln_load16(xio + (size_t)(grp * 16) * DM, lane, va);
        for (int r = 0; r < 16; r += 2) {
            ln_load16(xio + (size_t)(grp * 16 + r + 1) * DM, lane, vb); router_row(va, grp * 16 + r, lane, g, b, xb, wr, route_e, route_w, cnt);
            if (r + 2 < 16) ln_load16(xio + (size_t)(grp * 16 + r + 2) * DM, lane, va);
            router_row(vb, grp * 16 + r + 1, lane, g, b, xb, wr, route_e, route_w, cnt); }
        if (lane < 8) hist[grp * 8 + lane] = cnt;
    }
}

__device__ __forceinline__ void dispatch_phase(Frame& F) {
    LAS int* gpre = (LAS int*)(F.lds);
    LAS int* wtot = (LAS int*)(F.lds + 65536);
    LAS int* tst = (LAS int*)(F.lds + 65536 + 256);
    const int* hist = (const int*)(F.ws + WS_HIST); const int lane = mk_lane(), wid = F.wave, tid = wid * 64 + lane;
    int h[4][8], sum[8];
#pragma unroll
    for (int e = 0; e < 8; ++e) sum[e] = 0;
#pragma unroll
    for (int i = 0; i < 4; ++i) { const v4u a = *(const GAS v4u*)(hist + (4 * tid + i) * 8), b = *(const GAS v4u*)(hist + (4 * tid + i) * 8 + 4);
        h[i][0] = a.x; h[i][1] = a.y; h[i][2] = a.z; h[i][3] = a.w; h[i][4] = b.x; h[i][5] = b.y; h[i][6] = b.z; h[i][7] = b.w;
#pragma unroll
        for (int e = 0; e < 8; ++e) sum[e] += h[i][e]; }
    int inc[8];
#pragma unroll
    for (int e = 0; e < 8; ++e) { int v = sum[e];
#pragma unroll
        for (int o = 1; o < 64; o <<= 1) { const int t = __shfl_up(v, o); if (lane >= o) v += t; }
        inc[e] = v; if (lane == 63) wtot[wid * 8 + e] = v; }
    __syncthreads();
    int tot[8];
#pragma unroll
    for (int e = 0; e < 8; ++e) { int pre = 0, all = 0;
#pragma unroll
        for (int w = 0; w < 8; ++w) { const int t = wtot[w * 8 + e]; all += t; if (w < wid) pre += t; }
        tot[e] = all; int run = pre + inc[e] - sum[e];
#pragma unroll
        for (int i = 0; i < 4; ++i) { gpre[(4 * tid + i) * 8 + e] = run; run += h[i][e]; } }
    if (tid == 0) { int ts = 0;
#pragma unroll
        for (int e = 0; e < 8; ++e) { tst[e] = ts; ts += (tot[e] + 255) >> 8; } tst[8] = ts;
        if (blockIdx.x == 0) { int* tab = (int*)(F.ws + WS_MOETAB);
#pragma unroll
            for (int e = 0; e <= 8; ++e) tab[e] = tst[e]; } }
    __syncthreads();
    const int* route_e = (const int*)(F.ws + WS_ROUTE_E); const float* route_w = (const float*)(F.ws + WS_ROUTE_W);
    int* tokslot = (int*)(F.ws + WS_TOKSLOT); int* slottok = (int*)(F.ws + WS_SLOTTOK); float* slotgate = (float*)(F.ws + WS_SLOTGATE);
    const bf16* X3B = (const bf16*)(F.ws + WS_X3B); bf16* XS = (bf16*)(F.ws + WS_XS);
    const int gw = blockIdx.x * NWAVES + wid, NGW = F.G * NWAVES;
    for (int grp = gw; grp < NTOK / 16; grp += NGW) {
        const int a = lane & 31, tok = grp * 16 + (a >> 1), k = a & 1;
        const int e = (route_e[tok] >> (8 * k)) & 0xff; const float w = route_w[2 * tok + k];
        int rank = 0;
#pragma unroll
        for (int ee = 0; ee < 8; ++ee) { const unsigned long long mk = __ballot(lane < 32 && e == ee); if (e == ee) rank = __popcll(mk & ((1ull << lane) - 1ull)); }
        const int slot = tst[e] * 256 + gpre[grp * 8 + e] + rank;
        if (lane < 32) { slottok[slot] = tok; slotgate[slot] = w; tokslot[2 * tok + k] = slot; }
        for (int q4 = 0; q4 < 32; q4 += 4) {
#if MK_FP8_MOE
            v4u t_[4][2]; int sl[4];
#pragma unroll
            for (int u = 0; u < 4; ++u) { const int q = q4 + u; sl[u] = __shfl(slot, q); const int tk = grp * 16 + (q >> 1); const GAS v4u* src = (const GAS v4u*)((const unsigned char*)X3B + (size_t)tk * DM) + lane; t_[u][0] = src[0]; t_[u][1] = src[64]; }
#pragma unroll
            for (int u = 0; u < 4; ++u) { GAS v4u* dst = (GAS v4u*)((unsigned char*)XS + (size_t)sl[u] * DM) + lane; dst[0] = t_[u][0]; dst[64] = t_[u][1]; }
#else
            v4u t_[4][4]; int sl[4];
#pragma unroll
            for (int u = 0; u < 4; ++u) { const int q = q4 + u; sl[u] = __shfl(slot, q); const int tk = grp * 16 + (q >> 1); const GAS v4u* src = (const GAS v4u*)(X3B + (size_t)tk * DM) + lane;
#pragma unroll
                for (int j = 0; j < 4; ++j) t_[u][j] = src[64 * j]; }
#pragma unroll
            for (int u = 0; u < 4; ++u) { GAS v4u* dst = (GAS v4u*)(XS + (size_t)sl[u] * DM) + lane;
#pragma unroll
                for (int j = 0; j < 4; ++j) dst[64 * j] = t_[u][j]; }
#endif
        }
    }
}

__device__ __forceinline__ void add_os_row(f32x4 (&v)[8], const bf16* row, int lane) { const GAS unsigned long long* o = (const GAS unsigned long long*)row + lane;
#pragma unroll
    for (int j = 0; j < 8; ++j) { const unsigned long long p = __builtin_nontemporal_load(o + 64 * j); const unsigned p0 = (unsigned)p, p1 = (unsigned)(p >> 32); v[j].x += bflo(p0); v[j].y += bfhi(p0); v[j].z += bflo(p1); v[j].w += bfhi(p1); } }
__device__ __forceinline__ void final_phase(Frame& F, const float* g3, const float* b3, const float* g, const float* b) {
    const int* tokslot = (const int*)(F.ws + WS_TOKSLOT); const bf16* OS = (const bf16*)(F.ws + WS_OS); const bf16* OSK = (const bf16*)(F.ws + WS_OSK);
    const bf16* Y3 = (const bf16*)(F.ws + WS_Y3B);
    const int gw = blockIdx.x * NWAVES + F.wave, NGW = F.G * NWAVES, lane = mk_lane();
    int Tm = 1 << 30;
#if MK_FP8_MOE
    { const int T = ((const int*)(F.ws + WS_MOETAB))[8]; int Lt = T & 31; if (Lt > 8) Lt = 0; Tm = T - Lt; }
#endif
#define FIN_ROW(v, m, s0, s1) do { ln_norm(v, g3, b3, lane);     \
        _Pragma("unroll") for (int j = 0; j < 8; ++j) v[j] = v[j] * ALPHA; \
        { const int sl_[2] = {s0, s1}; _Pragma("unroll") for (int k = 0; k < 2; ++k) { const int s = sl_[k], tile = s >> 8; \
            if (tile >= Tm) { for (int q = 0; q < 4; ++q) add_os_row(v, OSK + ((size_t)(q * 8 + tile - Tm) * 256 + (s & 255)) * DM, lane); } \
            else add_os_row(v, OS + (size_t)s * DM, lane); } } \
        ln_norm(v, g, b, lane); ln_store(v, F.out + (size_t)(m) * DM, nullptr, lane); } while (0)
    for (int base = gw * 16; base < NTOK; base += NGW * 16) {
        f32x4 va[8], vb[8]; ln_load16(Y3 + (size_t)base * DM, lane, va); int a0 = tokslot[2 * base], a1 = tokslot[2 * base + 1], b0 = 0, b1 = 0;
        for (int r = 0; r < 16; r += 2) { const int m = base + r;
            ln_load16(Y3 + (size_t)(m + 1) * DM, lane, vb); b0 = tokslot[2 * (m + 1)]; b1 = tokslot[2 * (m + 1) + 1];
            FIN_ROW(va, m, a0, a1);
            if (r + 2 < 16) { ln_load16(Y3 + (size_t)(m + 2) * DM, lane, va); a0 = tokslot[2 * (m + 2)]; a1 = tokslot[2 * (m + 2) + 1]; }
            FIN_ROW(vb, m + 1, b0, b1); }
    }
#undef FIN_ROW
}

struct Args { const float* in[25]; float* out; unsigned char* ws; int ph_lo, ph_hi, ch_lo, ch_hi; };
__global__ void __launch_bounds__(NWAVES * 64, 2) mk_fwd(Args args) {
    extern __shared__ __attribute__((aligned(16))) unsigned char lds[];
    Frame F;
    F.lds = (LAS unsigned char*)lds; F.MISC = (volatile LAS unsigned*)(F.lds + MISC_OFF);
    F.wave = __builtin_amdgcn_readfirstlane(threadIdx.x >> 6); F.G = gridDim.x;
    F.ws = args.ws; F.ctl = (gu32*)(args.ws + WS_CTL); F.out = args.out;
#pragma unroll
    for (int i = 0; i < 25; ++i) F.in[i] = args.in[i];
    for (int u = threadIdx.x; u < (LDS_BYTES - LDSCTL_OFF) / 4; u += NWAVES * 64) ((LAS unsigned*)(F.lds + LDSCTL_OFF))[u] = 0u;
    __syncthreads();
    const int lo = args.ph_lo, hi = args.ph_hi;
    XcdBarrier bar; bar.bar = (unsigned*)(F.ctl + CW_BAR); bar.x = 0; bar.st = nullptr; bar.wave = F.wave;
    if (hi - lo > 1) { bar = xcd_barrier_post((unsigned*)(F.ctl + CW_BAR), F.MISC + 8); bar.wave = F.wave; }
#define IN(k) (((MK_PHMASK >> (k)) & 1) && lo <= (k) && (k) < hi)
#define BOTH(k) (IN(k) && IN((k) + 1))
#if MK_BG
    bool bg_done_ = false;
#define XCD_BAR_CALL() xcd_barrier_bg(bar, F, bg_done_)
#else
#define XCD_BAR_CALL() xcd_barrier(bar)
#endif
#if MK_PROBE == 3
    unsigned long long bar_wait_ = 0;
#define BG_DRAIN(X) do { const unsigned long long t0_ = rt(); bg_drain(F, X); bar_wait_ += rt() - t0_; } while (0)
#else
#define BG_DRAIN(X) bg_drain(F, X)
#endif
#if MK_PROBE == 2
    unsigned long long bar_wait_ = 0;
    int bar_idx_ = 0;
#define GRID_BAR() do { const unsigned long long t0_ = rt(); XCD_BAR_CALL(); if ((MK_PROBE_BARMASK >> bar_idx_) & 1) bar_wait_ += rt() - t0_; ++bar_idx_; } while (0)
#else
#define GRID_BAR() XCD_BAR_CALL()
#endif
#if MK_PROBE
    if (blockIdx.x == 0 && F.wave == 0 && mk_lane() == 0) __hip_atomic_store(F.ctl + CW_TS, (unsigned)rt(), RLX_AGENT);
#define STAMP(k) do { if (blockIdx.x == 0 && F.wave == 0 && mk_lane() == 0) __hip_atomic_store(F.ctl + CW_TS + 1 + (k), (unsigned)rt(), RLX_AGENT); } while (0)
#else
#define STAMP(k) do { } while (0)
#endif
    unsigned char* ws = args.ws;
    bf16* XB = (bf16*)(ws + WS_XB);
    LAS unsigned char* ring = F.lds + RING_OFF;

    if (IN(0)) { p0_prologue(F); if (BOTH(0)) GRID_BAR(); STAMP(0); }
    if (IN(1)) {
        { pg8::Gemm g{XB, (const bf16*)(ws + WS_W_A_IN), NTOK, A_IN, DM}; pg8::StaticOrder S; S.init(NTOK, A_IN, F.G, (int)blockIdx.x);
          pg8::EpiBf16 E{(bf16*)(ws + WS_H0), A_IN, 2 * MAINW}; pg8::gemm_phase<pg8::EpiBf16, pg8::StaticOrder, true, true>(ring, g, S, E, F.wave); }
        { pg8::Gemm g{(const bf16*)(ws + WS_MEMB), (const bf16*)(ws + WS_W_MEMKV), NBATCH * NMEM, 2048, DM}; pg8::StaticOrder S; S.init(NBATCH * NMEM, 2048, F.G, (int)blockIdx.x);
          pg8::EpiBf16 E{(bf16*)(ws + WS_MEMKV), 2048, 0}; pg8::gemm_phase<pg8::EpiBf16, pg8::StaticOrder, true, true>(ring, g, S, E, F.wave); }
        if (BOTH(1)) GRID_BAR(); STAMP(1);
    }
    if (IN(2)) {
        memattn_phase<A_IN>(F.G, F.wave, (char*)lds + RING_OFF, (const abf*)(ws + WS_H0) + 2 * MAINW, (const abf*)(ws + WS_MEMKV), (abf*)(ws + WS_CONCAT) + MAINW);
        __syncthreads();
        sg_phase(F);
        if (BOTH(2)) GRID_BAR(); STAMP(2);
    }
    if (IN(3)) {
        pg8::Gemm g{(const bf16*)(ws + WS_CONCAT), (const bf16*)(ws + WS_W_MIX), NTOK, DM, DM}; pg8::StaticOrder S; S.init(NTOK, DM, F.G, (int)blockIdx.x);
        pg8::EpiRes16 E{F.in[I_X], (bf16*)(ws + WS_Y3B)}; pg8::gemm_phase<pg8::EpiRes16, pg8::StaticOrder, true, true>(ring, g, S, E, F.wave);
        if (BOTH(3)) GRID_BAR(); STAMP(3);
    }
    if (IN(4)) { ln_phase<MK_FP8_FFN != 0>(F, (const bf16*)(ws + WS_Y3B), XB, F.in[I_LNG] + 0 * DM, F.in[I_LNB] + 0 * DM);
#if MK_BG
        BG_DRAIN(BG_EA1);
#endif
        if (BOTH(4)) GRID_BAR(); STAMP(4); }
    if (IN(5)) {
        pg8::StaticOrder S; S.init(NTOK, 2 * FF, F.G, (int)blockIdx.x);
#if MK_FP8_FFN
        pg8::Gemm g{XB, (const bf16*)(ws + WS_W_FFN_GU), NTOK, 2 * FF, DM / 2};
        pg8::EpiSwiglu8<false> E{ws + WS_HID, FF}; pg8::gemm_phase<pg8::EpiSwiglu8<false>, pg8::StaticOrder, true, true, SC_ONE, SC_M6>(ring, g, S, E, F.wave);
#else
        pg8::Gemm g{XB, (const bf16*)(ws + WS_W_FFN_GU), NTOK, 2 * FF, DM};
        pg8::EpiSwiglu E{(bf16*)(ws + WS_HID), FF}; pg8::gemm_phase<pg8::EpiSwiglu, pg8::StaticOrder, true, true>(ring, g, S, E, F.wave);
#endif
#if MK_BG
        BG_DRAIN(BG_EA);
#endif
        if (BOTH(5)) GRID_BAR(); STAMP(5);
    }
    if (IN(6)) {
        pg8::StaticOrder S; S.init(NTOK, DM, F.G, (int)blockIdx.x); pg8::EpiResLn16<true> E{ws + WS_Y3B, (bf16*)(ws + WS_Y3B), (const float*)(ws + WS_STATS), F.in[I_LNG] + 0 * DM, F.in[I_LNB] + 0 * DM};
#if MK_FP8_FFN
        pg8::Gemm g{(const bf16*)(ws + WS_HID), (const bf16*)(ws + WS_W_FFN_D), NTOK, DM, FF / 2};
        pg8::gemm_phase<pg8::EpiResLn16<true>, pg8::StaticOrder, true, true, SC_M4, SC_M7>(ring, g, S, E, F.wave);
#else
        pg8::Gemm g{(const bf16*)(ws + WS_HID), (const bf16*)(ws + WS_W_FFN_D), NTOK, DM, FF};
        pg8::gemm_phase<pg8::EpiResLn16<true>, pg8::StaticOrder, true, true>(ring, g, S, E, F.wave);
#endif
        if (BOTH(6)) GRID_BAR(); STAMP(6);
    }
    if (IN(7)) { ln_phase<false>(F, (const bf16*)(ws + WS_Y3B), XB, F.in[I_LNG] + 1 * DM, F.in[I_LNB] + 1 * DM);
#if MK_BG
        BG_DRAIN(BG_EB);
#endif
        if (BOTH(7)) GRID_BAR(); STAMP(7); }
    if (IN(8)) {
        pg8::Gemm g{XB, (const bf16*)(ws + WS_W_B_IN), NTOK, B_IN, DM}; pg8::StaticOrder S; S.init(NTOK, B_IN, F.G, (int)blockIdx.x);
        pg8::EpiBf16 E{(bf16*)(ws + WS_H1), B_IN, 0}; pg8::gemm_phase<pg8::EpiBf16, pg8::StaticOrder, true, true>(ring, g, S, E, F.wave);
        if (BOTH(8)) GRID_BAR(); STAMP(8);
    }
    if (IN(9)) { diffattn_phase(F.G, F.wave, F.lds + RING_OFF, (const abf*)(ws + WS_H1), (abf*)(ws + WS_AO)); if (BOTH(9)) GRID_BAR(); STAMP(9); }
    if (IN(10)) {
        memattn_phase<B_IN>(F.G, F.wave, (char*)lds + RING_OFF, (const abf*)(ws + WS_H1) + 4608, (const abf*)(ws + WS_MEMKV) + 1024, (abf*)(ws + WS_CONCAT1) + MAINW);
        combine_phase(F);
#if MK_BG
        __syncthreads(); BG_DRAIN(BG_EC);
#endif
        if (BOTH(10)) GRID_BAR(); STAMP(10);
    }
    if (IN(11)) {
        pg8::Gemm g{(const bf16*)(ws + WS_CONCAT1), (const bf16*)(ws + WS_W_MIX) + (size_t)DM * DM, NTOK, DM, DM}; pg8::StaticOrder S; S.init(NTOK, DM, F.G, (int)blockIdx.x);
        pg8::EpiResLn16<true> E{ws + WS_Y3B, (bf16*)(ws + WS_Y3B), (const float*)(ws + WS_STATS), F.in[I_LNG] + 1 * DM, F.in[I_LNB] + 1 * DM}; pg8::gemm_phase<pg8::EpiResLn16<true>, pg8::StaticOrder, true, true>(ring, g, S, E, F.wave);
        if (BOTH(11)) GRID_BAR(); STAMP(11);
    }
    if (IN(12)) { ln_router_phase(F, (const bf16*)(ws + WS_Y3B), (bf16*)(ws + WS_X3B), F.in[I_LNG] + 2 * DM, F.in[I_LNB] + 2 * DM); if (BOTH(12)) GRID_BAR(); STAMP(12); }
    if (IN(13)) { dispatch_phase(F);
#if MK_BG
        __syncthreads(); BG_DRAIN(BG_ED1);
#endif
        if (BOTH(13)) GRID_BAR(); STAMP(13); }
    if (IN(14) || IN(15)) {
        LAS int* tst = (LAS int*)(F.lds + LDSCTL_OFF);
        { const int t_ = F.wave * 64 + mk_lane(); if (t_ < 9) tst[t_] = ((const int*)(ws + WS_MOETAB))[t_]; }
        __syncthreads();
        const int T = tst[8];
        for (int ch = args.ch_lo; ch < args.ch_hi; ++ch) {
            const int t0 = ch * MOE_CHUNK_T; int nM = T - t0; nM = nM < 0 ? 0 : (nM > MOE_CHUNK_T ? MOE_CHUNK_T : nM);
            if (IN(14)) {
                pg8::MoeOrder<false> S; S.nM = nM; S.nN = 2 * FFE / 256; S.nwg = nM * S.nN; S.G = F.G; S.c = (int)blockIdx.x; S.t0 = t0; S.tstart = tst;
#if MK_FP8_MOE
                pg8::Gemm g{(const bf16*)(ws + WS_XS), (const bf16*)(ws + WS_W_MOE_GU), 0, 2 * FFE, DM / 2};
                pg8::EpiSwiglu8<false> E{ws + WS_HIDM, FFE}; pg8::gemm_phase<pg8::EpiSwiglu8<false>, pg8::MoeOrder<false>, true, true, SC_ONE, SC_M6>(ring, g, S, E, F.wave);
#else
                pg8::Gemm g{(const bf16*)(ws + WS_XS), (const bf16*)(ws + WS_W_MOE_GU), 0, 2 * FFE, DM};
                pg8::EpiSwiglu E{(bf16*)(ws + WS_HIDM), FFE}; pg8::gemm_phase<pg8::EpiSwiglu, pg8::MoeOrder<false>, true, true>(ring, g, S, E, F.wave);
#endif
#if MK_BG
                BG_DRAIN(BG_ED);
#endif
                if (IN(15)) GRID_BAR(); STAMP(14);
            }
            if (IN(15)) {
                pg8::EpiRowScale E{(bf16*)(ws + WS_OS), DM, (const float*)(ws + WS_SLOTGATE)};
#if MK_FP8_MOE
                int Lt = T & 31; if (Lt > 8) Lt = 0; const int Tm = T - Lt;
                { pg8::MoeOrder<true> S; S.nM = Tm; S.nN = DM / 256; S.nwg = Tm * S.nN; S.G = F.G; S.c = (int)blockIdx.x; S.t0 = 0; S.tstart = tst;
                  pg8::Gemm g{(const bf16*)(ws + WS_HIDM), (const bf16*)(ws + WS_W_MOE_D), 0, DM, FFE / 2, 0};
                  pg8::gemm_phase<pg8::EpiRowScale, pg8::MoeOrder<true>, true, true, SC_M4, SC_M7>(ring, g, S, E, F.wave); }
                { pg8::MoeLeftOrder S; S.L = Lt; S.G = F.G; S.c = (int)blockIdx.x; S.tl0 = Tm; S.kq = FFE / 4; S.tstart = tst;
                  pg8::Gemm g{(const bf16*)(ws + WS_HIDM), (const bf16*)(ws + WS_W_MOE_D), 0, DM, FFE / 2, FFE / 8};
                  pg8::EpiRowScale E2{(bf16*)(ws + WS_OSK), DM, (const float*)(ws + WS_SLOTGATE)};
                  pg8::gemm_phase<pg8::EpiRowScale, pg8::MoeLeftOrder, true, true, SC_M4, SC_M7>(ring, g, S, E2, F.wave); }
#else
                pg8::MoeOrder<true> S; S.nM = nM; S.nN = DM / 256; S.nwg = nM * S.nN; S.G = F.G; S.c = (int)blockIdx.x; S.t0 = t0; S.tstart = tst;
                pg8::Gemm g{(const bf16*)(ws + WS_HIDM), (const bf16*)(ws + WS_W_MOE_D), 0, DM, FFE, 0};
                pg8::gemm_phase<pg8::EpiRowScale, pg8::MoeOrder<true>, true, true>(ring, g, S, E, F.wave);
#endif
                if (ch + 1 < args.ch_hi ? IN(14) : IN(16)) GRID_BAR(); STAMP(15);
            }
        }
    }
    if (IN(16)) final_phase(F, F.in[I_LNG] + 2 * DM, F.in[I_LNB] + 2 * DM, F.in[I_LNG] + 3 * DM, F.in[I_LNB] + 3 * DM);
#if MK_PROBE
#if MK_PROBE == 2 || MK_PROBE == 3
    if (blockIdx.x == MK_PROBE_BLK && F.wave == 0 && mk_lane() == 0) { const unsigned long long t0 = rt(), target = bar_wait_ * MK_PROBE_MULT; while (rt() - t0 < target) __builtin_amdgcn_s_sleep(32); }
#else
    STAMP(16);
    if (blockIdx.x == 0 && F.wave == 0 && mk_lane() == 0) {
        unsigned ta = 0;
        for (int k = 0; k < 17; ++k) { const unsigned d = __hip_atomic_load(F.ctl + CW_TS + 1 + k, RLX_AGENT) - __hip_atomic_load(F.ctl + CW_TS + k, RLX_AGENT); if ((MK_PROBE_A >> k) & 1) ta += d; }
        const unsigned long long t0 = rt(), target = (unsigned long long)ta * MK_PROBE_MULT;
        while (rt() - t0 < target) __builtin_amdgcn_s_sleep(32);
    }
#endif
#endif
#undef IN
#undef BOTH
#undef GRID_BAR
#undef XCD_BAR_CALL
#undef BG_DRAIN
#undef STAMP
}

#if MK_DEBUG
__device__ __forceinline__ unsigned hash32(unsigned x) { x ^= x >> 16; x *= 0x7feb352dU; x ^= x >> 15; x *= 0x846ca68bU; x ^= x >> 16; return x; }
__device__ __forceinline__ float wdot(const bf16* a, const bf16* b, int K, int lane) { float s = 0.f; for (int k = lane; k < K; k += 64) s += bf2f(a[k]) * bf2f(b[k]); return wave_sum(s); }
__device__ __forceinline__ bool okf(float got, float ref, float rel, float ab) { return fabsf(got - ref) <= rel * fabsf(ref) + ab; }
__device__ __forceinline__ float gelu_ref(float x) { return 0.5f * x * (1.0f + tanhf(0.7978845608f * (x + 0.044715f * x * x * x))); }
__device__ __forceinline__ float silu_ref(float x) { return x / (1.0f + expf(-x)); }
__device__ __forceinline__ float f8f(unsigned char b) { return __builtin_amdgcn_cvt_f32_fp8((int)b, 0); }
__device__ __forceinline__ unsigned char f2f8(float x) { return (unsigned char)(__builtin_amdgcn_cvt_pk_fp8_f32(x, 0.f, 0, false) & 0xff); }
__device__ __forceinline__ float wdot8(const unsigned char* a, const unsigned char* b, int K, int lane) { float s = 0.f; for (int k = lane; k < K; k += 64) s += f8f(a[k]) * f8f(b[k]); return wave_sum(s); }
#define CHK_FAIL(stage) do { if (lane == 0) atomicAdd((unsigned*)(a.ws + WS_CTL) + CW_CHK + (stage), 1u); } while (0)
__device__ void chk_tr8(const Args& a, int stage, const float* W, int K, int N, const unsigned char* WT, int row_off, int mode, float mul, unsigned s, int lane) {
    const int k = hash32(s * 2 + 1) % K, n = hash32(s * 2 + 2) % N; const int drow = row_off + (mode == 0 ? n : ((n >> 7) * 256 + (n & 127) + (mode == 2 ? 128 : 0)));
    if (WT[(size_t)drow * K + k] != f2f8(W[(size_t)k * N + n] * mul)) CHK_FAIL(stage);
}
__device__ void chk_tr(const Args& a, int stage, const float* W, int K, int N, const bf16* WT, int row_off, int mode, unsigned s, int lane) {
    const int k = hash32(s * 2 + 1) % K, n = hash32(s * 2 + 2) % N; const int drow = row_off + (mode == 0 ? n : ((n >> 7) * 256 + (n & 127) + (mode == 2 ? 128 : 0)));
    if (WT[(size_t)drow * K + k] != (bf16)f2bf(W[(size_t)k * N + n])) CHK_FAIL(stage);
}
__device__ void chk_memattn(const Args& a, int stage, const bf16* q, const bf16* Kb, const bf16* Ob, float* pl, int lane) {
    float sc[4], mx = -3e38f;
    for (int i = 0; i < 4; ++i) { const int j = lane + 64 * i; float s = 0.f; for (int d = 0; d < 128; ++d) s += bf2f(q[d]) * bf2f(Kb[(size_t)j * 2048 + d]); sc[i] = s * 0.08838834764831845f; mx = fmaxf(mx, sc[i]); }
    for (int o = 1; o < 64; o <<= 1) mx = fmaxf(mx, __shfl_xor(mx, o));
    float sum = 0.f; for (int i = 0; i < 4; ++i) { sc[i] = expf(sc[i] - mx); sum += sc[i]; pl[lane + 64 * i] = sc[i]; }
    sum = wave_sum(sum); __syncthreads();
    bool bad = false;
    for (int dd = 0; dd < 2; ++dd) { const int d = lane + 64 * dd; float o = 0.f; for (int j = 0; j < 256; ++j) o += pl[j] * bf2f(Kb[(size_t)j * 2048 + 512 + d]); o /= sum;
        if (!okf(bf2f(Ob[d]), o, 0.03f, 0.004f)) bad = true; }
    if (__any(bad)) CHK_FAIL(stage);
    __syncthreads();
}
__global__ void __launch_bounds__(64) chk_kernel(Args a, int stage, int chunk) {
    __shared__ float pl[8192];
    const int lane = threadIdx.x; const unsigned s = blockIdx.x; unsigned char* ws = a.ws;
    const bf16* XB = (const bf16*)(ws + WS_XB);
    if (stage == 0 || (MK_BG && stage == 14)) {
        int cs = s % 12;
#if MK_BG
        { const bool fg = (cs == 0 || cs == 7 || cs == 11 || (cs == 1 && ((s / 12) & 1) == 0)); if ((stage == 0) != fg) cs = 99; }
#endif
        switch (cs) {
        case 99: break;
        case 0: chk_tr(a, 0, a.in[I_AWIN], DM, A_IN, (const bf16*)(ws + WS_W_A_IN), 0, 0, s, lane); break;
        case 1: { const int l = (s / 12) & 1; chk_tr(a, 0, a.in[I_WMIX] + (size_t)l * DM * DM, DM, DM, (const bf16*)(ws + WS_W_MIX), l * DM, 0, s, lane); } break;
#if MK_FP8_FFN
        case 2: chk_tr8(a, 0, a.in[I_FG], DM, FF, ws + WS_W_FFN_GU, 0, 1, W8_G_MUL, s, lane); break;
        case 3: chk_tr8(a, 0, a.in[I_FU], DM, FF, ws + WS_W_FFN_GU, 0, 2, W8_U_MUL, s, lane); break;
        case 4: chk_tr8(a, 0, a.in[I_FD], FF, DM, ws + WS_W_FFN_D, 0, 0, W8_D_MUL, s, lane); break;
#else
        case 2: chk_tr(a, 0, a.in[I_FG], DM, FF, (const bf16*)(ws + WS_W_FFN_GU), 0, 1, s, lane); break;
        case 3: chk_tr(a, 0, a.in[I_FU], DM, FF, (const bf16*)(ws + WS_W_FFN_GU), 0, 2, s, lane); break;
        case 4: chk_tr(a, 0, a.in[I_FD], FF, DM, (const bf16*)(ws + WS_W_FFN_D), 0, 0, s, lane); break;
#endif
        case 5: chk_tr(a, 0, a.in[I_SWKV], DM, 3072, (const bf16*)(ws + WS_W_B_IN), 0, 0, s, lane); break;
        case 6: chk_tr(a, 0, a.in[I_BWIN], DM, DM, (const bf16*)(ws + WS_W_B_IN), 3072, 0, s, lane); break;
        case 7: { const int l = (s / 12) & 1; chk_tr(a, 0, a.in[I_WMEMKV] + (size_t)l * DM * 1024, DM, 1024, (const bf16*)(ws + WS_W_MEMKV), l * 1024, 0, s, lane); } break;
#if MK_FP8_MOE
        case 8: { const int e = (s / 12) & 7; chk_tr8(a, 0, a.in[I_MG] + (size_t)e * DM * FFE, DM, FFE, ws + WS_W_MOE_GU, e * 2 * FFE, 1, W8_G_MUL, s, lane); } break;
        case 9: { const int e = (s / 12) & 7; chk_tr8(a, 0, a.in[I_MU] + (size_t)e * DM * FFE, DM, FFE, ws + WS_W_MOE_GU, e * 2 * FFE, 2, W8_U_MUL, s, lane); } break;
        case 10: { const int e = (s / 12) & 7; chk_tr8(a, 0, a.in[I_MD] + (size_t)e * FFE * DM, FFE, DM, ws + WS_W_MOE_D, e * DM, 0, W8_D_MUL, s, lane); } break;
#else
        case 8: { const int e = (s / 12) & 7; chk_tr(a, 0, a.in[I_MG] + (size_t)e * DM * FFE, DM, FFE, (const bf16*)(ws + WS_W_MOE_GU), e * 2 * FFE, 1, s, lane); } break;
        case 9: { const int e = (s / 12) & 7; chk_tr(a, 0, a.in[I_MU] + (size_t)e * DM * FFE, DM, FFE, (const bf16*)(ws + WS_W_MOE_GU), e * 2 * FFE, 2, s, lane); } break;
        case 10: { const int e = (s / 12) & 7; chk_tr(a, 0, a.in[I_MD] + (size_t)e * FFE * DM, FFE, DM, (const bf16*)(ws + WS_W_MOE_D), e * DM, 0, s, lane); } break;
#endif
        default: { const size_t i = hash32(s) % ((size_t)NTOK * DM); if (XB[i] != (bf16)f2bf(a.in[I_X][i])) CHK_FAIL(0);
                   const size_t i2 = hash32(s + 7) % ((size_t)1024 * DM); if (((const bf16*)(ws + WS_MEMB))[i2] != (bf16)f2bf(a.in[I_MEM][i2])) CHK_FAIL(0);
                   const int i3 = hash32(s + 9) % (NSG * 128 * 128), ss = i3 & 127, tt = (i3 >> 7) & 127; if (((const bf16*)(ws + WS_WSBF))[i3] != (bf16)(ss <= tt ? f2bf(a.in[I_AWS][i3]) : 0u)) CHK_FAIL(0); } break;
        }
    } else if (stage == 1) {
        const int row = hash32(s) % NTOK, col = (s & 1) ? (3072 + hash32(s + 1) % 512) : (hash32(s + 1) % A_IN);
        float ref = wdot(XB + (size_t)row * DM, (const bf16*)(ws + WS_W_A_IN) + (size_t)col * DM, DM, lane); if (col < 3072) ref = gelu_ref(ref);
        if (!okf(bf2f(((const bf16*)(ws + WS_H0))[(size_t)row * A_IN + col]), ref, 0.02f, 0.02f)) CHK_FAIL(1);
        const int r2 = hash32(s + 3) % 1024, c2 = hash32(s + 4) % 2048;
        const float ref2 = wdot((const bf16*)(ws + WS_MEMB) + (size_t)r2 * DM, (const bf16*)(ws + WS_W_MEMKV) + (size_t)c2 * DM, DM, lane);
        if (!okf(bf2f(((const bf16*)(ws + WS_MEMKV))[(size_t)r2 * 2048 + c2]), ref2, 0.02f, 0.02f)) CHK_FAIL(1);
    } else if (stage == 2) {
        const int tok = hash32(s) % NTOK, h = hash32(s + 1) & 3, b = tok / SEQ; const bf16* H0 = (const bf16*)(ws + WS_H0);
        chk_memattn(a, 2, H0 + (size_t)tok * A_IN + 3072 + h * 128, (const bf16*)(ws + WS_MEMKV) + (size_t)b * 256 * 2048 + h * 128, (const bf16*)(ws + WS_CONCAT) + (size_t)tok * DM + 1536 + h * 128, pl, lane);
        const int g = hash32(s + 2) % NSG, t = tok & 127; const size_t R0 = (size_t)(tok - t);
        float mean[2], rstd[2];
        for (int i = 0; i < 2; ++i) { const int sidx = lane + 64 * i; const bf16* vr = H0 + (R0 + sidx) * A_IN + MAINW; float sm = 0.f; for (int k = 0; k < MAINW; ++k) sm += bf2f(vr[k]); sm /= MAINW; float q = 0.f; for (int k = 0; k < MAINW; ++k) { const float d = bf2f(vr[k]) - sm; q += d * d; } mean[i] = sm; rstd[i] = 1.0f / sqrtf(q / MAINW + LN_EPS); }
        for (int dd = 0; dd < 2; ++dd) { const int d = hash32(s + 10 + dd) & 127, col = g * 128 + d; float acc = 0.f;
            for (int i = 0; i < 2; ++i) { const int sidx = lane + 64 * i; if (sidx <= t) { const float lv = (bf2f(H0[(R0 + sidx) * A_IN + MAINW + col]) - mean[i]) * rstd[i] * a.in[I_AVG][col] + a.in[I_AVB][col]; acc += a.in[I_AWS][((size_t)g * 128 + t) * 128 + sidx] * lv; } }
            acc = wave_sum(acc); const float ref = (acc + a.in[I_ABS][g * 128 + t]) * bf2f(H0[(R0 + t) * A_IN + col]);
            if (!okf(bf2f(((const bf16*)(ws + WS_CONCAT))[(R0 + t) * DM + col]), ref, 0.03f, 0.03f)) CHK_FAIL(3); }
    } else if (stage == 3 || stage == 6 || stage == 11) {
        const int row = hash32(s) % NTOK, col = hash32(s + 1) % DM; float ref;
        if (stage == 3) ref = ALPHA * a.in[I_X][(size_t)row * DM + col] + wdot((const bf16*)(ws + WS_CONCAT) + (size_t)row * DM, (const bf16*)(ws + WS_W_MIX) + (size_t)col * DM, DM, lane);
#if MK_FP8_FFN
        else if (stage == 6) ref = ALPHA * f8f((ws + WS_XB)[(size_t)row * DM + col]) + wdot8(ws + WS_HID + (size_t)row * FF, ws + WS_W_FFN_D + (size_t)col * FF, FF, lane) / (H8_MUL * W8_D_MUL);
#else
        else if (stage == 6) ref = ALPHA * bf2f(XB[(size_t)row * DM + col]) + wdot((const bf16*)(ws + WS_HID) + (size_t)row * FF, (const bf16*)(ws + WS_W_FFN_D) + (size_t)col * FF, FF, lane);
#endif
        else ref = ALPHA * bf2f(XB[(size_t)row * DM + col]) + wdot((const bf16*)(ws + WS_CONCAT1) + (size_t)row * DM, (const bf16*)(ws + WS_W_MIX) + (size_t)DM * DM + (size_t)col * DM, DM, lane);
        if (!okf(a.out[(size_t)row * DM + col], ref, 0.02f, (MK_FP8_FFN && stage == 6) ? 0.12f : 0.03f)) CHK_FAIL(stage == 3 ? 4 : (stage == 6 ? 7 : 13));
    } else if (stage == 4 || stage == 7 || stage == 12) {
        const int row = hash32(s) % NTOK, li = stage == 4 ? 0 : (stage == 7 ? 1 : 2); const float* y = a.out + (size_t)row * DM; const float* g = a.in[I_LNG] + li * DM; const float* bb = a.in[I_LNB] + li * DM;
        float s1 = 0.f; for (int k = lane; k < DM; k += 64) s1 += y[k]; const float mean = wave_sum(s1) / DM;
        float s2 = 0.f; for (int k = lane; k < DM; k += 64) { const float d = y[k] - mean; s2 += d * d; } const float rstd = 1.0f / sqrtf(wave_sum(s2) / DM + LN_EPS);
        bool bad = false;
        if (stage != 12) { const float* st = (const float*)(ws + WS_STATS) + 2 * row; if (!okf(st[0], mean, 1e-3f, 1e-4f) || !okf(st[1], rstd, 1e-3f, 1e-6f)) bad = true; }
        for (int k = lane; k < DM; k += 64) { const float x = (y[k] - mean) * rstd * g[k] + bb[k]; float got;
            if (stage == 12) got = MK_FP8_MOE ? f8f((ws + WS_X3B)[(size_t)row * DM + k]) : bf2f(((const bf16*)(ws + WS_X3B))[(size_t)row * DM + k]);
            else if (stage == 4 && MK_FP8_FFN) got = f8f((ws + WS_XB)[(size_t)row * DM + k]);
            else got = bf2f(XB[(size_t)row * DM + k]);
            if (!okf(got, x, 0.07f, 0.02f)) bad = true; }
        if (__any(bad)) CHK_FAIL(stage == 4 ? 5 : (stage == 7 ? 8 : 14));
        if (stage == 12) {
            float lg[8]; for (int e2 = 0; e2 < 8; ++e2) { float p = 0.f; for (int k = lane; k < DM; k += 64) p += ((y[k] - mean) * rstd * g[k] + bb[k]) * a.in[I_ROUTER][k * 8 + e2]; lg[e2] = wave_sum(p); }
            int e0 = 0; for (int e2 = 1; e2 < 8; ++e2) if (lg[e2] > lg[e0]) e0 = e2; int e1 = e0 == 0 ? 1 : 0; for (int e2 = 0; e2 < 8; ++e2) if (e2 != e0 && lg[e2] > lg[e1]) e1 = e2;
            const int re = ((const int*)(ws + WS_ROUTE_E))[row]; const float w0 = ((const float*)(ws + WS_ROUTE_W))[2 * row];
            float third = -3e38f; for (int e2 = 0; e2 < 8; ++e2) if (e2 != e0 && e2 != e1) third = fmaxf(third, lg[e2]);
            const bool tie = (lg[e0] - lg[e1] < 1e-4f) || (lg[e1] - third < 1e-4f);
            if (!tie && (re != (e0 | (e1 << 8)) || !okf(w0, 1.0f / (1.0f + expf(lg[e1] - lg[e0])), 1e-3f, 1e-4f))) CHK_FAIL(15);
        }
    } else if (stage == 5) {
        const int row = hash32(s) % NTOK, hc = hash32(s + 1) % FF;
#if MK_FP8_FFN
        const unsigned char* W = ws + WS_W_FFN_GU + (size_t)((hc >> 7) * 256 + (hc & 127)) * DM; const unsigned char* x = ws + WS_XB + (size_t)row * DM;
        const float g = wdot8(x, W, DM, lane) / W8_G_MUL, u = wdot8(x, W + (size_t)128 * DM, DM, lane) / W8_U_MUL;
        if (!okf(f8f((ws + WS_HID)[(size_t)row * FF + hc]) / H8_MUL, silu_ref(g) * u, 0.08f, 0.004f)) CHK_FAIL(6);
#else
        const bf16* W = (const bf16*)(ws + WS_W_FFN_GU) + (size_t)((hc >> 7) * 256 + (hc & 127)) * DM;
        const float g = wdot(XB + (size_t)row * DM, W, DM, lane), u = wdot(XB + (size_t)row * DM, W + (size_t)128 * DM, DM, lane);
        if (!okf(bf2f(((const bf16*)(ws + WS_HID))[(size_t)row * FF + hc]), silu_ref(g) * u, 0.02f, 0.01f)) CHK_FAIL(6);
#endif
    } else if (stage == 8) {
        const int row = hash32(s) % NTOK, col = hash32(s + 1) % B_IN;
        const float ref = wdot(XB + (size_t)row * DM, (const bf16*)(ws + WS_W_B_IN) + (size_t)col * DM, DM, lane);
        if (!okf(bf2f(((const bf16*)(ws + WS_H1))[(size_t)row * B_IN + col]), ref, 0.02f, 0.02f)) CHK_FAIL(9);
    } else if (stage == 9) {
        const int tok = (s & 3) == 0 ? ((hash32(s) % (NTOK / 256)) * 256 + (hash32(s + 5) & 1 ? 255 : 0)) : hash32(s) % NTOK; const int b = tok / SEQ, pos = tok % SEQ, h = hash32(s + 1) % 6, m = hash32(s + 2) & 1, half = hash32(s + 3) & 1;
        const bf16* H1 = (const bf16*)(ws + WS_H1); const bf16* q = H1 + (size_t)tok * B_IN + 3072 + (m * 6 + h) * 128; const bf16* Kb = H1 + (size_t)b * SEQ * B_IN + (m * 6 + h) * 128; const bf16* Vb = H1 + (size_t)b * SEQ * B_IN + 1536 + h * 256 + half * 128;
        float mx = -3e38f; for (int j = lane; j <= pos; j += 64) { float sc = 0.f; for (int d = 0; d < 128; ++d) sc += bf2f(q[d]) * bf2f(Kb[(size_t)j * B_IN + d]); sc *= 0.08838834764831845f; pl[j] = sc; mx = fmaxf(mx, sc); }
        for (int o = 1; o < 64; o <<= 1) mx = fmaxf(mx, __shfl_xor(mx, o));
        float sum = 0.f; for (int j = lane; j <= pos; j += 64) { const float p = expf(pl[j] - mx); pl[j] = p; sum += p; } sum = wave_sum(sum); __syncthreads();
        bool bad = false;
        for (int dd = 0; dd < 2; ++dd) { const int d = lane + 64 * dd; float o = 0.f; for (int j = 0; j <= pos; ++j) o += pl[j] * bf2f(Vb[(size_t)j * B_IN + d]); o /= sum;
            if (!okf(bf2f(((const bf16*)(ws + WS_AO))[(size_t)tok * 3072 + m * 1536 + h * 256 + half * 128 + d]), o, 0.03f, 0.004f)) bad = true; }
        if (__any(bad)) CHK_FAIL(10);
    } else if (stage == 10) {
        const int tok = hash32(s) % NTOK, h4 = hash32(s + 1) & 3, b = tok / SEQ; const bf16* H1 = (const bf16*)(ws + WS_H1);
        chk_memattn(a, 11, H1 + (size_t)tok * B_IN + 4608 + h4 * 128, (const bf16*)(ws + WS_MEMKV) + (size_t)b * 256 * 2048 + 1024 + h4 * 128, (const bf16*)(ws + WS_CONCAT1) + (size_t)tok * DM + 1536 + h4 * 128, pl, lane);
        const int h = hash32(s + 2) % 6; const bf16* AO = (const bf16*)(ws + WS_AO) + (size_t)tok * 3072;
        float s1 = 0.f, s2 = 0.f; for (int k = lane; k < 128; k += 64) { s1 += a.in[I_LQ1][k] * a.in[I_LK1][k]; s2 += a.in[I_LQ2][k] * a.in[I_LK2][k]; } s1 = wave_sum(s1); s2 = wave_sum(s2);
        const float lam = expf(s1) - expf(s2) + LAMBDA_INIT; float x[4], ss = 0.f;
        for (int i = 0; i < 4; ++i) { const int d = lane + 64 * i; x[i] = bf2f(AO[h * 256 + d]) - lam * bf2f(AO[1536 + h * 256 + d]); ss += x[i] * x[i]; } ss = wave_sum(ss);
        bool bad = false; for (int i = 0; i < 4; ++i) { const int d = lane + 64 * i; const float ref = x[i] / sqrtf(ss / 256.f + LN_EPS) * a.in[I_SUBLN][d] * (1.0f - LAMBDA_INIT);
            if (!okf(bf2f(((const bf16*)(ws + WS_CONCAT1))[(size_t)tok * DM + h * 256 + d]), ref, 0.02f, 0.01f)) bad = true; }
        if (__any(bad)) CHK_FAIL(12);
    }
    if (stage == 13 || stage == 14 || stage == 15) {
        const int tok = hash32(s) % NTOK, k = hash32(s + 1) & 1; const int slot = ((const int*)(ws + WS_TOKSLOT))[2 * tok + k]; const int* tab = (const int*)(ws + WS_MOETAB);
        const int e = (((const int*)(ws + WS_ROUTE_E))[tok] >> (8 * k)) & 0xff; const float gate = ((const float*)(ws + WS_ROUTE_W))[2 * tok + k];
        if (stage == 13) {
            bool bad = slot < 0 || slot >= MAXT * 256;
            if (!bad) { const int tile = slot >> 8; int te = 0; for (int j = 1; j < 8; ++j) te += tile >= tab[j]; bad = te != e || tile >= tab[8] || ((const int*)(ws + WS_SLOTTOK))[slot] != tok || ((const float*)(ws + WS_SLOTGATE))[slot] != gate;

#if MK_FP8_MOE
                for (int j = lane; j < DM; j += 64) if (((const unsigned char*)(ws + WS_XS))[(size_t)slot * DM + j] != ((const unsigned char*)(ws + WS_X3B))[(size_t)tok * DM + j]) bad = true; }
#else
                for (int j = lane; j < DM; j += 64) if (((const bf16*)(ws + WS_XS))[(size_t)slot * DM + j] != ((const bf16*)(ws + WS_X3B))[(size_t)tok * DM + j]) bad = true; }
#endif
            if (__any(bad)) CHK_FAIL(16);
        } else { const int loc = slot - chunk * MOE_CHUNK_T * 256;
            if (loc >= 0 && loc < MOE_CHUNK_T * 256) {
#if MK_FP8_MOE
                if (stage == 14) { const int hc = hash32(s + 2) % FFE; const unsigned char* W = ws + WS_W_MOE_GU + ((size_t)e * 2 * FFE + (hc >> 7) * 256 + (hc & 127)) * DM; const unsigned char* x = ws + WS_XS + (size_t)slot * DM;
                    const float g = wdot8(x, W, DM, lane) / W8_G_MUL, u = wdot8(x, W + (size_t)128 * DM, DM, lane) / W8_U_MUL;
                    if (!okf(f8f((ws + WS_HIDM)[(size_t)loc * FFE + hc]) / H8_MUL, silu_ref(g) * u, 0.08f, 0.004f)) CHK_FAIL(17);
                } else { const int col = hash32(s + 2) % DM; const float ref = gate * wdot8(ws + WS_HIDM + (size_t)loc * FFE, ws + WS_W_MOE_D + ((size_t)e * DM + col) * FFE, FFE, lane) / (H8_MUL * W8_D_MUL);
                    const int T = tab[8]; int Lt = T & 31; if (Lt > 8) Lt = 0; const int Tm = T - Lt, tile = slot >> 8; float got;
                    if (tile >= Tm) { got = 0.f; for (int q = 0; q < 4; ++q) got += bf2f(((const bf16*)(ws + WS_OSK))[((size_t)(q * 8 + tile - Tm) * 256 + (slot & 255)) * DM + col]); }
                    else got = bf2f(((const bf16*)(ws + WS_OS))[(size_t)slot * DM + col]);
                    if (!okf(got, ref, 0.02f, 0.004f)) CHK_FAIL(18); } } }
#else
                if (stage == 14) { const int hc = hash32(s + 2) % FFE; const bf16* W = (const bf16*)(ws + WS_W_MOE_GU) + ((size_t)e * 2 * FFE + (hc >> 7) * 256 + (hc & 127)) * DM; const bf16* x = (const bf16*)(ws + WS_XS) + (size_t)slot * DM;
                    const float g = wdot(x, W, DM, lane), u = wdot(x, W + (size_t)128 * DM, DM, lane);
                    if (!okf(bf2f(((const bf16*)(ws + WS_HIDM))[(size_t)loc * FFE + hc]), silu_ref(g) * u, 0.02f, 0.01f)) CHK_FAIL(17);
                } else { const int col = hash32(s + 2) % DM; const float ref = gate * wdot((const bf16*)(ws + WS_HIDM) + (size_t)loc * FFE, (const bf16*)(ws + WS_W_MOE_D) + ((size_t)e * DM + col) * FFE, FFE, lane);
                    if (!okf(bf2f(((const bf16*)(ws + WS_OS))[(size_t)slot * DM + col]), ref, 0.02f, 0.004f)) CHK_FAIL(18); } } }
#endif
    }
}
__global__ void fin_kernel(Args a, int complete) {
    const unsigned* c = (const unsigned*)(a.ws + WS_CTL) + CW_CHK; int first = -1; for (int i = 0; i < 32; ++i) if (c[i] && first < 0) first = i;
    const unsigned* ctl = (const unsigned*)(a.ws + WS_CTL); if (first < 0 && (ctl[CW_TMO] || ctl[CW_BAR + XB_TMO])) first = 30;
    if (first < 0 && complete) return;
    const float v = sqrtf(first < 0 ? 76.0f : 10.0f + first);
    for (size_t i = (size_t)blockIdx.x * blockDim.x + threadIdx.x; i < (size_t)NTOK * DM; i += (size_t)gridDim.x * blockDim.x) a.out[i] = v;
}
#endif

extern "C" void kernel_launch(void* const* d_in, const int* in_sizes, int n_in, void* d_out, int out_size, void* d_ws, size_t ws_size, hipStream_t stream) {
    static int grid = 0;
    if (grid == 0) {
        if (n_in != 25 || in_sizes[0] != NTOK * DM || out_size != NTOK * DM || ws_size < WS_END) { fprintf(stderr, "kernel_launch: unexpected shapes (n_in %d, in0 %d, out %d, ws %zu < %zu); nothing launched\n", n_in, n_in > 0 ? in_sizes[0] : -1, out_size, ws_size, (size_t)WS_END); grid = -1; return; }
        int dev = 0, cus = 0, per_cu = 0;
        if (hipGetDevice(&dev) != hipSuccess || hipDeviceGetAttribute(&cus, hipDeviceAttributeMultiprocessorCount, dev) != hipSuccess) { grid = -1; return; }
        if (hipFuncSetAttribute((const void*)mk_fwd, hipFuncAttributeMaxDynamicSharedMemorySize, LDS_BYTES) != hipSuccess) { fprintf(stderr, "kernel_launch: hipFuncSetAttribute failed\n"); grid = -1; return; }
        if (hipOccupancyMaxActiveBlocksPerMultiprocessor(&per_cu, (const void*)mk_fwd, NWAVES * 64, LDS_BYTES) != hipSuccess || per_cu < 1) fprintf(stderr, "kernel_launch: occupancy query reports %d\n", per_cu);
        (void)hipGetLastError();
        grid = cus;
    }
    if (grid < 0) return;
    if (hipMemsetAsync((char*)d_ws + WS_CTL, 0, CTL_ZERO_BYTES, stream) != hipSuccess) return;
    Args a{};
    for (int i = 0; i < 25; ++i) a.in[i] = (const float*)d_in[i];
    a.out = (float*)d_out; a.ws = (unsigned char*)d_ws;
#if MK_DEBUG
    const int last = MK_LAST_PHASE;
    auto run = [&](int ph, int ch) { a.ph_lo = ph; a.ph_hi = ph + 1; a.ch_lo = ch; a.ch_hi = ch + 1; hipLaunchKernelGGL(mk_fwd, dim3(grid), dim3(NWAVES * 64), LDS_BYTES, stream, a); };
    auto chk = [&](int stage, int ch) { hipLaunchKernelGGL(chk_kernel, dim3(1024), dim3(64), 0, stream, a, stage, ch); };
    for (int ph = 0; ph <= last && ph <= 13; ++ph) { run(ph, 0); chk(ph, 0); }
    if (last >= 14) for (int ch = 0; ch < (MAXT + MOE_CHUNK_T - 1) / MOE_CHUNK_T; ++ch) { run(14, ch); chk(14, ch); if (last >= 15) { run(15, ch); chk(15, ch); } }
    if (last >= 16) run(16, 0);
    hipLaunchKernelGGL(fin_kernel, dim3(1024), dim3(256), 0, stream, a, last >= 16 ? 1 : 0);
#else
    a.ph_lo = 0; a.ph_hi = 17; a.ch_lo = 0; a.ch_hi = (MAXT + MOE_CHUNK_T - 1) / MOE_CHUNK_T;
    hipLaunchKernelGGL(mk_fwd, dim3(grid), dim3(NWAVES * 64), LDS_BYTES, stream, a);
#endif
}
```

```cpp
#include <hip/hip_runtime.h>
#include <hip/hip_bf16.h>
#include <cstdio>
#include <cstdint>

#ifndef MK_DEBUG
#define MK_DEBUG 0
#endif
#ifndef MK_FP8_MOE
#define MK_FP8_MOE 1
#endif
#ifndef MK_FP8_FFN
#define MK_FP8_FFN 1
#endif
#ifndef MK_BG
#define MK_BG 1
#endif
#ifndef MK_PROBE
#define MK_PROBE 0
#endif
#ifndef MK_PROBE_A
#define MK_PROBE_A 0x1
#endif
#define MK_PROBE_MULT 8
#ifndef MK_PROBE_BARMASK
#define MK_PROBE_BARMASK 0xffffff
#endif
#ifndef MK_PROBE_BLK
#define MK_PROBE_BLK 0
#endif
#ifndef MK_PHMASK
#define MK_PHMASK 0x1ffff
#endif
#ifndef MK_LAST_PHASE
#define MK_LAST_PHASE 18
#endif

__device__ __forceinline__ int mk_lane() { int r; asm volatile("v_mbcnt_lo_u32_b32 %0, -1, 0\n\tv_mbcnt_hi_u32_b32 %0, -1, %0" : "=v"(r)); return r; }
namespace pg8 {
#define PG8_LAS __attribute__((address_space(3)))
typedef unsigned short bf16_t;
typedef short bf16x8 __attribute__((ext_vector_type(8)));
typedef float f32x4 __attribute__((ext_vector_type(4)));
typedef float f32x2 __attribute__((ext_vector_type(2)));
typedef unsigned u32x4 __attribute__((ext_vector_type(4)));
typedef int v4i_t __attribute__((ext_vector_type(4)));
constexpr int BM = 256, BK = 64, HALF = 128, HTB = HALF * BK * 2  , STAGE_BYTES = 8 * HTB, NXCD = 8, WGM = 8;

__host__ __device__ __forceinline__ int lds_byte(int r, int c) { const int st = (r >> 4) * 2 + (c >> 5), rr = r & 15, cc = c & 31, ob = rr * 64 + cc * 2; return st * 1024 + (ob ^ (((ob >> 9) & 1) << 5)); }
__host__ __device__ __forceinline__ void stage_rc(int b, int& R, int& C) { const int st = b / 1024, sb = b % 1024, swz = sb ^ (((sb >> 9) & 1) << 5); R = (st >> 1) * 16 + swz / 64; C = (st & 1) * 32 + (swz % 64) / 2; }
__host__ __device__ __forceinline__ int perm32(int rho) { const int n = rho >> 4, i = rho & 15; return 8 * (i >> 2) + 4 * n + (i & 3); }

struct Unit { int pa, pb, pm, pn, koff; };
struct Gemm { const bf16_t* A; const bf16_t* Bt; int M, N, K, KL; };

__host__ __device__ __forceinline__ void tile_of(int wgid, int nM, int nN, int& pm, int& pn) {
    const int nwg = nM * nN;
    { const int q = nwg / NXCD, r = nwg % NXCD, xcd = wgid % NXCD, off = wgid / NXCD; wgid = (xcd < r ? xcd * (q + 1) : r * (q + 1) + (xcd - r) * q) + off; }
    const int nig = WGM * nN, gid = wgid / nig, fm = gid * WGM, gsz = (nM - fm) < WGM ? (nM - fm) : WGM;
    pm = fm + ((wgid % nig) % gsz); pn = (wgid % nig) / gsz;
}
struct StaticOrder {
    int nM, nN, nwg, G, c;
    __host__ __device__ void init(int M, int N, int G_, int c_) { nM = M / BM; nN = N / BM; nwg = nM * nN; G = G_; c = c_; }
    __host__ __device__ bool next(int i, Unit& u) const {
        const long L = (long)i * G + c; if (L >= nwg) return false;
        int pm, pn; tile_of((int)L, nM, nN, pm, pn); u.pa = pm; u.pb = pn; u.pm = pm; u.pn = pn; u.koff = 0; return true;
    }
    __device__ __forceinline__ void a_ready(const Unit&) const {}
    __device__ __forceinline__ void done(const Unit&) const {}
};
template <bool A_LOCAL> struct MoeOrder {
    int nM, nN, nwg, G, c, t0; const PG8_LAS int* tstart;
    __device__ bool next(int i, Unit& u) const {
        const long L = (long)i * G + c; if (L >= nwg) return false;
        int pm, pn; tile_of((int)L, nM, nN, pm, pn); const int t = t0 + pm; int e = 0;
#pragma unroll
        for (int j = 1; j < 8; ++j) e += (t >= tstart[j]) ? 1 : 0;
        u.pa = A_LOCAL ? pm : t; u.pm = A_LOCAL ? t : pm; u.pb = e * nN + pn; u.pn = pn; u.koff = 0; return true;
    }
    __device__ __forceinline__ void a_ready(const Unit&) const {}
    __device__ __forceinline__ void done(const Unit&) const {}
};

struct MoeLeftOrder {
    int L, G, c, tl0, kq; const PG8_LAS int* tstart;
    __device__ bool next(int i, Unit& u) const {
        const long Lx = (long)i * G + c; if (Lx >= (long)L * 32) return false;
        const int q = (int)Lx & 3, pn = ((int)Lx >> 2) & 7, lt = (int)Lx >> 5, t = tl0 + lt; int e = 0;
#pragma unroll
        for (int j = 1; j < 8; ++j) e += (t >= tstart[j]) ? 1 : 0;
        u.pa = t; u.pb = e * 8 + pn; u.pm = q * 8 + lt; u.pn = pn; u.koff = q * kq; return true;
    }
    __device__ __forceinline__ void a_ready(const Unit&) const {}
    __device__ __forceinline__ void done(const Unit&) const {}
};

__device__ __forceinline__ unsigned cvt_pk_bf16(float lo, float hi) { unsigned r; asm volatile("v_cvt_pk_bf16_f32 %0, %1, %2" : "=v"(r) : "v"(lo), "v"(hi)); return r; }
__device__ __forceinline__ float gelu_tanh(float x) { const float u = x * (1.0f + 0.044715f * x * x); const float e = __builtin_amdgcn_exp2f(-2.302208198f * u); return x * __builtin_amdgcn_rcpf(1.0f + e); }
__device__ __forceinline__ float silu_f(float x) { const float e = __builtin_amdgcn_exp2f(-1.4426950409f * x); return x * __builtin_amdgcn_rcpf(1.0f + e); }

struct EpiBf16 {
    static constexpr bool PERM = true, AFTER_DRAIN = false;
    bf16_t* O; int ldc; int gelu_cols;
    __device__ __forceinline__ void operator()(const f32x4 (&acc)[2][2][4][2], const Unit& u, int wr, int wc, int fr, int fq) const {
        const int row0 = u.pm * BM + wr * 64 + fr, col0 = u.pn * BM + wc * 32 + 8 * fq; const bool act = (u.pn * BM) < gelu_cols;
#pragma unroll
        for (int ai = 0; ai < 2; ++ai)
#pragma unroll
            for (int m = 0; m < 4; ++m) { bf16_t* rowp = O + (size_t)(row0 + ai * HALF + m * 16) * ldc + col0;
#pragma unroll
                for (int bj = 0; bj < 2; ++bj) { f32x4 v0 = acc[ai][bj][m][0], v1 = acc[ai][bj][m][1];
                    if (act) {
#pragma unroll
                        for (int j = 0; j < 4; ++j) { v0[j] = gelu_tanh(v0[j]); v1[j] = gelu_tanh(v1[j]); } }
                    u32x4 w; w.x = cvt_pk_bf16(v0[0], v0[1]); w.y = cvt_pk_bf16(v0[2], v0[3]); w.z = cvt_pk_bf16(v1[0], v1[1]); w.w = cvt_pk_bf16(v1[2], v1[3]);
                    *(u32x4*)(rowp + bj * HALF) = w; } }
    }
};
struct EpiRes {
    static constexpr bool PERM = false, AFTER_DRAIN = false;
    const float* base; float* out; int ldc; float alpha;
    __device__ __forceinline__ void operator()(const f32x4 (&acc)[2][2][4][2], const Unit& u, int wr, int wc, int fr, int fq) const {
        const int row0 = u.pm * BM + wr * 64 + fr, col0 = u.pn * BM + wc * 32 + 4 * fq;
#pragma unroll
        for (int ai = 0; ai < 2; ++ai)
#pragma unroll
            for (int m = 0; m < 4; ++m) { const size_t off = (size_t)(row0 + ai * HALF + m * 16) * ldc + col0;
                f32x4 b[2][2];
#pragma unroll
                for (int bj = 0; bj < 2; ++bj)
#pragma unroll
                    for (int n = 0; n < 2; ++n) b[bj][n] = *(const f32x4*)(base + off + bj * HALF + n * 16);
#pragma unroll
                for (int bj = 0; bj < 2; ++bj)
#pragma unroll
                    for (int n = 0; n < 2; ++n) *(f32x4*)(out + off + bj * HALF + n * 16) = b[bj][n] * alpha + acc[ai][bj][m][n];
                asm volatile("" ::: "memory"); }
    }
};
struct EpiResLn {
    static constexpr bool PERM = false, AFTER_DRAIN = false;
    float* out; const float* stats; const float* g; const float* b;
    __device__ __forceinline__ void operator()(const f32x4 (&acc)[2][2][4][2], const Unit& u, int wr, int wc, int fr, int fq) const {
        constexpr int ldc = 2048; constexpr float alpha = 1.41421356237309515f;
        const int row0 = u.pm * BM + wr * 64 + fr, col0 = u.pn * BM + wc * 32 + 4 * fq;
        f32x4 gv[2][2], bv[2][2];
#pragma unroll
        for (int bj = 0; bj < 2; ++bj)
#pragma unroll
            for (int n = 0; n < 2; ++n) { gv[bj][n] = *(const f32x4*)(g + col0 + bj * HALF + n * 16) * alpha; bv[bj][n] = *(const f32x4*)(b + col0 + bj * HALF + n * 16) * alpha; }
#pragma unroll
        for (int ai = 0; ai < 2; ++ai)
#pragma unroll
            for (int m = 0; m < 4; ++m) { const int row = row0 + ai * HALF + m * 16; const size_t off = (size_t)row * ldc + col0; const f32x2 st = *(const f32x2*)(stats + 2 * row);
                f32x4 y[2][2];
#pragma unroll
                for (int bj = 0; bj < 2; ++bj)
#pragma unroll
                    for (int n = 0; n < 2; ++n) y[bj][n] = *(const f32x4*)(out + off + bj * HALF + n * 16);
#pragma unroll
                for (int bj = 0; bj < 2; ++bj)
#pragma unroll
                    for (int n = 0; n < 2; ++n) *(f32x4*)(out + off + bj * HALF + n * 16) = (y[bj][n] - st.x) * st.y * gv[bj][n] + bv[bj][n] + acc[ai][bj][m][n];
                __builtin_amdgcn_sched_barrier(0); }
    }
};
template <bool IN16> struct EpiRes16 {
    static constexpr bool PERM = true, AFTER_DRAIN = false;
    const void* base; bf16_t* o16;
    __device__ __forceinline__ void operator()(const f32x4 (&acc)[2][2][4][2], const Unit& u, int wr, int wc, int fr, int fq) const {
        constexpr int ldc = 2048; constexpr float alpha = 1.41421356237309515f;
        const int row0 = u.pm * BM + wr * 64 + fr, col0 = u.pn * BM + wc * 32 + 8 * fq;
#pragma unroll
        for (int ai = 0; ai < 2; ++ai)
#pragma unroll
            for (int m = 0; m < 4; ++m) { const size_t off = (size_t)(row0 + ai * HALF + m * 16) * ldc + col0;
                f32x4 y[2][2];
#pragma unroll
                for (int bj = 0; bj < 2; ++bj)
#pragma unroll
                    for (int n = 0; n < 2; ++n) if (!IN16) y[bj][n] = *(const f32x4*)((const float*)base + off + bj * HALF + n * 4);
                if (IN16) {
#pragma unroll
                    for (int bj = 0; bj < 2; ++bj) { const u32x4 t = *(const u32x4*)((const bf16_t*)base + off + bj * HALF);
                        y[bj][0][0] = __uint_as_float(t.x << 16); y[bj][0][1] = __uint_as_float(t.x & 0xffff0000u); y[bj][0][2] = __uint_as_float(t.y << 16); y[bj][0][3] = __uint_as_float(t.y & 0xffff0000u);
                        y[bj][1][0] = __uint_as_float(t.z << 16); y[bj][1][1] = __uint_as_float(t.z & 0xffff0000u); y[bj][1][2] = __uint_as_float(t.w << 16); y[bj][1][3] = __uint_as_float(t.w & 0xffff0000u); } }
#pragma unroll
                for (int bj = 0; bj < 2; ++bj) { const f32x4 v0 = y[bj][0] * alpha + acc[ai][bj][m][0], v1 = y[bj][1] * alpha + acc[ai][bj][m][1];
                    u32x4 w; w.x = cvt_pk_bf16(v0[0], v0[1]); w.y = cvt_pk_bf16(v0[2], v0[3]); w.z = cvt_pk_bf16(v1[0], v1[1]); w.w = cvt_pk_bf16(v1[2], v1[3]);
                    *(u32x4*)(o16 + off + bj * HALF) = w; }
                asm volatile("" ::: "memory"); }
    }
};
template <bool IN16> struct EpiResLn16 {
    static constexpr bool PERM = true, AFTER_DRAIN = false;
    const void* yin; bf16_t* o16; const float* stats; const float* g; const float* b;
    __device__ __forceinline__ void operator()(const f32x4 (&acc)[2][2][4][2], const Unit& u, int wr, int wc, int fr, int fq) const {
        constexpr int ldc = 2048; constexpr float alpha = 1.41421356237309515f;
        const int row0 = u.pm * BM + wr * 64 + fr, col0 = u.pn * BM + wc * 32 + 8 * fq;
        f32x4 gv[2][2], bv[2][2];
#pragma unroll
        for (int bj = 0; bj < 2; ++bj)
#pragma unroll
            for (int n = 0; n < 2; ++n) { gv[bj][n] = *(const f32x4*)(g + col0 + bj * HALF + n * 4) * alpha; bv[bj][n] = *(const f32x4*)(b + col0 + bj * HALF + n * 4) * alpha; }
#pragma unroll
        for (int ai = 0; ai < 2; ++ai)
#pragma unroll
            for (int m = 0; m < 4; ++m) { const int row = row0 + ai * HALF + m * 16; const size_t off = (size_t)row * ldc + col0; const f32x2 st = *(const f32x2*)(stats + 2 * row);
                f32x4 y[2][2];
#pragma unroll
                for (int bj = 0; bj < 2; ++bj)
#pragma unroll
                    for (int n = 0; n < 2; ++n) if (!IN16) y[bj][n] = *(const f32x4*)((const float*)yin + off + bj * HALF + n * 4);
                if (IN16) {
#pragma unroll
                    for (int bj = 0; bj < 2; ++bj) { const u32x4 t = *(const u32x4*)((const bf16_t*)yin + off + bj * HALF);
                        y[bj][0][0] = __uint_as_float(t.x << 16); y[bj][0][1] = __uint_as_float(t.x & 0xffff0000u); y[bj][0][2] = __uint_as_float(t.y << 16); y[bj][0][3] = __uint_as_float(t.y & 0xffff0000u);
                        y[bj][1][0] = __uint_as_float(t.z << 16); y[bj][1][1] = __uint_as_float(t.z & 0xffff0000u); y[bj][1][2] = __uint_as_float(t.w << 16); y[bj][1][3] = __uint_as_float(t.w & 0xffff0000u); } }
#pragma unroll
                for (int bj = 0; bj < 2; ++bj) { const f32x4 v0 = (y[bj][0] - st.x) * st.y * gv[bj][0] + bv[bj][0] + acc[ai][bj][m][0], v1 = (y[bj][1] - st.x) * st.y * gv[bj][1] + bv[bj][1] + acc[ai][bj][m][1];
                    u32x4 w; w.x = cvt_pk_bf16(v0[0], v0[1]); w.y = cvt_pk_bf16(v0[2], v0[3]); w.z = cvt_pk_bf16(v1[0], v1[1]); w.w = cvt_pk_bf16(v1[2], v1[3]);
                    *(u32x4*)(o16 + off + bj * HALF) = w; }
                __builtin_amdgcn_sched_barrier(0); }
    }
};
struct EpiSwiglu {
    static constexpr bool PERM = true, AFTER_DRAIN = false;
    bf16_t* H; int ldh;
    __device__ __forceinline__ void operator()(const f32x4 (&acc)[2][2][4][2], const Unit& u, int wr, int wc, int fr, int fq) const {
        const int row0 = u.pm * BM + wr * 64 + fr, col0 = u.pn * HALF + wc * 32 + 8 * fq;
#pragma unroll
        for (int ai = 0; ai < 2; ++ai)
#pragma unroll
            for (int m = 0; m < 4; ++m) { bf16_t* rowp = H + (size_t)(row0 + ai * HALF + m * 16) * ldh + col0;
                f32x4 v0, v1;
#pragma unroll
                for (int j = 0; j < 4; ++j) { v0[j] = silu_f(acc[ai][0][m][0][j]) * acc[ai][1][m][0][j]; v1[j] = silu_f(acc[ai][0][m][1][j]) * acc[ai][1][m][1][j]; }
                u32x4 w; w.x = cvt_pk_bf16(v0[0], v0[1]); w.y = cvt_pk_bf16(v0[2], v0[3]); w.z = cvt_pk_bf16(v1[0], v1[1]); w.w = cvt_pk_bf16(v1[2], v1[3]);
                *(u32x4*)rowp = w; }
    }
};
template <bool NT> struct EpiSwiglu8 {
    static constexpr bool PERM = true, AFTER_DRAIN = false;
    unsigned char* H; int ldh;
    __device__ __forceinline__ void operator()(const f32x4 (&acc)[2][2][4][2], const Unit& u, int wr, int wc, int fr, int fq) const {
        const int row0 = u.pm * BM + wr * 64 + fr, col0 = u.pn * HALF + wc * 32 + 8 * fq;
#pragma unroll
        for (int ai = 0; ai < 2; ++ai)
#pragma unroll
            for (int m = 0; m < 4; ++m) { unsigned char* rowp = H + (size_t)(row0 + ai * HALF + m * 16) * ldh + col0;
                f32x4 v0, v1;
#pragma unroll
                for (int j = 0; j < 4; ++j) { const float g0 = acc[ai][0][m][0][j], g1 = acc[ai][0][m][1][j];
                    v0[j] = g0 * acc[ai][1][m][0][j] * __builtin_amdgcn_rcpf(1.0f + __builtin_amdgcn_exp2f(g0)); v1[j] = g1 * acc[ai][1][m][1][j] * __builtin_amdgcn_rcpf(1.0f + __builtin_amdgcn_exp2f(g1)); }
                int w0 = 0, w1 = 0;
                w0 = __builtin_amdgcn_cvt_pk_fp8_f32(v0[0], v0[1], w0, false); w0 = __builtin_amdgcn_cvt_pk_fp8_f32(v0[2], v0[3], w0, true);
                w1 = __builtin_amdgcn_cvt_pk_fp8_f32(v1[0], v1[1], w1, false); w1 = __builtin_amdgcn_cvt_pk_fp8_f32(v1[2], v1[3], w1, true);
                const unsigned long long pk_ = (unsigned long long)(unsigned)w0 | ((unsigned long long)(unsigned)w1 << 32);
                if (NT) __builtin_nontemporal_store(pk_, (unsigned long long*)rowp); else *(unsigned long long*)rowp = pk_; }
    }
};
struct EpiRowScale {
    static constexpr bool PERM = true, AFTER_DRAIN = false;
    bf16_t* O; int ldc; const float* rs;
    __device__ __forceinline__ void operator()(const f32x4 (&acc)[2][2][4][2], const Unit& u, int wr, int wc, int fr, int fq) const {
        const int row0 = u.pm * BM + wr * 64 + fr, col0 = u.pn * BM + wc * 32 + 8 * fq;
#pragma unroll
        for (int ai = 0; ai < 2; ++ai)
#pragma unroll
            for (int m = 0; m < 4; ++m) { const int row = row0 + ai * HALF + m * 16; const float s = rs[row + (u.pa - u.pm) * BM]; bf16_t* rowp = O + (size_t)row * ldc + col0;
#pragma unroll
                for (int bj = 0; bj < 2; ++bj) { const f32x4 v0 = acc[ai][bj][m][0] * s, v1 = acc[ai][bj][m][1] * s;
                    u32x4 w; w.x = cvt_pk_bf16(v0[0], v0[1]); w.y = cvt_pk_bf16(v0[2], v0[3]); w.z = cvt_pk_bf16(v1[0], v1[1]); w.w = cvt_pk_bf16(v1[2], v1[3]);
                    *(u32x4*)(rowp + bj * HALF) = w; } }
    }
};

template <class Epi, class Sched, bool ALIGN_EPI = false, bool SP2 = false, int SCA = 0, int SCB = 0>
__device__ __forceinline__ void gemm_phase(PG8_LAS unsigned char* lds, const Gemm g, const Sched& S, const Epi& E, const int mk_wid) {
    const int wid = mk_wid, lane = mk_lane(), tid = wid * 64 + lane, wr = wid >> 2, wc = wid & 3, fr = lane & 15, fq = lane >> 4;
    const int K = g.K, nt = (g.KL ? g.KL : K) / BK;
    unsigned voffA[2], voffB[2];
#pragma unroll
    for (int i = 0; i < 2; ++i) { int R, C; stage_rc(tid * 16 + i * 8192, R, C); const int Rb = Epi::PERM ? ((R & ~31) + perm32(R & 31)) : R;
        voffA[i] = (unsigned)(R * K + C) * 2u; voffB[i] = (unsigned)(Rb * K + C) * 2u; }
    const size_t kstep = (size_t)(BK * 2);
    const size_t hstep = (size_t)HALF * K * 2;
    const size_t tstep = 2 * hstep;
    const unsigned ldsw = (unsigned)wid * 1024u;
    const int aoff = lds_byte(wr * 64 + fr, fq * 8), boff = lds_byte(wc * 32 + fr, fq * 8);
#define PG8_SA(b, h) (((b) * 2 + (h)) * HTB)
#define PG8_SB(b, h) ((4 + (b) * 2 + (h)) * HTB)
#define PG8_STAGE(bufoff, gbase, voff) do { _Pragma("unroll") for (int _i = 0; _i < 2; ++_i) \
        __builtin_amdgcn_global_load_lds((const unsigned*)((const char*)(gbase) + (voff)[_i]), (PG8_LAS unsigned*)(lds + (bufoff) + ldsw + _i * 8192), 16, 0, 0); } while (0)
#define PG8_LDA(dst, b, h) do { _Pragma("unroll") for (int m = 0; m < 4; ++m) _Pragma("unroll") for (int k = 0; k < 2; ++k) dst[m][k] = *(const PG8_LAS bf16x8*)(lds + PG8_SA(b, h) + aoff + m * 2048 + k * 1024); } while (0)
#define PG8_LDB(dst, b, h) do { _Pragma("unroll") for (int n = 0; n < 2; ++n) _Pragma("unroll") for (int k = 0; k < 2; ++k) dst[n][k] = *(const PG8_LAS bf16x8*)(lds + PG8_SB(b, h) + boff + n * 2048 + k * 1024); } while (0)
#define PG8_CAT8(x, y) __builtin_shufflevector(__builtin_bit_cast(v4i_t, x), __builtin_bit_cast(v4i_t, y), 0, 1, 2, 3, 4, 5, 6, 7)
#define PG8_MMA(ai, bj, At, Bt) do { __builtin_amdgcn_s_setprio(1); if constexpr (SCA != 0) asm volatile("s_nop 1" ::: "memory"); \
        if constexpr (SCA != 0) { _Pragma("unroll") for (int m = 0; m < 4; ++m) _Pragma("unroll") for (int n = 0; n < 2; ++n) \
            asm volatile("v_mfma_scale_f32_16x16x128_f8f6f4 %0, %1, %2, %0, %3, %4 op_sel_hi:[0,0,0]" : "+v"(acc[ai][bj][m][n]) : "v"(PG8_CAT8(Bt[n][0], Bt[n][1])), "v"(PG8_CAT8(At[m][0], At[m][1])), "v"(scb_), "v"(sca_)); } \
        else { _Pragma("unroll") for (int m = 0; m < 4; ++m) _Pragma("unroll") for (int n = 0; n < 2; ++n) _Pragma("unroll") for (int k = 0; k < 2; ++k) \
            acc[ai][bj][m][n] = __builtin_amdgcn_mfma_f32_16x16x32_bf16(Bt[n][k], At[m][k], acc[ai][bj][m][n], 0, 0, 0); } \
        __builtin_amdgcn_s_setprio(0); } while (0)
#define PG8_WAIT_V(n) asm volatile("s_waitcnt vmcnt(" #n ")" ::: "memory")
#define PG8_WAIT_L(n) asm volatile("s_waitcnt lgkmcnt(" #n ")" ::: "memory")
#define PG8_BAR __builtin_amdgcn_s_barrier()
#define PG8_SCHED __builtin_amdgcn_sched_barrier(0)
    Unit cur, nxt; int ui = 0;
    if (!S.next(0, cur)) return;
    f32x4 acc[2][2][4][2];
#pragma unroll
    for (int a = 0; a < 2; ++a)
#pragma unroll
        for (int b = 0; b < 2; ++b)
#pragma unroll
            for (int m = 0; m < 4; ++m)
#pragma unroll
                for (int n = 0; n < 2; ++n) acc[a][b][m][n] = (f32x4){0.f, 0.f, 0.f, 0.f};
    bf16x8 At[4][2], B0[2][2], B1[2][2];
    const int sca_ = SCA, scb_ = SCB;
    const char* cA = (const char*)g.A + (size_t)cur.pa * tstep + cur.koff; const char* cB = (const char*)g.Bt + (size_t)cur.pb * tstep + cur.koff;
    S.a_ready(cur);
    if constexpr (SP2) {
        PG8_STAGE(PG8_SB(0, 0), cB, voffB); PG8_STAGE(PG8_SB(0, 1), cB + hstep, voffB); PG8_STAGE(PG8_SA(0, 0), cA, voffA); PG8_STAGE(PG8_SA(0, 1), cA + hstep, voffA);
        if (wr == 1) PG8_BAR;
        PG8_WAIT_V(2); PG8_BAR;
        PG8_STAGE(PG8_SB(1, 0), cB + kstep, voffB); PG8_STAGE(PG8_SA(1, 0), cA + kstep, voffA); PG8_STAGE(PG8_SB(1, 1), cB + hstep + kstep, voffB);
        PG8_WAIT_V(6); PG8_BAR;
    } else {
        PG8_STAGE(PG8_SB(0, 0), cB, voffB); PG8_STAGE(PG8_SA(0, 0), cA, voffA); PG8_STAGE(PG8_SB(0, 1), cB + hstep, voffB); PG8_STAGE(PG8_SA(0, 1), cA + hstep, voffA);
        if (wr == 1) PG8_BAR;
        PG8_WAIT_V(4); PG8_BAR;
        PG8_STAGE(PG8_SB(1, 0), cB + kstep, voffB); PG8_STAGE(PG8_SA(1, 0), cA + kstep, voffA); PG8_STAGE(PG8_SB(1, 1), cB + hstep + kstep, voffB);
        PG8_WAIT_V(6); PG8_BAR;
    }
    for (;;) {
        const bool has_next = S.next(ui + 1, nxt);
        const char* nA = has_next ? (const char*)g.A + (size_t)nxt.pa * tstep + nxt.koff : cA; const char* nB = has_next ? (const char*)g.Bt + (size_t)nxt.pb * tstep + nxt.koff : cB;
        for (int t = 0; t < nt; t += 2) {
            const bool last = (t == nt - 2);
            const char* a1 = cA + (size_t)(t + 1) * kstep;
            const char* a2 = last ? nA : cA + (size_t)(t + 2) * kstep; const char* b2 = last ? nB : cB + (size_t)(t + 2) * kstep;
            const char* a3 = a2 + kstep; const char* b3 = b2 + kstep;
            if (last && has_next) S.a_ready(nxt);
            if constexpr (SP2) {
            PG8_LDB(B0, 0, 0); PG8_LDB(B1, 0, 1); PG8_SCHED; PG8_LDA(At, 0, 0); PG8_STAGE(PG8_SA(1, 1), a1 + hstep, voffA);
            PG8_WAIT_V(8); PG8_WAIT_L(0); PG8_BAR; PG8_MMA(0, 0, At, B0); PG8_MMA(0, 1, At, B1); PG8_BAR; PG8_SCHED;
            PG8_LDA(At, 0, 1); PG8_STAGE(PG8_SB(0, 0), b2, voffB); PG8_STAGE(PG8_SB(0, 1), b2 + hstep, voffB); PG8_STAGE(PG8_SA(0, 0), a2, voffA);
            PG8_WAIT_V(8); PG8_WAIT_L(0); PG8_BAR; PG8_MMA(1, 0, At, B0); PG8_MMA(1, 1, At, B1); PG8_BAR; PG8_SCHED;
            PG8_LDB(B0, 1, 0); PG8_LDB(B1, 1, 1); PG8_SCHED; PG8_LDA(At, 1, 0); PG8_STAGE(PG8_SA(0, 1), a2 + hstep, voffA);
            PG8_WAIT_V(8); PG8_WAIT_L(0); PG8_BAR; PG8_MMA(0, 0, At, B0); PG8_MMA(0, 1, At, B1); PG8_BAR; PG8_SCHED;
            PG8_LDA(At, 1, 1); PG8_STAGE(PG8_SB(1, 0), b3, voffB); PG8_STAGE(PG8_SB(1, 1), b3 + hstep, voffB); PG8_STAGE(PG8_SA(1, 0), a3, voffA);
            PG8_WAIT_V(8); PG8_WAIT_L(0); PG8_BAR; PG8_MMA(1, 0, At, B0); PG8_MMA(1, 1, At, B1); PG8_BAR; PG8_SCHED;
            } else {
            PG8_LDB(B0, 0, 0); PG8_SCHED; PG8_LDA(At, 0, 0); PG8_STAGE(PG8_SA(1, 1), a1 + hstep, voffA);
            PG8_WAIT_L(8); PG8_BAR; PG8_WAIT_L(0); PG8_MMA(0, 0, At, B0); PG8_BAR; PG8_SCHED;
            PG8_LDB(B1, 0, 1); PG8_STAGE(PG8_SB(0, 0), b2, voffB);
            PG8_BAR; PG8_WAIT_L(0); PG8_MMA(0, 1, At, B1); PG8_BAR;
            PG8_LDA(At, 0, 1); PG8_STAGE(PG8_SA(0, 0), a2, voffA);
            PG8_BAR; PG8_WAIT_L(0); PG8_MMA(1, 0, At, B0); PG8_BAR; PG8_SCHED;
            PG8_STAGE(PG8_SB(0, 1), b2 + hstep, voffB);
            PG8_WAIT_V(6); PG8_BAR; PG8_MMA(1, 1, At, B1); PG8_BAR;
            PG8_LDB(B0, 1, 0); PG8_SCHED; PG8_LDA(At, 1, 0); PG8_STAGE(PG8_SA(0, 1), a2 + hstep, voffA);
            PG8_WAIT_L(8); PG8_BAR; PG8_WAIT_L(0); PG8_MMA(0, 0, At, B0); PG8_BAR; PG8_SCHED;
            PG8_LDB(B1, 1, 1); PG8_STAGE(PG8_SB(1, 0), b3, voffB);
            PG8_BAR; PG8_WAIT_L(0); PG8_MMA(0, 1, At, B1); PG8_BAR;
            PG8_LDA(At, 1, 1); PG8_STAGE(PG8_SA(1, 0), a3, voffA);
            PG8_BAR; PG8_WAIT_L(0); PG8_MMA(1, 0, At, B0); PG8_BAR; PG8_SCHED;
            PG8_STAGE(PG8_SB(1, 1), b3 + hstep, voffB);
            PG8_WAIT_V(6); PG8_BAR; PG8_MMA(1, 1, At, B1); PG8_BAR;
            }
        }
        if constexpr (SCA != 0) asm volatile("s_nop 15\n\ts_nop 15" ::: "memory");
        if constexpr (ALIGN_EPI) { if (wr == 0) PG8_BAR; }
        if constexpr (!Epi::AFTER_DRAIN) { E(acc, cur, wr, wc, fr, fq); S.done(cur); }
        if (!has_next) break;
#pragma unroll
        for (int a = 0; a < 2; ++a)
#pragma unroll
            for (int b = 0; b < 2; ++b)
#pragma unroll
                for (int m = 0; m < 4; ++m)
#pragma unroll
                    for (int n = 0; n < 2; ++n) acc[a][b][m][n] = (f32x4){0.f, 0.f, 0.f, 0.f};
        cur = nxt; cA = nA; cB = nB; ++ui;
        if constexpr (ALIGN_EPI) { if (wr == 1) PG8_BAR; }
    }
    PG8_WAIT_V(0);
    if constexpr (!ALIGN_EPI) { if (wr == 0) PG8_BAR; }
    PG8_BAR;
    if constexpr (Epi::AFTER_DRAIN) { E.fused(acc, cur, wr, wc, fr, fq, lds, wid, lane); S.done(cur); }
#undef PG8_SA
#undef PG8_SB
#undef PG8_STAGE
#undef PG8_LDA
#undef PG8_LDB
#undef PG8_MMA
#undef PG8_CAT8
#undef PG8_WAIT_V
#undef PG8_WAIT_L
#undef PG8_BAR
#undef PG8_SCHED
}
}

namespace at128 {
constexpr int D = 128;
constexpr float THR = 8.f;
constexpr bool WSKIP = false;
constexpr float SCALE = 0.08838834764831845f;
constexpr int NW = 8, QBLK = 32, KVBLK = 64, QB = NW * QBLK;
constexpr int SHM_V = KVBLK * D * 2, SHM_K = KVBLK * D * 2;
constexpr int LDS_BYTES = 2 * SHM_V + 2 * SHM_K + NW * 64 * 4;

using bf16 = __hip_bfloat16;
typedef short bf16x8 __attribute__((ext_vector_type(8)));
typedef short s16x4 __attribute__((ext_vector_type(4)));
typedef float f32x16 __attribute__((ext_vector_type(16)));
typedef float f32x4 __attribute__((ext_vector_type(4)));
typedef unsigned u32x4 __attribute__((ext_vector_type(4)));
template <class A, class Bt> struct same_t { static constexpr bool v = false; };
template <class A> struct same_t<A, A> { static constexpr bool v = true; };

#define KSWZ(row, colB) ((row) * 256 + ((colB) ^ (((row) & 7) << 4)))
#define SBAR() __builtin_amdgcn_sched_barrier(0)
__device__ __forceinline__ int v_st(int k, int c) { const int kk = (k & ~0xC) | ((k & 4) << 1) | ((k & 8) >> 1); return ((kk >> 3) * 4 + (c >> 5)) * 512 + ((kk & 7) * 32 + (c & 31)) * 2; }
__device__ __forceinline__ int v_rd_base(int lane) { return ((lane & 3) << 3) | (((lane >> 2) & 3) << 6) | (((lane >> 4) & 1) << 5) | (((lane >> 5) & 1) << 8); }
constexpr int v_rd_off(int d0, int ks, int half) { return d0 * 512 + ks * 4096 + half * 2048; }
__device__ __forceinline__ int crow(int r, int hi) { return (r & 3) + 8 * (r >> 2) + 4 * hi; }
__device__ __forceinline__ unsigned cvtpk(float lo, float hi) {
    unsigned r; asm volatile("v_cvt_pk_bf16_f32 %0, %1, %2" : "=v"(r) : "v"(lo), "v"(hi)); return r;
}
__device__ __forceinline__ bf16x8 pack8(f32x4 a, f32x4 b) {
    u32x4 w = {cvtpk(a[0], a[1]), cvtpk(a[2], a[3]), cvtpk(b[0], b[1]), cvtpk(b[2], b[3])};
    return *reinterpret_cast<bf16x8*>(&w);
}
template <class T> __device__ __forceinline__ bf16x8 load8(const T* p) {
    if constexpr (same_t<T, float>::v) { return pack8(*(const f32x4*)p, *(const f32x4*)(p + 4)); }
    else { return *reinterpret_cast<const bf16x8*>(p); }
}
__device__ __forceinline__ void mask_tile(f32x16& p0, f32x16& p1, int dq, unsigned W) {
    const float NEG = -__builtin_inff();
#pragma unroll
    for (int r = 0; r < 16; ++r) {
        const int c = (r & 3) + 8 * (r >> 2);
        if ((unsigned)(dq - c) >= W) p0[r] = NEG;
        if ((unsigned)(dq - c - 32) >= W) p1[r] = NEG;
    }
}
__device__ __forceinline__ void partialSM(f32x16& p0, f32x16& p1, float& m_reg, float& mn, float& alpha) {
    float pmax = p0[0]; for (int r = 1; r < 16; ++r) pmax = fmaxf(pmax, p0[r]); for (int r = 0; r < 16; ++r) pmax = fmaxf(pmax, p1[r]);
    { auto rr = __builtin_amdgcn_permlane32_swap(__float_as_uint(pmax), __float_as_uint(pmax), false, false);
      pmax = fmaxf(__uint_as_float(rr[0]), __uint_as_float(rr[1])); }
    constexpr float C2 = 1.4426950408889634f * SCALE;
    if (__builtin_expect(__all((pmax - m_reg) * SCALE <= THR), 1)) { mn = m_reg; alpha = 1.f; }
    else { mn = fmaxf(m_reg, pmax); alpha = __builtin_amdgcn_exp2f((m_reg - mn) * C2); m_reg = mn; }
    const float mnL = -mn * C2;
    for (int r = 0; r < 16; ++r) p0[r] = fmaf(p0[r], C2, mnL); for (int r = 0; r < 16; ++r) p1[r] = fmaf(p1[r], C2, mnL);
    for (int r = 0; r < 16; ++r) p0[r] = __builtin_amdgcn_exp2f(p0[r]);
}
__device__ __forceinline__ void finishSM(f32x16& p0, f32x16& p1, float alpha, float& l_reg, bf16x8& pa0, bf16x8& pa1, bf16x8& pa2, bf16x8& pa3) {
    for (int r = 0; r < 16; ++r) p1[r] = __builtin_amdgcn_exp2f(p1[r]);
    float ps = 0; for (int r = 0; r < 16; ++r) ps += p0[r]; for (int r = 0; r < 16; ++r) ps += p1[r];
    { auto rr = __builtin_amdgcn_permlane32_swap(__float_as_uint(ps), __float_as_uint(ps), false, false);
      ps = __uint_as_float(rr[0]) + __uint_as_float(rr[1]); }
    l_reg = l_reg * alpha + ps;
#define PK4(P, B_, OUT) do { unsigned a0 = cvtpk(P[B_+0], P[B_+1]), a1 = cvtpk(P[B_+2], P[B_+3]);                          \
        unsigned b0 = cvtpk(P[B_+4], P[B_+5]), b1 = cvtpk(P[B_+6], P[B_+7]);                                             \
        auto r0 = __builtin_amdgcn_permlane32_swap(a0, b0, false, false); auto r1 = __builtin_amdgcn_permlane32_swap(a1, b1, false, false); \
        u32x4 w = {r0[0], r1[0], r0[1], r1[1]}; OUT = *reinterpret_cast<bf16x8*>(&w); } while (0)
    PK4(p0, 0, pa0); PK4(p0, 8, pa1); PK4(p1, 0, pa2); PK4(p1, 8, pa3);
#undef PK4
}
template <int KB, bool SK>
__device__ __forceinline__ void qkt(f32x16& p0, f32x16& p1, const char* K_lds, int r32, int hi, const bf16x8* qr, bool act) {
    if (SK && !act) { const float NEG = -__builtin_inff();
#pragma unroll
        for (int r = 0; r < 16; ++r) { p0[r] = NEG; p1[r] = NEG; } return; }
    p0 = f32x16{}; p1 = f32x16{};
    const char* kb[4];
#pragma unroll
    for (int dd = 0; dd < 4; ++dd) kb[dd] = K_lds + KB * SHM_K + KSWZ(r32, (dd * 16 + hi * 8) * 2);
#pragma unroll
    for (int d0 = 0; d0 < 8; ++d0) { const char* a = kb[d0 & 3] + (d0 >> 2) * 128;
        bf16x8 b0 = *reinterpret_cast<const bf16x8*>(a);
        bf16x8 b1 = *reinterpret_cast<const bf16x8*>(a + 32 * 256);
        p0 = __builtin_amdgcn_mfma_f32_32x32x16_bf16(b0, qr[d0], p0, 0, 0, 0);
        p1 = __builtin_amdgcn_mfma_f32_32x32x16_bf16(b1, qr[d0], p1, 0, 0, 0); }
}
template <int VB, bool SK>
__device__ __forceinline__ void pv_tile(f32x16* o, int vb0, bf16x8 pa0, bf16x8 pa1, bf16x8 pa2, bf16x8 pa3, bool act) {
    if (SK && !act) return;
#define TRRD(dst, off) asm volatile("ds_read_b64_tr_b16 %0, %1 offset:%2" : "=&v"(dst) : "v"(vb0), "i"(off) : "memory")
#define PV_D0(d0) do { s16x4 l0, l1, l2, l3, h0, h1, h2, h3; constexpr int b_ = VB * SHM_V + v_rd_off(d0, 0, 0);     \
        TRRD(l0, b_); TRRD(h0, b_ + 2048); TRRD(l1, b_ + 4096); TRRD(h1, b_ + 6144); TRRD(l2, b_ + 8192); TRRD(h2, b_ + 10240); TRRD(l3, b_ + 12288); TRRD(h3, b_ + 14336); \
        asm volatile("s_waitcnt lgkmcnt(0)" ::: "memory"); SBAR();                 \
        o[d0] = __builtin_amdgcn_mfma_f32_32x32x16_bf16(pa0, (bf16x8){l0[0], l0[1], l0[2], l0[3], h0[0], h0[1], h0[2], h0[3]}, o[d0], 0, 0, 0);   \
        o[d0] = __builtin_amdgcn_mfma_f32_32x32x16_bf16(pa1, (bf16x8){l1[0], l1[1], l1[2], l1[3], h1[0], h1[1], h1[2], h1[3]}, o[d0], 0, 0, 0);   \
        o[d0] = __builtin_amdgcn_mfma_f32_32x32x16_bf16(pa2, (bf16x8){l2[0], l2[1], l2[2], l2[3], h2[0], h2[1], h2[2], h2[3]}, o[d0], 0, 0, 0);   \
        o[d0] = __builtin_amdgcn_mfma_f32_32x32x16_bf16(pa3, (bf16x8){l3[0], l3[1], l3[2], l3[3], h3[0], h3[1], h3[2], h3[3]}, o[d0], 0, 0, 0); } while (0)
    PV_D0(0); PV_D0(1); PV_D0(2); PV_D0(3);
#undef PV_D0
#undef TRRD
}

template <class TIn, class TOut> struct BlockRef { const TIn* Q; const TIn* K; const TIn* V; TOut* O; int P0; };
template <class TIn> struct Seam {
    bf16x8 qr[8];
    bf16x8 st_v0, st_v1, st_k0, st_k1; f32x4 sf0, sf1, sf2, sf3;
    f32x4 tq[16];
};
__device__ __forceinline__ int swa_jlo(int P0, int W) { const int lowk = P0 - W + 1; return lowk > 0 ? lowk / KVBLK : 0; }
#define ROW(p, k0, rr) ((p) + (size_t)((k0) + (rr)) * PKV + sc)
#define VMW() asm volatile("s_waitcnt vmcnt(0)" ::: "memory")
#define VMWN(n) asm volatile("s_waitcnt vmcnt(%0)" :: "i"(n) : "memory")
#define SLOAD_H(Kp, Vp, k0) do { S.st_v0 = load8<TIn>(ROW(Vp, k0, sr)); S.st_v1 = load8<TIn>(ROW(Vp, k0, 32 + sr));              \
                         S.st_k0 = load8<TIn>(ROW(Kp, k0, sr)); S.st_k1 = load8<TIn>(ROW(Kp, k0, 32 + sr)); } while (0)
#define SWRITE_HK(bf) do { *(bf16x8*)(K_lds + (bf) * SHM_K + kws) = S.st_k0; *(bf16x8*)(K_lds + (bf) * SHM_K + kws + 32 * 256) = S.st_k1; } while (0)
#define SWRITE_HV(bf) do { *(bf16x8*)(V_lds + (bf) * SHM_V + vst0) = S.st_v0; *(bf16x8*)(V_lds + (bf) * SHM_V + vst1) = S.st_v1; } while (0)
#define SWRITE_H(bf) do { SWRITE_HV(bf); SWRITE_HK(bf); } while (0)
#define SLOAD_F(p, k0) do { S.sf0 = *(const f32x4*)ROW(p, k0, sr); S.sf1 = *(const f32x4*)(ROW(p, k0, sr) + 4);                \
                            S.sf2 = *(const f32x4*)ROW(p, k0, 32 + sr); S.sf3 = *(const f32x4*)(ROW(p, k0, 32 + sr) + 4); } while (0)
#define SWRITE_KF(bf) do { *(bf16x8*)(K_lds + (bf) * SHM_K + kws) = pack8(S.sf0, S.sf1); *(bf16x8*)(K_lds + (bf) * SHM_K + kws + 32 * 256) = pack8(S.sf2, S.sf3); } while (0)
#define SWRITE_VF(bf) do { *(bf16x8*)(V_lds + (bf) * SHM_V + vst0) = pack8(S.sf0, S.sf1); *(bf16x8*)(V_lds + (bf) * SHM_V + vst1) = pack8(S.sf2, S.sf3); } while (0)
template <class TIn, class TOut, int PQ, int PKV, int PO>
__device__ __forceinline__ void causal_swa_prime(const BlockRef<TIn, TOut>& cur, int W, char* lds, Seam<TIn>& S, const int mk_wid) {
    constexpr bool F32 = same_t<TIn, float>::v;
    const int wid = mk_wid, lane = mk_lane(), tid = wid * 64 + lane, r32 = lane & 31, hi = lane >> 5;
    const int sr = tid >> 4, sc = (tid & 15) * 8, kws = KSWZ(sr, sc * 2); char* K_lds = lds + 2 * SHM_V;
    const int kb0 = swa_jlo(cur.P0, W) * KVBLK;
    for (int d0 = 0; d0 < 8; ++d0) S.qr[d0] = load8<TIn>(cur.Q + (size_t)(wid * QBLK + r32) * PQ + d0 * 16 + hi * 8);
    if constexpr (F32) { SLOAD_F((const float*)cur.K, kb0); VMW(); SWRITE_KF(0); SBAR(); SLOAD_F((const float*)cur.V, kb0); }
    else { SLOAD_H(cur.K, cur.V, kb0); VMW(); SWRITE_HK(0); }
    __syncthreads();
}
template <class TIn, class TOut, int PQ, int PKV, int PO>
__device__ __forceinline__ void causal_swa_block(const BlockRef<TIn, TOut>& cur, const BlockRef<TIn, TOut>& nxt, int skv, int W, char* lds, Seam<TIn>& S, const int mk_wid) {
    constexpr bool F32 = same_t<TIn, float>::v;
    const int wid = mk_wid, lane = mk_lane(), tid = wid * 64 + lane, r32 = lane & 31, hi = lane >> 5;
    const int j_lo = swa_jlo(cur.P0, W);
    int j_hi = (cur.P0 + QB - 1) / KVBLK + 1; if (j_hi > skv / KVBLK) j_hi = skv / KVBLK;
    const int NT = j_hi - j_lo;
    const int kbn = swa_jlo(nxt.P0, W) * KVBLK;
    const int qlo = cur.P0 + wid * QBLK, qm = qlo + r32 - 4 * hi;
    char* V_lds = lds; char* K_lds = lds + 2 * SHM_V;
    float* ws = (float*)(lds + 2 * SHM_V + 2 * SHM_K) + wid * 64; float* li_l = ws, * al_l = ws + 32;
    float m_reg = -1e30f, l_reg = 0; f32x16 o[4] = {};
    const int sr = tid >> 4, sc = (tid & 15) * 8, vst0 = v_st(sr, sc), vst1 = v_st(32 + sr, sc), kws = KSWZ(sr, sc * 2);
    const int vb0 = (int)(uintptr_t)V_lds + v_rd_base(lane);
    const TIn* Kh = cur.K; const TIn* Vh = cur.V;
#define RESC(a) do { if (__any((a) < 1.f)) { if (hi == 0) al_l[r32] = (a); asm volatile("s_waitcnt lgkmcnt(0)" ::: "memory");              \
                     for (int d_ = 0; d_ < 4; ++d_) for (int r = 0; r < 16; ++r) o[d_][r] *= al_l[crow(r, hi)]; } } while (0)
#define KBASE(t) ((j_lo + (t)) * KVBLK)
#define ACT(t) (KBASE(t) <= qlo + QBLK - 1 && KBASE(t) + KVBLK - 1 >= qlo - W + 1)
#define MASKT(P0_, P1_, t) do { const int kb_ = KBASE(t); if ((!SK || ACT(t)) && (kb_ + KVBLK - 1 > qlo || kb_ <= qlo + QBLK - 1 - W)) mask_tile(P0_, P1_, qm - kb_, (unsigned)W); } while (0)
    constexpr int NQL = F32 ? 16 : 8;
    constexpr bool SK = WSKIP && !F32;
#define SEAM_K0() do { VMWN(NQL); if constexpr (F32) { SWRITE_KF(0); SBAR(); SLOAD_F((const float*)nxt.V, kbn); } else { SWRITE_HK(0); } SBAR(); } while (0)
    f32x16 pA0, pA1, pB0, pB1; float mnA, mnB, alA, alB; bf16x8 pa0, pa1, pa2, pa3;
    if constexpr (F32) { VMW(); SWRITE_VF(0); SBAR(); } else { SWRITE_HV(0); SBAR(); }
    if (NT > 1) { if constexpr (F32) SLOAD_F((const float*)Kh, KBASE(1)); else SLOAD_H(Kh, Vh, KBASE(1)); }
    SBAR(); qkt<0, SK>(pA0, pA1, K_lds, r32, hi, S.qr, ACT(0));
    if constexpr (F32) { if (NT > 1) { VMW(); SWRITE_KF(1); SBAR(); SLOAD_F((const float*)Vh, KBASE(1)); } }
    MASKT(pA0, pA1, 0); partialSM(pA0, pA1, m_reg, mnA, alA);
    if (NT > 1) { VMW(); if constexpr (F32) { SWRITE_VF(1); SBAR(); if (NT > 2) SLOAD_F((const float*)Kh, KBASE(2)); } else SWRITE_H(1); }
    __syncthreads();
#define HALF_STEP(PX0, PX1, mnX, alX, PY0, PY1, alY, t, KB, VB, SB) do {                                                      \
        SBAR(); qkt<KB, SK>(PX0, PX1, K_lds, r32, hi, S.qr, ACT(t));                                             \
        finishSM(PY0, PY1, alY, l_reg, pa0, pa1, pa2, pa3); SBAR();                                                           \
        if ((t) + 1 < NT) { if constexpr (F32) { VMW(); SWRITE_KF(SB); SBAR(); SLOAD_F((const float*)Vh, KBASE((t) + 1)); }  \
                            else { SLOAD_H(Kh, Vh, KBASE((t) + 1)); } SBAR(); }                                               \
        pv_tile<VB, SK>(o, vb0, pa0, pa1, pa2, pa3, ACT((t) - 1)); MASKT(PX0, PX1, (t)); partialSM(PX0, PX1, m_reg, mnX, alX);                                        \
        __syncthreads();                                                                                                      \
        if ((t) + 1 < NT) { VMW(); if constexpr (F32) { SWRITE_VF(SB); SBAR(); if ((t) + 2 < NT) SLOAD_F((const float*)Kh, KBASE((t) + 2)); } \
                            else { SWRITE_H(SB); } }                                                                          \
        RESC(alX); __syncthreads(); } while (0)
    for (int t = 1; t + 1 < NT; t += 2) {
        HALF_STEP(pB0, pB1, mnB, alB, pA0, pA1, alA, t, 1, 0, 0);
        HALF_STEP(pA0, pA1, mnA, alA, pB0, pB1, alB, t + 1, 0, 1, 1);
    }
    const bool even = (NT & 1) == 0;
    if (even) { SBAR(); qkt<1, SK>(pB0, pB1, K_lds, r32, hi, S.qr, ACT(NT - 1)); SBAR(); }
#define QROW(e) (nxt.Q + (size_t)(wid * QBLK + r32) * PQ + ((e) >> 1) * 16 + hi * 8 + ((e) & 1) * 4)
    if constexpr (F32) { SLOAD_F((const float*)nxt.K, kbn); SBAR();
#pragma unroll
        for (int e = 0; e < 8; ++e) S.tq[e] = *(const f32x4*)QROW(e); }
    else { SLOAD_H(nxt.K, nxt.V, kbn); SBAR();
#pragma unroll
        for (int d0 = 0; d0 < 8; ++d0) S.qr[d0] = load8<TIn>(nxt.Q + (size_t)(wid * QBLK + r32) * PQ + d0 * 16 + hi * 8); }
    SBAR();
    finishSM(pA0, pA1, alA, l_reg, pa0, pa1, pa2, pa3); SBAR();
    if constexpr (F32) {
#pragma unroll
        for (int e = 8; e < 16; ++e) S.tq[e] = *(const f32x4*)QROW(e); SBAR(); }
#undef QROW
    pv_tile<0, SK>(o, vb0, pa0, pa1, pa2, pa3, ACT(even ? NT - 2 : NT - 1));
    if (even) { MASKT(pB0, pB1, NT - 1); partialSM(pB0, pB1, m_reg, mnB, alB); __syncthreads(); RESC(alB);
        finishSM(pB0, pB1, alB, l_reg, pa0, pa1, pa2, pa3); SBAR(); pv_tile<1, SK>(o, vb0, pa0, pa1, pa2, pa3, ACT(NT - 1)); }
    SBAR(); SEAM_K0();
    if (hi == 0) li_l[r32] = l_reg; asm volatile("s_waitcnt lgkmcnt(0)" ::: "memory");
    float rli[16];
#pragma unroll
    for (int r = 0; r < 16; ++r) rli[r] = __builtin_amdgcn_rcpf(li_l[crow(r, hi)]);
    TOut* Ow = cur.O + (size_t)(wid * QBLK) * PO;
#pragma unroll
    for (int r = 0; r < 16; ++r) { const int orow = crow(r, hi);
#pragma unroll
        for (int d0 = 0; d0 < 4; ++d0) { const float v = o[d0][r] * rli[r];
            if constexpr (same_t<TOut, float>::v) { Ow[(size_t)orow * PO + d0 * 32 + r32] = v; }
            else { const float vn = __shfl_xor(v, 1);
                   if ((r32 & 1) == 0) *(unsigned*)(Ow + (size_t)orow * PO + d0 * 32 + r32) = cvtpk(v, vn); } } }
    if constexpr (F32) {
#pragma unroll
        for (int d0 = 0; d0 < 8; ++d0) S.qr[d0] = pack8(S.tq[2 * d0], S.tq[2 * d0 + 1]); }
    __syncthreads();
#undef RESC
#undef KBASE
#undef ACT
#undef MASKT
#undef SEAM_K0
#undef HALF_STEP
}
#undef ROW
#undef VMW
#undef VMWN
#undef SLOAD_H
#undef SWRITE_HK
#undef SWRITE_HV
#undef SWRITE_H
#undef SLOAD_F
#undef SWRITE_KF
#undef SWRITE_VF

typedef bf16 abf_t;
}

namespace at256 {
using at128::bf16x8; using at128::f32x16; using at128::f32x4; using at128::abf_t;
constexpr int L_K = 0, L_V = 32768, L_WS = 98304, LDS_NEED = L_WS + 8 * 64 * 4;
__device__ __forceinline__ int swap23(int k) { return (k & ~0xC) | ((k & 4) << 1) | ((k & 8) >> 1); }
template <int IMM> __device__ __forceinline__ void glds16(const void* gbase  , unsigned voff  , unsigned lds_dst) { unsigned keep;
    asm volatile("s_mov_b32 %0, m0\n\ts_mov_b32 m0, %3\n\ts_nop 0\n\tglobal_load_lds_dwordx4 %1, %2 offset:%4\n\ts_mov_b32 m0, %0" : "=&s"(keep) : "v"(voff), "s"(gbase), "s"(lds_dst), "i"(IMM) : "memory"); }
template <int BUF> __device__ __forceinline__ void pv256(f32x16* o, int vb0, bf16x8 pa0, bf16x8 pa1, bf16x8 pa2, bf16x8 pa3) {
    typedef at128::s16x4 s4;
    s4 fa[8], fb[8];
#define A256_TR(dst, off) asm volatile("ds_read_b64_tr_b16 %0, %1 offset:%2" : "=&v"(dst) : "v"(vb0), "i"(off) : "memory")
#define A256_LD(f, d0) do { constexpr int b_ = (BUF * 2 + ((d0) >> 2)) * 16384 + ((d0) & 3) * 512; \
        A256_TR(f[0], b_); A256_TR(f[1], b_ + 2048); A256_TR(f[2], b_ + 4096); A256_TR(f[3], b_ + 6144); A256_TR(f[4], b_ + 8192); A256_TR(f[5], b_ + 10240); A256_TR(f[6], b_ + 12288); A256_TR(f[7], b_ + 14336); } while (0)
#define A256_MM(f, d0) do { \
        o[d0] = __builtin_amdgcn_mfma_f32_32x32x16_bf16(pa0, (bf16x8){f[0][0], f[0][1], f[0][2], f[0][3], f[1][0], f[1][1], f[1][2], f[1][3]}, o[d0], 0, 0, 0); \
        o[d0] = __builtin_amdgcn_mfma_f32_32x32x16_bf16(pa1, (bf16x8){f[2][0], f[2][1], f[2][2], f[2][3], f[3][0], f[3][1], f[3][2], f[3][3]}, o[d0], 0, 0, 0); \
        o[d0] = __builtin_amdgcn_mfma_f32_32x32x16_bf16(pa2, (bf16x8){f[4][0], f[4][1], f[4][2], f[4][3], f[5][0], f[5][1], f[5][2], f[5][3]}, o[d0], 0, 0, 0); \
        o[d0] = __builtin_amdgcn_mfma_f32_32x32x16_bf16(pa3, (bf16x8){f[6][0], f[6][1], f[6][2], f[6][3], f[7][0], f[7][1], f[7][2], f[7][3]}, o[d0], 0, 0, 0); } while (0)
#define A256_W8() do { asm volatile("s_waitcnt lgkmcnt(8)" ::: "memory"); __builtin_amdgcn_sched_barrier(0); } while (0)
#define A256_W0() do { asm volatile("s_waitcnt lgkmcnt(0)" ::: "memory"); __builtin_amdgcn_sched_barrier(0); } while (0)
    A256_LD(fa, 0);
    A256_LD(fb, 1); A256_W8(); A256_MM(fa, 0); __builtin_amdgcn_sched_barrier(0);
    A256_LD(fa, 2); A256_W8(); A256_MM(fb, 1); __builtin_amdgcn_sched_barrier(0);
    A256_LD(fb, 3); A256_W8(); A256_MM(fa, 2); __builtin_amdgcn_sched_barrier(0);
    A256_LD(fa, 4); A256_W8(); A256_MM(fb, 3); __builtin_amdgcn_sched_barrier(0);
    A256_LD(fb, 5); A256_W8(); A256_MM(fa, 4); __builtin_amdgcn_sched_barrier(0);
    A256_LD(fa, 6); A256_W8(); A256_MM(fb, 5); __builtin_amdgcn_sched_barrier(0);
    A256_LD(fb, 7); A256_W8(); A256_MM(fa, 6); __builtin_amdgcn_sched_barrier(0);
    A256_W0(); A256_MM(fb, 7);
#undef A256_TR
#undef A256_LD
#undef A256_MM
#undef A256_W8
#undef A256_W0
}
struct Blk { const abf_t* Q; const abf_t* K; const abf_t* V; abf_t* O; int P0; };
template <int PQ, int PKV, int PO>
__device__ __forceinline__ void attn_block(const Blk& B, __attribute__((address_space(3))) unsigned char* ldsL, const int wid) {
    char* lds = (char*)ldsL;
    const int lane = mk_lane(), r32 = lane & 31, hi = lane >> 5;
    const unsigned lbase = (unsigned)(unsigned long)ldsL;
    unsigned offK, offV;
    { const int q = wid * 64 + lane, row = q >> 4, ch = (q & 15) ^ (row & 7); offK = (unsigned)(row * PKV + ch * 8) * 2u; }
    { const int q = wid * 128 + lane, st = q >> 5, rowk = (q >> 2) & 7, cch = q & 3, k = swap23((st >> 2) * 8 + rowk), c = (st & 3) * 32 + cch * 8; offV = (unsigned)(k * PKV + c) * 2u; }
    const unsigned lpk = (unsigned)wid * 1024u, lpv = (unsigned)wid * 2048u;
#define A256_DMA(buf, key0) do { const abf_t* kg_ = B.K + (size_t)(key0) * PKV; const abf_t* vg_ = B.V + (size_t)(key0) * PKV; \
        glds16<0>(kg_, offK, lbase + L_K + (buf) * 16384 + lpk); glds16<0>(kg_ + 32 * PKV, offK, lbase + L_K + (buf) * 16384 + lpk + 8192); \
        glds16<0>(vg_, offV, lbase + L_V + ((buf) * 2 + 0) * 16384 + lpv); glds16<128>(vg_, offV, lbase + L_V + ((buf) * 2 + 0) * 16384 + lpv + 1024 - 128); \
        glds16<256>(vg_, offV, lbase + L_V + ((buf) * 2 + 1) * 16384 + lpv - 256); glds16<384>(vg_, offV, lbase + L_V + ((buf) * 2 + 1) * 16384 + lpv + 1024 - 384); } while (0)
    const int NT = (B.P0 + 256) / 64;
    const int qlo = B.P0 + wid * 32, qm = qlo + r32 - 4 * hi;
    A256_DMA(0, 0);
    bf16x8 qr[8];
#pragma unroll
    for (int d0 = 0; d0 < 8; ++d0) qr[d0] = __builtin_nontemporal_load(reinterpret_cast<const bf16x8*>(B.Q + (size_t)(wid * 32 + r32) * PQ + d0 * 16 + hi * 8));
    float* wsf = (float*)(lds + L_WS) + wid * 64; float* li_l = wsf; float* al_l = wsf + 32;
    float m_reg = -1e30f, l_reg = 0.f; f32x16 o[8] = {};
    const int vb0 = (int)lbase + L_V + at128::v_rd_base(lane);
    asm volatile("s_waitcnt vmcnt(0)" ::: "memory"); __syncthreads();
#define A256_STEP(buf, t) do { \
        if ((t) + 1 < NT) A256_DMA(1 - (buf), ((t) + 1) * 64); \
        f32x16 p0, p1; float mn, alpha; bf16x8 pa0, pa1, pa2, pa3; \
        at128::qkt<buf, false>(p0, p1, lds + L_K, r32, hi, qr, true); \
        { const int kb_ = (t) * 64; if (kb_ + 63 > qlo) at128::mask_tile(p0, p1, qm - kb_, 0x7fffffffu); } \
        at128::partialSM(p0, p1, m_reg, mn, alpha); \
        if (__any(alpha < 1.f)) { if (hi == 0) al_l[r32] = alpha; asm volatile("s_waitcnt lgkmcnt(0)" ::: "memory"); \
            _Pragma("unroll") for (int r_ = 0; r_ < 16; ++r_) { const float a_ = al_l[at128::crow(r_, hi)]; _Pragma("unroll") for (int d_ = 0; d_ < 8; ++d_) o[d_][r_] *= a_; } } \
        at128::finishSM(p0, p1, alpha, l_reg, pa0, pa1, pa2, pa3); __builtin_amdgcn_sched_barrier(0); \
        pv256<buf>(o, vb0, pa0, pa1, pa2, pa3); \
        asm volatile("s_waitcnt vmcnt(0)" ::: "memory"); __syncthreads(); } while (0)
    for (int t = 0; t < NT; t += 2) { A256_STEP(0, t); A256_STEP(1, t + 1); }
    if (hi == 0) li_l[r32] = l_reg; asm volatile("s_waitcnt lgkmcnt(0)" ::: "memory");
    abf_t* Ow = B.O + (size_t)(wid * 32) * PO;
#pragma unroll
    for (int r = 0; r < 16; ++r) { const int orow = at128::crow(r, hi); const float rl = __builtin_amdgcn_rcpf(li_l[orow]);
#pragma unroll
        for (int d0 = 0; d0 < 8; ++d0) { const float v = o[d0][r] * rl; const float vn = __shfl_xor(v, 1);
            if ((r32 & 1) == 0) *(unsigned*)(Ow + (size_t)orow * PO + d0 * 32 + r32) = at128::cvtpk(v, vn); } }
    __syncthreads();
#undef A256_STEP
#undef A256_DMA
}
}

constexpr int NWAVES = 8;
constexpr int NTOK = 32768, DM = 2048, SEQ = 8192, NBATCH = 4;
constexpr int MAINW = 1536, MEMW = 512, NMEM = 256;
constexpr int A_IN = 3584;
constexpr int B_IN = 5120;
constexpr int FF = 5632, FFE = 7168, NEXP = 8;
constexpr int NSG = 12;
constexpr float ALPHA = 1.41421356237309515f;
constexpr float LN_EPS = 1e-5f;
constexpr float LAMBDA_INIT = 0.355509067592f;
constexpr int MAXT = 264;
constexpr int NPHASE = 17;
constexpr float W8_D_MUL = 128.f, H8_MUL = 4.f;
constexpr float W8_G_MUL = -64.f * 1.4426950408889634f, W8_U_MUL = -64.f * 4.f / 1.4426950408889634f;
constexpr int SC_ONE = 0x7f7f7f7f, SC_M4 = 0x7d7d7d7d, SC_M6 = 0x79797979, SC_M7 = 0x78787878;

constexpr size_t MiB = 1u << 20;
constexpr size_t WS_CTL = 0, CTL_ZERO_BYTES = 64 * 1024;
constexpr size_t WS_WSBF = 1 * MiB;
constexpr size_t WS_MEMB = 2 * MiB;
constexpr size_t WS_MEMKV = 6 * MiB;
constexpr size_t WS_ROUTE_E = 10 * MiB;
constexpr size_t WS_ROUTE_W = 10 * MiB + 256 * 1024;
constexpr size_t WS_TOKSLOT = 10 * MiB + 512 * 1024;
constexpr size_t WS_SLOTGATE = 11 * MiB;
constexpr size_t WS_SLOTTOK = 11 * MiB + 512 * 1024;
constexpr size_t WS_HIST = 12 * MiB;
constexpr size_t WS_MOETAB = 12 * MiB + 256 * 1024;
constexpr size_t WS_OSK = 1644 * MiB;
constexpr size_t WS_STATS = 13 * MiB;
#if MK_FP8_MOE
constexpr int MOE_CHUNK_T = MAXT;
constexpr size_t WS_W_MOE_GU = 16 * MiB;
constexpr size_t WS_W_MOE_D = 240 * MiB;
constexpr size_t WS_XS = 352 * MiB;
#else
constexpr size_t WS_W_MOE_GU = 16 * MiB;
constexpr size_t WS_W_MOE_D = 464 * MiB;
constexpr size_t WS_XS = 812 * MiB;
#endif
constexpr size_t WS_W_A_IN = 688 * MiB;
constexpr size_t WS_W_MIX = 702 * MiB;
constexpr size_t WS_W_FFN_GU = 718 * MiB;
constexpr size_t WS_W_FFN_D = 762 * MiB;
constexpr size_t WS_W_B_IN = 784 * MiB;
constexpr size_t WS_W_MEMKV = 804 * MiB;
constexpr size_t WS_XB = 812 * MiB;
constexpr size_t WS_H0 = 940 * MiB;
constexpr size_t WS_CONCAT = 1164 * MiB;
constexpr size_t WS_HID = 940 * MiB;
constexpr size_t WS_H1 = 940 * MiB;
constexpr size_t WS_AO = 1260 * MiB;
constexpr size_t WS_CONCAT1 = 1452 * MiB;
constexpr size_t WS_X3B = 1580 * MiB;
#if MK_FP8_MOE
constexpr size_t WS_OS = 812 * MiB;
constexpr size_t WS_HIDM = 1076 * MiB;
constexpr size_t WS_END = 1708 * MiB;
constexpr size_t WS_Y3B = 496 * MiB;
static_assert(WS_XS + (size_t)MAXT * 256 * DM <= WS_Y3B && WS_Y3B + (size_t)NTOK * DM * 2 <= WS_W_A_IN, "y3 map");
static_assert(WS_W_MOE_D + (size_t)NEXP * DM * FFE <= WS_XS && WS_XS + (size_t)MAXT * 256 * DM <= WS_W_A_IN, "fp8 MoE weight map");
static_assert(WS_OS + (size_t)MAXT * 256 * DM * 2 <= WS_HIDM && WS_HIDM + (size_t)MAXT * 256 * FFE <= WS_X3B, "fp8 MoE map");
#else
constexpr size_t WS_OS = 1076 * MiB;
constexpr size_t WS_HIDM = 1340 * MiB;
constexpr size_t WS_END = 1802 * MiB;
static_assert(WS_XS + (size_t)MAXT * 256 * DM * 2 <= WS_OS && WS_OS + (size_t)MAXT * 256 * DM * 2 <= WS_HIDM && WS_HIDM + (size_t)MOE_CHUNK_T * 256 * FFE * 2 <= WS_END, "MoE map");
static_assert(WS_XS + (size_t)MAXT * 256 * DM * 2 <= WS_CONCAT1, "XS must not overlap CONCAT1/X3B");
#endif
static_assert(WS_H0 + (size_t)NTOK * A_IN * 2 <= WS_CONCAT && WS_HID + (size_t)NTOK * FF * 2 <= 1292 * MiB && WS_H1 + (size_t)NTOK * B_IN * 2 <= WS_AO && WS_AO + (size_t)NTOK * 3072 * 2 <= WS_CONCAT1, "activation map");
static_assert(WS_CONCAT1 + (size_t)NTOK * DM * 2 <= WS_X3B && WS_X3B + (size_t)NTOK * DM * 2 <= 1708 * MiB, "activation map 2");
constexpr int CW_TMO = 0, CW_CODE = 1;
constexpr int CW_BAR = 4096;
constexpr int CW_BGQ = 12288;
constexpr int CW_TS = 8300;
constexpr int CW_CHK = 8192;

constexpr int RING_OFF = 0, RING_BYTES = 131072;
constexpr int LDSCTL_OFF = 147456 - 1024, MISC_OFF = LDSCTL_OFF + 320;
constexpr int LDS_BYTES = 147456;

#define GAS __attribute__((address_space(1)))
#define LAS __attribute__((address_space(3)))
typedef unsigned short bf16;
typedef unsigned v4u __attribute__((ext_vector_type(4)));
typedef float f32x4 __attribute__((ext_vector_type(4)));
typedef short bf16x8 __attribute__((ext_vector_type(8)));
typedef GAS unsigned gu32;
typedef GAS unsigned long long gu64;
#define RLX_AGENT __ATOMIC_RELAXED, __HIP_MEMORY_SCOPE_AGENT
#define LDS_WAIT() asm volatile("s_waitcnt lgkmcnt(0)" ::: "memory")
#define VM_WAIT() asm volatile("s_waitcnt vmcnt(0)" ::: "memory")
__device__ __forceinline__ unsigned long long rt() { return __builtin_amdgcn_s_memrealtime(); }
__device__ __forceinline__ unsigned f2bf(float f) { unsigned u = __builtin_bit_cast(unsigned, f); return (u + 0x7fffu + ((u >> 16) & 1u)) >> 16; }
__device__ __forceinline__ unsigned pk2(float lo, float hi) { return f2bf(lo) | (f2bf(hi) << 16); }

#define XB_TMO      128
#define XB_XCNT(j)  (256  + 64 * (j))
#define XB_XSUB(j)  (1280 + 64 * (j))
#define XB_XGEN(j)  (2304 + 64 * (j))
#define XB_TOP      3328
#define XB_TOPGEN   3392
#define XCD_BAR_WORDS 3456
#define XB_SPIN_CAP (1u << 18)

__device__ __forceinline__ unsigned xb_ld(unsigned* p)              { return __hip_atomic_load(p, __ATOMIC_RELAXED, __HIP_MEMORY_SCOPE_AGENT); }
__device__ __forceinline__ unsigned xb_add(unsigned* p, unsigned v) { return __hip_atomic_fetch_add(p, v, __ATOMIC_RELAXED, __HIP_MEMORY_SCOPE_AGENT); }
__device__ __forceinline__ unsigned xb_xcc_id() { return (unsigned)__builtin_amdgcn_s_getreg((3 << 11) | 20) & 0xFu; }
#define XB_SPIN(cond, bar) do { unsigned _sp = 0; while (cond) { __builtin_amdgcn_s_sleep(1); \
    if ((++_sp & 255u) == 0u) { if (xb_ld(&(bar)[XB_TMO])) break; if (_sp > XB_SPIN_CAP) { atomicAdd(&(bar)[XB_TMO], 1u); break; } } } } while (0)

struct XcdBarrier {
    unsigned* bar; unsigned x; int wave;
    volatile LAS unsigned* st;
};

__device__ __forceinline__ XcdBarrier xcd_barrier_post(unsigned* bar, volatile LAS unsigned* st) {
    XcdBarrier b; b.bar = bar; b.x = xb_xcc_id(); b.st = st;
    if (threadIdx.x == 0) (void)xb_add(&bar[XB_XCNT(b.x)], 1u);
    return b;
}
__device__ __forceinline__ void xcd_barrier_complete(unsigned* bar, unsigned x, unsigned& nloc, unsigned& nx) {
    const unsigned G = gridDim.x * gridDim.y * gridDim.z;
    unsigned sum, cnt, mine, sp = 0u;
    for (;;) {
        sum = 0u; cnt = 0u; mine = 0u;
#pragma unroll
        for (unsigned j = 0; j < 16; ++j) { const unsigned c = xb_ld(&bar[XB_XCNT(j)]); sum += c; cnt += (c > 0u) ? 1u : 0u; mine = (j == x) ? c : mine; }
        if (sum == G) break;
        __builtin_amdgcn_s_sleep(1);
        if ((++sp & 255u) == 0u) { if (xb_ld(&bar[XB_TMO])) break; if (sp > XB_SPIN_CAP) { atomicAdd(&bar[XB_TMO], 1u); break; } }
    }
    nloc = mine > 0u ? mine : 1u; nx = cnt > 0u ? cnt : 1u;
}

__device__ __forceinline__ void xcd_barrier(const XcdBarrier& b) {
    asm volatile("s_waitcnt vmcnt(0)" ::: "memory");
    __syncthreads();
    if (b.wave == 0 && mk_lane() == 0) {
        unsigned* bar = b.bar;
        __builtin_amdgcn_s_waitcnt(0);
        unsigned nloc = b.st[0], nx = b.st[1];
        if (nloc == 0u) { xcd_barrier_complete(bar, b.x, nloc, nx); b.st[0] = nloc; b.st[1] = nx; }
        const unsigned old = xb_add(&bar[XB_XSUB(b.x)], 1u);
        const unsigned gen = old / nloc;
        if (old + 1u == (gen + 1u) * nloc) {
            __builtin_amdgcn_fence(__ATOMIC_RELEASE, "agent");
            asm volatile("s_waitcnt vmcnt(0)" ::: "memory");
            const unsigned og = xb_add(&bar[XB_TOP], 1u);
            const unsigned tg = og / nx;
            if (og + 1u == (tg + 1u) * nx) xb_add(&bar[XB_TOPGEN], 1u);
            else XB_SPIN(xb_ld(&bar[XB_TOPGEN]) == tg, bar);
            __builtin_amdgcn_fence(__ATOMIC_ACQUIRE, "agent");
            xb_add(&bar[XB_XGEN(b.x)], 1u);
            asm volatile("s_waitcnt vmcnt(0)" ::: "memory");
        } else {
            XB_SPIN(xb_ld(&bar[XB_XGEN(b.x)]) == gen, bar);
            __builtin_amdgcn_fence(__ATOMIC_ACQUIRE, "agent");
            asm volatile("s_waitcnt vmcnt(0)" ::: "memory");
        }
    }
    __syncthreads();
}


struct Frame {
    LAS unsigned char* lds;
    volatile LAS unsigned* MISC;
    gu32* ctl;
    int wave;
    int G;
    unsigned char* ws;
    const float* in[25]; float* out;
};
enum { I_X = 0, I_MEM, I_LNG, I_LNB, I_WMIX, I_WMEMKV, I_AWIN, I_AVG, I_AVB, I_AWS, I_ABS, I_SWKV, I_BWIN, I_LQ1, I_LK1, I_LQ2, I_LK2, I_SUBLN, I_FG, I_FU, I_FD, I_ROUTER, I_MG, I_MU, I_MD };

template <int CTRL> __device__ __forceinline__ float dpp_f(float v) { return __builtin_bit_cast(float, __builtin_amdgcn_update_dpp(0, __builtin_bit_cast(int, v), CTRL, 0xf, 0xf, true)); }
__device__ __forceinline__ float wave_sum(float v) {
    v += dpp_f<0xB1>(v); v += dpp_f<0x4E>(v); v += dpp_f<0x141>(v); v += dpp_f<0x140>(v);
    { auto t = __builtin_amdgcn_permlane16_swap(__float_as_uint(v), __float_as_uint(v), false, false); v = __uint_as_float(t[0]) + __uint_as_float(t[1]); }
    { auto t = __builtin_amdgcn_permlane32_swap(__float_as_uint(v), __float_as_uint(v), false, false); v = __uint_as_float(t[0]) + __uint_as_float(t[1]); }
    return v;
}
__device__ __forceinline__ float bf2f(unsigned short b) { return __builtin_bit_cast(float, (unsigned)b << 16); }
__device__ __forceinline__ float bflo(unsigned w) { return __builtin_bit_cast(float, w << 16); }
__device__ __forceinline__ float bfhi(unsigned w) { return __builtin_bit_cast(float, w & 0xffff0000u); }

__device__ __forceinline__ void tr_item(const float* W, int K, int N, bf16* WT, int k0, int n0, int drow0, LAS float* scr, int lane) {
    float t_[32];
#pragma unroll
    for (int i = 0; i < 32; ++i) { const int kk = 2 * i + (lane >> 5); t_[i] = __builtin_nontemporal_load(W + (size_t)(k0 + kk) * N + n0 + (lane & 31)); }
#pragma unroll
    for (int i = 0; i < 32; ++i) { const int kk = 2 * i + (lane >> 5); scr[kk * 33 + (lane & 31)] = t_[i]; }
    LDS_WAIT(); asm volatile("" ::: "memory");
    const int c = lane & 7;
#pragma unroll
    for (int j = 0; j < 4; ++j) { const int n = (lane >> 3) + 8 * j; const LAS float* s = scr + (8 * c) * 33 + n;
        v4u o; o.x = pk2(s[0 * 33], s[1 * 33]); o.y = pk2(s[2 * 33], s[3 * 33]); o.z = pk2(s[4 * 33], s[5 * 33]); o.w = pk2(s[6 * 33], s[7 * 33]);
        *(GAS v4u*)(WT + (size_t)(drow0 + n) * K + k0 + 8 * c) = o; }
    LDS_WAIT(); asm volatile("" ::: "memory");
}
__device__ __forceinline__ void tr_item8(const float* W, int K, int N, unsigned char* WT, int k0, int n0, int drow0, float mul, LAS float* scr, int lane) {
    float t_[64];
#pragma unroll
    for (int i = 0; i < 64; ++i) { const int kk = 2 * i + (lane >> 5); t_[i] = __builtin_nontemporal_load(W + (size_t)(k0 + kk) * N + n0 + (lane & 31)); }
#pragma unroll
    for (int i = 0; i < 64; ++i) { const int kk = 2 * i + (lane >> 5); scr[kk * 33 + (lane & 31)] = t_[i]; }
    LDS_WAIT(); asm volatile("" ::: "memory");
    const int n = lane >> 1, hf = lane & 1; const LAS float* s = scr + (64 * hf) * 33 + n;
    GAS v4u* dst = (GAS v4u*)(WT + (size_t)(drow0 + n) * K + k0 + 64 * hf);
#pragma unroll
    for (int g = 0; g < 4; ++g) { int w[4];
#pragma unroll
        for (int q = 0; q < 4; ++q) { const int kq = 16 * g + 4 * q; int t = 0; t = __builtin_amdgcn_cvt_pk_fp8_f32(s[kq * 33] * mul, s[(kq + 1) * 33] * mul, t, false); t = __builtin_amdgcn_cvt_pk_fp8_f32(s[(kq + 2) * 33] * mul, s[(kq + 3) * 33] * mul, t, true); w[q] = t; }
        dst[g] = (v4u){(unsigned)w[0], (unsigned)w[1], (unsigned)w[2], (unsigned)w[3]}; }
    LDS_WAIT(); asm volatile("" ::: "memory");
}
__device__ __forceinline__ void tr_matrix_item8(const float* W, int K, int N, unsigned char* WT, int row_off, int mode, float mul, int item, LAS float* scr, int lane) {
    const int nblk = N / 32, kb = item / nblk, nb = item % nblk, k0 = 128 * kb, n0 = 32 * nb;
    const int drow0 = row_off + (mode == 0 ? n0 : ((n0 >> 7) * 256 + (n0 & 127) + (mode == 2 ? 128 : 0)));
    tr_item8(W, K, N, WT, k0, n0, drow0, mul, scr, lane);
}
__device__ __forceinline__ void tr_matrix_item(const float* W, int K, int N, bf16* WT, int row_off, int mode, int item, LAS float* scr, int lane) {
    const int nblk = N / 32, kb = item / nblk, nb = item % nblk, k0 = 64 * kb, n0 = 32 * nb;
    const int drow0 = row_off + (mode == 0 ? n0 : ((n0 >> 7) * 256 + (n0 & 127) + (mode == 2 ? 128 : 0)));
    tr_item(W, K, N, WT, k0, n0, drow0, scr, lane);
}
__device__ __forceinline__ void p0_prologue(Frame& F) {
    const int lane_ = mk_lane(), tid_ = F.wave * 64 + lane_;
    LAS float* scr = (LAS float*)(F.lds + RING_OFF + F.wave * 16896);
    const int gw = blockIdx.x * NWAVES + F.wave, NGW = F.G * NWAVES;
    bf16* ws16 = (bf16*)F.ws;
    constexpr int KD8 = MK_FP8_MOE ? 128 : 64, KF8 = MK_FP8_FFN ? 128 : 64;
    constexpr int I_E = (DM / KD8) * (FFE / 32);
    constexpr int I_MOE = 3 * NEXP * I_E;
    constexpr int I_AIN = (DM / 64) * (A_IN / 32), I_MIXW = (DM / 64) * (DM / 32), I_FGU = (DM / KF8) * (FF / 32), I_FDN = (FF / KF8) * (DM / 32);
    constexpr int I_KV = (DM / 64) * (3072 / 32), I_BIN = (DM / 64) * (DM / 32), I_MKV = (DM / 64) * (1024 / 32);
    constexpr int NITEMS = I_MOE + I_AIN + 2 * I_MIXW + 2 * I_FGU + I_FDN + I_KV + I_BIN + 2 * I_MKV;
#if MK_BG
    constexpr int NFG = I_AIN + I_MIXW + 2 * I_MKV;
    for (int it = gw; it < NFG; it += NGW) { int r = it;
        if (r < I_AIN) { tr_matrix_item(F.in[I_AWIN], DM, A_IN, (bf16*)(F.ws + WS_W_A_IN), 0, 0, r, scr, lane_); continue; } r -= I_AIN;
        if (r < I_MIXW) { tr_matrix_item(F.in[I_WMIX], DM, DM, (bf16*)(F.ws + WS_W_MIX), 0, 0, r, scr, lane_); continue; } r -= I_MIXW;
        { const int l = r / I_MKV; tr_matrix_item(F.in[I_WMEMKV] + (size_t)l * DM * 1024, DM, 1024, (bf16*)(F.ws + WS_W_MEMKV), l * 1024, 0, r % I_MKV, scr, lane_); } }
    if (false)
#endif
    for (int it = gw; it < NITEMS; it += NGW) {
        int r = it;
        if (r < I_MOE) { const int which = r / (NEXP * I_E), rr = r % (NEXP * I_E), e = rr / I_E, item = rr % I_E;
#if MK_FP8_MOE
            if (which == 0) tr_matrix_item8(F.in[I_MG] + (size_t)e * DM * FFE, DM, FFE, F.ws + WS_W_MOE_GU, e * 2 * FFE, 1, W8_G_MUL, item, scr, lane_);
            else if (which == 1) tr_matrix_item8(F.in[I_MU] + (size_t)e * DM * FFE, DM, FFE, F.ws + WS_W_MOE_GU, e * 2 * FFE, 2, W8_U_MUL, item, scr, lane_);
            else tr_matrix_item8(F.in[I_MD] + (size_t)e * FFE * DM, FFE, DM, F.ws + WS_W_MOE_D, e * DM, 0, W8_D_MUL, item, scr, lane_);
#else
            if (which == 0) tr_matrix_item(F.in[I_MG] + (size_t)e * DM * FFE, DM, FFE, (bf16*)(F.ws + WS_W_MOE_GU), e * 2 * FFE, 1, item, scr, lane_);
            else if (which == 1) tr_matrix_item(F.in[I_MU] + (size_t)e * DM * FFE, DM, FFE, (bf16*)(F.ws + WS_W_MOE_GU), e * 2 * FFE, 2, item, scr, lane_);
            else tr_matrix_item(F.in[I_MD] + (size_t)e * FFE * DM, FFE, DM, (bf16*)(F.ws + WS_W_MOE_D), e * DM, 0, item, scr, lane_);
#endif
            continue; } r -= I_MOE;
        if (r < I_AIN) { tr_matrix_item(F.in[I_AWIN], DM, A_IN, (bf16*)(F.ws + WS_W_A_IN), 0, 0, r, scr, lane_); continue; } r -= I_AIN;
        if (r < 2 * I_MIXW) { const int l = r / I_MIXW; tr_matrix_item(F.in[I_WMIX] + (size_t)l * DM * DM, DM, DM, (bf16*)(F.ws + WS_W_MIX), l * DM, 0, r % I_MIXW, scr, lane_); continue; } r -= 2 * I_MIXW;
#if MK_FP8_FFN
        if (r < I_FGU) { tr_matrix_item8(F.in[I_FG], DM, FF, F.ws + WS_W_FFN_GU, 0, 1, W8_G_MUL, r, scr, lane_); continue; } r -= I_FGU;
        if (r < I_FGU) { tr_matrix_item8(F.in[I_FU], DM, FF, F.ws + WS_W_FFN_GU, 0, 2, W8_U_MUL, r, scr, lane_); continue; } r -= I_FGU;
        if (r < I_FDN) { tr_matrix_item8(F.in[I_FD], FF, DM, F.ws + WS_W_FFN_D, 0, 0, W8_D_MUL, r, scr, lane_); continue; } r -= I_FDN;
#else
        if (r < I_FGU) { tr_matrix_item(F.in[I_FG], DM, FF, (bf16*)(F.ws + WS_W_FFN_GU), 0, 1, r, scr, lane_); continue; } r -= I_FGU;
        if (r < I_FGU) { tr_matrix_item(F.in[I_FU], DM, FF, (bf16*)(F.ws + WS_W_FFN_GU), 0, 2, r, scr, lane_); continue; } r -= I_FGU;
        if (r < I_FDN) { tr_matrix_item(F.in[I_FD], FF, DM, (bf16*)(F.ws + WS_W_FFN_D), 0, 0, r, scr, lane_); continue; } r -= I_FDN;
#endif
        if (r < I_KV) { tr_matrix_item(F.in[I_SWKV], DM, 3072, (bf16*)(F.ws + WS_W_B_IN), 0, 0, r, scr, lane_); continue; } r -= I_KV;
        if (r < I_BIN) { tr_matrix_item(F.in[I_BWIN], DM, DM, (bf16*)(F.ws + WS_W_B_IN), 3072, 0, r, scr, lane_); continue; } r -= I_BIN;
        { const int l = r / I_MKV; tr_matrix_item(F.in[I_WMEMKV] + (size_t)l * DM * 1024, DM, 1024, (bf16*)(F.ws + WS_W_MEMKV), l * 1024, 0, r % I_MKV, scr, lane_); }
    }
    (void)ws16;
    { const size_t gt = (size_t)blockIdx.x * (NWAVES * 64) + tid_, NT = (size_t)F.G * NWAVES * 64;
      const GAS f32x4* x4 = (const GAS f32x4*)F.in[I_X]; GAS v4u* xb = (GAS v4u*)(F.ws + WS_XB);
      for (size_t i = gt; i < (size_t)NTOK * DM / 8; i += NT) { const f32x4 a = __builtin_nontemporal_load(x4 + 2 * i), b = __builtin_nontemporal_load(x4 + 2 * i + 1); v4u o; o.x = pk2(a.x, a.y); o.y = pk2(a.z, a.w); o.z = pk2(b.x, b.y); o.w = pk2(b.z, b.w); xb[i] = o; }
      const GAS f32x4* m4 = (const GAS f32x4*)F.in[I_MEM]; GAS v4u* mb = (GAS v4u*)(F.ws + WS_MEMB);
      for (size_t i = gt; i < (size_t)NBATCH * NMEM * DM / 8; i += NT) { const f32x4 a = m4[2 * i], b = m4[2 * i + 1]; v4u o; o.x = pk2(a.x, a.y); o.y = pk2(a.z, a.w); o.z = pk2(b.x, b.y); o.w = pk2(b.z, b.w); mb[i] = o; }
      const float* wsrc = F.in[I_AWS]; bf16* wd = (bf16*)(F.ws + WS_WSBF);
      for (size_t i = gt; i < (size_t)NSG * 128 * 128; i += NT) { const int s = (int)(i & 127), t = (int)((i >> 7) & 127); wd[i] = (bf16)(s <= t ? f2bf(wsrc[i]) : 0u); }
    }
}

#if MK_BG
static_assert(MK_FP8_MOE, "the background item list is written for the fp8 MoE build");
constexpr int BG_F = (DM / (MK_FP8_FFN ? 128 : 64)) * (FF / 32);
constexpr int BG_EA = 3 * BG_F;
constexpr int BG_KV = (DM / 64) * (3072 / 32), BG_BIN = (DM / 64) * (DM / 32), BG_MIX = (DM / 64) * (DM / 32);
constexpr int BG_EB = BG_EA + BG_KV + BG_BIN;
constexpr int BG_EC = BG_EB + BG_MIX;
constexpr int BG_IE = (DM / 128) * (FFE / 32);
constexpr int BG_ED = BG_EC + 3 * NEXP * BG_IE;
constexpr int BG_EA1 = 2 * BG_F;
constexpr int BG_ED1 = BG_EC + 2 * NEXP * BG_IE;
static_assert(BG_EA % 8 == 0 && BG_EB % 8 == 0 && BG_EC % 8 == 0 && BG_ED % 8 == 0 && BG_EA1 % 8 == 0 && BG_ED1 % 8 == 0, "segments are whole 8-item batches");
__device__ __forceinline__ void bg_item(Frame& F, int it, LAS float* scr, int lane) {
    int r = it;
    if (r < BG_EA) { const int w = r / BG_F, item = r % BG_F;
#if MK_FP8_FFN
        if (w == 0) tr_matrix_item8(F.in[I_FG], DM, FF, F.ws + WS_W_FFN_GU, 0, 1, W8_G_MUL, item, scr, lane);
        else if (w == 1) tr_matrix_item8(F.in[I_FU], DM, FF, F.ws + WS_W_FFN_GU, 0, 2, W8_U_MUL, item, scr, lane);
        else tr_matrix_item8(F.in[I_FD], FF, DM, F.ws + WS_W_FFN_D, 0, 0, W8_D_MUL, item, scr, lane);
#else
        if (w == 0) tr_matrix_item(F.in[I_FG], DM, FF, (bf16*)(F.ws + WS_W_FFN_GU), 0, 1, item, scr, lane);
        else if (w == 1) tr_matrix_item(F.in[I_FU], DM, FF, (bf16*)(F.ws + WS_W_FFN_GU), 0, 2, item, scr, lane);
        else tr_matrix_item(F.in[I_FD], FF, DM, (bf16*)(F.ws + WS_W_FFN_D), 0, 0, item, scr, lane);
#endif
        return; } r -= BG_EA;
    if (r < BG_KV) { tr_matrix_item(F.in[I_SWKV], DM, 3072, (bf16*)(F.ws + WS_W_B_IN), 0, 0, r, scr, lane); return; } r -= BG_KV;
    if (r < BG_BIN) { tr_matrix_item(F.in[I_BWIN], DM, DM, (bf16*)(F.ws + WS_W_B_IN), 3072, 0, r, scr, lane); return; } r -= BG_BIN;
    if (r < BG_MIX) { tr_matrix_item(F.in[I_WMIX] + (size_t)DM * DM, DM, DM, (bf16*)(F.ws + WS_W_MIX), DM, 0, r, scr, lane); return; } r -= BG_MIX;
    { const int which = r / (NEXP * BG_IE), rr = r % (NEXP * BG_IE), e = rr / BG_IE, item = rr % BG_IE;
      if (which == 0) tr_matrix_item8(F.in[I_MG] + (size_t)e * DM * FFE, DM, FFE, F.ws + WS_W_MOE_GU, e * 2 * FFE, 1, W8_G_MUL, item, scr, lane);
      else if (which == 1) tr_matrix_item8(F.in[I_MU] + (size_t)e * DM * FFE, DM, FFE, F.ws + WS_W_MOE_GU, e * 2 * FFE, 2, W8_U_MUL, item, scr, lane);
      else tr_matrix_item8(F.in[I_MD] + (size_t)e * FFE * DM, FFE, DM, F.ws + WS_W_MOE_D, e * DM, 0, W8_D_MUL, item, scr, lane); }
}
__device__ __forceinline__ int bg_round(Frame& F) {
    volatile LAS int* w = (volatile LAS int*)(F.lds + LDSCTL_OFF + 128);
    const int lane = mk_lane();
    if (F.wave == 0 && lane == 0) w[0] = (int)__hip_atomic_fetch_add(F.ctl + CW_BGQ, 8u, RLX_AGENT);
    __syncthreads();
    const int base = w[0];
    if (base >= 0 && base < BG_ED) bg_item(F, base + F.wave, (LAS float*)(F.lds + RING_OFF + F.wave * 16896), lane);
    __syncthreads();
    return (base >= 0) ? base : BG_ED;
}
__device__ __forceinline__ void bg_drain(Frame& F, int X) {
    volatile LAS int* w = (volatile LAS int*)(F.lds + LDSCTL_OFF + 128);
    for (;;) {
        if (F.wave == 0 && mk_lane() == 0) w[3] = (int)__hip_atomic_load(F.ctl + CW_BGQ, RLX_AGENT);
        __syncthreads();
        const int head = w[3];
        __syncthreads();
        if (head < 0 || head >= X) break;
        (void)bg_round(F);
    }
}
#endif

#if MK_BG
__device__ __forceinline__ void xcd_barrier_bg(const XcdBarrier& b, Frame& F, bool& bg_done) {
    asm volatile("s_waitcnt vmcnt(0)" ::: "memory");
    __syncthreads();
    volatile LAS int* w = (volatile LAS int*)(F.lds + LDSCTL_OFF + 128);
    const bool t0 = (b.wave == 0 && mk_lane() == 0);
    if (t0) {
        unsigned* bar = b.bar;
        __builtin_amdgcn_s_waitcnt(0);
        unsigned nloc = b.st[0], nx = b.st[1];
        if (nloc == 0u) { xcd_barrier_complete(bar, b.x, nloc, nx); b.st[0] = nloc; b.st[1] = nx; }
        const unsigned old = xb_add(&bar[XB_XSUB(b.x)], 1u);
        const unsigned gen = old / nloc;
        if (old + 1u == (gen + 1u) * nloc) {
            __builtin_amdgcn_fence(__ATOMIC_RELEASE, "agent");
            asm volatile("s_waitcnt vmcnt(0)" ::: "memory");
            const unsigned og = xb_add(&bar[XB_TOP], 1u);
            const unsigned tg = og / nx;
            if (og + 1u == (tg + 1u) * nx) xb_add(&bar[XB_TOPGEN], 1u);
            else XB_SPIN(xb_ld(&bar[XB_TOPGEN]) == tg, bar);
            __builtin_amdgcn_fence(__ATOMIC_ACQUIRE, "agent");
            xb_add(&bar[XB_XGEN(b.x)], 1u);
            asm volatile("s_waitcnt vmcnt(0)" ::: "memory");
            w[1] = 1;
        } else { w[1] = 0; w[2] = (int)gen; }
    }
    __syncthreads();
    if (w[1] == 0) {
        for (unsigned it = 0;; ++it) {
            if (t0) { unsigned* bar = b.bar; int rel = xb_ld(&bar[XB_XGEN(b.x)]) != (unsigned)w[2];
                if (!rel && (it & 63u) == 63u) { if (xb_ld(&bar[XB_TMO])) rel = 1; else if (it > (1u << 17)) { atomicAdd(&bar[XB_TMO], 1u); rel = 1; } }
                w[4 + (it & 1u)] = rel; }
            __syncthreads();
            if (w[4 + (it & 1u)]) break;
            if (!bg_done) { if (bg_round(F) >= BG_ED) bg_done = true; } else __builtin_amdgcn_s_sleep(2);
        }
        if (t0) { __builtin_amdgcn_fence(__ATOMIC_ACQUIRE, "agent"); asm volatile("s_waitcnt vmcnt(0)" ::: "memory"); }
    }
    __syncthreads();
}
#endif

__device__ __forceinline__ void ln_load(const float* row, int lane, f32x4 (&v)[8]) { const GAS f32x4* xr = (const GAS f32x4*)row + lane;
#pragma unroll
    for (int j = 0; j < 8; ++j) v[j] = __builtin_nontemporal_load(xr + 64 * j); }
__device__ __forceinline__ void ln_load16(const bf16* row, int lane, f32x4 (&v)[8]) { const GAS unsigned long long* xr = (const GAS unsigned long long*)row + lane;
#pragma unroll
    for (int j = 0; j < 8; ++j) { const unsigned long long t = __builtin_nontemporal_load(xr + 64 * j); const unsigned lo = (unsigned)t, hi = (unsigned)(t >> 32);
        v[j].x = __uint_as_float(lo << 16); v[j].y = __uint_as_float(lo & 0xffff0000u); v[j].z = __uint_as_float(hi << 16); v[j].w = __uint_as_float(hi & 0xffff0000u); } }
__device__ __forceinline__ void ln_norm(f32x4 (&v)[8], const float* g, const float* b, int lane, float* mean_o = nullptr, float* rstd_o = nullptr) {
    float s = 0.f;
#pragma unroll
    for (int j = 0; j < 8; ++j) s += (v[j].x + v[j].y) + (v[j].z + v[j].w);
    const float mean = wave_sum(s) * (1.f / DM); float s2 = 0.f;
#pragma unroll
    for (int j = 0; j < 8; ++j) { v[j] = v[j] - mean; s2 += (v[j].x * v[j].x + v[j].y * v[j].y) + (v[j].z * v[j].z + v[j].w * v[j].w); }
    const float rstd = 1.f / sqrtf(wave_sum(s2) * (1.f / DM) + LN_EPS);
    if (mean_o) { *mean_o = mean; *rstd_o = rstd; }
    const GAS f32x4* g4 = (const GAS f32x4*)g + lane; const GAS f32x4* b4 = (const GAS f32x4*)b + lane;
#pragma unroll
    for (int j = 0; j < 8; ++j) v[j] = v[j] * rstd * g4[64 * j] + b4[64 * j];
}
__device__ __forceinline__ void ln_store16(const f32x4 (&v)[8], bf16* brow, int lane) {
    GAS unsigned long long* o8 = (GAS unsigned long long*)brow + lane;
#pragma unroll
    for (int j = 0; j < 8; ++j) o8[64 * j] = (unsigned long long)pk2(v[j].x, v[j].y) | ((unsigned long long)pk2(v[j].z, v[j].w) << 32);
}
__device__ __forceinline__ void ln_store(const f32x4 (&v)[8], float* drow, bf16* brow, int lane) {
    GAS f32x4* o4 = (GAS f32x4*)drow + lane;
#pragma unroll
    for (int j = 0; j < 8; ++j) __builtin_nontemporal_store(v[j], o4 + 64 * j);
    if (brow) { GAS unsigned long long* o8 = (GAS unsigned long long*)brow + lane;
#pragma unroll
        for (int j = 0; j < 8; ++j) o8[64 * j] = (unsigned long long)pk2(v[j].x, v[j].y) | ((unsigned long long)pk2(v[j].z, v[j].w) << 32); }
}
__device__ __forceinline__ void ln_store8(const f32x4 (&v)[8], unsigned char* brow, int lane) {
    GAS unsigned* o4 = (GAS unsigned*)brow + lane;
#pragma unroll
    for (int j = 0; j < 8; ++j) { int t = 0; t = __builtin_amdgcn_cvt_pk_fp8_f32(v[j].x, v[j].y, t, false); t = __builtin_amdgcn_cvt_pk_fp8_f32(v[j].z, v[j].w, t, true); o4[64 * j] = (unsigned)t; }
}
template <bool F8 = false> __device__ __forceinline__ void ln_phase(Frame& F, const bf16* src, void* dstb, const float* g, const float* b) {
    const int lane_ = mk_lane();
    const int gw = blockIdx.x * NWAVES + F.wave, NGW = F.G * NWAVES; float* stats = (float*)(F.ws + WS_STATS);
#define LN_ROW(v, m) do { float mean, rstd; ln_norm(v, g, b, lane_, &mean, &rstd); \
        if (F8) ln_store8(v, (unsigned char*)dstb + (size_t)(m) * DM, lane_); else ln_store16(v, (bf16*)dstb + (size_t)(m) * DM, lane_); \
        if (lane_ == 0) { stats[2 * (m)] = mean; stats[2 * (m) + 1] = rstd; } } while (0)
    for (int base = gw * 16; base < NTOK; base += NGW * 16) {
        f32x4 va[8], vb[8]; ln_load16(src + (size_t)base * DM, lane_, va);
        for (int r = 0; r < 16; r += 2) {
            ln_load16(src + (size_t)(base + r + 1) * DM, lane_, vb); LN_ROW(va, base + r);
            if (r + 2 < 16) ln_load16(src + (size_t)(base + r + 2) * DM, lane_, va);
            LN_ROW(vb, base + r + 1); }
    }
#undef LN_ROW
}

typedef at128::bf16 abf;
typedef at128::BlockRef<abf, abf> ABlk;
template <int PQ> __device__ __forceinline__ ABlk memattn_ref(int L, const abf* Qb, const abf* KVb, abf* Ob) {
    const int tile = L >> 2, h = L & 3, b = tile >> 5; ABlk r;
    r.Q = Qb + (size_t)tile * 256 * PQ + h * 128; r.K = KVb + (size_t)b * NMEM * 2048 + h * 128; r.V = r.K + MEMW; r.O = Ob + (size_t)tile * 256 * DM + h * 128; r.P0 = 1 << 20; return r;
}
template <int PQ> __device__ __forceinline__ void memattn_phase(int G, int wv, char* lds, const abf* Qb, const abf* KVb, abf* Ob) {
    constexpr int total = (NTOK / 256) * 4, W = 1 << 30;
    int L = blockIdx.x; if (L >= total) return;
    ABlk cur = memattn_ref<PQ>(L, Qb, KVb, Ob); at128::Seam<abf> S;
    at128::causal_swa_prime<abf, abf, PQ, 2048, DM>(cur, W, lds, S, wv);
    for (;;) { const bool last = L + G >= total; const ABlk nxt = last ? cur : memattn_ref<PQ>(L + G, Qb, KVb, Ob);
        at128::causal_swa_block<abf, abf, PQ, 2048, DM>(cur, nxt, NMEM, W, lds, S, wv); if (last) break; cur = nxt; L += G; }
}
__device__ __forceinline__ at256::Blk diff_blk(int vh, int qb, const abf* H1, abf* AO) {
    const int b = vh / 12, rem = vh % 12, h = rem >> 1, m = rem & 1; at256::Blk r; const abf* base = H1 + (size_t)b * SEQ * B_IN;
    r.Q = base + (size_t)qb * 256 * B_IN + 3072 + (m * 6 + h) * 128; r.K = base + (m * 6 + h) * 128; r.V = base + 1536 + h * 256;
    r.O = AO + ((size_t)b * SEQ + (size_t)qb * 256) * 3072 + m * 1536 + h * 256; r.P0 = qb * 256; return r;
}
__device__ __forceinline__ void diffattn_phase(int G, int wv, LAS unsigned char* ldsL, const abf* H1, abf* AO) {
    constexpr int NX = 16, total = 48 * NX;
    if (G == 256) {
        const int c = blockIdx.x, x8 = c & 7, j = c >> 3;
        for (int i = 0; i < 3; ++i) { const int vh = 2 * (i * 8 + x8) + (j >> 4), x = j & 15;
            at256::attn_block<B_IN, B_IN, 3072>(diff_blk(vh, x, H1, AO), ldsL, wv);
            at256::attn_block<B_IN, B_IN, 3072>(diff_blk(vh, 31 - x, H1, AO), ldsL, wv); }
    } else {
        for (int L = blockIdx.x; L < total; L += G) { const int vh = L / NX, x = L % NX;
            at256::attn_block<B_IN, B_IN, 3072>(diff_blk(vh, x, H1, AO), ldsL, wv);
            at256::attn_block<B_IN, B_IN, 3072>(diff_blk(vh, 31 - x, H1, AO), ldsL, wv); }
    }
}

__device__ __forceinline__ void sg_phase(Frame& F) {
    const bf16* H0 = (const bf16*)(F.ws + WS_H0); bf16* CC = (bf16*)(F.ws + WS_CONCAT); const bf16* WSB = (const bf16*)(F.ws + WS_WSBF);
    const float* vg = F.in[I_AVG]; const float* vb = F.in[I_AVB]; const float* bsp = F.in[I_ABS];
    const int lane = mk_lane(), wid = F.wave, tid = wid * 64 + lane, r32 = lane & 31, hi = lane >> 5;
    LAS float* stats = (LAS float*)(F.lds + 65536);
    LAS unsigned char* sw = F.lds + 66560 + wid * 8192;
    for (int c = blockIdx.x; c < NTOK / 128; c += F.G) {
        const size_t R0 = (size_t)c * 128;
        for (int r4 = 0; r4 < 16; r4 += 4) {
            v4u w[4][3];
#pragma unroll
            for (int q = 0; q < 4; ++q)
#pragma unroll
                for (int j = 0; j < 3; ++j) w[q][j] = *(const GAS v4u*)(H0 + (R0 + wid * 16 + r4 + q) * A_IN + MAINW + j * 512 + lane * 8);
#pragma unroll
            for (int q = 0; q < 4; ++q) { float x[24];
#pragma unroll
                for (int j = 0; j < 3; ++j) { x[8 * j + 0] = bflo(w[q][j].x); x[8 * j + 1] = bfhi(w[q][j].x); x[8 * j + 2] = bflo(w[q][j].y); x[8 * j + 3] = bfhi(w[q][j].y); x[8 * j + 4] = bflo(w[q][j].z); x[8 * j + 5] = bfhi(w[q][j].z); x[8 * j + 6] = bflo(w[q][j].w); x[8 * j + 7] = bfhi(w[q][j].w); }
                float s = 0.f;
#pragma unroll
                for (int j = 0; j < 24; ++j) s += x[j];
                const float mean = wave_sum(s) * (1.f / MAINW); float qq = 0.f;
#pragma unroll
                for (int j = 0; j < 24; ++j) { const float dd = x[j] - mean; qq += dd * dd; }
                const float rstd = 1.f / sqrtf(wave_sum(qq) * (1.f / MAINW) + LN_EPS);
                if (lane == 0) { const int t = wid * 16 + r4 + q; stats[2 * t] = mean; stats[2 * t + 1] = rstd; } asm volatile("" ::: "memory"); }
        }
        __syncthreads();
        const char* hbase = (const char*)(H0 + R0 * A_IN);
        v4u wst[8];
#define SG_LOADV(gp_) do { unsigned soff = (unsigned)(((tid >> 4) * A_IN + MAINW + (tid & 15) * 8) * 2); asm volatile("" : "+v"(soff)); \
        _Pragma("unroll") for (int i = 0; i < 8; ++i) wst[i] = *(const GAS v4u*)(hbase + (soff + (unsigned)(((((i >> 1) & 1) * 64 + (i & 1) * 32) * A_IN + (2 * (gp_) + (i >> 2)) * 128) * 2))); } while (0)
        SG_LOADV(0);
        for (int gp = 0; gp < NSG / 2; ++gp) {
#pragma unroll
            for (int i = 0; i < 8; ++i) {
                const int p = tid + 512 * i, gsel = p >> 11, kt = (p >> 10) & 1, key = (p >> 4) & 63, c8 = (p & 15) * 8, tok = kt * 64 + key, col = (2 * gp + gsel) * 128 + c8;
                const v4u w = wst[i];
                const float mean = stats[2 * tok], rstd = stats[2 * tok + 1];
                const f32x4 g0 = *(const GAS f32x4*)(vg + col), g1 = *(const GAS f32x4*)(vg + col + 4), b0 = *(const GAS f32x4*)(vb + col), b1 = *(const GAS f32x4*)(vb + col + 4);
                v4u o;
                o.x = pg8::cvt_pk_bf16((bflo(w.x) - mean) * rstd * g0.x + b0.x, (bfhi(w.x) - mean) * rstd * g0.y + b0.y);
                o.y = pg8::cvt_pk_bf16((bflo(w.y) - mean) * rstd * g0.z + b0.z, (bfhi(w.y) - mean) * rstd * g0.w + b0.w);
                o.z = pg8::cvt_pk_bf16((bflo(w.z) - mean) * rstd * g1.x + b1.x, (bfhi(w.z) - mean) * rstd * g1.y + b1.y);
                o.w = pg8::cvt_pk_bf16((bflo(w.w) - mean) * rstd * g1.z + b1.z, (bfhi(w.w) - mean) * rstd * g1.w + b1.w);
                *(LAS v4u*)(F.lds + (gsel * 2 + kt) * 16384 + at128::v_st(key, c8)) = o;
            }
            __syncthreads();
            if (gp + 1 < NSG / 2) SG_LOADV(gp + 1);
            { const int gsel = wid >> 2, tb = wid & 3, g = 2 * gp + gsel;
              const int er = lane >> 4, ec = (lane & 15) * 8; v4u uu[8];
              unsigned uoff = (unsigned)(((tb * 32 + er) * A_IN + g * 128 + ec) * 2); asm volatile("" : "+v"(uoff));
#pragma unroll
              for (int j = 0; j < 8; ++j) uu[j] = __builtin_nontemporal_load((const GAS v4u*)(hbase + (uoff + (unsigned)(4 * j * A_IN * 2))));
              at128::f32x16 o[4] = {};
              const int vb0 = (int)(unsigned long)(F.lds) + gsel * 32768 + at128::v_rd_base(lane);
              const bf16* wrow = WSB + ((size_t)g * 128 + tb * 32 + r32) * 128 + hi * 8;
              { const at128::bf16x8 pa0 = *(const GAS at128::bf16x8*)(wrow), pa1 = *(const GAS at128::bf16x8*)(wrow + 16), pa2 = *(const GAS at128::bf16x8*)(wrow + 32), pa3 = *(const GAS at128::bf16x8*)(wrow + 48);
                at128::pv_tile<0, false>(o, vb0, pa0, pa1, pa2, pa3, true); }
              if (tb >= 2) { const at128::bf16x8 pa0 = *(const GAS at128::bf16x8*)(wrow + 64), pa1 = *(const GAS at128::bf16x8*)(wrow + 80), pa2 = *(const GAS at128::bf16x8*)(wrow + 96), pa3 = *(const GAS at128::bf16x8*)(wrow + 112);
                at128::pv_tile<1, false>(o, vb0, pa0, pa1, pa2, pa3, true); }
#pragma unroll
              for (int r = 0; r < 16; ++r) { const int t = at128::crow(r, hi); const float bsv = bsp[g * 128 + tb * 32 + t];
#pragma unroll
                  for (int d0 = 0; d0 < 4; ++d0) { const float val = o[d0][r] + bsv; const float vn = __shfl_xor(val, 1);
                      if ((r32 & 1) == 0) *(LAS unsigned*)(sw + t * 256 + (d0 * 32 + r32) * 2) = pg8::cvt_pk_bf16(val, vn); } }
              char* cbase = (char*)(CC + R0 * DM); unsigned coff = (unsigned)(((tb * 32 + er) * DM + g * 128 + ec) * 2); asm volatile("" : "+v"(coff));
              LDS_WAIT(); asm volatile("" ::: "memory");
#pragma unroll
              for (int j = 0; j < 8; ++j) { const v4u sv = *(const LAS v4u*)(sw + (er + 4 * j) * 256 + ec * 2); v4u ov;
                  ov.x = pg8::cvt_pk_bf16(bflo(sv.x) * bflo(uu[j].x), bfhi(sv.x) * bfhi(uu[j].x)); ov.y = pg8::cvt_pk_bf16(bflo(sv.y) * bflo(uu[j].y), bfhi(sv.y) * bfhi(uu[j].y));
                  ov.z = pg8::cvt_pk_bf16(bflo(sv.z) * bflo(uu[j].z), bfhi(sv.z) * bfhi(uu[j].z)); ov.w = pg8::cvt_pk_bf16(bflo(sv.w) * bflo(uu[j].w), bfhi(sv.w) * bfhi(uu[j].w));
                  *(GAS v4u*)(cbase + (coff + (unsigned)(4 * j * DM * 2))) = ov; asm volatile("" ::: "memory"); }
            }
            __syncthreads();
        }
    }
#undef SG_LOADV
}

__device__ __forceinline__ void combine_phase(Frame& F) {
    const bf16* AO = (const bf16*)(F.ws + WS_AO); bf16* CC = (bf16*)(F.ws + WS_CONCAT1);
    const int lane = mk_lane(), gw = blockIdx.x * NWAVES + F.wave, NGW = F.G * NWAVES;
    const float* q1 = F.in[I_LQ1]; const float* k1 = F.in[I_LK1]; const float* q2 = F.in[I_LQ2]; const float* k2 = F.in[I_LK2];
    const float s1 = wave_sum(q1[lane] * k1[lane] + q1[lane + 64] * k1[lane + 64]), s2 = wave_sum(q2[lane] * k2[lane] + q2[lane + 64] * k2[lane + 64]);
    const float lam = expf(s1) - expf(s2) + LAMBDA_INIT, post = 1.0f - LAMBDA_INIT;
    const f32x4 g4 = *(const GAS f32x4*)(F.in[I_SUBLN] + 4 * lane);
#define CB_LOAD(av, bv, m0_) do { _Pragma("unroll") for (int t = 0; t < 2; ++t) { const bf16* r1 = AO + (size_t)((m0_) + t) * 3072 + 4 * lane; \
        _Pragma("unroll") for (int h = 0; h < 6; ++h) { av[t][h] = __builtin_nontemporal_load((const GAS unsigned long long*)(r1 + h * 256)); bv[t][h] = __builtin_nontemporal_load((const GAS unsigned long long*)(r1 + 1536 + h * 256)); } } } while (0)
#define CB_DO(av, bv, m0_) do { _Pragma("unroll") for (int t = 0; t < 2; ++t) { bf16* orow = CC + (size_t)((m0_) + t) * DM + 4 * lane; \
        _Pragma("unroll") for (int h = 0; h < 6; ++h) { \
            const unsigned a0 = (unsigned)av[t][h], a1 = (unsigned)(av[t][h] >> 32), b0 = (unsigned)bv[t][h], b1 = (unsigned)(bv[t][h] >> 32); \
            const float x0 = bflo(a0) - lam * bflo(b0), x1 = bfhi(a0) - lam * bfhi(b0), x2 = bflo(a1) - lam * bflo(b1), x3 = bfhi(a1) - lam * bfhi(b1); \
            const float ss = wave_sum((x0 * x0 + x1 * x1) + (x2 * x2 + x3 * x3)); \
            const float r = post / sqrtf(ss * (1.f / 256.f) + LN_EPS); \
            *(GAS unsigned long long*)(orow + h * 256) = (unsigned long long)pg8::cvt_pk_bf16(x0 * r * g4.x, x1 * r * g4.y) | ((unsigned long long)pg8::cvt_pk_bf16(x2 * r * g4.z, x3 * r * g4.w) << 32); } } } while (0)
    const int step = NGW * 2; int m0 = gw * 2;
    if (m0 < NTOK) {
        unsigned long long a_[2][6], b_[2][6], c_[2][6], d_[2][6];
        CB_LOAD(a_, b_, m0);
        for (;;) {
            const int m1 = m0 + step; if (m1 < NTOK) CB_LOAD(c_, d_, m1);
            CB_DO(a_, b_, m0); if (m1 >= NTOK) break;
            const int m2 = m1 + step; if (m2 < NTOK) CB_LOAD(a_, b_, m2);
            CB_DO(c_, d_, m1); if (m2 >= NTOK) break;
            m0 = m2; }
    }
#undef CB_LOAD
#undef CB_DO
}

__device__ __forceinline__ void router_row(f32x4 (&v)[8], int m, int lane, const float* g, const float* b, bf16* xb, const LAS float* wr, int* route_e, float* route_w, int& cnt) {
            ln_norm(v, g, b, lane);
#if MK_FP8_MOE
            ln_store8(v, (unsigned char*)xb + (size_t)m * DM, lane);
#else
            ln_store16(v, xb + (size_t)m * DM, lane);
#endif
            float lg[8];
#pragma unroll
            for (int e = 0; e < 8; ++e) lg[e] = 0.f;
#pragma unroll
            for (int j = 0; j < 8; ++j) {
#pragma unroll
                for (int e = 0; e < 8; ++e) { const f32x4 w = *(const LAS f32x4*)(wr + e * DM + 256 * j + 4 * lane); lg[e] += (v[j].x * w.x + v[j].y * w.y) + (v[j].z * w.z + v[j].w * w.w); }
                asm volatile("" ::: "memory"); }
#pragma unroll
            for (int e = 0; e < 8; ++e) lg[e] = wave_sum(lg[e]);
            int e0 = 0; float l0 = lg[0];
#pragma unroll
            for (int e = 1; e < 8; ++e) if (lg[e] > l0) { l0 = lg[e]; e0 = e; }
            int e1 = -1; float l1 = -3.0e38f;
#pragma unroll
            for (int e = 0; e < 8; ++e) if (e != e0 && lg[e] > l1) { l1 = lg[e]; e1 = e; }
            const float ex = expf(l1 - l0), w0 = 1.0f / (1.0f + ex), w1 = ex / (1.0f + ex);
            if (lane == 0) { route_e[m] = e0 | (e1 << 8); route_w[2 * m] = w0; route_w[2 * m + 1] = w1; }
            cnt += (lane == e0) + (lane == e1);
}
__device__ __forceinline__ void ln_router_phase(Frame& F, const bf16* xio, bf16* xb, const float* g, const float* b) {
    LAS float* wr = (LAS float*)(F.lds);
    const float* wsrc = F.in[I_ROUTER];
    const int lane = mk_lane();
    for (int i = F.wave * 64 + lane; i < DM * NEXP; i += NWAVES * 64) wr[(i & 7) * DM + (i >> 3)] = wsrc[i];
    __syncthreads();
    int* route_e = (int*)(F.ws + WS_ROUTE_E); float* route_w = (float*)(F.ws + WS_ROUTE_W); int* hist = (int*)(F.ws + WS_HIST);
    const int gw = blockIdx.x * NWAVES + F.wave, NGW = F.G * NWAVES;
    for (int grp = gw; grp < NTOK / 16; grp += NGW) {
        int cnt = 0;
        f32x4 va[8], vb[8]; ln_load16(xio + (size_t)(grp * 16) * DM, lane, va);
        for (int r = 0; r < 16; r += 2) {
            ln_load16(xio + (size_t)(grp * 16 + r + 1) * DM, lane, vb); router_row(va, grp * 16 + r, lane, g, b, xb, wr, route_e, route_w, cnt);
            if (r + 2 < 16) ln_load16(xio + (size_t)(grp * 16 + r + 2) * DM, lane, va);
            router_row(vb, grp * 16 + r + 1, lane, g, b, xb, wr, route_e, route_w, cnt); }
        if (lane < 8) hist[grp * 8 + lane] = cnt;
    }
}

__device__ __forceinline__ void dispatch_phase(Frame& F) {
    LAS int* gpre = (LAS int*)(F.lds);
    LAS int* wtot = (LAS int*)(F.lds + 65536);
    LAS int* tst = (LAS int*)(F.lds + 65536 + 256);
    const int* hist = (const int*)(F.ws + WS_HIST); const int lane = mk_lane(), wid = F.wave, tid = wid * 64 + lane;
    int h[4][8], sum[8];
#pragma unroll
    for (int e = 0; e < 8; ++e) sum[e] = 0;
#pragma unroll
    for (int i = 0; i < 4; ++i) { const v4u a = *(const GAS v4u*)(hist + (4 * tid + i) * 8), b = *(const GAS v4u*)(hist + (4 * tid + i) * 8 + 4);
        h[i][0] = a.x; h[i][1] = a.y; h[i][2] = a.z; h[i][3] = a.w; h[i][4] = b.x; h[i][5] = b.y; h[i][6] = b.z; h[i][7] = b.w;
#pragma unroll
        for (int e = 0; e < 8; ++e) sum[e] += h[i][e]; }
    int inc[8];
#pragma unroll
    for (int e = 0; e < 8; ++e) { int v = sum[e];
#pragma unroll
        for (int o = 1; o < 64; o <<= 1) { const int t = __shfl_up(v, o); if (lane >= o) v += t; }
        inc[e] = v; if (lane == 63) wtot[wid * 8 + e] = v; }
    __syncthreads();
    int tot[8];
#pragma unroll
    for (int e = 0; e < 8; ++e) { int pre = 0, all = 0;
#pragma unroll
        for (int w = 0; w < 8; ++w) { const int t = wtot[w * 8 + e]; all += t; if (w < wid) pre += t; }
        tot[e] = all; int run = pre + inc[e] - sum[e];
#pragma unroll
        for (int i = 0; i < 4; ++i) { gpre[(4 * tid + i) * 8 + e] = run; run += h[i][e]; } }
    if (tid == 0) { int ts = 0;
#pragma unroll
        for (int e = 0; e < 8; ++e) { tst[e] = ts; ts += (tot[e] + 255) >> 8; } tst[8] = ts;
        if (blockIdx.x == 0) { int* tab = (int*)(F.ws + WS_MOETAB);
#pragma unroll
            for (int e = 0; e <= 8; ++e) tab[e] = tst[e]; } }
    __syncthreads();
    const int* route_e = (const int*)(F.ws + WS_ROUTE_E); const float* route_w = (const float*)(F.ws + WS_ROUTE_W);
    int* tokslot = (int*)(F.ws + WS_TOKSLOT); int* slottok = (int*)(F.ws + WS_SLOTTOK); float* slotgate = (float*)(F.ws + WS_SLOTGATE);
    const bf16* X3B = (const bf16*)(F.ws + WS_X3B); bf16* XS = (bf16*)(F.ws + WS_XS);
    const int gw = blockIdx.x * NWAVES + wid, NGW = F.G * NWAVES;
    for (int grp = gw; grp < NTOK / 16; grp += NGW) {
        const int a = lane & 31, tok = grp * 16 + (a >> 1), k = a & 1;
        const int e = (route_e[tok] >> (8 * k)) & 0xff; const float w = route_w[2 * tok + k];
        int rank = 0;
#pragma unroll
        for (int ee = 0; ee < 8; ++ee) { const unsigned long long mk = __ballot(lane < 32 && e == ee); if (e == ee) rank = __popcll(mk & ((1ull << lane) - 1ull)); }
        const int slot = tst[e] * 256 + gpre[grp * 8 + e] + rank;
        if (lane < 32) { slottok[slot] = tok; slotgate[slot] = w; tokslot[2 * tok + k] = slot; }
        for (int q4 = 0; q4 < 32; q4 += 4) {
#if MK_FP8_MOE
            v4u t_[4][2]; int sl[4];
#pragma unroll
            for (int u = 0; u < 4; ++u) { const int q = q4 + u; sl[u] = __shfl(slot, q); const int tk = grp * 16 + (q >> 1); const GAS v4u* src = (const GAS v4u*)((const unsigned char*)X3B + (size_t)tk * DM) + lane; t_[u][0] = src[0]; t_[u][1] = src[64]; }
#pragma unroll
            for (int u = 0; u < 4; ++u) { GAS v4u* dst = (GAS v4u*)((unsigned char*)XS + (size_t)sl[u] * DM) + lane; dst[0] = t_[u][0]; dst[64] = t_[u][1]; }
#else
            v4u t_[4][4]; int sl[4];
#pragma unroll
            for (int u = 0; u < 4; ++u) { const int q = q4 + u; sl[u] = __shfl(slot, q); const int tk = grp * 16 + (q >> 1); const GAS v4u* src = (const GAS v4u*)(X3B + (size_t)tk * DM) + lane;
#pragma unroll
                for (int j = 0; j < 4; ++j) t_[u][j] = src[64 * j]; }
#pragma unroll
            for (int u = 0; u < 4; ++u) { GAS v4u* dst = (GAS v4u*)(XS + (size_t)sl[u] * DM) + lane;
#pragma unroll
                for (int j = 0; j < 4; ++j) dst[64 * j] = t_[u][j]; }
#endif
        }
    }
}

__device__ __forceinline__ void add_os_row(f32x4 (&v)[8], const bf16* row, int lane) { const GAS unsigned long long* o = (const GAS unsigned long long*)row + lane;
#pragma unroll
    for (int j = 0; j < 8; ++j) { const unsigned long long p = __builtin_nontemporal_load(o + 64 * j); const unsigned p0 = (unsigned)p, p1 = (unsigned)(p >> 32); v[j].x += bflo(p0); v[j].y += bfhi(p0); v[j].z += bflo(p1); v[j].w += bfhi(p1); } }
__device__ __forceinline__ void final_phase(Frame& F, const float* g3, const float* b3, const float* g, const float* b) {
    const int* tokslot = (const int*)(F.ws + WS_TOKSLOT); const bf16* OS = (const bf16*)(F.ws + WS_OS); const bf16* OSK = (const bf16*)(F.ws + WS_OSK);
    const bf16* Y3 = (const bf16*)(F.ws + WS_Y3B);
    const int gw = blockIdx.x * NWAVES + F.wave, NGW = F.G * NWAVES, lane = mk_lane();
    int Tm = 1 << 30;
#if MK_FP8_MOE
    { const int T = ((const int*)(F.ws + WS_MOETAB))[8]; int Lt = T & 31; if (Lt > 8) Lt = 0; Tm = T - Lt; }
#endif
#define FIN_ROW(v, m, s0, s1) do { ln_norm(v, g3, b3, lane);     \
        _Pragma("unroll") for (int j = 0; j < 8; ++j) v[j] = v[j] * ALPHA; \
        { const int sl_[2] = {s0, s1}; _Pragma("unroll") for (int k = 0; k < 2; ++k) { const int s = sl_[k], tile = s >> 8; \
            if (tile >= Tm) { for (int q = 0; q < 4; ++q) add_os_row(v, OSK + ((size_t)(q * 8 + tile - Tm) * 256 + (s & 255)) * DM, lane); } \
            else add_os_row(v, OS + (size_t)s * DM, lane); } } \
        ln_norm(v, g, b, lane); ln_store(v, F.out + (size_t)(m) * DM, nullptr, lane); } while (0)
    for (int base = gw * 16; base < NTOK; base += NGW * 16) {
        f32x4 va[8], vb[8]; ln_load16(Y3 + (size_t)base * DM, lane, va); int a0 = tokslot[2 * base], a1 = tokslot[2 * base + 1], b0 = 0, b1 = 0;
        for (int r = 0; r < 16; r += 2) { const int m = base + r;
            ln_load16(Y3 + (size_t)(m + 1) * DM, lane, vb); b0 = tokslot[2 * (m + 1)]; b1 = tokslot[2 * (m + 1) + 1];
            FIN_ROW(va, m, a0, a1);
            if (r + 2 < 16) { ln_load16(Y3 + (size_t)(m + 2) * DM, lane, va); a0 = tokslot[2 * (m + 2)]; a1 = tokslot[2 * (m + 2) + 1]; }
            FIN_ROW(vb, m + 1, b0, b1); }
    }
#undef FIN_ROW
}

struct Args { const float* in[25]; float* out; unsigned char* ws; int ph_lo, ph_hi, ch_lo, ch_hi; };
__global__ void __launch_bounds__(NWAVES * 64, 2) mk_fwd(Args args) {
    extern __shared__ __attribute__((aligned(16))) unsigned char lds[];
    Frame F;
    F.lds = (LAS unsigned char*)lds; F.MISC = (volatile LAS unsigned*)(F.lds + MISC_OFF);
    F.wave = __builtin_amdgcn_readfirstlane(threadIdx.x >> 6); F.G = gridDim.x;
    F.ws = args.ws; F.ctl = (gu32*)(args.ws + WS_CTL); F.out = args.out;
#pragma unroll
    for (int i = 0; i < 25; ++i) F.in[i] = args.in[i];
    for (int u = threadIdx.x; u < (LDS_BYTES - LDSCTL_OFF) / 4; u += NWAVES * 64) ((LAS unsigned*)(F.lds + LDSCTL_OFF))[u] = 0u;
    __syncthreads();
    const int lo = args.ph_lo, hi = args.ph_hi;
    XcdBarrier bar; bar.bar = (unsigned*)(F.ctl + CW_BAR); bar.x = 0; bar.st = nullptr; bar.wave = F.wave;
    if (hi - lo > 1) { bar = xcd_barrier_post((unsigned*)(F.ctl + CW_BAR), F.MISC + 8); bar.wave = F.wave; }
#define IN(k) (((MK_PHMASK >> (k)) & 1) && lo <= (k) && (k) < hi)
#define BOTH(k) (IN(k) && IN((k) + 1))
#if MK_BG
    bool bg_done_ = false;
#define XCD_BAR_CALL() xcd_barrier_bg(bar, F, bg_done_)
#else
#define XCD_BAR_CALL() xcd_barrier(bar)
#endif
#if MK_PROBE == 3
    unsigned long long bar_wait_ = 0;
#define BG_DRAIN(X) do { const unsigned long long t0_ = rt(); bg_drain(F, X); bar_wait_ += rt() - t0_; } while (0)
#else
#define BG_DRAIN(X) bg_drain(F, X)
#endif
#if MK_PROBE == 2
    unsigned long long bar_wait_ = 0;
    int bar_idx_ = 0;
#define GRID_BAR() do { const unsigned long long t0_ = rt(); XCD_BAR_CALL(); if ((MK_PROBE_BARMASK >> bar_idx_) & 1) bar_wait_ += rt() - t0_; ++bar_idx_; } while (0)
#else
#define GRID_BAR() XCD_BAR_CALL()
#endif
#if MK_PROBE
    if (blockIdx.x == 0 && F.wave == 0 && mk_lane() == 0) __hip_atomic_store(F.ctl + CW_TS, (unsigned)rt(), RLX_AGENT);
#define STAMP(k) do { if (blockIdx.x == 0 && F.wave == 0 && mk_lane() == 0) __hip_atomic_store(F.ctl + CW_TS + 1 + (k), (unsigned)rt(), RLX_AGENT); } while (0)
#else
#define STAMP(k) do { } while (0)
#endif
    unsigned char* ws = args.ws;
    bf16* XB = (bf16*)(ws + WS_XB);
    LAS unsigned char* ring = F.lds + RING_OFF;

    if (IN(0)) { p0_prologue(F); if (BOTH(0)) GRID_BAR(); STAMP(0); }
    if (IN(1)) {
        { pg8::Gemm g{XB, (const bf16*)(ws + WS_W_A_IN), NTOK, A_IN, DM}; pg8::StaticOrder S; S.init(NTOK, A_IN, F.G, (int)blockIdx.x);
          pg8::EpiBf16 E{(bf16*)(ws + WS_H0), A_IN, 2 * MAINW}; pg8::gemm_phase<pg8::EpiBf16, pg8::StaticOrder, true, true>(ring, g, S, E, F.wave); }
        { pg8::Gemm g{(const bf16*)(ws + WS_MEMB), (const bf16*)(ws + WS_W_MEMKV), NBATCH * NMEM, 2048, DM}; pg8::StaticOrder S; S.init(NBATCH * NMEM, 2048, F.G, (int)blockIdx.x);
          pg8::EpiBf16 E{(bf16*)(ws + WS_MEMKV), 2048, 0}; pg8::gemm_phase<pg8::EpiBf16, pg8::StaticOrder, true, true>(ring, g, S, E, F.wave); }
        if (BOTH(1)) GRID_BAR(); STAMP(1);
    }
    if (IN(2)) {
        memattn_phase<A_IN>(F.G, F.wave, (char*)lds + RING_OFF, (const abf*)(ws + WS_H0) + 2 * MAINW, (const abf*)(ws + WS_MEMKV), (abf*)(ws + WS_CONCAT) + MAINW);
        __syncthreads();
        sg_phase(F);
        if (BOTH(2)) GRID_BAR(); STAMP(2);
    }
    if (IN(3)) {
        pg8::Gemm g{(const bf16*)(ws + WS_CONCAT), (const bf16*)(ws + WS_W_MIX), NTOK, DM, DM}; pg8::StaticOrder S; S.init(NTOK, DM, F.G, (int)blockIdx.x);
        pg8::EpiRes16<true> E{XB, (bf16*)(ws + WS_Y3B)}; pg8::gemm_phase<pg8::EpiRes16<true>, pg8::StaticOrder, true, true>(ring, g, S, E, F.wave);
        if (BOTH(3)) GRID_BAR(); STAMP(3);
    }
    if (IN(4)) { ln_phase<MK_FP8_FFN != 0>(F, (const bf16*)(ws + WS_Y3B), XB, F.in[I_LNG] + 0 * DM, F.in[I_LNB] + 0 * DM);
#if MK_BG
        BG_DRAIN(BG_EA1);
#endif
        if (BOTH(4)) GRID_BAR(); STAMP(4); }
    if (IN(5)) {
        pg8::StaticOrder S; S.init(NTOK, 2 * FF, F.G, (int)blockIdx.x);
#if MK_FP8_FFN
        pg8::Gemm g{XB, (const bf16*)(ws + WS_W_FFN_GU), NTOK, 2 * FF, DM / 2};
        pg8::EpiSwiglu8<false> E{ws + WS_HID, FF}; pg8::gemm_phase<pg8::EpiSwiglu8<false>, pg8::StaticOrder, true, true, SC_ONE, SC_M6>(ring, g, S, E, F.wave);
#else
        pg8::Gemm g{XB, (const bf16*)(ws + WS_W_FFN_GU), NTOK, 2 * FF, DM};
        pg8::EpiSwiglu E{(bf16*)(ws + WS_HID), FF}; pg8::gemm_phase<pg8::EpiSwiglu, pg8::StaticOrder, true, true>(ring, g, S, E, F.wave);
#endif
#if MK_BG
        BG_DRAIN(BG_EA);
#endif
        if (BOTH(5)) GRID_BAR(); STAMP(5);
    }
    if (IN(6)) {
        pg8::StaticOrder S; S.init(NTOK, DM, F.G, (int)blockIdx.x); pg8::EpiResLn16<true> E{ws + WS_Y3B, (bf16*)(ws + WS_Y3B), (const float*)(ws + WS_STATS), F.in[I_LNG] + 0 * DM, F.in[I_LNB] + 0 * DM};
#if MK_FP8_FFN
        pg8::Gemm g{(const bf16*)(ws + WS_HID), (const bf16*)(ws + WS_W_FFN_D), NTOK, DM, FF / 2};
        pg8::gemm_phase<pg8::EpiResLn16<true>, pg8::StaticOrder, true, true, SC_M4, SC_M7>(ring, g, S, E, F.wave);
#else
        pg8::Gemm g{(const bf16*)(ws + WS_HID), (const bf16*)(ws + WS_W_FFN_D), NTOK, DM, FF};
        pg8::gemm_phase<pg8::EpiResLn16<true>, pg8::StaticOrder, true, true>(ring, g, S, E, F.wave);
#endif
        if (BOTH(6)) GRID_BAR(); STAMP(6);
    }
    if (IN(7)) { ln_phase<false>(F, (const bf16*)(ws + WS_Y3B), XB, F.in[I_LNG] + 1 * DM, F.in[I_LNB] + 1 * DM);
#if MK_BG
        BG_DRAIN(BG_EB);
#endif
        if (BOTH(7)) GRID_BAR(); STAMP(7); }
    if (IN(8)) {
        pg8::Gemm g{XB, (const bf16*)(ws + WS_W_B_IN), NTOK, B_IN, DM}; pg8::StaticOrder S; S.init(NTOK, B_IN, F.G, (int)blockIdx.x);
        pg8::EpiBf16 E{(bf16*)(ws + WS_H1), B_IN, 0}; pg8::gemm_phase<pg8::EpiBf16, pg8::StaticOrder, true, true>(ring, g, S, E, F.wave);
        if (BOTH(8)) GRID_BAR(); STAMP(8);
    }
    if (IN(9)) { diffattn_phase(F.G, F.wave, F.lds + RING_OFF, (const abf*)(ws + WS_H1), (abf*)(ws + WS_AO)); if (BOTH(9)) GRID_BAR(); STAMP(9); }
    if (IN(10)) {
        memattn_phase<B_IN>(F.G, F.wave, (char*)lds + RING_OFF, (const abf*)(ws + WS_H1) + 4608, (const abf*)(ws + WS_MEMKV) + 1024, (abf*)(ws + WS_CONCAT1) + MAINW);
        combine_phase(F);
#if MK_BG
        __syncthreads(); BG_DRAIN(BG_EC);
#endif
        if (BOTH(10)) GRID_BAR(); STAMP(10);
    }
    if (IN(11)) {
        pg8::Gemm g{(const bf16*)(ws + WS_CONCAT1), (const bf16*)(ws + WS_W_MIX) + (size_t)DM * DM, NTOK, DM, DM}; pg8::StaticOrder S; S.init(NTOK, DM, F.G, (int)blockIdx.x);
        pg8::EpiResLn16<true> E{ws + WS_Y3B, (bf16*)(ws + WS_Y3B), (const float*)(ws + WS_STATS), F.in[I_LNG] + 1 * DM, F.in[I_LNB] + 1 * DM}; pg8::gemm_phase<pg8::EpiResLn16<true>, pg8::StaticOrder, true, true>(ring, g, S, E, F.wave);
        if (BOTH(11)) GRID_BAR(); STAMP(11);
    }
    if (IN(12)) { ln_router_phase(F, (const bf16*)(ws + WS_Y3B), (bf16*)(ws + WS_X3B), F.in[I_LNG] + 2 * DM, F.in[I_LNB] + 2 * DM); if (BOTH(12)) GRID_BAR(); STAMP(12); }
    if (IN(13)) { dispatch_phase(F);
#if MK_BG
        __syncthreads(); BG_DRAIN(BG_ED1);
#endif
        if (BOTH(13)) GRID_BAR(); STAMP(13); }
    if (IN(14) || IN(15)) {
        LAS int* tst = (LAS int*)(F.lds + LDSCTL_OFF);
        { const int t_ = F.wave * 64 + mk_lane(); if (t_ < 9) tst[t_] = ((const int*)(ws + WS_MOETAB))[t_]; }
        __syncthreads();
        const int T = tst[8];
        for (int ch = args.ch_lo; ch < args.ch_hi; ++ch) {
            const int t0 = ch * MOE_CHUNK_T; int nM = T - t0; nM = nM < 0 ? 0 : (nM > MOE_CHUNK_T ? MOE_CHUNK_T : nM);
            if (IN(14)) {
                pg8::MoeOrder<false> S; S.nM = nM; S.nN = 2 * FFE / 256; S.nwg = nM * S.nN; S.G = F.G; S.c = (int)blockIdx.x; S.t0 = t0; S.tstart = tst;
#if MK_FP8_MOE
                pg8::Gemm g{(const bf16*)(ws + WS_XS), (const bf16*)(ws + WS_W_MOE_GU), 0, 2 * FFE, DM / 2};
                pg8::EpiSwiglu8<false> E{ws + WS_HIDM, FFE}; pg8::gemm_phase<pg8::EpiSwiglu8<false>, pg8::MoeOrder<false>, true, true, SC_ONE, SC_M6>(ring, g, S, E, F.wave);
#else
                pg8::Gemm g{(const bf16*)(ws + WS_XS), (const bf16*)(ws + WS_W_MOE_GU), 0, 2 * FFE, DM};
                pg8::EpiSwiglu E{(bf16*)(ws + WS_HIDM), FFE}; pg8::gemm_phase<pg8::EpiSwiglu, pg8::MoeOrder<false>, true, true>(ring, g, S, E, F.wave);
#endif
#if MK_BG
                BG_DRAIN(BG_ED);
#endif
                if (IN(15)) GRID_BAR(); STAMP(14);
            }
            if (IN(15)) {
                pg8::EpiRowScale E{(bf16*)(ws + WS_OS), DM, (const float*)(ws + WS_SLOTGATE)};
#if MK_FP8_MOE
                int Lt = T & 31; if (Lt > 8) Lt = 0; const int Tm = T - Lt;
                { pg8::MoeOrder<true> S; S.nM = Tm; S.nN = DM / 256; S.nwg = Tm * S.nN; S.G = F.G; S.c = (int)blockIdx.x; S.t0 = 0; S.tstart = tst;
                  pg8::Gemm g{(const bf16*)(ws + WS_HIDM), (const bf16*)(ws + WS_W_MOE_D), 0, DM, FFE / 2, 0};
                  pg8::gemm_phase<pg8::EpiRowScale, pg8::MoeOrder<true>, true, true, SC_M4, SC_M7>(ring, g, S, E, F.wave); }
                { pg8::MoeLeftOrder S; S.L = Lt; S.G = F.G; S.c = (int)blockIdx.x; S.tl0 = Tm; S.kq = FFE / 4; S.tstart = tst;
                  pg8::Gemm g{(const bf16*)(ws + WS_HIDM), (const bf16*)(ws + WS_W_MOE_D), 0, DM, FFE / 2, FFE / 8};
                  pg8::EpiRowScale E2{(bf16*)(ws + WS_OSK), DM, (const float*)(ws + WS_SLOTGATE)};
                  pg8::gemm_phase<pg8::EpiRowScale, pg8::MoeLeftOrder, true, true, SC_M4, SC_M7>(ring, g, S, E2, F.wave); }
#else
                pg8::MoeOrder<true> S; S.nM = nM; S.nN = DM / 256; S.nwg = nM * S.nN; S.G = F.G; S.c = (int)blockIdx.x; S.t0 = t0; S.tstart = tst;
                pg8::Gemm g{(const bf16*)(ws + WS_HIDM), (const bf16*)(ws + WS_W_MOE_D), 0, DM, FFE, 0};
                pg8::gemm_phase<pg8::EpiRowScale, pg8::MoeOrder<true>, true, true>(ring, g, S, E, F.wave);
#endif
                if (ch + 1 < args.ch_hi ? IN(14) : IN(16)) GRID_BAR(); STAMP(15);
            }
        }
    }
    if (IN(16)) final_phase(F, F.in[I_LNG] + 2 * DM, F.in[I_LNB] + 2 * DM, F.in[I_LNG] + 3 * DM, F.in[I_LNB] + 3 * DM);
#if MK_PROBE
#if MK_PROBE == 2 || MK_PROBE == 3
    if (blockIdx.x == MK_PROBE_BLK && F.wave == 0 && mk_lane() == 0) { const unsigned long long t0 = rt(), target = bar_wait_ * MK_PROBE_MULT; while (rt() - t0 < target) __builtin_amdgcn_s_sleep(32); }
#else
    STAMP(16);
    if (blockIdx.x == 0 && F.wave == 0 && mk_lane() == 0) {
        unsigned ta = 0;
        for (int k = 0; k < 17; ++k) { const unsigned d = __hip_atomic_load(F.ctl + CW_TS + 1 + k, RLX_AGENT) - __hip_atomic_load(F.ctl + CW_TS + k, RLX_AGENT); if ((MK_PROBE_A >> k) & 1) ta += d; }
        const unsigned long long t0 = rt(), target = (unsigned long long)ta * MK_PROBE_MULT;
        while (rt() - t0 < target) __builtin_amdgcn_s_sleep(32);
    }
#endif
#endif
#undef IN
#undef BOTH
#undef GRID_BAR
#undef XCD_BAR_CALL
#undef BG_DRAIN
#undef STAMP
}

#if MK_DEBUG
__device__ __forceinline__ unsigned hash32(unsigned x) { x ^= x >> 16; x *= 0x7feb352dU; x ^= x >> 15; x *= 0x846ca68bU; x ^= x >> 16; return x; }
__device__ __forceinline__ float wdot(const bf16* a, const bf16* b, int K, int lane) { float s = 0.f; for (int k = lane; k < K; k += 64) s += bf2f(a[k]) * bf2f(b[k]); return wave_sum(s); }
__device__ __forceinline__ bool okf(float got, float ref, float rel, float ab) { return fabsf(got - ref) <= rel * fabsf(ref) + ab; }
__device__ __forceinline__ float gelu_ref(float x) { return 0.5f * x * (1.0f + tanhf(0.7978845608f * (x + 0.044715f * x * x * x))); }
__device__ __forceinline__ float silu_ref(float x) { return x / (1.0f + expf(-x)); }
__device__ __forceinline__ float f8f(unsigned char b) { return __builtin_amdgcn_cvt_f32_fp8((int)b, 0); }
__device__ __forceinline__ unsigned char f2f8(float x) { return (unsigned char)(__builtin_amdgcn_cvt_pk_fp8_f32(x, 0.f, 0, false) & 0xff); }
__device__ __forceinline__ float wdot8(const unsigned char* a, const unsigned char* b, int K, int lane) { float s = 0.f; for (int k = lane; k < K; k += 64) s += f8f(a[k]) * f8f(b[k]); return wave_sum(s); }
#define CHK_FAIL(stage) do { if (lane == 0) atomicAdd((unsigned*)(a.ws + WS_CTL) + CW_CHK + (stage), 1u); } while (0)
__device__ void chk_tr8(const Args& a, int stage, const float* W, int K, int N, const unsigned char* WT, int row_off, int mode, float mul, unsigned s, int lane) {
    const int k = hash32(s * 2 + 1) % K, n = hash32(s * 2 + 2) % N; const int drow = row_off + (mode == 0 ? n : ((n >> 7) * 256 + (n & 127) + (mode == 2 ? 128 : 0)));
    if (WT[(size_t)drow * K + k] != f2f8(W[(size_t)k * N + n] * mul)) CHK_FAIL(stage);
}
__device__ void chk_tr(const Args& a, int stage, const float* W, int K, int N, const bf16* WT, int row_off, int mode, unsigned s, int lane) {
    const int k = hash32(s * 2 + 1) % K, n = hash32(s * 2 + 2) % N; const int drow = row_off + (mode == 0 ? n : ((n >> 7) * 256 + (n & 127) + (mode == 2 ? 128 : 0)));
    if (WT[(size_t)drow * K + k] != (bf16)f2bf(W[(size_t)k * N + n])) CHK_FAIL(stage);
}
__device__ void chk_memattn(const Args& a, int stage, const bf16* q, const bf16* Kb, const bf16* Ob, float* pl, int lane) {
    float sc[4], mx = -3e38f;
    for (int i = 0; i < 4; ++i) { const int j = lane + 64 * i; float s = 0.f; for (int d = 0; d < 128; ++d) s += bf2f(q[d]) * bf2f(Kb[(size_t)j * 2048 + d]); sc[i] = s * 0.08838834764831845f; mx = fmaxf(mx, sc[i]); }
    for (int o = 1; o < 64; o <<= 1) mx = fmaxf(mx, __shfl_xor(mx, o));
    float sum = 0.f; for (int i = 0; i < 4; ++i) { sc[i] = expf(sc[i] - mx); sum += sc[i]; pl[lane + 64 * i] = sc[i]; }
    sum = wave_sum(sum); __syncthreads();
    bool bad = false;
    for (int dd = 0; dd < 2; ++dd) { const int d = lane + 64 * dd; float o = 0.f; for (int j = 0; j < 256; ++j) o += pl[j] * bf2f(Kb[(size_t)j * 2048 + 512 + d]); o /= sum;
        if (!okf(bf2f(Ob[d]), o, 0.03f, 0.004f)) bad = true; }
    if (__any(bad)) CHK_FAIL(stage);
    __syncthreads();
}
__global__ void __launch_bounds__(64) chk_kernel(Args a, int stage, int chunk) {
    __shared__ float pl[8192];
    const int lane = threadIdx.x; const unsigned s = blockIdx.x; unsigned char* ws = a.ws;
    const bf16* XB = (const bf16*)(ws + WS_XB);
    if (stage == 0 || (MK_BG && stage == 14)) {
        int cs = s % 12;
#if MK_BG
        { const bool fg = (cs == 0 || cs == 7 || cs == 11 || (cs == 1 && ((s / 12) & 1) == 0)); if ((stage == 0) != fg) cs = 99; }
#endif
        switch (cs) {
        case 99: break;
        case 0: chk_tr(a, 0, a.in[I_AWIN], DM, A_IN, (const bf16*)(ws + WS_W_A_IN), 0, 0, s, lane); break;
        case 1: { const int l = (s / 12) & 1; chk_tr(a, 0, a.in[I_WMIX] + (size_t)l * DM * DM, DM, DM, (const bf16*)(ws + WS_W_MIX), l * DM, 0, s, lane); } break;
#if MK_FP8_FFN
        case 2: chk_tr8(a, 0, a.in[I_FG], DM, FF, ws + WS_W_FFN_GU, 0, 1, W8_G_MUL, s, lane); break;
        case 3: chk_tr8(a, 0, a.in[I_FU], DM, FF, ws + WS_W_FFN_GU, 0, 2, W8_U_MUL, s, lane); break;
        case 4: chk_tr8(a, 0, a.in[I_FD], FF, DM, ws + WS_W_FFN_D, 0, 0, W8_D_MUL, s, lane); break;
#else
        case 2: chk_tr(a, 0, a.in[I_FG], DM, FF, (const bf16*)(ws + WS_W_FFN_GU), 0, 1, s, lane); break;
        case 3: chk_tr(a, 0, a.in[I_FU], DM, FF, (const bf16*)(ws + WS_W_FFN_GU), 0, 2, s, lane); break;
        case 4: chk_tr(a, 0, a.in[I_FD], FF, DM, (const bf16*)(ws + WS_W_FFN_D), 0, 0, s, lane); break;
#endif
        case 5: chk_tr(a, 0, a.in[I_SWKV], DM, 3072, (const bf16*)(ws + WS_W_B_IN), 0, 0, s, lane); break;
        case 6: chk_tr(a, 0, a.in[I_BWIN], DM, DM, (const bf16*)(ws + WS_W_B_IN), 3072, 0, s, lane); break;
        case 7: { const int l = (s / 12) & 1; chk_tr(a, 0, a.in[I_WMEMKV] + (size_t)l * DM * 1024, DM, 1024, (const bf16*)(ws + WS_W_MEMKV), l * 1024, 0, s, lane); } break;
#if MK_FP8_MOE
        case 8: { const int e = (s / 12) & 7; chk_tr8(a, 0, a.in[I_MG] + (size_t)e * DM * FFE, DM, FFE, ws + WS_W_MOE_GU, e * 2 * FFE, 1, W8_G_MUL, s, lane); } break;
        case 9: { const int e = (s / 12) & 7; chk_tr8(a, 0, a.in[I_MU] + (size_t)e * DM * FFE, DM, FFE, ws + WS_W_MOE_GU, e * 2 * FFE, 2, W8_U_MUL, s, lane); } break;
        case 10: { const int e = (s / 12) & 7; chk_tr8(a, 0, a.in[I_MD] + (size_t)e * FFE * DM, FFE, DM, ws + WS_W_MOE_D, e * DM, 0, W8_D_MUL, s, lane); } break;
#else
        case 8: { const int e = (s / 12) & 7; chk_tr(a, 0, a.in[I_MG] + (size_t)e * DM * FFE, DM, FFE, (const bf16*)(ws + WS_W_MOE_GU), e * 2 * FFE, 1, s, lane); } break;
        case 9: { const int e = (s / 12) & 7; chk_tr(a, 0, a.in[I_MU] + (size_t)e * DM * FFE, DM, FFE, (const bf16*)(ws + WS_W_MOE_GU), e * 2 * FFE, 2, s, lane); } break;
        case 10: { const int e = (s / 12) & 7; chk_tr(a, 0, a.in[I_MD] + (size_t)e * FFE * DM, FFE, DM, (const bf16*)(ws + WS_W_MOE_D), e * DM, 0, s, lane); } break;
#endif
        default: { const size_t i = hash32(s) % ((size_t)NTOK * DM); if (XB[i] != (bf16)f2bf(a.in[I_X][i])) CHK_FAIL(0);
                   const size_t i2 = hash32(s + 7) % ((size_t)1024 * DM); if (((const bf16*)(ws + WS_MEMB))[i2] != (bf16)f2bf(a.in[I_MEM][i2])) CHK_FAIL(0);
                   const int i3 = hash32(s + 9) % (NSG * 128 * 128), ss = i3 & 127, tt = (i3 >> 7) & 127; if (((const bf16*)(ws + WS_WSBF))[i3] != (bf16)(ss <= tt ? f2bf(a.in[I_AWS][i3]) : 0u)) CHK_FAIL(0); } break;
        }
    } else if (stage == 1) {
        const int row = hash32(s) % NTOK, col = (s & 1) ? (3072 + hash32(s + 1) % 512) : (hash32(s + 1) % A_IN);
        float ref = wdot(XB + (size_t)row * DM, (const bf16*)(ws + WS_W_A_IN) + (size_t)col * DM, DM, lane); if (col < 3072) ref = gelu_ref(ref);
        if (!okf(bf2f(((const bf16*)(ws + WS_H0))[(size_t)row * A_IN + col]), ref, 0.02f, 0.02f)) CHK_FAIL(1);
        const int r2 = hash32(s + 3) % 1024, c2 = hash32(s + 4) % 2048;
        const float ref2 = wdot((const bf16*)(ws + WS_MEMB) + (size_t)r2 * DM, (const bf16*)(ws + WS_W_MEMKV) + (size_t)c2 * DM, DM, lane);
        if (!okf(bf2f(((const bf16*)(ws + WS_MEMKV))[(size_t)r2 * 2048 + c2]), ref2, 0.02f, 0.02f)) CHK_FAIL(1);
    } else if (stage == 2) {
        const int tok = hash32(s) % NTOK, h = hash32(s + 1) & 3, b = tok / SEQ; const bf16* H0 = (const bf16*)(ws + WS_H0);
        chk_memattn(a, 2, H0 + (size_t)tok * A_IN + 3072 + h * 128, (const bf16*)(ws + WS_MEMKV) + (size_t)b * 256 * 2048 + h * 128, (const bf16*)(ws + WS_CONCAT) + (size_t)tok * DM + 1536 + h * 128, pl, lane);
        const int g = hash32(s + 2) % NSG, t = tok & 127; const size_t R0 = (size_t)(tok - t);
        float mean[2], rstd[2];
        for (int i = 0; i < 2; ++i) { const int sidx = lane + 64 * i; const bf16* vr = H0 + (R0 + sidx) * A_IN + MAINW; float sm = 0.f; for (int k = 0; k < MAINW; ++k) sm += bf2f(vr[k]); sm /= MAINW; float q = 0.f; for (int k = 0; k < MAINW; ++k) { const float d = bf2f(vr[k]) - sm; q += d * d; } mean[i] = sm; rstd[i] = 1.0f / sqrtf(q / MAINW + LN_EPS); }
        for (int dd = 0; dd < 2; ++dd) { const int d = hash32(s + 10 + dd) & 127, col = g * 128 + d; float acc = 0.f;
            for (int i = 0; i < 2; ++i) { const int sidx = lane + 64 * i; if (sidx <= t) { const float lv = (bf2f(H0[(R0 + sidx) * A_IN + MAINW + col]) - mean[i]) * rstd[i] * a.in[I_AVG][col] + a.in[I_AVB][col]; acc += a.in[I_AWS][((size_t)g * 128 + t) * 128 + sidx] * lv; } }
            acc = wave_sum(acc); const float ref = (acc + a.in[I_ABS][g * 128 + t]) * bf2f(H0[(R0 + t) * A_IN + col]);
            if (!okf(bf2f(((const bf16*)(ws + WS_CONCAT))[(R0 + t) * DM + col]), ref, 0.03f, 0.03f)) CHK_FAIL(3); }
    } else if (stage == 3 || stage == 6 || stage == 11) {
        const int row = hash32(s) % NTOK, col = hash32(s + 1) % DM; float ref;
        if (stage == 3) ref = ALPHA * a.in[I_X][(size_t)row * DM + col] + wdot((const bf16*)(ws + WS_CONCAT) + (size_t)row * DM, (const bf16*)(ws + WS_W_MIX) + (size_t)col * DM, DM, lane);
#if MK_FP8_FFN
        else if (stage == 6) ref = ALPHA * f8f((ws + WS_XB)[(size_t)row * DM + col]) + wdot8(ws + WS_HID + (size_t)row * FF, ws + WS_W_FFN_D + (size_t)col * FF, FF, lane) / (H8_MUL * W8_D_MUL);
#else
        else if (stage == 6) ref = ALPHA * bf2f(XB[(size_t)row * DM + col]) + wdot((const bf16*)(ws + WS_HID) + (size_t)row * FF, (const bf16*)(ws + WS_W_FFN_D) + (size_t)col * FF, FF, lane);
#endif
        else ref = ALPHA * bf2f(XB[(size_t)row * DM + col]) + wdot((const bf16*)(ws + WS_CONCAT1) + (size_t)row * DM, (const bf16*)(ws + WS_W_MIX) + (size_t)DM * DM + (size_t)col * DM, DM, lane);
        if (!okf(a.out[(size_t)row * DM + col], ref, 0.02f, (MK_FP8_FFN && stage == 6) ? 0.12f : 0.03f)) CHK_FAIL(stage == 3 ? 4 : (stage == 6 ? 7 : 13));
    } else if (stage == 4 || stage == 7 || stage == 12) {
        const int row = hash32(s) % NTOK, li = stage == 4 ? 0 : (stage == 7 ? 1 : 2); const float* y = a.out + (size_t)row * DM; const float* g = a.in[I_LNG] + li * DM; const float* bb = a.in[I_LNB] + li * DM;
        float s1 = 0.f; for (int k = lane; k < DM; k += 64) s1 += y[k]; const float mean = wave_sum(s1) / DM;
        float s2 = 0.f; for (int k = lane; k < DM; k += 64) { const float d = y[k] - mean; s2 += d * d; } const float rstd = 1.0f / sqrtf(wave_sum(s2) / DM + LN_EPS);
        bool bad = false;
        if (stage != 12) { const float* st = (const float*)(ws + WS_STATS) + 2 * row; if (!okf(st[0], mean, 1e-3f, 1e-4f) || !okf(st[1], rstd, 1e-3f, 1e-6f)) bad = true; }
        for (int k = lane; k < DM; k += 64) { const float x = (y[k] - mean) * rstd * g[k] + bb[k]; float got;
            if (stage == 12) got = MK_FP8_MOE ? f8f((ws + WS_X3B)[(size_t)row * DM + k]) : bf2f(((const bf16*)(ws + WS_X3B))[(size_t)row * DM + k]);
            else if (stage == 4 && MK_FP8_FFN) got = f8f((ws + WS_XB)[(size_t)row * DM + k]);
            else got = bf2f(XB[(size_t)row * DM + k]);
            if (!okf(got, x, 0.07f, 0.02f)) bad = true; }
        if (__any(bad)) CHK_FAIL(stage == 4 ? 5 : (stage == 7 ? 8 : 14));
        if (stage == 12) {
            float lg[8]; for (int e2 = 0; e2 < 8; ++e2) { float p = 0.f; for (int k = lane; k < DM; k += 64) p += ((y[k] - mean) * rstd * g[k] + bb[k]) * a.in[I_ROUTER][k * 8 + e2]; lg[e2] = wave_sum(p); }
            int e0 = 0; for (int e2 = 1; e2 < 8; ++e2) if (lg[e2] > lg[e0]) e0 = e2; int e1 = e0 == 0 ? 1 : 0; for (int e2 = 0; e2 < 8; ++e2) if (e2 != e0 && lg[e2] > lg[e1]) e1 = e2;
            const int re = ((const int*)(ws + WS_ROUTE_E))[row]; const float w0 = ((const float*)(ws + WS_ROUTE_W))[2 * row];
            float third = -3e38f; for (int e2 = 0; e2 < 8; ++e2) if (e2 != e0 && e2 != e1) third = fmaxf(third, lg[e2]);
            const bool tie = (lg[e0] - lg[e1] < 1e-4f) || (lg[e1] - third < 1e-4f);
            if (!tie && (re != (e0 | (e1 << 8)) || !okf(w0, 1.0f / (1.0f + expf(lg[e1] - lg[e0])), 1e-3f, 1e-4f))) CHK_FAIL(15);
        }
    } else if (stage == 5) {
        const int row = hash32(s) % NTOK, hc = hash32(s + 1) % FF;
#if MK_FP8_FFN
        const unsigned char* W = ws + WS_W_FFN_GU + (size_t)((hc >> 7) * 256 + (hc & 127)) * DM; const unsigned char* x = ws + WS_XB + (size_t)row * DM;
        const float g = wdot8(x, W, DM, lane) / W8_G_MUL, u = wdot8(x, W + (size_t)128 * DM, DM, lane) / W8_U_MUL;
        if (!okf(f8f((ws + WS_HID)[(size_t)row * FF + hc]) / H8_MUL, silu_ref(g) * u, 0.08f, 0.004f)) CHK_FAIL(6);
#else
        const bf16* W = (const bf16*)(ws + WS_W_FFN_GU) + (size_t)((hc >> 7) * 256 + (hc & 127)) * DM;
        const float g = wdot(XB + (size_t)row * DM, W, DM, lane), u = wdot(XB + (size_t)row * DM, W + (size_t)128 * DM, DM, lane);
        if (!okf(bf2f(((const bf16*)(ws + WS_HID))[(size_t)row * FF + hc]), silu_ref(g) * u, 0.02f, 0.01f)) CHK_FAIL(6);
#endif
    } else if (stage == 8) {
        const int row = hash32(s) % NTOK, col = hash32(s + 1) % B_IN;
        const float ref = wdot(XB + (size_t)row * DM, (const bf16*)(ws + WS_W_B_IN) + (size_t)col * DM, DM, lane);
        if (!okf(bf2f(((const bf16*)(ws + WS_H1))[(size_t)row * B_IN + col]), ref, 0.02f, 0.02f)) CHK_FAIL(9);
    } else if (stage == 9) {
        const int tok = (s & 3) == 0 ? ((hash32(s) % (NTOK / 256)) * 256 + (hash32(s + 5) & 1 ? 255 : 0)) : hash32(s) % NTOK; const int b = tok / SEQ, pos = tok % SEQ, h = hash32(s + 1) % 6, m = hash32(s + 2) & 1, half = hash32(s + 3) & 1;
        const bf16* H1 = (const bf16*)(ws + WS_H1); const bf16* q = H1 + (size_t)tok * B_IN + 3072 + (m * 6 + h) * 128; const bf16* Kb = H1 + (size_t)b * SEQ * B_IN + (m * 6 + h) * 128; const bf16* Vb = H1 + (size_t)b * SEQ * B_IN + 1536 + h * 256 + half * 128;
        float mx = -3e38f; for (int j = lane; j <= pos; j += 64) { float sc = 0.f; for (int d = 0; d < 128; ++d) sc += bf2f(q[d]) * bf2f(Kb[(size_t)j * B_IN + d]); sc *= 0.08838834764831845f; pl[j] = sc; mx = fmaxf(mx, sc); }
        for (int o = 1; o < 64; o <<= 1) mx = fmaxf(mx, __shfl_xor(mx, o));
        float sum = 0.f; for (int j = lane; j <= pos; j += 64) { const float p = expf(pl[j] - mx); pl[j] = p; sum += p; } sum = wave_sum(sum); __syncthreads();
        bool bad = false;
        for (int dd = 0; dd < 2; ++dd) { const int d = lane + 64 * dd; float o = 0.f; for (int j = 0; j <= pos; ++j) o += pl[j] * bf2f(Vb[(size_t)j * B_IN + d]); o /= sum;
            if (!okf(bf2f(((const bf16*)(ws + WS_AO))[(size_t)tok * 3072 + m * 1536 + h * 256 + half * 128 + d]), o, 0.03f, 0.004f)) bad = true; }
        if (__any(bad)) CHK_FAIL(10);
    } else if (stage == 10) {
        const int tok = hash32(s) % NTOK, h4 = hash32(s + 1) & 3, b = tok / SEQ; const bf16* H1 = (const bf16*)(ws + WS_H1);
        chk_memattn(a, 11, H1 + (size_t)tok * B_IN + 4608 + h4 * 128, (const bf16*)(ws + WS_MEMKV) + (size_t)b * 256 * 2048 + 1024 + h4 * 128, (const bf16*)(ws + WS_CONCAT1) + (size_t)tok * DM + 1536 + h4 * 128, pl, lane);
        const int h = hash32(s + 2) % 6; const bf16* AO = (const bf16*)(ws + WS_AO) + (size_t)tok * 3072;
        float s1 = 0.f, s2 = 0.f; for (int k = lane; k < 128; k += 64) { s1 += a.in[I_LQ1][k] * a.in[I_LK1][k]; s2 += a.in[I_LQ2][k] * a.in[I_LK2][k]; } s1 = wave_sum(s1); s2 = wave_sum(s2);
        const float lam = expf(s1) - expf(s2) + LAMBDA_INIT; float x[4], ss = 0.f;
        for (int i = 0; i < 4; ++i) { const int d = lane + 64 * i; x[i] = bf2f(AO[h * 256 + d]) - lam * bf2f(AO[1536 + h * 256 + d]); ss += x[i] * x[i]; } ss = wave_sum(ss);
        bool bad = false; for (int i = 0; i < 4; ++i) { const int d = lane + 64 * i; const float ref = x[i] / sqrtf(ss / 256.f + LN_EPS) * a.in[I_SUBLN][d] * (1.0f - LAMBDA_INIT);
            if (!okf(bf2f(((const bf16*)(ws + WS_CONCAT1))[(size_t)tok * DM + h * 256 + d]), ref, 0.02f, 0.01f)) bad = true; }
        if (__any(bad)) CHK_FAIL(12);
    }
    if (stage == 13 || stage == 14 || stage == 15) {
        const int tok = hash32(s) % NTOK, k = hash32(s + 1) & 1; const int slot = ((const int*)(ws + WS_TOKSLOT))[2 * tok + k]; const int* tab = (const int*)(ws + WS_MOETAB);
        const int e = (((const int*)(ws + WS_ROUTE_E))[tok] >> (8 * k)) & 0xff; const float gate = ((const float*)(ws + WS_ROUTE_W))[2 * tok + k];
        if (stage == 13) {
            bool bad = slot < 0 || slot >= MAXT * 256;
            if (!bad) { const int tile = slot >> 8; int te = 0; for (int j = 1; j < 8; ++j) te += tile >= tab[j]; bad = te != e || tile >= tab[8] || ((const int*)(ws + WS_SLOTTOK))[slot] != tok || ((const float*)(ws + WS_SLOTGATE))[slot] != gate;

#if MK_FP8_MOE
                for (int j = lane; j < DM; j += 64) if (((const unsigned char*)(ws + WS_XS))[(size_t)slot * DM + j] != ((const unsigned char*)(ws + WS_X3B))[(size_t)tok * DM + j]) bad = true; }
#else
                for (int j = lane; j < DM; j += 64) if (((const bf16*)(ws + WS_XS))[(size_t)slot * DM + j] != ((const bf16*)(ws + WS_X3B))[(size_t)tok * DM + j]) bad = true; }
#endif
            if (__any(bad)) CHK_FAIL(16);
        } else { const int loc = slot - chunk * MOE_CHUNK_T * 256;
            if (loc >= 0 && loc < MOE_CHUNK_T * 256) {
#if MK_FP8_MOE
                if (stage == 14) { const int hc = hash32(s + 2) % FFE; const unsigned char* W = ws + WS_W_MOE_GU + ((size_t)e * 2 * FFE + (hc >> 7) * 256 + (hc & 127)) * DM; const unsigned char* x = ws + WS_XS + (size_t)slot * DM;
                    const float g = wdot8(x, W, DM, lane) / W8_G_MUL, u = wdot8(x, W + (size_t)128 * DM, DM, lane) / W8_U_MUL;
                    if (!okf(f8f((ws + WS_HIDM)[(size_t)loc * FFE + hc]) / H8_MUL, silu_ref(g) * u, 0.08f, 0.004f)) CHK_FAIL(17);
                } else { const int col = hash32(s + 2) % DM; const float ref = gate * wdot8(ws + WS_HIDM + (size_t)loc * FFE, ws + WS_W_MOE_D + ((size_t)e * DM + col) * FFE, FFE, lane) / (H8_MUL * W8_D_MUL);
                    const int T = tab[8]; int Lt = T & 31; if (Lt > 8) Lt = 0; const int Tm = T - Lt, tile = slot >> 8; float got;
                    if (tile >= Tm) { got = 0.f; for (int q = 0; q < 4; ++q) got += bf2f(((const bf16*)(ws + WS_OSK))[((size_t)(q * 8 + tile - Tm) * 256 + (slot & 255)) * DM + col]); }
                    else got = bf2f(((const bf16*)(ws + WS_OS))[(size_t)slot * DM + col]);
                    if (!okf(got, ref, 0.02f, 0.004f)) CHK_FAIL(18); } } }
#else
                if (stage == 14) { const int hc = hash32(s + 2) % FFE; const bf16* W = (const bf16*)(ws + WS_W_MOE_GU) + ((size_t)e * 2 * FFE + (hc >> 7) * 256 + (hc & 127)) * DM; const bf16* x = (const bf16*)(ws + WS_XS) + (size_t)slot * DM;
                    const float g = wdot(x, W, DM, lane), u = wdot(x, W + (size_t)128 * DM, DM, lane);
                    if (!okf(bf2f(((const bf16*)(ws + WS_HIDM))[(size_t)loc * FFE + hc]), silu_ref(g) * u, 0.02f, 0.01f)) CHK_FAIL(17);
                } else { const int col = hash32(s + 2) % DM; const float ref = gate * wdot((const bf16*)(ws + WS_HIDM) + (size_t)loc * FFE, (const bf16*)(ws + WS_W_MOE_D) + ((size_t)e * DM + col) * FFE, FFE, lane);
                    if (!okf(bf2f(((const bf16*)(ws + WS_OS))[(size_t)slot * DM + col]), ref, 0.02f, 0.004f)) CHK_FAIL(18); } } }
#endif
    }
}
__global__ void fin_kernel(Args a, int complete) {
    const unsigned* c = (const unsigned*)(a.ws + WS_CTL) + CW_CHK; int first = -1; for (int i = 0; i < 32; ++i) if (c[i] && first < 0) first = i;
    const unsigned* ctl = (const unsigned*)(a.ws + WS_CTL); if (first < 0 && (ctl[CW_TMO] || ctl[CW_BAR + XB_TMO])) first = 30;
    if (first < 0 && complete) return;
    const float v = sqrtf(first < 0 ? 76.0f : 10.0f + first);
    for (size_t i = (size_t)blockIdx.x * blockDim.x + threadIdx.x; i < (size_t)NTOK * DM; i += (size_t)gridDim.x * blockDim.x) a.out[i] = v;
}
#endif

extern "C" void kernel_launch(void* const* d_in, const int* in_sizes, int n_in, void* d_out, int out_size, void* d_ws, size_t ws_size, hipStream_t stream) {
    static int grid = 0;
    if (grid == 0) {
        if (n_in != 25 || in_sizes[0] != NTOK * DM || out_size != NTOK * DM || ws_size < WS_END) { fprintf(stderr, "kernel_launch: unexpected shapes (n_in %d, in0 %d, out %d, ws %zu < %zu); nothing launched\n", n_in, n_in > 0 ? in_sizes[0] : -1, out_size, ws_size, (size_t)WS_END); grid = -1; return; }
        int dev = 0, cus = 0, per_cu = 0;
        if (hipGetDevice(&dev) != hipSuccess || hipDeviceGetAttribute(&cus, hipDeviceAttributeMultiprocessorCount, dev) != hipSuccess) { grid = -1; return; }
        if (hipFuncSetAttribute((const void*)mk_fwd, hipFuncAttributeMaxDynamicSharedMemorySize, LDS_BYTES) != hipSuccess) { fprintf(stderr, "kernel_launch: hipFuncSetAttribute failed\n"); grid = -1; return; }
        if (hipOccupancyMaxActiveBlocksPerMultiprocessor(&per_cu, (const void*)mk_fwd, NWAVES * 64, LDS_BYTES) != hipSuccess || per_cu < 1) fprintf(stderr, "kernel_launch: occupancy query reports %d\n", per_cu);
        (void)hipGetLastError();
        grid = cus;
    }
    if (grid < 0) return;
    if (hipMemsetAsync((char*)d_ws + WS_CTL, 0, CTL_ZERO_BYTES, stream) != hipSuccess) return;
    Args a{};
    for (int i = 0; i < 25; ++i) a.in[i] = (const float*)d_in[i];
    a.out = (float*)d_out; a.ws = (unsigned char*)d_ws;
#if MK_DEBUG
    const int last = MK_LAST_PHASE;
    auto run = [&](int ph, int ch) { a.ph_lo = ph; a.ph_hi = ph + 1; a.ch_lo = ch; a.ch_hi = ch + 1; hipLaunchKernelGGL(mk_fwd, dim3(grid), dim3(NWAVES * 64), LDS_BYTES, stream, a); };
    auto chk = [&](int stage, int ch) { hipLaunchKernelGGL(chk_kernel, dim3(1024), dim3(64), 0, stream, a, stage, ch); };
    for (int ph = 0; ph <= last && ph <= 13; ++ph) { run(ph, 0); chk(ph, 0); }
    if (last >= 14) for (int ch = 0; ch < (MAXT + MOE_CHUNK_T - 1) / MOE_CHUNK_T; ++ch) { run(14, ch); chk(14, ch); if (last >= 15) { run(15, ch); chk(15, ch); } }
    if (last >= 16) run(16, 0);
    hipLaunchKernelGGL(fin_kernel, dim3(1024), dim3(256), 0, stream, a, last >= 16 ? 1 : 0);
#else
    a.ph_lo = 0; a.ph_hi = 17; a.ch_lo = 0; a.ch_hi = (MAXT + MOE_CHUNK_T - 1) / MOE_CHUNK_T;
    hipLaunchKernelGGL(mk_fwd, dim3(grid), dim3(NWAVES * 64), LDS_BYTES, stream, a);
#endif
}
```
